# Optimizing an MI355X kernel written in HIP

```python
import math
import jax, jax.numpy as jnp
from jax import lax
import numpy as np

D_MODEL = 1024
BATCH = 4
SEQ = 4096
DEPTH = 1

RET_HEADS = 8
RET_QK_DIM = 64
RET_V_DIM = 128
RET_CHUNK = 128
ROPE_BASE = 10000.0

MOBA_HEADS = 8
MOBA_HEAD_DIM = 64
MOBA_BLOCK = 256
MOBA_TOPK = 3
MOBA_Q_CHUNK = 32

REL_BUCKETS = 32
REL_MAX_DIST = 2048

PEER_HEADS = 8
PEER_N_KEYS = 128
PEER_N_EXPERTS = PEER_N_KEYS * PEER_N_KEYS
PEER_QUERY_DIM = 256
PEER_TOPK = 16
PEER_TOKEN_CHUNK = 128

NORM_EPS = 1e-6
NEG_INF = -1e30

RET_QK_W = RET_HEADS * RET_QK_DIM
RET_V_W = RET_HEADS * RET_V_DIM
MOBA_W = MOBA_HEADS * MOBA_HEAD_DIM
IN_SIZES = (RET_QK_W, RET_QK_W, RET_V_W, RET_V_W, MOBA_W, MOBA_W, MOBA_W, D_MODEL, D_MODEL)
IN_WIDTH = sum(IN_SIZES)

kernel_name = "hybrid_retention_moba_peer_layer"


def rmsnorm(x, g):
    xf = x.astype(jnp.float32)
    y = xf * lax.rsqrt(jnp.mean(xf * xf, axis=-1, keepdims=True) + NORM_EPS)
    return (y * g.astype(jnp.float32)).astype(x.dtype)


def to_heads(t, n_heads):
    b, s, _ = t.shape
    return t.reshape(b, s, n_heads, -1).transpose(0, 2, 1, 3)


def from_heads(t):
    b, h, s, d = t.shape
    return t.transpose(0, 2, 1, 3).reshape(b, s, h * d)


def rotary(x, pos):
    half = x.shape[-1] // 2
    inv = ROPE_BASE ** (-jnp.arange(half, dtype=jnp.float32) / half)
    ang = pos.astype(jnp.float32)[:, None] * inv[None, :]
    cos, sin = jnp.cos(ang), jnp.sin(ang)
    x1, x2 = x[..., :half], x[..., half:]
    return jnp.concatenate([x1 * cos - x2 * sin, x1 * sin + x2 * cos], axis=-1).astype(x.dtype)


def retention(q, k, v):
    B, H, S, dk = q.shape
    dv = v.shape[-1]
    C = RET_CHUNK
    n = S // C
    log_g = jnp.log1p(-jnp.exp2(-5.0 - jnp.arange(H, dtype=jnp.float32)))
    idx = jnp.arange(C, dtype=jnp.float32)
    rel = idx[:, None] - idx[None, :]
    decay_in = jnp.where(rel[None] >= 0, jnp.exp(jnp.maximum(rel, 0.0)[None] * log_g[:, None, None]), 0.0)
    qc = q.reshape(B, H, n, C, dk)
    kc = k.reshape(B, H, n, C, dk)
    vc = v.reshape(B, H, n, C, dv)
    scores = jnp.einsum('bhnid,bhnjd->bhnij', qc, kc) * decay_in[None, :, None]
    o_in = jnp.einsum('bhnij,bhnje->bhnie', scores, vc)
    k_dec = kc * jnp.exp((C - 1 - idx)[None, :] * log_g[:, None])[None, :, None, :, None]
    kv = jnp.einsum('bhncd,bhnce->bhnde', k_dec, vc)
    chunk_decay = jnp.exp(C * log_g)[None, :, None, None]

    def step(state, kv_n):
        return state * chunk_decay + kv_n, state

    state0 = jnp.zeros((B, H, dk, dv), kv.dtype)
    _, prev = lax.scan(step, state0, jnp.moveaxis(kv, 2, 0))
    prev = jnp.moveaxis(prev, 0, 2)
    q_dec = jnp.exp((idx + 1.0)[None, :] * log_g[:, None])
    o_cross = jnp.einsum('bhncd,bhnde->bhnce', qc, prev) * q_dec[None, :, None, :, None]
    o = (o_in + o_cross).reshape(B, H, S, dv).astype(jnp.float32)
    mu = jnp.mean(o, axis=-1, keepdims=True)
    var = jnp.mean(jnp.square(o - mu), axis=-1, keepdims=True)
    return ((o - mu) * lax.rsqrt(var + NORM_EPS)).astype(q.dtype)


def head_rmsnorm(t, g):
    tf = t.astype(jnp.float32)
    y = tf * lax.rsqrt(jnp.mean(tf * tf, axis=-1, keepdims=True) + NORM_EPS)
    return (y * g.astype(jnp.float32)).astype(t.dtype)


def rel_bucket(dist):
    max_exact = REL_BUCKETS // 2
    n = jnp.maximum(dist, 0)
    nf = jnp.maximum(n, 1).astype(jnp.float32)
    large = max_exact + (jnp.log(nf / max_exact) / math.log(REL_MAX_DIST / max_exact)
                         * (REL_BUCKETS - max_exact)).astype(jnp.int32)
    large = jnp.minimum(large, REL_BUCKETS - 1)
    return jnp.where(n < max_exact, n, large)


def moba_attention(q, k, v, rel_bias):
    B, H, S, dh = q.shape
    L = MOBA_BLOCK
    n_blk = -(-S // L)
    s_pad = n_blk * L
    pad = ((0, 0), (0, 0), (0, s_pad - S), (0, 0))
    k_pad = jnp.pad(k, pad)
    v_pad = jnp.pad(v, pad)
    k_blocks = k_pad.reshape(B, H, n_blk, L, dh)
    v_blocks = v_pad.reshape(B, H, n_blk, L, dh)
    k_mean = jnp.mean(k_blocks.astype(jnp.float32), axis=3)
    n_sel = min(MOBA_TOPK, n_blk)
    Qc = MOBA_Q_CHUNK
    n_qc = S // Qc
    q_chunks = jnp.moveaxis(q.reshape(B, H, n_qc, Qc, dh), 2, 0)
    bias_hb = rel_bias.T.astype(jnp.float32)
    b_idx = jnp.arange(B)[:, None, None, None]
    h_idx = jnp.arange(H)[None, :, None, None]
    h_idx5 = jnp.arange(H)[None, :, None, None, None]
    offs = jnp.arange(L)
    blk_ids = jnp.arange(n_blk)

    def one_chunk(args):
        qc, c = args
        q_start = c * Qc
        blk = q_start // L
        qpos = q_start + jnp.arange(Qc)
        gate = jnp.einsum('bhqd,bhnd->bhqn', qc.astype(jnp.float32), k_mean)
        gate = jnp.where(blk_ids < blk, gate, NEG_INF)
        _, sel = lax.top_k(gate, n_sel)
        valid = sel < blk
        k_sel = k_blocks[b_idx, h_idx, sel]
        v_sel = v_blocks[b_idx, h_idx, sel]
        kpos_sel = sel[..., None] * L + offs
        bias_sel = bias_hb[h_idx5, rel_bucket(qpos[None, None, :, None, None] - kpos_sel)]
        logit_sel = jnp.einsum('bhqd,bhqnkd->bhqnk', qc, k_sel).astype(jnp.float32) + bias_sel
        logit_sel = jnp.where(valid[..., None], logit_sel, NEG_INF).reshape(B, H, Qc, n_sel * L)
        k_own = lax.dynamic_slice_in_dim(k_pad, blk * L, L, axis=2)
        v_own = lax.dynamic_slice_in_dim(v_pad, blk * L, L, axis=2)
        dist_own = qpos[:, None] - (blk * L + offs)[None, :]
        bias_own = bias_hb[:, rel_bucket(dist_own)]
        logit_own = jnp.einsum('bhqd,bhkd->bhqk', qc, k_own).astype(jnp.float32) + bias_own[None]
        logit_own = jnp.where(dist_own >= 0, logit_own, NEG_INF)
        p = jax.nn.softmax(jnp.concatenate([logit_sel, logit_own], axis=-1), axis=-1)
        p_sel = p[..., :n_sel * L].reshape(B, H, Qc, n_sel, L).astype(v.dtype)
        p_own = p[..., n_sel * L:].astype(v.dtype)
        return (jnp.einsum('bhqnk,bhqnkd->bhqd', p_sel, v_sel)
                + jnp.einsum('bhqk,bhkd->bhqd', p_own, v_own))

    out = lax.map(one_chunk, (q_chunks, jnp.arange(n_qc)))
    return jnp.moveaxis(out, 0, 2).reshape(B, H, S, dh)


def peer(h, w_q, sub_keys, u_tab, v_tab):
    B, S, D = h.shape
    T = B * S
    ht = h.reshape(T, D)
    half = PEER_QUERY_DIM // 2
    q = (ht @ w_q).reshape(T, PEER_HEADS, 2, half)
    s = jnp.einsum('thcd,hcnd->thcn', q, sub_keys).astype(jnp.float32)
    s1, i1 = lax.top_k(s[:, :, 0], PEER_TOPK)
    s2, i2 = lax.top_k(s[:, :, 1], PEER_TOPK)
    cand_s = (s1[..., :, None] + s2[..., None, :]).reshape(T, PEER_HEADS, PEER_TOPK * PEER_TOPK)
    cand_i = (i1[..., :, None] * PEER_N_KEYS + i2[..., None, :]).reshape(T, PEER_HEADS, PEER_TOPK * PEER_TOPK)
    top_s, pos = lax.top_k(cand_s, PEER_TOPK)
    experts = jnp.take_along_axis(cand_i, pos, axis=-1)
    gates = jax.nn.softmax(top_s, axis=-1).astype(h.dtype)
    Pc = PEER_TOKEN_CHUNK
    n_c = T // Pc

    def one_chunk(args):
        hc, ec, gc = args
        u = u_tab[ec]
        a = jax.nn.gelu(jnp.einsum('td,thkd->thk', hc, u), approximate=False)
        return jnp.einsum('thk,thkd->td', gc * a, v_tab[ec])

    out = lax.map(one_chunk, (ht.reshape(n_c, Pc, D),
                              experts.reshape(n_c, Pc, PEER_HEADS, PEER_TOPK),
                              gates.reshape(n_c, Pc, PEER_HEADS, PEER_TOPK)))
    return out.reshape(B, S, D)


def setup_inputs(seed: int = 0) -> dict:
    key = jax.random.key(seed)
    ks = jax.random.split(key, 14)
    f32 = jnp.float32
    nrm = lambda k, shape, scale: jax.random.normal(k, shape, f32) * scale
    return {
        "x": nrm(ks[0], (BATCH, SEQ, D_MODEL), 1.0),
        "mix_norm_g": 1.0 + nrm(ks[1], (DEPTH, D_MODEL), 0.1),
        "w_in": nrm(ks[2], (DEPTH, D_MODEL, IN_WIDTH), D_MODEL ** -0.5),
        "ret_w_branch": nrm(ks[3], (DEPTH, RET_V_W, D_MODEL), RET_V_W ** -0.5),
        "moba_q_gain": 1.0 + nrm(ks[4], (DEPTH, MOBA_HEAD_DIM), 0.1),
        "moba_k_gain": 1.0 + nrm(ks[5], (DEPTH, MOBA_HEAD_DIM), 0.1),
        "moba_w_branch": nrm(ks[6], (DEPTH, MOBA_W, D_MODEL), MOBA_W ** -0.5),
        "rel_bias": nrm(ks[7], (REL_BUCKETS, MOBA_HEADS), 0.5),
        "w_out": nrm(ks[8], (DEPTH, D_MODEL, D_MODEL), D_MODEL ** -0.5),
        "ffn_norm_g": 1.0 + nrm(ks[9], (DEPTH, D_MODEL), 0.1),
        "peer_w_q": nrm(ks[10], (DEPTH, D_MODEL, PEER_HEADS * PEER_QUERY_DIM), D_MODEL ** -0.5),
        "peer_sub_keys": nrm(ks[11], (DEPTH, PEER_HEADS, 2, PEER_N_KEYS, PEER_QUERY_DIM // 2), (PEER_QUERY_DIM // 2) ** -0.5),
        "peer_u": nrm(ks[12], (DEPTH, PEER_N_EXPERTS, D_MODEL), D_MODEL ** -0.5),
        "peer_v": nrm(ks[13], (DEPTH, PEER_N_EXPERTS, D_MODEL), D_MODEL ** -0.5),
    }


def reference(x, mix_norm_g, w_in, ret_w_branch, moba_q_gain, moba_k_gain, moba_w_branch,
              rel_bias, w_out, ffn_norm_g, peer_w_q, peer_sub_keys, peer_u, peer_v):
    B, S, D = x.shape
    pos = jnp.arange(S)
    offsets = tuple(int(o) for o in np.cumsum(IN_SIZES)[:-1])
    for l in range(DEPTH):
        h = rmsnorm(x, mix_norm_g[l])
        proj = h @ w_in[l]
        rq, rk, rv, rg, mq, mk, mv, ga, gb = jnp.split(proj, offsets, axis=-1)
        rq = rotary(to_heads(rq, RET_HEADS), pos)
        rk = rotary(to_heads(rk, RET_HEADS), pos) * (RET_QK_DIM ** -0.5)
        ret = retention(rq, rk, to_heads(rv, RET_HEADS))
        y_a = (from_heads(ret) * jax.nn.silu(rg)) @ ret_w_branch[l]
        mq = head_rmsnorm(to_heads(mq, MOBA_HEADS), moba_q_gain[l]) * (MOBA_HEAD_DIM ** -0.5)
        mk = head_rmsnorm(to_heads(mk, MOBA_HEADS), moba_k_gain[l])
        att = moba_attention(mq, mk, to_heads(mv, MOBA_HEADS), rel_bias)
        y_b = from_heads(att) @ moba_w_branch[l]
        merged = jax.nn.sigmoid(ga) * y_a + jax.nn.sigmoid(gb) * y_b
        x = x + merged @ w_out[l]
        h2 = rmsnorm(x, ffn_norm_g[l])
        x = x + peer(h2, peer_w_q[l], peer_sub_keys[l], peer_u[l], peer_v[l])
    return x
```

```cpp
#include <hip/hip_runtime.h>
#include <cstdio>
#include <cstdint>

#define GAS __attribute__((address_space(1)))
#define LAS __attribute__((address_space(3)))
typedef unsigned short bf16;
typedef unsigned v4u __attribute__((ext_vector_type(4)));
typedef unsigned v2u __attribute__((ext_vector_type(2)));
typedef float f32x4 __attribute__((ext_vector_type(4)));
typedef short bf16x8 __attribute__((ext_vector_type(8)));
typedef float f32x16 __attribute__((ext_vector_type(16)));
typedef GAS unsigned gu32;
#define RLX_AGENT __ATOMIC_RELAXED, __HIP_MEMORY_SCOPE_AGENT
#define LDS_WAIT() asm volatile("s_waitcnt lgkmcnt(0)" ::: "memory")
#define VM_WAIT() asm volatile("s_waitcnt vmcnt(0)" ::: "memory")

constexpr int BATCH = 4, SEQ = 4096, DM = 1024, T = BATCH * SEQ;
constexpr int RH = 8, RDK = 64, RDV = 128, RC = 128, NCH = SEQ / RC;
constexpr int MH = 8, MD = 64, MBLK = 256, NBLK = SEQ / MBLK;
constexpr int PH = 8, PNK = 128, PTOP = 16, PQD = 256;
constexpr int NEXP = PNK * PNK;
constexpr int INW = 6656;
constexpr float EPS = 1e-6f;

__device__ __forceinline__ unsigned f2bf(float f) { unsigned u = __builtin_bit_cast(unsigned, f); return (u + 0x7fffu + ((u >> 16) & 1u)) >> 16; }
typedef float f32x2_t __attribute__((ext_vector_type(2))); typedef __bf16 bf16x2_t __attribute__((ext_vector_type(2)));
__device__ __forceinline__ unsigned pk2(float lo, float hi) { const f32x2_t v = {lo, hi}; const bf16x2_t b = __builtin_convertvector(v, bf16x2_t); return __builtin_bit_cast(unsigned, b); }
__device__ __forceinline__ float bf2f(unsigned short b) { return __builtin_bit_cast(float, (unsigned)b << 16); }
__device__ __forceinline__ float bflo(unsigned w) { return __builtin_bit_cast(float, w << 16); }
__device__ __forceinline__ float bfhi(unsigned w) { return __builtin_bit_cast(float, w & 0xffff0000u); }
__device__ __forceinline__ float wave_sum(float v) {
#pragma unroll
    for (int o = 1; o < 64; o <<= 1) v += __shfl_xor(v, o);
    return v;
}
__device__ __forceinline__ float dpp_sum8(float v) {
    v += __builtin_bit_cast(float, __builtin_amdgcn_mov_dpp(__builtin_bit_cast(int, v), 0xB1, 0xF, 0xF, true));
    v += __builtin_bit_cast(float, __builtin_amdgcn_mov_dpp(__builtin_bit_cast(int, v), 0x4E, 0xF, 0xF, true));
    v += __builtin_bit_cast(float, __builtin_amdgcn_mov_dpp(__builtin_bit_cast(int, v), 0x141, 0xF, 0xF, true));
    return v;
}
__device__ __forceinline__ float ret_l2g(int h) { return log1pf(-exp2f(-5.0f - (float)h)) * 1.4426950408889634f; }

__host__ __device__ __forceinline__ int perm_row_of_col(int a) {
    const int tile = a >> 8, w = a & 255, wc = w >> 6, bj = (w >> 5) & 1, q = w & 31, fq = q >> 3, n = (q >> 2) & 1, e = q & 3;
    return tile * 256 + 128 * bj + 32 * wc + 16 * n + 4 * fq + e;
}
namespace pg8 {
#define PG8_LAS __attribute__((address_space(3)))
typedef unsigned short bf16_t;
typedef short bf16x8 __attribute__((ext_vector_type(8)));
typedef float f32x4 __attribute__((ext_vector_type(4)));
typedef unsigned u32x4 __attribute__((ext_vector_type(4)));
constexpr int BM = 256, BK = 64, HALF = 128, HTB = HALF * BK * 2  , STAGE_BYTES = 8 * HTB, NXCD = 8, WGM = 8;

__host__ __device__ __forceinline__ int lds_byte(int r, int c) { const int st = (r >> 4) * 2 + (c >> 5), rr = r & 15, cc = c & 31, ob = rr * 64 + cc * 2; return st * 1024 + (ob ^ (((ob >> 9) & 1) << 5)); }
__host__ __device__ __forceinline__ void stage_rc(int b, int& R, int& C) { const int st = b / 1024, sb = b % 1024, swz = sb ^ (((sb >> 9) & 1) << 5); R = (st >> 1) * 16 + swz / 64; C = (st & 1) * 32 + (swz % 64) / 2; }
__host__ __device__ __forceinline__ int perm32(int rho) { const int n = rho >> 4, i = rho & 15; return 8 * (i >> 2) + 4 * n + (i & 3); }

struct Unit { int pm, pn, seg; };
struct Gemm { const bf16_t* A; const bf16_t* Bt; int M, N, K, lda, ldb, bpm; };

struct StaticOrder {
    int nM, nN, nwg, G, c;
    __host__ __device__ void init(int M, int N, int G_, int c_) { nM = M / BM; nN = N / BM; nwg = nM * nN; G = G_; c = c_; }
    __host__ __device__ bool next(int i, Unit& u) const {
        const long L = (long)i * G + c; if (L >= nwg) return false;
        int wgid = (int)L; { const int q = nwg / NXCD, r = nwg % NXCD, xcd = wgid % NXCD, off = wgid / NXCD; wgid = (xcd < r ? xcd * (q + 1) : r * (q + 1) + (xcd - r) * q) + off; }
        const int nig = WGM * nN, gid = wgid / nig, fm = gid * WGM, gsz = (nM - fm) < WGM ? (nM - fm) : WGM;
        u.pm = fm + ((wgid % nig) % gsz); u.pn = (wgid % nig) / gsz; u.seg = 0; return true;
    }
    __device__ __forceinline__ void a_ready(const Unit&) const {}
    __device__ __forceinline__ void done(const Unit&) const {}
};


template <class Epi, class Sched, bool ALIGN_EPI = false, bool SP2 = false>
__device__ __forceinline__ void gemm_phase(PG8_LAS unsigned char* lds, const Gemm g, const Sched& S, const Epi& E) {
    int tid_ = threadIdx.x; asm volatile("" : "+v"(tid_));
    const int tid = tid_, wid = __builtin_amdgcn_readfirstlane(tid >> 6), lane = tid & 63, wr = wid >> 2, wc = wid & 3, fr = lane & 15, fq = lane >> 4;
    const int K = g.K, nt = K / BK;
    unsigned voffA[2], voffB[2];
#pragma unroll
    for (int i = 0; i < 2; ++i) { int R, C; stage_rc(tid * 16 + i * 8192, R, C);
        voffA[i] = (unsigned)(R * g.lda + C) * 2u; voffB[i] = (unsigned)(R * g.ldb + C) * 2u; }
    const size_t kstep = (size_t)(BK * 2);
    const size_t hstepA = (size_t)HALF * g.lda * 2, hstepB = (size_t)HALF * g.ldb * 2;
    const size_t tstepA = 2 * hstepA, tstepB = 2 * hstepB;
    const unsigned ldsw = (unsigned)wid * 1024u;
    const int aoff = lds_byte(wr * 64 + fr, fq * 8), boff = lds_byte(wc * 32 + fr, fq * 8);
#define PG8_SA(b, h) (((b) * 2 + (h)) * HTB)
#define PG8_SB(b, h) ((4 + (b) * 2 + (h)) * HTB)
#define PG8_STAGE(bufoff, gbase, voff) do { _Pragma("unroll") for (int _i = 0; _i < 2; ++_i) \
        __builtin_amdgcn_global_load_lds((const unsigned*)((const char*)(gbase) + (voff)[_i]), (PG8_LAS unsigned*)(lds + (bufoff) + ldsw + _i * 8192), 16, 0, 0); } while (0)
#define PG8_LDA(dst, b, h) do { _Pragma("unroll") for (int m = 0; m < 4; ++m) _Pragma("unroll") for (int k = 0; k < 2; ++k) dst[m][k] = *(const PG8_LAS bf16x8*)(lds + PG8_SA(b, h) + aoff + m * 2048 + k * 1024); } while (0)
#define PG8_LDB(dst, b, h) do { _Pragma("unroll") for (int n = 0; n < 2; ++n) _Pragma("unroll") for (int k = 0; k < 2; ++k) dst[n][k] = *(const PG8_LAS bf16x8*)(lds + PG8_SB(b, h) + boff + n * 2048 + k * 1024); } while (0)
#define PG8_MMA(ai, bj, At, Bt) do { __builtin_amdgcn_s_setprio(1); _Pragma("unroll") for (int m = 0; m < 4; ++m) _Pragma("unroll") for (int n = 0; n < 2; ++n) _Pragma("unroll") for (int k = 0; k < 2; ++k) \
        acc[ai][bj][m][n] = __builtin_amdgcn_mfma_f32_16x16x32_bf16(Bt[n][k], At[m][k], acc[ai][bj][m][n], 0, 0, 0); __builtin_amdgcn_s_setprio(0); } while (0)
#define PG8_WAIT_V(n) asm volatile("s_waitcnt vmcnt(" #n ")" ::: "memory")
#define PG8_WAIT_L(n) asm volatile("s_waitcnt lgkmcnt(" #n ")" ::: "memory")
#define PG8_BAR __builtin_amdgcn_s_barrier()
#define PG8_SCHED __builtin_amdgcn_sched_barrier(0)
    Unit cur, nxt; int ui = 0;
    if (!S.next(0, cur)) return;
    f32x4 acc[2][2][4][2];
#pragma unroll
    for (int a = 0; a < 2; ++a)
#pragma unroll
        for (int b = 0; b < 2; ++b)
#pragma unroll
            for (int m = 0; m < 4; ++m)
#pragma unroll
                for (int n = 0; n < 2; ++n) acc[a][b][m][n] = (f32x4){0.f, 0.f, 0.f, 0.f};
    bf16x8 At[4][2], B0[2][2], B1[2][2];
    const char* cA = (const char*)g.A + (size_t)cur.pm * tstepA; const char* cB = (const char*)g.Bt + (size_t)cur.pn * tstepB + (size_t)cur.pm * g.bpm;
    S.a_ready(cur);
    if constexpr (SP2) {
        PG8_STAGE(PG8_SB(0, 0), cB, voffB); PG8_STAGE(PG8_SB(0, 1), cB + hstepB, voffB); PG8_STAGE(PG8_SA(0, 0), cA, voffA); PG8_STAGE(PG8_SA(0, 1), cA + hstepA, voffA);
        if (wr == 1) PG8_BAR;
        PG8_WAIT_V(2); PG8_BAR;
        PG8_STAGE(PG8_SB(1, 0), cB + kstep, voffB); PG8_STAGE(PG8_SA(1, 0), cA + kstep, voffA); PG8_STAGE(PG8_SB(1, 1), cB + hstepB + kstep, voffB);
        PG8_WAIT_V(6); PG8_BAR;
    } else {
        PG8_STAGE(PG8_SB(0, 0), cB, voffB); PG8_STAGE(PG8_SA(0, 0), cA, voffA); PG8_STAGE(PG8_SB(0, 1), cB + hstepB, voffB); PG8_STAGE(PG8_SA(0, 1), cA + hstepA, voffA);
        if (wr == 1) PG8_BAR;
        PG8_WAIT_V(4); PG8_BAR;
        PG8_STAGE(PG8_SB(1, 0), cB + kstep, voffB); PG8_STAGE(PG8_SA(1, 0), cA + kstep, voffA); PG8_STAGE(PG8_SB(1, 1), cB + hstepB + kstep, voffB);
        PG8_WAIT_V(6); PG8_BAR;
    }
    for (;;) {
        const bool has_next = S.next(ui + 1, nxt);
        const char* nA = has_next ? (const char*)g.A + (size_t)nxt.pm * tstepA : cA; const char* nB = has_next ? (const char*)g.Bt + (size_t)nxt.pn * tstepB + (size_t)nxt.pm * g.bpm : cB;
        for (int t = 0; t < nt; t += 2) {
            const bool last = (t == nt - 2);
            const char* a1 = cA + (size_t)(t + 1) * kstep;
            const char* a2 = last ? nA : cA + (size_t)(t + 2) * kstep; const char* b2 = last ? nB : cB + (size_t)(t + 2) * kstep;
            const char* a3 = a2 + kstep; const char* b3 = b2 + kstep;
            if (last && has_next) S.a_ready(nxt);
            if constexpr (SP2) {
            PG8_LDB(B0, 0, 0); PG8_LDB(B1, 0, 1); PG8_SCHED; PG8_LDA(At, 0, 0); PG8_STAGE(PG8_SA(1, 1), a1 + hstepA, voffA);
            PG8_WAIT_V(8); PG8_WAIT_L(0); PG8_BAR; PG8_MMA(0, 0, At, B0); PG8_MMA(0, 1, At, B1); PG8_BAR; PG8_SCHED;
            PG8_LDA(At, 0, 1); PG8_STAGE(PG8_SB(0, 0), b2, voffB); PG8_STAGE(PG8_SB(0, 1), b2 + hstepB, voffB); PG8_STAGE(PG8_SA(0, 0), a2, voffA);
            PG8_WAIT_V(8); PG8_WAIT_L(0); PG8_BAR; PG8_MMA(1, 0, At, B0); PG8_MMA(1, 1, At, B1); PG8_BAR; PG8_SCHED;
            PG8_LDB(B0, 1, 0); PG8_LDB(B1, 1, 1); PG8_SCHED; PG8_LDA(At, 1, 0); PG8_STAGE(PG8_SA(0, 1), a2 + hstepA, voffA);
            PG8_WAIT_V(8); PG8_WAIT_L(0); PG8_BAR; PG8_MMA(0, 0, At, B0); PG8_MMA(0, 1, At, B1); PG8_BAR; PG8_SCHED;
            PG8_LDA(At, 1, 1); PG8_STAGE(PG8_SB(1, 0), b3, voffB); PG8_STAGE(PG8_SB(1, 1), b3 + hstepB, voffB); PG8_STAGE(PG8_SA(1, 0), a3, voffA);
            PG8_WAIT_V(8); PG8_WAIT_L(0); PG8_BAR; PG8_MMA(1, 0, At, B0); PG8_MMA(1, 1, At, B1); PG8_BAR; PG8_SCHED;
            } else {
            PG8_LDB(B0, 0, 0); PG8_SCHED; PG8_LDA(At, 0, 0); PG8_STAGE(PG8_SA(1, 1), a1 + hstepA, voffA);
            PG8_WAIT_L(8); PG8_BAR; PG8_WAIT_L(0); PG8_MMA(0, 0, At, B0); PG8_BAR; PG8_SCHED;
            PG8_LDB(B1, 0, 1); PG8_STAGE(PG8_SB(0, 0), b2, voffB);
            PG8_BAR; PG8_WAIT_L(0); PG8_MMA(0, 1, At, B1); PG8_BAR;
            PG8_LDA(At, 0, 1); PG8_STAGE(PG8_SA(0, 0), a2, voffA);
            PG8_BAR; PG8_WAIT_L(0); PG8_MMA(1, 0, At, B0); PG8_BAR; PG8_SCHED;
            PG8_STAGE(PG8_SB(0, 1), b2 + hstepB, voffB);
            PG8_WAIT_V(6); PG8_BAR; PG8_MMA(1, 1, At, B1); PG8_BAR;
            PG8_LDB(B0, 1, 0); PG8_SCHED; PG8_LDA(At, 1, 0); PG8_STAGE(PG8_SA(0, 1), a2 + hstepA, voffA);
            PG8_WAIT_L(8); PG8_BAR; PG8_WAIT_L(0); PG8_MMA(0, 0, At, B0); PG8_BAR; PG8_SCHED;
            PG8_LDB(B1, 1, 1); PG8_STAGE(PG8_SB(1, 0), b3, voffB);
            PG8_BAR; PG8_WAIT_L(0); PG8_MMA(0, 1, At, B1); PG8_BAR;
            PG8_LDA(At, 1, 1); PG8_STAGE(PG8_SA(1, 0), a3, voffA);
            PG8_BAR; PG8_WAIT_L(0); PG8_MMA(1, 0, At, B0); PG8_BAR; PG8_SCHED;
            PG8_STAGE(PG8_SB(1, 1), b3 + hstepB, voffB);
            PG8_WAIT_V(6); PG8_BAR; PG8_MMA(1, 1, At, B1); PG8_BAR;
            }
        }
        if constexpr (ALIGN_EPI) { if (wr == 0) PG8_BAR; }
        if constexpr (!Epi::AFTER_DRAIN) { E(acc, cur, wr, wc, fr, fq); S.done(cur); }
        if (!has_next) break;
#pragma unroll
        for (int a = 0; a < 2; ++a)
#pragma unroll
            for (int b = 0; b < 2; ++b)
#pragma unroll
                for (int m = 0; m < 4; ++m)
#pragma unroll
                    for (int n = 0; n < 2; ++n) acc[a][b][m][n] = (f32x4){0.f, 0.f, 0.f, 0.f};
        cur = nxt; cA = nA; cB = nB; ++ui;
        if constexpr (ALIGN_EPI) { if (wr == 1) PG8_BAR; }
    }
    PG8_WAIT_V(0);
    if constexpr (!ALIGN_EPI) { if (wr == 0) PG8_BAR; }
    PG8_BAR;
    if constexpr (Epi::AFTER_DRAIN) { E.fused(acc, cur, wr, wc, fr, fq, lds, wid, lane); S.done(cur); }
#undef PG8_SA
#undef PG8_SB
#undef PG8_STAGE
#undef PG8_LDA
#undef PG8_LDB
#undef PG8_MMA
#undef PG8_WAIT_V
#undef PG8_WAIT_L
#undef PG8_BAR
#undef PG8_SCHED
}
template <class Epi, class Sched, bool ALIGN_EPI = false, bool SP2 = false>
__device__ __forceinline__ void gemm_phase2(PG8_LAS unsigned char* lds, const Gemm g0, const Gemm g1, const Sched& S, const Epi& E) {
    int tid_ = threadIdx.x; asm volatile("" : "+v"(tid_));
    const int tid = tid_, wid = __builtin_amdgcn_readfirstlane(tid >> 6), lane = tid & 63, wr = wid >> 2, wc = wid & 3, fr = lane & 15, fq = lane >> 4;
    unsigned voffA0[2], voffB0[2], voffA1[2], voffB1[2];
#pragma unroll
    for (int i = 0; i < 2; ++i) { int R, C; stage_rc(tid * 16 + i * 8192, R, C);
        voffA0[i] = (unsigned)(R * g0.lda + C) * 2u; voffB0[i] = (unsigned)(R * g0.ldb + C) * 2u; voffA1[i] = (unsigned)(R * g1.lda + C) * 2u; voffB1[i] = (unsigned)(R * g1.ldb + C) * 2u; }
    const size_t kstep = (size_t)(BK * 2);
    const size_t hstepA0 = (size_t)HALF * g0.lda * 2, hstepB0 = (size_t)HALF * g0.ldb * 2, hstepA1 = (size_t)HALF * g1.lda * 2, hstepB1 = (size_t)HALF * g1.ldb * 2;
    const size_t tstepA0 = 2 * hstepA0, tstepB0 = 2 * hstepB0, tstepA1 = 2 * hstepA1, tstepB1 = 2 * hstepB1;
    const unsigned ldsw = (unsigned)wid * 1024u;
    const int aoff = lds_byte(wr * 64 + fr, fq * 8), boff = lds_byte(wc * 32 + fr, fq * 8);
#define PG8_SA(b, h) (((b) * 2 + (h)) * HTB)
#define PG8_SB(b, h) ((4 + (b) * 2 + (h)) * HTB)
#define PG8_STAGE(bufoff, gbase, voff) do { _Pragma("unroll") for (int _i = 0; _i < 2; ++_i) \
        __builtin_amdgcn_global_load_lds((const unsigned*)((const char*)(gbase) + (voff)[_i]), (PG8_LAS unsigned*)(lds + (bufoff) + ldsw + _i * 8192), 16, 0, 0); } while (0)
#define PG8_LDA(dst, b, h) do { _Pragma("unroll") for (int m = 0; m < 4; ++m) _Pragma("unroll") for (int k = 0; k < 2; ++k) dst[m][k] = *(const PG8_LAS bf16x8*)(lds + PG8_SA(b, h) + aoff + m * 2048 + k * 1024); } while (0)
#define PG8_LDB(dst, b, h) do { _Pragma("unroll") for (int n = 0; n < 2; ++n) _Pragma("unroll") for (int k = 0; k < 2; ++k) dst[n][k] = *(const PG8_LAS bf16x8*)(lds + PG8_SB(b, h) + boff + n * 2048 + k * 1024); } while (0)
#define PG8_MMA(ai, bj, At, Bt) do { __builtin_amdgcn_s_setprio(1); _Pragma("unroll") for (int m = 0; m < 4; ++m) _Pragma("unroll") for (int n = 0; n < 2; ++n) _Pragma("unroll") for (int k = 0; k < 2; ++k) \
        acc[ai][bj][m][n] = __builtin_amdgcn_mfma_f32_16x16x32_bf16(Bt[n][k], At[m][k], acc[ai][bj][m][n], 0, 0, 0); __builtin_amdgcn_s_setprio(0); } while (0)
#define PG8_WAIT_V(n) asm volatile("s_waitcnt vmcnt(" #n ")" ::: "memory")
#define PG8_WAIT_L(n) asm volatile("s_waitcnt lgkmcnt(" #n ")" ::: "memory")
#define PG8_BAR __builtin_amdgcn_s_barrier()
#define PG8_SCHED __builtin_amdgcn_sched_barrier(0)
    Unit cur, nxt; int ui = 0;
    if (!S.next(0, cur)) return;
    f32x4 acc[2][2][4][2];
#pragma unroll
    for (int a = 0; a < 2; ++a)
#pragma unroll
        for (int b = 0; b < 2; ++b)
#pragma unroll
            for (int m = 0; m < 4; ++m)
#pragma unroll
                for (int n = 0; n < 2; ++n) acc[a][b][m][n] = (f32x4){0.f, 0.f, 0.f, 0.f};
    bf16x8 At[4][2], B0[2][2], B1[2][2];
#define PG8_UA(u_) ((u_).seg ? (const char*)g1.A + (size_t)(u_).pm * tstepA1 : (const char*)g0.A + (size_t)(u_).pm * tstepA0)
#define PG8_UB(u_) ((u_).seg ? (const char*)g1.Bt + (size_t)(u_).pn * tstepB1 : (const char*)g0.Bt + (size_t)(u_).pn * tstepB0)
    const char* cA = PG8_UA(cur); const char* cB = PG8_UB(cur);
    size_t hAc = cur.seg ? hstepA1 : hstepA0, hBc = cur.seg ? hstepB1 : hstepB0; unsigned vAc[2], vBc[2];
#pragma unroll
    for (int i = 0; i < 2; ++i) { vAc[i] = cur.seg ? voffA1[i] : voffA0[i]; vBc[i] = cur.seg ? voffB1[i] : voffB0[i]; }
    int nt = (cur.seg ? g1.K : g0.K) / BK;
    S.a_ready(cur);
    if constexpr (SP2) {
        PG8_STAGE(PG8_SB(0, 0), cB, vBc); PG8_STAGE(PG8_SB(0, 1), cB + hBc, vBc); PG8_STAGE(PG8_SA(0, 0), cA, vAc); PG8_STAGE(PG8_SA(0, 1), cA + hAc, vAc);
        if (wr == 1) PG8_BAR;
        PG8_WAIT_V(2); PG8_BAR;
        PG8_STAGE(PG8_SB(1, 0), cB + kstep, vBc); PG8_STAGE(PG8_SA(1, 0), cA + kstep, vAc); PG8_STAGE(PG8_SB(1, 1), cB + hBc + kstep, vBc);
        PG8_WAIT_V(6); PG8_BAR;
    } else {
        PG8_STAGE(PG8_SB(0, 0), cB, vBc); PG8_STAGE(PG8_SA(0, 0), cA, vAc); PG8_STAGE(PG8_SB(0, 1), cB + hBc, vBc); PG8_STAGE(PG8_SA(0, 1), cA + hAc, vAc);
        if (wr == 1) PG8_BAR;
        PG8_WAIT_V(4); PG8_BAR;
        PG8_STAGE(PG8_SB(1, 0), cB + kstep, vBc); PG8_STAGE(PG8_SA(1, 0), cA + kstep, vAc); PG8_STAGE(PG8_SB(1, 1), cB + hBc + kstep, vBc);
        PG8_WAIT_V(6); PG8_BAR;
    }
    for (;;) {
        const bool has_next = S.next(ui + 1, nxt);
        const char* nA = has_next ? PG8_UA(nxt) : cA; const char* nB = has_next ? PG8_UB(nxt) : cB;
        const int sn = has_next ? nxt.seg : cur.seg; const size_t hAn = sn ? hstepA1 : hstepA0, hBn = sn ? hstepB1 : hstepB0; unsigned vAn[2], vBn[2];
#pragma unroll
        for (int i = 0; i < 2; ++i) { vAn[i] = sn ? voffA1[i] : voffA0[i]; vBn[i] = sn ? voffB1[i] : voffB0[i]; }
        for (int t = 0; t < nt; t += 2) {
            const bool last = (t == nt - 2);
            const size_t hA2 = last ? hAn : hAc, hB2 = last ? hBn : hBc; unsigned vA2[2], vB2[2];
#pragma unroll
            for (int i = 0; i < 2; ++i) { vA2[i] = last ? vAn[i] : vAc[i]; vB2[i] = last ? vBn[i] : vBc[i]; }
            const char* a1 = cA + (size_t)(t + 1) * kstep;
            const char* a2 = last ? nA : cA + (size_t)(t + 2) * kstep; const char* b2 = last ? nB : cB + (size_t)(t + 2) * kstep;
            const char* a3 = a2 + kstep; const char* b3 = b2 + kstep;
            if (last && has_next) S.a_ready(nxt);
            if constexpr (SP2) {
            PG8_LDB(B0, 0, 0); PG8_LDB(B1, 0, 1); PG8_SCHED; PG8_LDA(At, 0, 0); PG8_STAGE(PG8_SA(1, 1), a1 + hAc, vAc);
            PG8_WAIT_V(8); PG8_WAIT_L(0); PG8_BAR; PG8_MMA(0, 0, At, B0); PG8_MMA(0, 1, At, B1); PG8_BAR; PG8_SCHED;
            PG8_LDA(At, 0, 1); PG8_STAGE(PG8_SB(0, 0), b2, vB2); PG8_STAGE(PG8_SB(0, 1), b2 + hB2, vB2); PG8_STAGE(PG8_SA(0, 0), a2, vA2);
            PG8_WAIT_V(8); PG8_WAIT_L(0); PG8_BAR; PG8_MMA(1, 0, At, B0); PG8_MMA(1, 1, At, B1); PG8_BAR; PG8_SCHED;
            PG8_LDB(B0, 1, 0); PG8_LDB(B1, 1, 1); PG8_SCHED; PG8_LDA(At, 1, 0); PG8_STAGE(PG8_SA(0, 1), a2 + hA2, vA2);
            PG8_WAIT_V(8); PG8_WAIT_L(0); PG8_BAR; PG8_MMA(0, 0, At, B0); PG8_MMA(0, 1, At, B1); PG8_BAR; PG8_SCHED;
            PG8_LDA(At, 1, 1); PG8_STAGE(PG8_SB(1, 0), b3, vB2); PG8_STAGE(PG8_SB(1, 1), b3 + hB2, vB2); PG8_STAGE(PG8_SA(1, 0), a3, vA2);
            PG8_WAIT_V(8); PG8_WAIT_L(0); PG8_BAR; PG8_MMA(1, 0, At, B0); PG8_MMA(1, 1, At, B1); PG8_BAR; PG8_SCHED;
            } else {
            PG8_LDB(B0, 0, 0); PG8_SCHED; PG8_LDA(At, 0, 0); PG8_STAGE(PG8_SA(1, 1), a1 + hAc, vAc);
            PG8_WAIT_L(8); PG8_BAR; PG8_WAIT_L(0); PG8_MMA(0, 0, At, B0); PG8_BAR; PG8_SCHED;
            PG8_LDB(B1, 0, 1); PG8_STAGE(PG8_SB(0, 0), b2, vB2);
            PG8_BAR; PG8_WAIT_L(0); PG8_MMA(0, 1, At, B1); PG8_BAR;
            PG8_LDA(At, 0, 1); PG8_STAGE(PG8_SA(0, 0), a2, vA2);
            PG8_BAR; PG8_WAIT_L(0); PG8_MMA(1, 0, At, B0); PG8_BAR; PG8_SCHED;
            PG8_STAGE(PG8_SB(0, 1), b2 + hB2, vB2);
            PG8_WAIT_V(6); PG8_BAR; PG8_MMA(1, 1, At, B1); PG8_BAR;
            PG8_LDB(B0, 1, 0); PG8_SCHED; PG8_LDA(At, 1, 0); PG8_STAGE(PG8_SA(0, 1), a2 + hA2, vA2);
            PG8_WAIT_L(8); PG8_BAR; PG8_WAIT_L(0); PG8_MMA(0, 0, At, B0); PG8_BAR; PG8_SCHED;
            PG8_LDB(B1, 1, 1); PG8_STAGE(PG8_SB(1, 0), b3, vB2);
            PG8_BAR; PG8_WAIT_L(0); PG8_MMA(0, 1, At, B1); PG8_BAR;
            PG8_LDA(At, 1, 1); PG8_STAGE(PG8_SA(1, 0), a3, vA2);
            PG8_BAR; PG8_WAIT_L(0); PG8_MMA(1, 0, At, B0); PG8_BAR; PG8_SCHED;
            PG8_STAGE(PG8_SB(1, 1), b3 + hB2, vB2);
            PG8_WAIT_V(6); PG8_BAR; PG8_MMA(1, 1, At, B1); PG8_BAR;
            }
        }
        if constexpr (ALIGN_EPI) { if (wr == 0) PG8_BAR; }
        if (cur.seg == 0) E.mid(acc, cur, wr, wc, fr, fq); else { E(acc, cur, wr, wc, fr, fq); S.done(cur); }
        if (!has_next) break;
        if (cur.seg == 1) {
#pragma unroll
        for (int a = 0; a < 2; ++a)
#pragma unroll
            for (int b = 0; b < 2; ++b)
#pragma unroll
                for (int m = 0; m < 4; ++m)
#pragma unroll
                    for (int n = 0; n < 2; ++n) acc[a][b][m][n] = (f32x4){0.f, 0.f, 0.f, 0.f};
        }
        cur = nxt; cA = nA; cB = nB; ++ui; hAc = hAn; hBc = hBn; vAc[0] = vAn[0]; vAc[1] = vAn[1]; vBc[0] = vBn[0]; vBc[1] = vBn[1]; nt = (cur.seg ? g1.K : g0.K) / BK;
        if constexpr (ALIGN_EPI) { if (wr == 1) PG8_BAR; }
    }
    PG8_WAIT_V(0);
    if constexpr (!ALIGN_EPI) { if (wr == 0) PG8_BAR; }
    PG8_BAR;
#undef PG8_UA
#undef PG8_UB
#undef PG8_SA
#undef PG8_SB
#undef PG8_STAGE
#undef PG8_LDA
#undef PG8_LDB
#undef PG8_MMA
#undef PG8_WAIT_V
#undef PG8_WAIT_L
#undef PG8_BAR
#undef PG8_SCHED
}
}

#define XB_TMO      128
#define XB_XCNT(j)  (256  + 64 * (j))
#define XB_XSUB(j)  (1280 + 64 * (j))
#define XB_XGEN(j)  (2304 + 64 * (j))
#define XB_TOP      3328
#define XB_TOPGEN   3392
#define XCD_BAR_WORDS 3456
#define XB_SPIN_CAP (1u << 18)

__device__ __forceinline__ unsigned xb_ld(unsigned* p)              { return __hip_atomic_load(p, __ATOMIC_RELAXED, __HIP_MEMORY_SCOPE_AGENT); }
__device__ __forceinline__ unsigned xb_add(unsigned* p, unsigned v) { return __hip_atomic_fetch_add(p, v, __ATOMIC_RELAXED, __HIP_MEMORY_SCOPE_AGENT); }
__device__ __forceinline__ unsigned xb_xcc_id() { return (unsigned)__builtin_amdgcn_s_getreg((3 << 11) | 20) & 0xFu; }
#define XB_SPIN(cond, bar) do { unsigned _sp = 0; while (cond) { __builtin_amdgcn_s_sleep(1); \
    if ((++_sp & 255u) == 0u) { if (xb_ld(&(bar)[XB_TMO])) break; if (_sp > XB_SPIN_CAP) { atomicAdd(&(bar)[XB_TMO], 1u); break; } } } } while (0)

struct XcdBarrier {
    unsigned* bar; unsigned x;
    volatile LAS unsigned* st;
};

__device__ __forceinline__ XcdBarrier xcd_barrier_post(unsigned* bar, volatile LAS unsigned* st) {
    XcdBarrier b; b.bar = bar; b.x = xb_xcc_id(); b.st = st;
    if (threadIdx.x == 0) (void)xb_add(&bar[XB_XCNT(b.x)], 1u);
    return b;
}
__device__ __forceinline__ void xcd_barrier_complete(unsigned* bar, unsigned x, unsigned& nloc, unsigned& nx) {
    const unsigned G = gridDim.x * gridDim.y * gridDim.z;
    unsigned sum, cnt, mine, sp = 0u;
    for (;;) {
        sum = 0u; cnt = 0u; mine = 0u;
#pragma unroll
        for (unsigned j = 0; j < 16; ++j) { const unsigned c = xb_ld(&bar[XB_XCNT(j)]); sum += c; cnt += (c > 0u) ? 1u : 0u; mine = (j == x) ? c : mine; }
        if (sum == G) break;
        __builtin_amdgcn_s_sleep(1);
        if ((++sp & 255u) == 0u) { if (xb_ld(&bar[XB_TMO])) break; if (sp > XB_SPIN_CAP) { atomicAdd(&bar[XB_TMO], 1u); break; } }
    }
    nloc = mine > 0u ? mine : 1u; nx = cnt > 0u ? cnt : 1u;
}

__device__ __forceinline__ void xcd_barrier(const XcdBarrier& b) {
    asm volatile("s_waitcnt vmcnt(0)" ::: "memory");
    __syncthreads();
    if (threadIdx.x == 0) {
        unsigned* bar = b.bar;
        __builtin_amdgcn_s_waitcnt(0);
        unsigned nloc = b.st[0], nx = b.st[1];
        if (nloc == 0u) { xcd_barrier_complete(bar, b.x, nloc, nx); b.st[0] = nloc; b.st[1] = nx; }
        const unsigned old = xb_add(&bar[XB_XSUB(b.x)], 1u);
        const unsigned gen = old / nloc;
        if (old + 1u == (gen + 1u) * nloc) {
            __builtin_amdgcn_fence(__ATOMIC_RELEASE, "agent");
            asm volatile("s_waitcnt vmcnt(0)" ::: "memory");
            const unsigned og = xb_add(&bar[XB_TOP], 1u);
            const unsigned tg = og / nx;
            if (og + 1u == (tg + 1u) * nx) xb_add(&bar[XB_TOPGEN], 1u);
            else XB_SPIN(xb_ld(&bar[XB_TOPGEN]) == tg, bar);
            __builtin_amdgcn_fence(__ATOMIC_ACQUIRE, "agent");
            xb_add(&bar[XB_XGEN(b.x)], 1u);
            asm volatile("s_waitcnt vmcnt(0)" ::: "memory");
        } else {
            XB_SPIN(xb_ld(&bar[XB_XGEN(b.x)]) == gen, bar);
            __builtin_amdgcn_fence(__ATOMIC_ACQUIRE, "agent");
            asm volatile("s_waitcnt vmcnt(0)" ::: "memory");
        }
    }
    __syncthreads();
}

constexpr size_t MiB = 1u << 20;
constexpr size_t WS_CTL = 0, CTL_ZERO_BYTES = 192 * 1024;
constexpr size_t WS_SUMSQ = 128 * 1024;
constexpr int CW_BAR = 1024;
constexpr size_t WS_WIN = 1 * MiB;
constexpr size_t WS_WA = 14 * MiB;
constexpr size_t WS_WB = 16 * MiB;
constexpr size_t WS_WO = 17 * MiB;
constexpr size_t WS_WQ = 19 * MiB;
constexpr size_t WS_SKB = 23 * MiB;
constexpr size_t WS_ROPE = 24 * MiB;
constexpr size_t WS_BIAS = 25 * MiB;
constexpr size_t WS_KM = 25 * MiB + 256 * 1024;
constexpr size_t WS_PREV = 26 * MiB;
constexpr size_t WS_ACT = 42 * MiB;
constexpr size_t WS_RQ = WS_ACT, WS_RK = WS_RQ + 16 * MiB, WS_RV = WS_RK + 16 * MiB, WS_RG = WS_RV + 32 * MiB;
constexpr size_t WS_MQ = WS_RG + 32 * MiB, WS_MK = WS_MQ + 16 * MiB, WS_MV = WS_MK + 16 * MiB;
constexpr size_t WS_GA = WS_MV + 16 * MiB, WS_GB = WS_GA + 32 * MiB;
constexpr size_t WS_END = 256 * MiB;
constexpr size_t WS_YB = WS_ACT;
constexpr size_t WS_MRG = WS_ACT + 32 * MiB;
constexpr size_t WS_H2 = WS_ACT + 64 * MiB;
constexpr size_t WS_EG = WS_ACT + 96 * MiB;
constexpr size_t WS_QP = WS_ACT;
constexpr size_t WS_UV = WS_ACT;
constexpr size_t WS_UV8 = WS_ACT + 112 * MiB;
constexpr size_t WS_ST = WS_ACT + 144 * MiB;
static_assert(WS_GB + 32 * MiB <= WS_END && WS_EG + 16 * MiB <= WS_ST && WS_ST + 64 * MiB <= WS_END, "d_ws map");

constexpr int LDS_BYTES = 159 * 1024;
constexpr int MISC_OFF = LDS_BYTES - 256;
constexpr int NWAVES = 8;


using pg8::Unit;
__device__ __forceinline__ void store8_bf16(bf16* p, f32x4 a, f32x4 b) { v4u w; w.x = pk2(a[0], a[1]); w.y = pk2(a[2], a[3]); w.z = pk2(b[0], b[1]); w.w = pk2(b[2], b[3]); *(v4u*)p = w; }
__device__ __forceinline__ void load8_bf16(const bf16* p, f32x4& a, f32x4& b) { const v4u w = *(const v4u*)p; a = (f32x4){bflo(w.x), bfhi(w.x), bflo(w.y), bfhi(w.y)}; b = (f32x4){bflo(w.z), bfhi(w.z), bflo(w.w), bfhi(w.w)}; }
__device__ __forceinline__ float sigmoidf_(float x) { return __builtin_amdgcn_rcpf(1.0f + __builtin_amdgcn_exp2f(-1.4426950408889634f * x)); }
__device__ __forceinline__ f32x4 sig4(f32x4 v) { return (f32x4){sigmoidf_(v[0]), sigmoidf_(v[1]), sigmoidf_(v[2]), sigmoidf_(v[3])}; }
__device__ __forceinline__ f32x4 silu4(f32x4 v) { return v * sig4(v); }

#ifdef MOBA_NAIVE
constexpr float MOBA_QSCALE = 0.125f;
#else
constexpr float MOBA_QSCALE = 0.125f * 1.4426950408889634f;
#endif
struct EpiInProj {
    static constexpr bool AFTER_DRAIN = false;
    bf16 *RQ, *RK, *RV, *RG, *MQ, *MK, *MV, *GA, *GB; const float* rope; const float* qgain; const float* kgain; float* KMP;
    __device__ __forceinline__ void operator()(const f32x4 (&acc)[2][2][4][2], const Unit& u, int wr, int wc, int fr, int fq) const {
        const int pn = u.pn, rowb = u.pm * 256 + wr * 64 + fr, cw = 64 * wc + 8 * fq;
        if (pn < 4) {
            bf16* dst = (pn < 2 ? RQ : RK) + (pn & 1) * 256 + cw; const float sc = pn < 2 ? 1.0f : 0.125f;
#pragma unroll
            for (int ai = 0; ai < 2; ++ai)
#pragma unroll
                for (int m = 0; m < 4; ++m) {
                    const int row = rowb + ai * 128 + m * 16; const float* rp = rope + (size_t)(row & (SEQ - 1)) * 64 + 8 * fq;
                    const f32x4 c0 = *(const f32x4*)rp * sc, c1 = *(const f32x4*)(rp + 4) * sc, s0 = *(const f32x4*)(rp + 32) * sc, s1 = *(const f32x4*)(rp + 36) * sc;
                    const f32x4 x10 = acc[ai][0][m][0], x11 = acc[ai][0][m][1], x20 = acc[ai][1][m][0], x21 = acc[ai][1][m][1];
                    bf16* p = dst + (size_t)row * 512;
                    store8_bf16(p, x10 * c0 - x20 * s0, x11 * c1 - x21 * s1);
                    store8_bf16(p + 32, x10 * s0 + x20 * c0, x11 * s1 + x21 * c1);
                }
        } else if (pn < 12 || (pn >= 16)) {
            bf16* dst; int ld, mode;
            if (pn < 8) { dst = RV + (pn - 4) * 256; ld = 1024; mode = 0; }
            else if (pn < 12) { dst = RG + (pn - 8) * 256; ld = 1024; mode = 1; }
            else if (pn < 18) { dst = MV + (pn - 16) * 256; ld = 512; mode = 0; }
            else if (pn < 22) { dst = GA + (pn - 18) * 256; ld = 1024; mode = 2; }
            else { dst = GB + (pn - 22) * 256; ld = 1024; mode = 2; }
            dst += cw;
#pragma unroll
            for (int ai = 0; ai < 2; ++ai)
#pragma unroll
                for (int m = 0; m < 4; ++m) {
                    const int row = rowb + ai * 128 + m * 16; bf16* p = dst + (size_t)row * ld;
#pragma unroll
                    for (int bj = 0; bj < 2; ++bj) {
                        f32x4 a = acc[ai][bj][m][0], b = acc[ai][bj][m][1];
                        if (mode == 1) { a = silu4(a); b = silu4(b); } else if (mode == 2) { a = sig4(a); b = sig4(b); }
                        store8_bf16(p + 32 * bj, a, b);
                    }
                }
        } else {
            const bool isq = pn < 14; bf16* dst = (isq ? MQ : MK) + (pn & 1) * 256 + cw; const float* gain = (isq ? qgain : kgain) + 8 * fq; const float sc = isq ? MOBA_QSCALE : 1.0f;
            f32x4 cs00 = {0.f, 0.f, 0.f, 0.f}, cs01 = cs00, cs10 = cs00, cs11 = cs00;
            const f32x4 g00 = *(const f32x4*)gain * sc, g01 = *(const f32x4*)(gain + 4) * sc, g10 = *(const f32x4*)(gain + 32) * sc, g11 = *(const f32x4*)(gain + 36) * sc;
#pragma unroll
            for (int ai = 0; ai < 2; ++ai)
#pragma unroll
                for (int m = 0; m < 4; ++m) {
                    const int row = rowb + ai * 128 + m * 16; bf16* p = dst + (size_t)row * 512;
                    const f32x4 a0 = acc[ai][0][m][0], a1 = acc[ai][0][m][1], b0 = acc[ai][1][m][0], b1 = acc[ai][1][m][1];
                    const f32x4 q = a0 * a0 + a1 * a1 + b0 * b0 + b1 * b1; float ss = (q[0] + q[1]) + (q[2] + q[3]);
                    ss += __shfl_xor(ss, 16); ss += __shfl_xor(ss, 32);
                    const float r = rsqrtf(ss * (1.0f / 64.0f) + EPS);
                    const f32x4 y00 = a0 * r * g00, y01 = a1 * r * g01, y10 = b0 * r * g10, y11 = b1 * r * g11;
                    store8_bf16(p, y00, y01);
                    store8_bf16(p + 32, y10, y11);
                    if (!isq) { cs00 += y00; cs01 += y01; cs10 += y10; cs11 += y11; }
                }
            if (!isq) {
#pragma unroll
                for (int e = 0; e < 4; ++e) {
#pragma unroll
                    for (int o = 1; o < 16; o <<= 1) { cs00[e] += __shfl_xor(cs00[e], o); cs01[e] += __shfl_xor(cs01[e], o); cs10[e] += __shfl_xor(cs10[e], o); cs11[e] += __shfl_xor(cs11[e], o); }
                }
                if (fr == 0) { float* kp = KMP + (((size_t)u.pm * 2 + (pn & 1)) * 2 + wr) * 256 + cw;
                    *(f32x4*)kp = cs00; *(f32x4*)(kp + 4) = cs01; *(f32x4*)(kp + 32) = cs10; *(f32x4*)(kp + 36) = cs11; }
            }
        }
    }
};
struct EpiMerge2 {
    static constexpr bool AFTER_DRAIN = false;
    bf16* O; const bf16* GA; const bf16* GB;
    __device__ __forceinline__ void mid(f32x4 (&acc)[2][2][4][2], const Unit& u, int wr, int wc, int fr, int fq) const {
        const int rowb = u.pm * 256 + wr * 64 + fr, col = u.pn * 256 + 64 * wc + 8 * fq;
#pragma unroll
        for (int ai = 0; ai < 2; ++ai)
#pragma unroll
            for (int m = 0; m < 4; ++m) {
                const size_t off = (size_t)(rowb + ai * 128 + m * 16) * 1024 + col;
#pragma unroll
                for (int bj = 0; bj < 2; ++bj) { f32x4 a0, a1, b0, b1; load8_bf16(GA + off + 32 * bj, a0, a1); load8_bf16(GB + off + 32 * bj, b0, b1);
#pragma unroll
                    for (int e = 0; e < 4; ++e) { acc[ai][bj][m][0][e] *= b0[e] * __builtin_amdgcn_rcpf(fmaxf(a0[e], 1e-6f)); acc[ai][bj][m][1][e] *= b1[e] * __builtin_amdgcn_rcpf(fmaxf(a1[e], 1e-6f)); } }
            }
    }
    __device__ __forceinline__ void operator()(const f32x4 (&acc)[2][2][4][2], const Unit& u, int wr, int wc, int fr, int fq) const {
        const int rowb = u.pm * 256 + wr * 64 + fr, col = u.pn * 256 + 64 * wc + 8 * fq;
#pragma unroll
        for (int ai = 0; ai < 2; ++ai)
#pragma unroll
            for (int m = 0; m < 4; ++m) {
                const size_t off = (size_t)(rowb + ai * 128 + m * 16) * 1024 + col;
#pragma unroll
                for (int bj = 0; bj < 2; ++bj) { f32x4 a0, a1; load8_bf16(GA + off + 32 * bj, a0, a1);
#pragma unroll
                    for (int e = 0; e < 4; ++e) { a0[e] = fmaxf(a0[e], 1e-6f); a1[e] = fmaxf(a1[e], 1e-6f); }
                    store8_bf16(O + off + 32 * bj, acc[ai][bj][m][0] * a0, acc[ai][bj][m][1] * a1); }
            }
    }
};
struct TwoSegOrder {
    pg8::StaticOrder B;
    __device__ __forceinline__ bool next(int i, pg8::Unit& u) const { if (!B.next(i >> 1, u)) return false; u.seg = i & 1; return true; }
    __device__ __forceinline__ void a_ready(const pg8::Unit&) const {}
    __device__ __forceinline__ void done(const pg8::Unit&) const {}
};
struct EpiResid {
    static constexpr bool AFTER_DRAIN = false;
    const float* base; float* out; bf16* XG; const float* g2; float* SS;
    __device__ __forceinline__ void operator()(const f32x4 (&acc)[2][2][4][2], const Unit& u, int wr, int wc, int fr, int fq) const {
        const int rowb = u.pm * 256 + wr * 64 + fr, col = u.pn * 256 + 64 * wc + 8 * fq;
        const f32x4 g00 = *(const f32x4*)(g2 + col), g01 = *(const f32x4*)(g2 + col + 4), g10 = *(const f32x4*)(g2 + col + 32), g11 = *(const f32x4*)(g2 + col + 36);
#pragma unroll
        for (int ai = 0; ai < 2; ++ai)
#pragma unroll
            for (int m = 0; m < 4; ++m) {
                const int row = rowb + ai * 128 + m * 16; const size_t off = (size_t)row * 1024 + col;
                const f32x4 x00 = __builtin_nontemporal_load((const f32x4*)(base + off)) + acc[ai][0][m][0], x01 = __builtin_nontemporal_load((const f32x4*)(base + off + 4)) + acc[ai][0][m][1];
                const f32x4 x10 = __builtin_nontemporal_load((const f32x4*)(base + off + 32)) + acc[ai][1][m][0], x11 = __builtin_nontemporal_load((const f32x4*)(base + off + 36)) + acc[ai][1][m][1];
                *(f32x4*)(out + off) = x00; *(f32x4*)(out + off + 4) = x01; *(f32x4*)(out + off + 32) = x10; *(f32x4*)(out + off + 36) = x11;
                store8_bf16(XG + off, x00 * g00, x01 * g01); store8_bf16(XG + off + 32, x10 * g10, x11 * g11);
                const f32x4 q = x00 * x00 + x01 * x01 + x10 * x10 + x11 * x11; float ss = (q[0] + q[1]) + (q[2] + q[3]);
                ss += __shfl_xor(ss, 16); ss += __shfl_xor(ss, 32);
                if (fq == 0) atomicAdd(SS + row, ss);
            }
    }
};
struct EpiPlainBf16 {
    static constexpr bool AFTER_DRAIN = false;
    bf16* O; int ldc;
    __device__ __forceinline__ void operator()(const f32x4 (&acc)[2][2][4][2], const Unit& u, int wr, int wc, int fr, int fq) const {
        const int rowb = u.pm * 256 + wr * 64 + fr, col = u.pn * 256 + 64 * wc + 8 * fq;
#pragma unroll
        for (int ai = 0; ai < 2; ++ai)
#pragma unroll
            for (int m = 0; m < 4; ++m) {
                const size_t off = (size_t)(rowb + ai * 128 + m * 16) * ldc + col;
#pragma unroll
                for (int bj = 0; bj < 2; ++bj) store8_bf16(O + off + 32 * bj, acc[ai][bj][m][0], acc[ai][bj][m][1]);
            }
    }
};
struct EpiNatBf16 {
    static constexpr bool AFTER_DRAIN = false;
    bf16* O; int ldc; const float* SS;
    __device__ __forceinline__ void operator()(const f32x4 (&acc)[2][2][4][2], const Unit& u, int wr, int wc, int fr, int fq) const {
        const int rowb = u.pm * 256 + wr * 64 + fr, col = u.pn * 256 + 32 * wc + 4 * fq;
        f32x4 rs[2][2];
#pragma unroll
        for (int bj = 0; bj < 2; ++bj)
#pragma unroll
            for (int n = 0; n < 2; ++n) { const f32x4 s = *(const f32x4*)(SS + col + 128 * bj + 16 * n); rs[bj][n] = (f32x4){rsqrtf(s[0] * (1.0f / DM) + EPS), rsqrtf(s[1] * (1.0f / DM) + EPS), rsqrtf(s[2] * (1.0f / DM) + EPS), rsqrtf(s[3] * (1.0f / DM) + EPS)}; }
#pragma unroll
        for (int ai = 0; ai < 2; ++ai)
#pragma unroll
            for (int m = 0; m < 4; ++m) {
                const size_t off = (size_t)(rowb + ai * 128 + m * 16) * ldc + col;
#pragma unroll
                for (int bj = 0; bj < 2; ++bj)
#pragma unroll
                    for (int n = 0; n < 2; ++n) { const f32x4 v = acc[ai][bj][m][n] * rs[bj][n]; v2u w; w.x = pk2(v[0], v[1]); w.y = pk2(v[2], v[3]); *(v2u*)(O + off + 128 * bj + 16 * n) = w; }
            }
    }
};

struct Frame {
    LAS unsigned char* lds;
    volatile LAS unsigned* MISC;
    gu32* ctl;
    int tid, lane, wave, G, bid;
};

__device__ __forceinline__ void p0_transpose_item(const float* W, int K, int N, bf16* WT, LAS float* scr, int item, int lane) {
    const int nblk = N / 32, kb = item / nblk, nb = item % nblk, k0 = 64 * kb, n0 = 32 * nb;
#pragma unroll 8
    for (int i = 0; i < 32; ++i) { const int kk = 2 * i + (lane >> 5); scr[kk * 33 + (lane & 31)] = __builtin_nontemporal_load(&W[(size_t)(k0 + kk) * N + n0 + (lane & 31)]); }
    LDS_WAIT(); asm volatile("" ::: "memory");
    const int c = lane & 7;
#pragma unroll
    for (int j = 0; j < 4; ++j) { const int n = (lane >> 3) + 8 * j; const LAS float* s = scr + (8 * c) * 33 + n;
        v4u o; o.x = pk2(s[0 * 33], s[1 * 33]); o.y = pk2(s[2 * 33], s[3 * 33]); o.z = pk2(s[4 * 33], s[5 * 33]); o.w = pk2(s[6 * 33], s[7 * 33]);
        *(GAS v4u*)(WT + (size_t)perm_row_of_col(n0 + n) * K + k0 + 8 * c) = o; }
    LDS_WAIT(); asm volatile("" ::: "memory");
}
__device__ __forceinline__ void rms_row_to_bf16(const float* xrow, const float* g, bf16* orow, int lane) {
    const GAS f32x4* xr = (const GAS f32x4*)xrow + lane; const GAS f32x4* gr = (const GAS f32x4*)g + lane;
    f32x4 v[4]; float s = 0.f;
#pragma unroll
    for (int j = 0; j < 4; ++j) { v[j] = __builtin_nontemporal_load(&xr[64 * j]); s += (v[j].x * v[j].x + v[j].y * v[j].y) + (v[j].z * v[j].z + v[j].w * v[j].w); }
    const float r = rsqrtf(wave_sum(s) * (1.0f / DM) + EPS);
    GAS v2u* o8 = (GAS v2u*)orow + lane;
#pragma unroll
    for (int j = 0; j < 4; ++j) { const f32x4 gg = gr[64 * j]; v2u w; w.x = pk2(v[j].x * r * gg.x, v[j].y * r * gg.y); w.y = pk2(v[j].z * r * gg.z, v[j].w * r * gg.w); o8[64 * j] = w; }
}
__device__ __forceinline__ float t5_bias_of_dist(const float* rel_bias, int h, int dist) {
    int bkt;
    if (dist < 16) bkt = dist;
    else { const float nf = (float)dist; int lg = 16 + (int)(logf(nf / 16.0f) / 4.852030263919617f * 16.0f); bkt = lg < 31 ? lg : 31; }
    return rel_bias[bkt * MH + h];
}

struct Ptrs {
    const float *x, *mix_g, *w_in, *ret_w, *q_gain, *k_gain, *moba_w, *rel_bias, *w_out, *ffn_g, *peer_wq, *sub_keys, *peer_u, *peer_v;
    float* out; unsigned char* ws;
};

__device__ __forceinline__ void p0_prologue(Frame& F, const Ptrs& P) {
    LAS float* scr = (LAS float*)(F.lds + F.wave * 16384);
    const int gw = F.bid * NWAVES + F.wave, NGW = F.G * NWAVES;
    unsigned char* ws = P.ws;
    constexpr int I_IN = (DM / 64) * (INW / 32), I_A = (1024 / 64) * (1024 / 32), I_B = (512 / 64) * (1024 / 32), I_O = I_A, I_Q = (1024 / 64) * (2048 / 32);
    constexpr int NITEMS = I_IN + I_A + I_B + I_O; (void)I_Q;
    (void)NITEMS;
    for (int it = gw; it < I_IN; it += NGW) p0_transpose_item(P.w_in, DM, INW, (bf16*)(ws + WS_WIN), scr, it, F.lane);
    bf16* XN = (bf16*)P.out;
    for (int m = gw; m < T; m += NGW) rms_row_to_bf16(P.x + (size_t)m * DM, P.mix_g, XN + (size_t)m * DM, F.lane);
    const int gt = F.bid * 512 + F.tid, NGT = F.G * 512;
    float* rope = (float*)(ws + WS_ROPE);
    for (int i = gt; i < SEQ * 32; i += NGT) { const int pos = i >> 5, j = i & 31; const float inv = powf(10000.0f, -(float)j / 32.0f); const float ang = (float)pos * inv; float sn, cs; sincosf(ang, &sn, &cs);
        rope[pos * 64 + j] = cs; rope[pos * 64 + 32 + j] = sn; }
    float* BT = (float*)(ws + WS_BIAS);
    for (int i = gt; i < MH * SEQ; i += NGT) { const int h = i >> 12, dist = i & (SEQ - 1); BT[i] = t5_bias_of_dist(P.rel_bias, h, dist); }
}


__device__ __forceinline__ void p0b_late_weights(Frame& F, const Ptrs& P, int idx, int n) {
    LAS float* scr = (LAS float*)(F.lds + F.wave * 16384);
    const int gw = idx * NWAVES + F.wave, NGW = n * NWAVES;
    unsigned char* ws = P.ws;
    constexpr int I_A = (1024 / 64) * (1024 / 32), I_B = (512 / 64) * (1024 / 32), I_O = I_A;
    for (int it = gw; it < I_A + I_B + I_O; it += NGW) {
        int r = it;
        if (r < I_A) { p0_transpose_item(P.ret_w, 1024, 1024, (bf16*)(ws + WS_WA), scr, r, F.lane); continue; } r -= I_A;
        if (r < I_B) { p0_transpose_item(P.moba_w, 512, 1024, (bf16*)(ws + WS_WB), scr, r, F.lane); continue; } r -= I_B;
        p0_transpose_item(P.w_out, 1024, 1024, (bf16*)(ws + WS_WO), scr, r, F.lane);
    }
    { bf16* WST = (bf16*)(ws + WS_WQ);
      for (int wt = gw; wt < 16 * 4 * 32; wt += NGW) {
          const int blk = wt >> 7, nt = (wt >> 5) & 3, mt = wt & 31, r32 = F.lane & 31, hi = F.lane >> 5;
          const float* ap = P.sub_keys + ((size_t)blk * PNK + 32 * nt + r32) * 128 + 8 * hi;
          const float* bp = P.peer_wq + (size_t)(32 * mt + r32) * 2048 + blk * 128 + 8 * hi;
          f32x16 acc;
#pragma unroll
          for (int r = 0; r < 16; ++r) acc[r] = 0.f;
#pragma unroll
          for (int ds = 0; ds < 8; ++ds) {
              const f32x4 a0 = *(const f32x4*)(ap + 16 * ds), a1 = *(const f32x4*)(ap + 16 * ds + 4), b0 = *(const f32x4*)(bp + 16 * ds), b1 = *(const f32x4*)(bp + 16 * ds + 4);
              v4u aw, bw; aw.x = pk2(a0[0], a0[1]); aw.y = pk2(a0[2], a0[3]); aw.z = pk2(a1[0], a1[1]); aw.w = pk2(a1[2], a1[3]);
              bw.x = pk2(b0[0], b0[1]); bw.y = pk2(b0[2], b0[3]); bw.z = pk2(b1[0], b1[1]); bw.w = pk2(b1[2], b1[3]);
              acc = __builtin_amdgcn_mfma_f32_32x32x16_bf16(__builtin_bit_cast(bf16x8, aw), __builtin_bit_cast(bf16x8, bw), acc, 0, 0, 0);
          }
          bf16* op = WST + ((size_t)blk * 128 + 32 * nt) * DM + 32 * mt + r32;
#pragma unroll
          for (int r = 0; r < 16; ++r) op[(size_t)((r & 3) + 8 * (r >> 2) + 4 * hi) * DM] = (bf16)f2bf(acc[r]);
      } }
}
__device__ __forceinline__ void p2a_kv(Frame& F, const Ptrs& P) {
    unsigned char* ws = P.ws; const bf16* RK = (const bf16*)(ws + WS_RK); const bf16* RV = (const bf16*)(ws + WS_RV); const bf16* MK = (const bf16*)(ws + WS_MK);
    float* KVT = (float*)((unsigned char*)P.out + 32 * MiB); float* KM = (float*)(ws + WS_KM);
    LAS bf16* lK = (LAS bf16*)F.lds;
    LAS bf16* lV = (LAS bf16*)(F.lds + 16384);
    const int tid = F.tid;
    for (int task = F.bid; task < BATCH * RH * NCH; task += F.G) {
        const int b = task >> 8, h = (task >> 5) & 7, n = task & 31; const size_t row0 = (size_t)b * SEQ + n * RC; const float l2g = ret_l2g(h);
#pragma unroll
        for (int j = 0; j < 2; ++j) { const int idx = tid + 512 * j, c = idx >> 3, part = idx & 7; *(LAS v4u*)(lK + c * 64 + part * 8) = *(const v4u*)(RK + (row0 + c) * 512 + h * 64 + part * 8); }
#pragma unroll
        for (int j = 0; j < 4; ++j) { const int idx = tid + 512 * j, c = idx >> 4, part = idx & 15; *(LAS v4u*)(lV + c * 128 + part * 8) = *(const v4u*)(RV + (row0 + c) * 1024 + h * 128 + part * 8); }
        __syncthreads();
        const int dk = tid & 63, dv0 = (tid >> 6) * 16;
        float acc[16];
#pragma unroll
        for (int e = 0; e < 16; ++e) acc[e] = 0.f;
        for (int c = 0; c < RC; ++c) {
            const float kd = bf2f(lK[c * 64 + dk]) * exp2f((float)(RC - 1 - c) * l2g);
            const v4u v0 = *(LAS v4u*)(lV + c * 128 + dv0), v1 = *(LAS v4u*)(lV + c * 128 + dv0 + 8);
            acc[0] += kd * bflo(v0.x); acc[1] += kd * bfhi(v0.x); acc[2] += kd * bflo(v0.y); acc[3] += kd * bfhi(v0.y);
            acc[4] += kd * bflo(v0.z); acc[5] += kd * bfhi(v0.z); acc[6] += kd * bflo(v0.w); acc[7] += kd * bfhi(v0.w);
            acc[8] += kd * bflo(v1.x); acc[9] += kd * bfhi(v1.x); acc[10] += kd * bflo(v1.y); acc[11] += kd * bfhi(v1.y);
            acc[12] += kd * bflo(v1.z); acc[13] += kd * bfhi(v1.z); acc[14] += kd * bflo(v1.w); acc[15] += kd * bfhi(v1.w);
        }
        float* o = KVT + (size_t)task * (RDV * RDK);
#pragma unroll
        for (int e = 0; e < 16; ++e) o[(dv0 + e) * 64 + dk] = acc[e];
        __syncthreads();
    }
    const int gw = F.bid * NWAVES + F.wave, NGW = F.G * NWAVES;
    for (int wt = gw; wt < BATCH * MH * NBLK; wt += NGW) {
        const int b = wt >> 7, h = (wt >> 4) & 7, blk = wt & 15; const bf16* p = MK + ((size_t)b * SEQ + blk * MBLK) * 512 + h * 64 + F.lane;
        float s = 0.f;
        for (int j = 0; j < MBLK; ++j) s += bf2f(p[(size_t)j * 512]);
        KM[wt * 64 + F.lane] = s * (1.0f / MBLK);
    }
}
__device__ __forceinline__ void p2b_scan(Frame& F, const Ptrs& P) {
    const float* KVT = (const float*)((unsigned char*)P.out + 32 * MiB); bf16* PREV = (bf16*)(P.ws + WS_PREV);
    const int gt = F.bid * 512 + F.tid, NGT = F.G * 512;
    for (int e = gt; e < BATCH * RH * RDV * RDK; e += NGT) {
        const int bh = e >> 13, el = e & 8191, h = bh & 7; const float dC = exp2f((float)RC * ret_l2g(h));
        float S = 0.f; const size_t base = (size_t)bh * NCH * 8192 + el;
        for (int n = 0; n < NCH; ++n) { PREV[base + (size_t)n * 8192] = (bf16)f2bf(S); S = S * dC + KVT[base + (size_t)n * 8192]; }
    }
}
__device__ __forceinline__ void p3a_retention(Frame& F, const Ptrs& P) {
    unsigned char* ws = P.ws; const bf16* RQ = (const bf16*)(ws + WS_RQ); const bf16* RK = (const bf16*)(ws + WS_RK); const bf16* RV = (const bf16*)(ws + WS_RV);
    const bf16* RG = (const bf16*)(ws + WS_RG); const bf16* PREV = (const bf16*)(ws + WS_PREV); bf16* RETG = (bf16*)P.out;
    LAS bf16* lQ = (LAS bf16*)F.lds;
    LAS bf16* lK = (LAS bf16*)(F.lds + 16384);
    LAS bf16* lV = (LAS bf16*)(F.lds + 16384 + 16896);
    LAS bf16* lP = (LAS bf16*)(F.lds + 16384 + 16896 + 32768);
    LAS float* lS = (LAS float*)(F.lds + 16384 + 16896 + 32768 + 16896);
    const int tid = F.tid, lane = F.lane, wave = F.wave;
    for (int task = F.bid; task < BATCH * RH * NCH; task += F.G) {
        const int b = task >> 8, h = (task >> 5) & 7, n = task & 31; const size_t row0 = (size_t)b * SEQ + n * RC; const float l2g = ret_l2g(h);
#pragma unroll
        for (int j = 0; j < 2; ++j) { const int idx = tid + 512 * j, c = idx >> 3, part = idx & 7; *(LAS v4u*)(lQ + c * 64 + part * 8) = *(const v4u*)(RQ + (row0 + c) * 512 + h * 64 + part * 8); }
#pragma unroll
        for (int j = 0; j < 8; ++j) { const int idx = tid + 512 * j, c = idx >> 5, w = idx & 31; *(LAS unsigned*)(lK + c * 66 + w * 2) = *(const unsigned*)(RK + (row0 + c) * 512 + h * 64 + w * 2); }
#pragma unroll
        for (int j = 0; j < 4; ++j) { const int idx = tid + 512 * j, c = idx >> 4, part = idx & 15; *(LAS v4u*)(lV + c * 128 + part * 8) = *(const v4u*)(RV + (row0 + c) * 1024 + h * 128 + part * 8); }
#pragma unroll
        for (int j = 0; j < 8; ++j) { const int idx = tid + 512 * j, dv = idx >> 5, w = idx & 31; *(LAS unsigned*)(lP + dv * 66 + w * 2) = *(const unsigned*)(PREV + (size_t)task * 8192 + dv * 64 + w * 2); }
        __syncthreads();
        for (int t = 0; t < 32; ++t) {
            const int e = tid + 512 * t, i = e >> 7, j = e & 127;
            float s = 0.f;
            if (j <= i) {
                float d = 0.f;
#pragma unroll
                for (int w = 0; w < 32; ++w) { const unsigned qa = *(LAS unsigned*)(lQ + i * 64 + 2 * w), ka = *(LAS unsigned*)(lK + j * 66 + 2 * w); d += bflo(qa) * bflo(ka) + bfhi(qa) * bfhi(ka); }
                s = d * exp2f((float)(i - j) * l2g);
            }
            lS[i * 128 + j] = s;
        }
        __syncthreads();
        for (int r = 0; r < 16; ++r) {
            const int i = wave * 16 + r;
            float a0 = 0.f, a1 = 0.f;
            for (int j = 0; j <= i; ++j) { const float sv = lS[i * 128 + j]; a0 += sv * bf2f(lV[j * 128 + lane]); a1 += sv * bf2f(lV[j * 128 + lane + 64]); }
            float c0 = 0.f, c1 = 0.f;
#pragma unroll 8
            for (int w = 0; w < 32; ++w) { const unsigned qa = *(LAS unsigned*)(lQ + i * 64 + 2 * w), p0 = *(LAS unsigned*)(lP + lane * 66 + 2 * w), p1 = *(LAS unsigned*)(lP + (lane + 64) * 66 + 2 * w);
                c0 += bflo(qa) * bflo(p0) + bfhi(qa) * bfhi(p0); c1 += bflo(qa) * bflo(p1) + bfhi(qa) * bfhi(p1); }
            const float qd = exp2f((float)(i + 1) * l2g);
            const float o0 = a0 + c0 * qd, o1 = a1 + c1 * qd;
            const float mu = wave_sum(o0 + o1) * (1.0f / RDV); const float d0 = o0 - mu, d1 = o1 - mu;
            const float var = wave_sum(d0 * d0 + d1 * d1) * (1.0f / RDV); const float rs = rsqrtf(var + EPS);
            const size_t off = (row0 + i) * 1024 + h * 128 + lane;
            RETG[off] = (bf16)f2bf(d0 * rs * bf2f(RG[off])); RETG[off + 64] = (bf16)f2bf(d1 * rs * bf2f(RG[off + 64]));
        }
        __syncthreads();
    }
}
__device__ __forceinline__ void p3b_moba(Frame& F, const Ptrs& P) {
    unsigned char* ws = P.ws; const bf16* MQ = (const bf16*)(ws + WS_MQ); const bf16* MK = (const bf16*)(ws + WS_MK); const bf16* MV = (const bf16*)(ws + WS_MV);
    const float* KM = (const float*)(ws + WS_KM); const float* BT = (const float*)(ws + WS_BIAS); bf16* ATT = (bf16*)((unsigned char*)P.out + 32 * MiB);
    LAS float* lB = (LAS float*)F.lds;
    LAS bf16* lK = (LAS bf16*)(F.lds + 16384);
    LAS bf16* lV = (LAS bf16*)(F.lds + 16384 + 32768);
    LAS float* lKM = (LAS float*)(F.lds + 16384 + 65536);
    const int tid = F.tid, ql = tid >> 2, sub = tid & 3;
    for (int unit = F.bid; unit < BATCH * MH * 32; unit += F.G) {
        const int qh = 31 - (unit >> 5), bh = unit & 31, b = bh >> 3, h = bh & 7;
        const int qpos = qh * 128 + ql, qb = qh >> 1;
        for (int i = tid; i < SEQ; i += 512) lB[i] = BT[h * SEQ + i];
        float qf[64];
        { const bf16* qp = MQ + ((size_t)b * SEQ + qpos) * 512 + h * 64;
#pragma unroll
          for (int w = 0; w < 8; ++w) { const v4u x = *(const v4u*)(qp + 8 * w); qf[8 * w] = bflo(x.x); qf[8 * w + 1] = bfhi(x.x); qf[8 * w + 2] = bflo(x.y); qf[8 * w + 3] = bfhi(x.y);
              qf[8 * w + 4] = bflo(x.z); qf[8 * w + 5] = bfhi(x.z); qf[8 * w + 6] = bflo(x.w); qf[8 * w + 7] = bfhi(x.w); } }
        for (int i = tid; i < qb * 64; i += 512) lKM[i] = KM[(size_t)bh * NBLK * 64 + i];
        __syncthreads();
        unsigned mask;
        if (qb <= 3) mask = (1u << qb) - 1u;
        else {
            float g1 = -3e38f, g2 = -3e38f, g3 = -3e38f; int i1 = 0, i2 = 0, i3 = 0;
            for (int kb = 0; kb < qb; ++kb) {
                const LAS float* km = lKM + kb * 64; float g = 0.f;
#pragma unroll
                for (int d = 0; d < 64; ++d) g += qf[d] * km[d];
                if (g > g1) { g3 = g2; i3 = i2; g2 = g1; i2 = i1; g1 = g; i1 = kb; }
                else if (g > g2) { g3 = g2; i3 = i2; g2 = g; i2 = kb; }
                else if (g > g3) { g3 = g; i3 = kb; }
            }
            mask = (1u << i1) | (1u << i2) | (1u << i3);
        }
        float m = -1e30f, l = 0.f, o[64];
#pragma unroll
        for (int d = 0; d < 64; ++d) o[d] = 0.f;
        for (int kb = 0; kb <= qb; ++kb) {
            __syncthreads();
            const size_t krow0 = (size_t)b * SEQ + kb * MBLK;
#pragma unroll
            for (int j = 0; j < 4; ++j) { const int idx = tid + 512 * j, r = idx >> 3, part = idx & 7;
                *(LAS v4u*)(lK + r * 64 + part * 8) = *(const v4u*)(MK + (krow0 + r) * 512 + h * 64 + part * 8);
                *(LAS v4u*)(lV + r * 64 + part * 8) = *(const v4u*)(MV + (krow0 + r) * 512 + h * 64 + part * 8); }
            __syncthreads();
            const bool act = (kb == qb) || ((mask >> kb) & 1u);
            if (act) {
                for (int jj = 0; jj < 64; ++jj) {
                    const int j = jj * 4 + sub, kpos = kb * MBLK + j;
                    if (kpos > qpos) continue;
                    float dot = 0.f;
#pragma unroll
                    for (int w = 0; w < 8; ++w) { const v4u x = *(LAS v4u*)(lK + j * 64 + 8 * w);
                        dot += qf[8 * w] * bflo(x.x) + qf[8 * w + 1] * bfhi(x.x) + qf[8 * w + 2] * bflo(x.y) + qf[8 * w + 3] * bfhi(x.y)
                             + qf[8 * w + 4] * bflo(x.z) + qf[8 * w + 5] * bfhi(x.z) + qf[8 * w + 6] * bflo(x.w) + qf[8 * w + 7] * bfhi(x.w); }
                    const float logit = dot + lB[qpos - kpos];
                    const float mn = fmaxf(m, logit), sc = __expf(m - mn), p = __expf(logit - mn);
                    l = l * sc + p; m = mn;
#pragma unroll
                    for (int w = 0; w < 8; ++w) { const v4u x = *(LAS v4u*)(lV + j * 64 + 8 * w);
                        o[8 * w] = o[8 * w] * sc + p * bflo(x.x); o[8 * w + 1] = o[8 * w + 1] * sc + p * bfhi(x.x); o[8 * w + 2] = o[8 * w + 2] * sc + p * bflo(x.y); o[8 * w + 3] = o[8 * w + 3] * sc + p * bfhi(x.y);
                        o[8 * w + 4] = o[8 * w + 4] * sc + p * bflo(x.z); o[8 * w + 5] = o[8 * w + 5] * sc + p * bfhi(x.z); o[8 * w + 6] = o[8 * w + 6] * sc + p * bflo(x.w); o[8 * w + 7] = o[8 * w + 7] * sc + p * bfhi(x.w); }
                }
            }
        }
        float mm = fmaxf(m, __shfl_xor(m, 1)); mm = fmaxf(mm, __shfl_xor(mm, 2));
        const float f = __expf(m - mm); l *= f; l += __shfl_xor(l, 1); l += __shfl_xor(l, 2);
        const float il = 1.0f / l;
#pragma unroll
        for (int d = 0; d < 64; ++d) { float v = o[d] * f; v += __shfl_xor(v, 1); v += __shfl_xor(v, 2); o[d] = v * il; }
        bf16* op = ATT + ((size_t)b * SEQ + qpos) * 512 + h * 64;
#pragma unroll
        for (int s4 = 0; s4 < 4; ++s4) if (sub == s4) {
            v4u w0, w1; w0.x = pk2(o[16 * s4], o[16 * s4 + 1]); w0.y = pk2(o[16 * s4 + 2], o[16 * s4 + 3]); w0.z = pk2(o[16 * s4 + 4], o[16 * s4 + 5]); w0.w = pk2(o[16 * s4 + 6], o[16 * s4 + 7]);
            w1.x = pk2(o[16 * s4 + 8], o[16 * s4 + 9]); w1.y = pk2(o[16 * s4 + 10], o[16 * s4 + 11]); w1.z = pk2(o[16 * s4 + 12], o[16 * s4 + 13]); w1.w = pk2(o[16 * s4 + 14], o[16 * s4 + 15]);
            *(v4u*)(op + 16 * s4) = w0; *(v4u*)(op + 16 * s4 + 8) = w1; }
        __syncthreads();
    }
}

typedef short s16x4 __attribute__((ext_vector_type(4)));
typedef short v4i16_t __attribute__((ext_vector_type(4)));
__device__ __forceinline__ s16x4 vtr_read(const LAS unsigned char* p) { return __builtin_bit_cast(s16x4, __builtin_amdgcn_ds_read_tr16_b64_v4i16((LAS v4i16_t*)p)); }
constexpr float LOG2E = 1.4426950408889634f;
constexpr float MOBA_NEG = -1.0e30f;
constexpr float MOBA_THR = 3.0f;
constexpr int MB_LB = 0, MB_LKM = 16640, MB_WSC = 20480, MB_K0 = 24576, MB_V0 = 24576 + 65536;
static_assert(MB_V0 + 65536 <= MISC_OFF, "MoBA LDS map");

template <int ABL> __device__ __forceinline__ void p3b_moba_mfma(Frame& F, const Ptrs& P) {
    unsigned char* ws = P.ws; const bf16* MQ = (const bf16*)(ws + WS_MQ); const bf16* MK = (const bf16*)(ws + WS_MK); const bf16* MV = (const bf16*)(ws + WS_MV);
    const float* KMP = (const float*)(ws + WS_KM); const float* BT = (const float*)(ws + WS_BIAS); bf16* ATT = (bf16*)((unsigned char*)P.out + (ABL ? 48 : 32) * MiB);
    LAS float* lB = (LAS float*)(F.lds + MB_LB);
    LAS float* lKM = (LAS float*)(F.lds + MB_LKM);
    LAS float* wsc = (LAS float*)(F.lds + MB_WSC) + F.wave * 64;
    const int tid = F.tid, lane = F.lane, wave = F.wave, r32 = lane & 31, hi = lane >> 5;
    for (int vcu0 = F.bid; vcu0 < 256; vcu0 += F.G) {
    const int vcu = (F.G == 256) ? (vcu0 & 7) * 32 + (vcu0 >> 3) : vcu0;
    const int bh = vcu >> 3, sidx = vcu & 7, b = bh >> 3, h = bh & 7;
    __syncthreads();
    for (int i = tid; i < SEQ + 64; i += 512) lB[i] = (i < 64) ? 0.f : BT[h * SEQ + (i - 64)] * LOG2E;
    unsigned ksrc[4], vsrc[4];
#pragma unroll
    for (int j = 0; j < 4; ++j) { const int pc = wave * 4 + j, krow = 8 * pc + (lane >> 3); ksrc[j] = (unsigned)(krow * 512 + (((lane & 7) ^ (krow & 7)) * 8));
        const int vkey = 8 * pc + ((lane & 31) >> 2); vsrc[j] = (unsigned)(vkey * 512 + 32 * (lane >> 5) + 8 * (lane & 3)); }
#define MOBA_STAGE(kgp, vgp, kdst, vdst) do { _Pragma("unroll") for (int j = 0; j < 4; ++j) { \
        __builtin_amdgcn_global_load_lds((const unsigned*)((kgp) + ksrc[j]), (LAS unsigned*)(F.lds + (kdst) + (wave * 4 + j) * 1024), 16, 0, 0); \
        __builtin_amdgcn_global_load_lds((const unsigned*)((vgp) + vsrc[j]), (LAS unsigned*)(F.lds + (vdst) + (wave * 4 + j) * 1024), 16, 0, 0); } } while (0)
    const unsigned vbase = (unsigned)((4 * hi + ((lane & 15) >> 2)) * 64 + ((lane >> 4) & 1) * 32 + (lane & 3) * 8);
    for (int ui = 0; ui < 2; ++ui) {
        const int qb = ui == 0 ? 15 - sidx : sidx;
        const int nblk = qb + 1;
        __syncthreads();
        for (int i = tid; i < qb * 64; i += 512) { const int kb = i >> 6, dd = i & 63; const float* kp = KMP + (((size_t)(b * NBLK + kb) * 2 + (h >> 2)) * 2) * 256 + (h & 3) * 64 + dd; lKM[i] = (kp[0] + kp[256]) * (1.0f / MBLK); }
        const int qw0 = qb * MBLK + wave * 32, qpos = qw0 + r32;
        bf16x8 qf[4];
        { const bf16* qp = MQ + ((size_t)b * SEQ + qpos) * 512 + h * 64 + 8 * hi;
#pragma unroll
          for (int ds = 0; ds < 4; ++ds) qf[ds] = *(const bf16x8*)(qp + 16 * ds); }
        { const bf16* kg = MK + ((size_t)b * SEQ + (size_t)qb * MBLK) * 512 + h * 64; const bf16* vg = MV + ((size_t)b * SEQ + (size_t)qb * MBLK) * 512 + h * 64;
          MOBA_STAGE(kg, vg, MB_K0, MB_V0); }
        VM_WAIT(); __syncthreads();
        unsigned mask;
        if (qb <= 3) mask = (1u << qb) - 1u;
        else {
            float g1 = -3e38f, g2 = -3e38f, g3 = -3e38f; int i1 = 0, i2 = 0, i3 = 0;
            for (int kb = 0; kb < qb; ++kb) {
                float g = 0.f;
#pragma unroll
                for (int ds = 0; ds < 4; ++ds) { const LAS float* km = lKM + kb * 64 + 16 * ds + 8 * hi; const f32x4 k0 = *(const LAS f32x4*)km, k1 = *(const LAS f32x4*)(km + 4);
                    const v4u qx = __builtin_bit_cast(v4u, qf[ds]);
                    g += bflo(qx.x) * k0[0] + bfhi(qx.x) * k0[1] + bflo(qx.y) * k0[2] + bfhi(qx.y) * k0[3] + bflo(qx.z) * k1[0] + bfhi(qx.z) * k1[1] + bflo(qx.w) * k1[2] + bfhi(qx.w) * k1[3]; }
                g += __shfl_xor(g, 32);
                if (g > g1) { g3 = g2; i3 = i2; g2 = g1; i2 = i1; g1 = g; i1 = kb; }
                else if (g > g2) { g3 = g2; i3 = i2; g2 = g; i2 = kb; }
                else if (g > g3) { g3 = g; i3 = kb; }
            }
            mask = (1u << i1) | (1u << i2) | (1u << i3);
        }
        float m = 0.f, l = 0.f; bool first = true, pending = false;
        f32x16 o0, o1; v4u ppa[4]; unsigned pvoff = MB_V0;
#pragma unroll
        for (int r = 0; r < 16; ++r) { o0[r] = 0.f; o1[r] = 0.f; }
#pragma unroll
        for (int q = 0; q < 4; ++q) ppa[q] = (v4u){0u, 0u, 0u, 0u};
#define MOBA_PV(pa_, voff_) do { const LAS unsigned char* vp_ = F.lds + (voff_) + vbase; \
        _Pragma("unroll") for (int ks = 0; ks < 4; ++ks) { const bf16x8 pav = __builtin_bit_cast(bf16x8, pa_[ks]); \
            _Pragma("unroll") for (int db = 0; db < 2; ++db) { const s16x4 lo = vtr_read(vp_ + ((2 * ks) * 2 + db) * 512), hh = vtr_read(vp_ + ((2 * ks + 1) * 2 + db) * 512); \
                const bf16x8 vf = (bf16x8){lo[0], lo[1], lo[2], lo[3], hh[0], hh[1], hh[2], hh[3]}; \
                if (db == 0) o0 = __builtin_amdgcn_mfma_f32_32x32x16_bf16(pav, vf, o0, 0, 0, 0); else o1 = __builtin_amdgcn_mfma_f32_32x32x16_bf16(pav, vf, o1, 0, 0, 0); } } } while (0)
        for (int bi = 0; bi < nblk; ++bi) {
            const int kb = bi == 0 ? qb : bi - 1;
            const unsigned kbuf = MB_K0 + (bi & 1) * 32768, vbuf = MB_V0 + (bi & 1) * 32768;
            const bool has_next = bi + 1 < nblk;
            if (has_next) { const int kn = bi;
                if (pending) { MOBA_PV(ppa, pvoff); pending = false;
#pragma unroll
                    for (int q = 0; q < 4; ++q) ppa[q] = (v4u){0u, 0u, 0u, 0u}; }
                const bf16* kg = MK + ((size_t)b * SEQ + (size_t)kn * MBLK) * 512 + h * 64; const bf16* vg = MV + ((size_t)b * SEQ + (size_t)kn * MBLK) * 512 + h * 64;
                MOBA_STAGE(kg, vg, MB_K0 + ((bi + 1) & 1) * 32768, MB_V0 + ((bi + 1) & 1) * 32768); }
            const bool own = bi == 0;
            const bool sel = own || ((mask >> kb) & 1u);
            if (!(ABL & 16) && __any(sel)) {
                float msub = sel ? m : 1.0e30f;
                f32x16 cneg;
#pragma unroll
                for (int r = 0; r < 16; ++r) cneg[r] = -msub;
                const int npair = own ? (wave >> 1) + 1 : 4;
#define MOBA_QK(jq_, dA_, dB_) do { const int keyA_ = 64 * (jq_) + r32, keyB_ = keyA_ + 32; const LAS unsigned char* kpA_ = F.lds + kbuf + keyA_ * 128; const LAS unsigned char* kpB_ = F.lds + kbuf + keyB_ * 128; \
        _Pragma("unroll") for (int ds = 0; ds < 4; ++ds) { const bf16x8 aA_ = *(const LAS bf16x8*)(kpA_ + (((2 * ds + hi) ^ (keyA_ & 7)) * 16)), aB_ = *(const LAS bf16x8*)(kpB_ + (((2 * ds + hi) ^ (keyB_ & 7)) * 16)); \
            if (!(ABL & 8)) { dA_ = __builtin_amdgcn_mfma_f32_32x32x16_bf16(aA_, qf[ds], ds == 0 ? cneg : dA_, 0, 0, 0); dB_ = __builtin_amdgcn_mfma_f32_32x32x16_bf16(aB_, qf[ds], ds == 0 ? cneg : dB_, 0, 0, 0); } else if (ds == 0) { dA_ = cneg; dB_ = cneg; } } } while (0)
                f32x16 sA, sB, nA, nB;
                MOBA_QK(0, sA, sB);
                for (int jp = 0; jp < npair; ++jp) {
                    const int k0 = kb * MBLK + 64 * jp, dmin = qw0 - k0 - 63, dmax = qw0 + 31 - k0;
                    bool uni = false; float bu = 0.f;
                    if (dmin >= 256) { const float b0 = lB[64 + dmin], b1 = lB[64 + dmax]; uni = (b0 == b1); bu = b0; }
                    if (ABL & 1) {} else if (uni) {
#pragma unroll
                        for (int r = 0; r < 16; ++r) { sA[r] += bu; sB[r] += bu; }
                    } else {
                        const LAS float* bp = lB + (64 + qpos - k0 - 4 * hi - 27 - 32);
#pragma unroll
                        for (int r = 0; r < 16; ++r) { sA[r] += bp[32 + 27 - ((r & 3) + 8 * (r >> 2))]; sB[r] += bp[27 - ((r & 3) + 8 * (r >> 2))]; }
                    }
                    if (own && 2 * jp + 1 >= wave) {
                        const int limA = 32 * wave + r32 - 64 * jp - 4 * hi, limB = limA - 32;
#pragma unroll
                        for (int r = 0; r < 16; ++r) { const int cr = (r & 3) + 8 * (r >> 2); if (cr > limA) sA[r] = MOBA_NEG; if (cr > limB) sB[r] = MOBA_NEG; }
                    }
                    float tm = fmaxf(fmaxf(fmaxf(sA[0], sA[1]), fmaxf(sA[2], sA[3])), fmaxf(fmaxf(sB[0], sB[1]), fmaxf(sB[2], sB[3])));
#pragma unroll
                    for (int r = 4; r < 16; r += 4) tm = fmaxf(tm, fmaxf(fmaxf(fmaxf(sA[r], sA[r + 1]), fmaxf(sA[r + 2], sA[r + 3])), fmaxf(fmaxf(sB[r], sB[r + 1]), fmaxf(sB[r + 2], sB[r + 3]))));
                    if (first || __any(tm > MOBA_THR)) {
                        tm = fmaxf(tm, __shfl_xor(tm, 32));
                        const float dl = first ? tm : fmaxf(tm, 0.f);
                        first = false;
                        m += dl;
#pragma unroll
                        for (int r = 0; r < 16; ++r) { sA[r] -= dl; sB[r] -= dl; }
                        const float al = __builtin_amdgcn_exp2f(-dl);
                        l *= al;
                        if (hi == 0) wsc[r32] = al;
                        LDS_WAIT(); asm volatile("" ::: "memory");
#pragma unroll
                        for (int r = 0; r < 16; ++r) { const float a = wsc[(r & 3) + 8 * (r >> 2) + 4 * hi]; o0[r] *= a; o1[r] *= a; }
                        LDS_WAIT(); asm volatile("" ::: "memory");
                        {
#pragma unroll
                            for (int q = 0; q < 4; ++q) { ppa[q].x = pk2(bflo(ppa[q].x) * al, bfhi(ppa[q].x) * al); ppa[q].y = pk2(bflo(ppa[q].y) * al, bfhi(ppa[q].y) * al);
                                ppa[q].z = pk2(bflo(ppa[q].z) * al, bfhi(ppa[q].z) * al); ppa[q].w = pk2(bflo(ppa[q].w) * al, bfhi(ppa[q].w) * al); }
                        }
                        msub = sel ? m : 1.0e30f;
#pragma unroll
                        for (int r = 0; r < 16; ++r) cneg[r] = -msub;
                    }
                    {
                        const int jn = jp + 1 < npair ? jp + 1 : jp;
                        const int keyA_ = 64 * jn + r32, keyB_ = keyA_ + 32; const LAS unsigned char* kpA_ = F.lds + kbuf + keyA_ * 128; const LAS unsigned char* kpB_ = F.lds + kbuf + keyB_ * 128;
                        const LAS unsigned char* vp_ = F.lds + pvoff + vbase;
                        float ps = 0.f;
#pragma unroll
                        for (int i = 0; i < 4; ++i) {
                            if (!(ABL & 4)) { const bf16x8 pav = __builtin_bit_cast(bf16x8, ppa[i]);
#pragma unroll
                                for (int db = 0; db < 2; ++db) { const s16x4 lo = vtr_read(vp_ + ((2 * i) * 2 + db) * 512), hh = vtr_read(vp_ + ((2 * i + 1) * 2 + db) * 512);
                                    const bf16x8 vf = (bf16x8){lo[0], lo[1], lo[2], lo[3], hh[0], hh[1], hh[2], hh[3]};
                                    if (db == 0) o0 = __builtin_amdgcn_mfma_f32_32x32x16_bf16(pav, vf, o0, 0, 0, 0); else o1 = __builtin_amdgcn_mfma_f32_32x32x16_bf16(pav, vf, o1, 0, 0, 0); } }
                            { const bf16x8 aA_ = *(const LAS bf16x8*)(kpA_ + (((2 * i + hi) ^ (keyA_ & 7)) * 16)), aB_ = *(const LAS bf16x8*)(kpB_ + (((2 * i + hi) ^ (keyB_ & 7)) * 16));
                              if (!(ABL & 8)) { nA = __builtin_amdgcn_mfma_f32_32x32x16_bf16(aA_, qf[i], i == 0 ? cneg : nA, 0, 0, 0); nB = __builtin_amdgcn_mfma_f32_32x32x16_bf16(aB_, qf[i], i == 0 ? cneg : nB, 0, 0, 0); } else if (i == 0) { nA = cneg; nB = cneg; } }
                            float pv8[8];
#pragma unroll
                            for (int q = 0; q < 8; ++q) { const float sv = i < 2 ? sA[8 * i + q] : sB[8 * (i - 2) + q]; pv8[q] = (ABL & 2) ? sv : __builtin_amdgcn_exp2f(sv); ps += pv8[q]; }
                            ppa[i].x = pk2(pv8[0], pv8[1]); ppa[i].y = pk2(pv8[2], pv8[3]); ppa[i].z = pk2(pv8[4], pv8[5]); ppa[i].w = pk2(pv8[6], pv8[7]);
                            __builtin_amdgcn_sched_barrier(0);
                        }
                        l += ps;
                    }
                    pvoff = vbuf + (8 * jp) * 1024; pending = true;
                    sA = nA; sB = nB;
                }
#undef MOBA_QK
            }
            VM_WAIT(); __syncthreads();
        }
        if (pending) { MOBA_PV(ppa, pvoff); pending = false; }
#undef MOBA_PV
        l += __shfl_xor(l, 32);
        if (hi == 0) wsc[r32] = 1.0f / l;
        LDS_WAIT(); asm volatile("" ::: "memory");
        bf16* op = ATT + ((size_t)b * SEQ + qw0) * 512 + h * 64 + r32;
#pragma unroll
        for (int r = 0; r < 16; ++r) { const int qr = (r & 3) + 8 * (r >> 2) + 4 * hi; const float a = wsc[qr];
            op[(size_t)qr * 512] = (bf16)f2bf(o0[r] * a); op[(size_t)qr * 512 + 32] = (bf16)f2bf(o1[r] * a); }
        LDS_WAIT(); asm volatile("" ::: "memory");
    }
    }
#undef MOBA_STAGE
}


constexpr int RT_K = 0, RT_P = 16384, RT_V = 32768, RT_O = 65536, RT_OP = 132;
__device__ __forceinline__ void p3a_retention_mfma(Frame& F, const Ptrs& P) {
    unsigned char* ws = P.ws; const bf16* RQ = (const bf16*)(ws + WS_RQ); const bf16* RK = (const bf16*)(ws + WS_RK); const bf16* RV = (const bf16*)(ws + WS_RV);
    const bf16* RG = (const bf16*)(ws + WS_RG); const bf16* PREV = (const bf16*)(ws + WS_PREV); bf16* RETG = (bf16*)P.out;
    LAS float* lO = (LAS float*)(F.lds + RT_O);
    const int lane = F.lane, wave = F.wave, r32 = lane & 31, hi = lane >> 5, rt = wave >> 1, dh = wave & 1;
    const unsigned vbase = (unsigned)((4 * hi + ((lane & 15) >> 2)) * 64 + ((lane >> 4) & 1) * 32 + (lane & 3) * 8);
    unsigned ksrc[2], psrc[2], vsrc[4];
#pragma unroll
    for (int j = 0; j < 2; ++j) { const int pc = wave * 2 + j, row = 8 * pc + (lane >> 3), ch = (lane & 7) ^ (row & 7); ksrc[j] = (unsigned)(row * 512 + ch * 8); psrc[j] = (unsigned)(row * 64 + ch * 8); }
#pragma unroll
    for (int j = 0; j < 4; ++j) { const int pc = wave * 4 + j, key = 8 * (pc >> 1) + ((lane & 31) >> 2), db = 2 * (pc & 1) + (lane >> 5); vsrc[j] = (unsigned)(key * 1024 + 32 * db + 8 * (lane & 3)); }
#define RT_STAGE(task_) do { const int b_ = (task_) >> 8, h_ = ((task_) >> 5) & 7, n_ = (task_) & 31; const size_t r0_ = (size_t)b_ * SEQ + n_ * RC; \
        const bf16* kg_ = RK + r0_ * 512 + h_ * 64; const bf16* pg_ = PREV + (size_t)(task_) * 8192; const bf16* vg_ = RV + r0_ * 1024 + h_ * 128; \
        _Pragma("unroll") for (int j = 0; j < 2; ++j) { __builtin_amdgcn_global_load_lds((const unsigned*)(kg_ + ksrc[j]), (LAS unsigned*)(F.lds + RT_K + (wave * 2 + j) * 1024), 16, 0, 0); \
            __builtin_amdgcn_global_load_lds((const unsigned*)(pg_ + psrc[j]), (LAS unsigned*)(F.lds + RT_P + (wave * 2 + j) * 1024), 16, 0, 0); } \
        _Pragma("unroll") for (int j = 0; j < 4; ++j) __builtin_amdgcn_global_load_lds((const unsigned*)(vg_ + vsrc[j]), (LAS unsigned*)(F.lds + RT_V + (wave * 4 + j) * 1024), 16, 0, 0); } while (0)
    int task = F.bid;
    if (task < BATCH * RH * NCH) RT_STAGE(task);
    for (; task < BATCH * RH * NCH; task += F.G) {
        const int b = task >> 8, h = (task >> 5) & 7, n = task & 31; const size_t row0 = (size_t)b * SEQ + n * RC; const float l2g = ret_l2g(h);
        bf16x8 qf[4];
        { const bf16* qp = RQ + (row0 + 32 * rt + r32) * 512 + h * 64 + 8 * hi;
#pragma unroll
          for (int ds = 0; ds < 4; ++ds) qf[ds] = *(const bf16x8*)(qp + 16 * ds); }
        VM_WAIT(); __syncthreads();
        f32x16 o0, o1;
#pragma unroll
        for (int r = 0; r < 16; ++r) { o0[r] = 0.f; o1[r] = 0.f; }
#pragma unroll
        for (int ds = 0; ds < 4; ++ds) {
#pragma unroll
            for (int db = 0; db < 2; ++db) { const int dv = 64 * dh + 32 * db + r32; const bf16x8 bfr = *(const LAS bf16x8*)(F.lds + RT_P + dv * 128 + (((2 * ds + hi) ^ (dv & 7)) * 16));
                if (db == 0) o0 = __builtin_amdgcn_mfma_f32_32x32x16_bf16(qf[ds], bfr, o0, 0, 0, 0); else o1 = __builtin_amdgcn_mfma_f32_32x32x16_bf16(qf[ds], bfr, o1, 0, 0, 0); }
        }
#pragma unroll
        for (int r = 0; r < 16; ++r) { const float qd = __builtin_amdgcn_exp2f((float)(32 * rt + (r & 3) + 8 * (r >> 2) + 4 * hi + 1) * l2g); o0[r] *= qd; o1[r] *= qd; }
        for (int kt = 0; kt <= rt; ++kt) {
            f32x16 s;
#pragma unroll
            for (int r = 0; r < 16; ++r) s[r] = 0.f;
            { const int key = 32 * kt + r32; const LAS unsigned char* kp = F.lds + RT_K + key * 128;
#pragma unroll
              for (int ds = 0; ds < 4; ++ds) { const bf16x8 a = *(const LAS bf16x8*)(kp + (((2 * ds + hi) ^ (key & 7)) * 16)); s = __builtin_amdgcn_mfma_f32_32x32x16_bf16(a, qf[ds], s, 0, 0, 0); } }
            const int dbase = 32 * (rt - kt) + r32 - 4 * hi;
#pragma unroll
            for (int r = 0; r < 16; ++r) { const int dj = dbase - ((r & 3) + 8 * (r >> 2)); s[r] = dj >= 0 ? s[r] * __builtin_amdgcn_exp2f((float)dj * l2g) : 0.f; }
            v4u pa0, pa1;
            pa0.x = pk2(s[0], s[1]); pa0.y = pk2(s[2], s[3]); pa0.z = pk2(s[4], s[5]); pa0.w = pk2(s[6], s[7]);
            pa1.x = pk2(s[8], s[9]); pa1.y = pk2(s[10], s[11]); pa1.z = pk2(s[12], s[13]); pa1.w = pk2(s[14], s[15]);
            const LAS unsigned char* vp = F.lds + RT_V + vbase + (4 * kt) * 2048 + (2 * dh) * 512;
#pragma unroll
            for (int ks = 0; ks < 2; ++ks) {
                const bf16x8 pa = __builtin_bit_cast(bf16x8, ks == 0 ? pa0 : pa1);
#pragma unroll
                for (int db = 0; db < 2; ++db) {
                    const s16x4 lo = vtr_read(vp + (2 * ks) * 2048 + db * 512), hh = vtr_read(vp + (2 * ks + 1) * 2048 + db * 512);
                    const bf16x8 vf = (bf16x8){lo[0], lo[1], lo[2], lo[3], hh[0], hh[1], hh[2], hh[3]};
                    if (db == 0) o0 = __builtin_amdgcn_mfma_f32_32x32x16_bf16(pa, vf, o0, 0, 0, 0); else o1 = __builtin_amdgcn_mfma_f32_32x32x16_bf16(pa, vf, o1, 0, 0, 0);
                }
            }
        }
#pragma unroll
        for (int r = 0; r < 16; ++r) { const int qr = 32 * rt + (r & 3) + 8 * (r >> 2) + 4 * hi; lO[qr * RT_OP + 64 * dh + r32] = o0[r]; lO[qr * RT_OP + 64 * dh + 32 + r32] = o1[r]; }
        __syncthreads();
        if (task + F.G < BATCH * RH * NCH) RT_STAGE(task + F.G);
#pragma unroll
        for (int it = 0; it < 2; ++it) {
            const int i = wave * 16 + it * 8 + (lane >> 3), cc = lane & 7;
            f32x4 v[4];
#pragma unroll
            for (int q = 0; q < 4; ++q) v[q] = *(const LAS f32x4*)(lO + i * RT_OP + 16 * cc + 4 * q);
            const f32x4 sv = (v[0] + v[1]) + (v[2] + v[3]);
            const float mu = dpp_sum8((sv[0] + sv[1]) + (sv[2] + sv[3])) * (1.0f / RDV);
            f32x4 qv = {0.f, 0.f, 0.f, 0.f};
#pragma unroll
            for (int q = 0; q < 4; ++q) { v[q] = v[q] - mu; qv += v[q] * v[q]; }
            const float rs = rsqrtf(dpp_sum8((qv[0] + qv[1]) + (qv[2] + qv[3])) * (1.0f / RDV) + EPS);
            const size_t off = (row0 + i) * 1024 + h * 128 + 16 * cc;
            f32x4 g0, g1, g2, g3; load8_bf16(RG + off, g0, g1); load8_bf16(RG + off + 8, g2, g3);
            store8_bf16(RETG + off, v[0] * rs * g0, v[1] * rs * g1); store8_bf16(RETG + off + 8, v[2] * rs * g2, v[3] * rs * g3);
        }
    }
#undef RT_STAGE
}
constexpr int KV_K = 0, KV_V = 16384;
__device__ __forceinline__ void p2a_kv_mfma(Frame& F, const Ptrs& P) {
    unsigned char* ws = P.ws; const bf16* RK = (const bf16*)(ws + WS_RK); const bf16* RV = (const bf16*)(ws + WS_RV); float* KVT = (float*)((unsigned char*)P.out + 32 * MiB);
    const int tid = F.tid, lane = F.lane, wave = F.wave, r32 = lane & 31, hi = lane >> 5, mb = wave >> 1, nb = wave & 1;
    const unsigned vbase = (unsigned)((4 * hi + ((lane & 15) >> 2)) * 64 + ((lane >> 4) & 1) * 32 + (lane & 3) * 8);
    for (int task = F.bid; task < BATCH * RH * NCH; task += F.G) {
        const int b = task >> 8, h = (task >> 5) & 7, n = task & 31; const size_t row0 = (size_t)b * SEQ + n * RC; const float l2g = ret_l2g(h);
        __syncthreads();
#pragma unroll
        for (int j = 0; j < 2; ++j) { const int idx = tid + 512 * j, r = idx >> 3, c = idx & 7; const v4u kx = *(const v4u*)(RK + (row0 + r) * 512 + h * 64 + c * 8);
            const float dec = __builtin_amdgcn_exp2f((float)(RC - 1 - r) * l2g); v4u ko;
            ko.x = pk2(bflo(kx.x) * dec, bfhi(kx.x) * dec); ko.y = pk2(bflo(kx.y) * dec, bfhi(kx.y) * dec); ko.z = pk2(bflo(kx.z) * dec, bfhi(kx.z) * dec); ko.w = pk2(bflo(kx.w) * dec, bfhi(kx.w) * dec);
            *(LAS v4u*)(F.lds + KV_K + (((r >> 3) * 2 + (c >> 2)) * 512) + (r & 7) * 64 + (c & 3) * 16) = ko; }
#pragma unroll
        for (int j = 0; j < 4; ++j) { const int idx = tid + 512 * j, r = idx >> 4, c = idx & 15;
            *(LAS v4u*)(F.lds + KV_V + (((r >> 3) * 4 + (c >> 2)) * 512) + (r & 7) * 64 + (c & 3) * 16) = *(const v4u*)(RV + (row0 + r) * 1024 + h * 128 + c * 8); }
        __syncthreads();
        f32x16 acc;
#pragma unroll
        for (int r = 0; r < 16; ++r) acc[r] = 0.f;
#pragma unroll
        for (int ks = 0; ks < 8; ++ks) {
            const LAS unsigned char* ap = F.lds + KV_V + vbase + ((2 * ks) * 4 + mb) * 512; const LAS unsigned char* bp = F.lds + KV_K + vbase + ((2 * ks) * 2 + nb) * 512;
            const s16x4 alo = vtr_read(ap), ahi = vtr_read(ap + 4 * 512), blo = vtr_read(bp), bhi = vtr_read(bp + 2 * 512);
            const bf16x8 af = (bf16x8){alo[0], alo[1], alo[2], alo[3], ahi[0], ahi[1], ahi[2], ahi[3]}, bfv = (bf16x8){blo[0], blo[1], blo[2], blo[3], bhi[0], bhi[1], bhi[2], bhi[3]};
            acc = __builtin_amdgcn_mfma_f32_32x32x16_bf16(af, bfv, acc, 0, 0, 0);
        }
        float* o = KVT + (size_t)task * (RDV * RDK) + 32 * nb + r32;
#pragma unroll
        for (int r = 0; r < 16; ++r) o[(32 * mb + (r & 3) + 8 * (r >> 2) + 4 * hi) * 64] = acc[r];
    }
}
#define CE_D(a, i, j) do { const unsigned _hi = a[i] > a[j] ? a[i] : a[j]; const unsigned _lo = a[i] > a[j] ? a[j] : a[i]; a[i] = _hi; a[j] = _lo; } while (0)
#define CE_A(a, i, j) do { const unsigned _hi = a[i] > a[j] ? a[i] : a[j]; const unsigned _lo = a[i] > a[j] ? a[j] : a[i]; a[i] = _lo; a[j] = _hi; } while (0)
#define SORT16_DESC(a) do { CE_D(a, 0, 1); CE_A(a, 2, 3); CE_D(a, 4, 5); CE_A(a, 6, 7); CE_D(a, 8, 9); CE_A(a, 10, 11); CE_D(a, 12, 13); CE_A(a, 14, 15); CE_D(a, 0, 2); CE_D(a, 1, 3); CE_A(a, 4, 6); CE_A(a, 5, 7); CE_D(a, 8, 10); CE_D(a, 9, 11); CE_A(a, 12, 14); CE_A(a, 13, 15); CE_D(a, 0, 1); CE_D(a, 2, 3); CE_A(a, 4, 5); CE_A(a, 6, 7); CE_D(a, 8, 9); CE_D(a, 10, 11); CE_A(a, 12, 13); CE_A(a, 14, 15); CE_D(a, 0, 4); CE_D(a, 1, 5); CE_D(a, 2, 6); CE_D(a, 3, 7); CE_A(a, 8, 12); CE_A(a, 9, 13); CE_A(a, 10, 14); CE_A(a, 11, 15); CE_D(a, 0, 2); CE_D(a, 1, 3); CE_D(a, 4, 6); CE_D(a, 5, 7); CE_A(a, 8, 10); CE_A(a, 9, 11); CE_A(a, 12, 14); CE_A(a, 13, 15); CE_D(a, 0, 1); CE_D(a, 2, 3); CE_D(a, 4, 5); CE_D(a, 6, 7); CE_A(a, 8, 9); CE_A(a, 10, 11); CE_A(a, 12, 13); CE_A(a, 14, 15); CE_D(a, 0, 8); CE_D(a, 1, 9); CE_D(a, 2, 10); CE_D(a, 3, 11); CE_D(a, 4, 12); CE_D(a, 5, 13); CE_D(a, 6, 14); CE_D(a, 7, 15); CE_D(a, 0, 4); CE_D(a, 1, 5); CE_D(a, 2, 6); CE_D(a, 3, 7); CE_D(a, 8, 12); CE_D(a, 9, 13); CE_D(a, 10, 14); CE_D(a, 11, 15); CE_D(a, 0, 2); CE_D(a, 1, 3); CE_D(a, 4, 6); CE_D(a, 5, 7); CE_D(a, 8, 10); CE_D(a, 9, 11); CE_D(a, 12, 14); CE_D(a, 13, 15); CE_D(a, 0, 1); CE_D(a, 2, 3); CE_D(a, 4, 5); CE_D(a, 6, 7); CE_D(a, 8, 9); CE_D(a, 10, 11); CE_D(a, 12, 13); CE_D(a, 14, 15); } while (0)
#define MERGE16_DESC(a) do { CE_D(a, 0, 8); CE_D(a, 1, 9); CE_D(a, 2, 10); CE_D(a, 3, 11); CE_D(a, 4, 12); CE_D(a, 5, 13); CE_D(a, 6, 14); CE_D(a, 7, 15); CE_D(a, 0, 4); CE_D(a, 1, 5); CE_D(a, 2, 6); CE_D(a, 3, 7); CE_D(a, 8, 12); CE_D(a, 9, 13); CE_D(a, 10, 14); CE_D(a, 11, 15); CE_D(a, 0, 2); CE_D(a, 1, 3); CE_D(a, 4, 6); CE_D(a, 5, 7); CE_D(a, 8, 10); CE_D(a, 9, 11); CE_D(a, 12, 14); CE_D(a, 13, 15); CE_D(a, 0, 1); CE_D(a, 2, 3); CE_D(a, 4, 5); CE_D(a, 6, 7); CE_D(a, 8, 9); CE_D(a, 10, 11); CE_D(a, 12, 13); CE_D(a, 14, 15); } while (0)

#ifndef CONV_IN_TOPK
#define CONV_IN_TOPK 1
#endif
constexpr size_t CONV_N16 = (size_t)NEXP * DM / 16;
__device__ __forceinline__ void conv_load(const Ptrs& P, size_t i, f32x4 (&a)[4]) {
    const float* src = (i < CONV_N16) ? P.peer_u + i * 16 : P.peer_v + (i - CONV_N16) * 16;
#pragma unroll
    for (int q = 0; q < 4; ++q) a[q] = __builtin_nontemporal_load((const f32x4*)(src + 4 * q));
}
__device__ __forceinline__ void conv_store(const Ptrs& P, size_t i, const f32x4 (&a)[4]) {
    v4u w;
    if (i < CONV_N16) {
#pragma unroll
        for (int q = 0; q < 4; ++q) { const f32x4 s = a[q] * 512.0f; int pk = __builtin_amdgcn_cvt_pk_fp8_f32(s[0], s[1], 0, false); pk = __builtin_amdgcn_cvt_pk_fp8_f32(s[2], s[3], pk, true); w[q] = (unsigned)pk; }
    } else {
#pragma unroll
        for (int q = 0; q < 4; ++q) { const f32x4 s = a[q] * 512.0f; int pk = __builtin_amdgcn_cvt_pk_bf8_f32(s[0], s[1], 0, false); pk = __builtin_amdgcn_cvt_pk_bf8_f32(s[2], s[3], pk, true); w[q] = (unsigned)pk; }
    }
    const size_t tab = i < CONV_N16 ? 0 : CONV_N16, r = i - tab, e = r >> 6, blk = (r >> 3) & 7, ch = r & 7;
    *(v4u*)(P.ws + WS_UV8 + (tab + e * 64 + (((blk + e) & 7) << 3) + ch) * 16) = w;
}
__device__ __forceinline__ void conv_all(Frame& F, const Ptrs& P) {
    const size_t cbase = (size_t)F.bid * 512 + F.tid, CNGT = (size_t)F.G * 512;
    for (size_t ci = cbase; ci < 2 * CONV_N16; ci += CNGT) { f32x4 cv[4]; conv_load(P, ci, cv); conv_store(P, ci, cv); }
}
__device__ __forceinline__ unsigned mono32(float f) { const unsigned u = __builtin_bit_cast(unsigned, f); return u ^ ((u >> 31) ? 0xffffffffu : 0x80000000u); }
__device__ __forceinline__ float unmono32(unsigned k) { const unsigned u = k ^ ((k >> 31) ? 0x80000000u : 0xffffffffu); return __builtin_bit_cast(float, u); }
__device__ __forceinline__ float key_val(unsigned k) { const unsigned m = k >> 16; return __builtin_bit_cast(float, (m ^ ((m & 0x8000u) ? 0x8000u : 0xffffu)) << 16); }
#define INS16(a, x) do { _Pragma("unroll") for (int _j = 0; _j < 16; ++_j) { const unsigned _t = a[_j] > x ? a[_j] : x; x = a[_j] > x ? x : a[_j]; a[_j] = _t; } } while (0)
__device__ __forceinline__ void p6_topk(Frame& F, const Ptrs& P) {
    unsigned char* ws = P.ws; const bf16* ST = (const bf16*)(ws + WS_ST); int* EXP = (int*)(ws + WS_EG); float* GT = (float*)(ws + WS_EG + 8 * MiB);
    LAS unsigned* lsc = (LAS unsigned*)F.lds;
    pg8::StaticOrder S8; S8.init(T, 2048, F.G, F.bid);
    pg8::Unit uq;
    const size_t cbase = (size_t)F.bid * 512 + F.tid, CNGT = (size_t)F.G * 512; int citem = 0;
    for (int ii = F.wave >> 2; S8.next(ii, uq); ii += 2) {
        const int hd = uq.pn, tok = uq.pm * 256 + (F.wave & 3) * 64 + F.lane;
        const bf16* sp = ST + (size_t)hd * 256 * T + tok;
        unsigned a1[16], a2[16];
#pragma unroll
        for (int j = 0; j < 16; ++j) { a1[j] = 0u; a2[j] = 0u; }
#pragma unroll 1
        for (int g = 0; g < 8; ++g) {
            f32x4 cv0[4], cv1[4]; const size_t ci0 = cbase + (size_t)citem * CNGT, ci1 = ci0 + CNGT; const bool ok0 = CONV_IN_TOPK && ci0 < 2 * CONV_N16, ok1 = CONV_IN_TOPK && ci1 < 2 * CONV_N16;
            unsigned short rr1[16], rr2[16];
#pragma unroll
            for (int q = 0; q < 16; ++q) { const int n = 16 * g + q; rr1[q] = sp[(size_t)n * T]; rr2[q] = sp[(size_t)(PNK + n) * T]; }
            asm volatile("" ::: "memory");
            if (ok0) conv_load(P, ci0, cv0);
            if (ok1) conv_load(P, ci1, cv1);
            unsigned g1[16], g2[16];
#pragma unroll
            for (int q = 0; q < 16; ++q) { const int n = 16 * g + q; const unsigned short r1 = rr1[q], r2 = rr2[q];
                g1[q] = (((unsigned)r1 ^ ((r1 & 0x8000u) ? 0xffffu : 0x8000u)) << 16) | (unsigned)(127 - n);
                g2[q] = (((unsigned)r2 ^ ((r2 & 0x8000u) ? 0xffffu : 0x8000u)) << 16) | (unsigned)(127 - n); }
            SORT16_DESC(g1); SORT16_DESC(g2);
            if (g == 0) {
#pragma unroll
                for (int q = 0; q < 16; ++q) { a1[q] = g1[q]; a2[q] = g2[q]; }
            } else {
#pragma unroll
                for (int q = 0; q < 16; ++q) { a1[q] = a1[q] > g1[15 - q] ? a1[q] : g1[15 - q]; a2[q] = a2[q] > g2[15 - q] ? a2[q] : g2[15 - q]; }
                MERGE16_DESC(a1); MERGE16_DESC(a2);
            }
            if (ok0) conv_store(P, ci0, cv0);
            if (ok1) conv_store(P, ci1, cv1);
            citem += 2;
            __builtin_amdgcn_sched_barrier(0);
        }
#pragma unroll
        for (int i = 0; i < 16; ++i) { lsc[i * 512 + F.tid] = a1[i]; lsc[(16 + i) * 512 + F.tid] = a2[i]; }
        unsigned kb[16];
#pragma unroll
        for (int j = 0; j < 16; ++j) kb[j] = 0u;
#pragma unroll
        for (int i = 0; i < 16; ++i) {
            const float s1 = key_val(a1[i]);
#pragma unroll
            for (int j = 0; j < 16; ++j) if ((i + 1) * (j + 1) <= 16) {
                unsigned xk = (mono32(s1 + key_val(a2[j])) & 0xffffff00u) | (unsigned)(i * 16 + j);
                INS16(kb, xk);
                __builtin_amdgcn_sched_barrier(0);
            }
        }
        float sv[16]; unsigned ev[16]; float smax = -3e38f;
#pragma unroll
        for (int q = 0; q < 16; ++q) { const unsigned i = (kb[q] >> 4) & 15u, j = kb[q] & 15u; const unsigned k1 = lsc[i * 512 + F.tid], k2 = lsc[(16 + j) * 512 + F.tid];
            sv[q] = key_val(k1) + key_val(k2); ev[q] = (127u - (k1 & 127u)) * 128u + (127u - (k2 & 127u)); smax = fmaxf(smax, sv[q]); }
        float gs = 0.f;
#pragma unroll
        for (int q = 0; q < 16; ++q) { sv[q] = __expf(sv[q] - smax); gs += sv[q]; }
        const float ig = 1.0f / gs;
        int* ep = EXP + (size_t)tok * 128 + hd * 16; float* gp = GT + (size_t)tok * 128 + hd * 16;
#pragma unroll
        for (int q = 0; q < 4; ++q) { *(v4u*)(ep + 4 * q) = (v4u){ev[4 * q], ev[4 * q + 1], ev[4 * q + 2], ev[4 * q + 3]};
            *(f32x4*)(gp + 4 * q) = (f32x4){sv[4 * q] * ig, sv[4 * q + 1] * ig, sv[4 * q + 2] * ig, sv[4 * q + 3] * ig}; }
    }
    if (CONV_IN_TOPK) for (;; ++citem) { const size_t ci = cbase + (size_t)citem * CNGT; if (ci >= 2 * CONV_N16) break; f32x4 cv[4]; conv_load(P, ci, cv); conv_store(P, ci, cv); }
}
__device__ __forceinline__ float dot8(const v4u w, const float* h) {
    return h[0] * bflo(w.x) + h[1] * bfhi(w.x) + h[2] * bflo(w.y) + h[3] * bfhi(w.y) + h[4] * bflo(w.z) + h[5] * bfhi(w.z) + h[6] * bflo(w.w) + h[7] * bfhi(w.w);
}
__device__ __forceinline__ void axpy8(float* acc, float c, const v4u w) {
    acc[0] += c * bflo(w.x); acc[1] += c * bfhi(w.x); acc[2] += c * bflo(w.y); acc[3] += c * bfhi(w.y); acc[4] += c * bflo(w.z); acc[5] += c * bfhi(w.z); acc[6] += c * bflo(w.w); acc[7] += c * bfhi(w.w);
}
#ifndef PB
#define PB 8
#endif
__device__ __forceinline__ void p7_peer(Frame& F, const Ptrs& P, float* dst) {
    unsigned char* ws = P.ws; const bf16* H2 = (const bf16*)(ws + WS_H2); const int* EXP = (const int*)(ws + WS_EG); const float* GT = (const float*)(ws + WS_EG + 8 * MiB);
    const bf16* U = (const bf16*)(ws + WS_UV); const bf16* V = U + (size_t)NEXP * DM; float* out = P.out;
    const int gw = F.bid * NWAVES + F.wave, NGW = F.G * NWAVES, lane = F.lane;
    for (int tok = gw; tok < T; tok += NGW) {
        float hv[16], acc[16];
        { const v4u h0 = *(const v4u*)(H2 + (size_t)tok * DM + 8 * lane), h1 = *(const v4u*)(H2 + (size_t)tok * DM + 512 + 8 * lane);
          hv[0] = bflo(h0.x); hv[1] = bfhi(h0.x); hv[2] = bflo(h0.y); hv[3] = bfhi(h0.y); hv[4] = bflo(h0.z); hv[5] = bfhi(h0.z); hv[6] = bflo(h0.w); hv[7] = bfhi(h0.w);
          hv[8] = bflo(h1.x); hv[9] = bfhi(h1.x); hv[10] = bflo(h1.y); hv[11] = bfhi(h1.y); hv[12] = bflo(h1.z); hv[13] = bfhi(h1.z); hv[14] = bflo(h1.w); hv[15] = bfhi(h1.w); }
#pragma unroll
        for (int e = 0; e < 16; ++e) acc[e] = 0.f;
        int e_lo = EXP[(size_t)tok * 128 + lane], e_hi = EXP[(size_t)tok * 128 + 64 + lane];
        float g_lo = GT[(size_t)tok * 128 + lane], g_hi = GT[(size_t)tok * 128 + 64 + lane];
#ifndef PEER_NOSORT
        {
            LAS unsigned* le = (LAS unsigned*)(F.lds + F.wave * 1024); LAS float* lg = (LAS float*)(le + 128);
            const unsigned b_lo = (unsigned)e_lo >> 9, b_hi = (unsigned)e_hi >> 9; unsigned pos_lo = 0, pos_hi = 0, base = 0;
            for (unsigned bk = 0; bk < 32; ++bk) {
                const unsigned long long mlo = __ballot(b_lo == bk), mhi = __ballot(b_hi == bk);
                const unsigned clo = (unsigned)__popcll(mlo), chi = (unsigned)__popcll(mhi);
                if (b_lo == bk) pos_lo = base + __builtin_amdgcn_mbcnt_hi((unsigned)(mlo >> 32), __builtin_amdgcn_mbcnt_lo((unsigned)mlo, 0u));
                if (b_hi == bk) pos_hi = base + clo + __builtin_amdgcn_mbcnt_hi((unsigned)(mhi >> 32), __builtin_amdgcn_mbcnt_lo((unsigned)mhi, 0u));
                base += clo + chi;
            }
            le[pos_lo] = (unsigned)e_lo; lg[pos_lo] = g_lo; le[pos_hi] = (unsigned)e_hi; lg[pos_hi] = g_hi;
            LDS_WAIT(); asm volatile("" ::: "memory");
            e_lo = (int)le[lane]; e_hi = (int)le[64 + lane]; g_lo = lg[lane]; g_hi = lg[64 + lane];
            LDS_WAIT(); asm volatile("" ::: "memory");
        }
#endif
        for (int k = 0; k < 128; k += PB) {
            int ex[PB]; float gg[PB]; v4u u0[PB], u1[PB], v0[PB], v1[PB];
#pragma unroll
            for (int q = 0; q < PB; ++q) { const int kk = k + q; ex[q] = __shfl(kk < 64 ? e_lo : e_hi, kk & 63); gg[q] = __shfl(kk < 64 ? g_lo : g_hi, kk & 63); }
#pragma unroll
            for (int q = 0; q < PB; ++q) { const bf16* up = U + (size_t)ex[q] * DM + 8 * lane; const bf16* vp = V + (size_t)ex[q] * DM + 8 * lane;
                u0[q] = *(const v4u*)up; u1[q] = *(const v4u*)(up + 512); v0[q] = *(const v4u*)vp; v1[q] = *(const v4u*)(vp + 512); }
            float d[PB];
#pragma unroll
            for (int q = 0; q < PB; ++q) d[q] = dot8(u0[q], hv) + dot8(u1[q], hv + 8);
#pragma unroll
            for (int o = 1; o < 64; o <<= 1) {
#pragma unroll
                for (int q = 0; q < PB; ++q) d[q] += __shfl_xor(d[q], o);
            }
#pragma unroll
            for (int q = 0; q < PB; ++q) { const float z = d[q]; const float a = 0.5f * z * (1.0f + erff(z * 0.70710678118654752f)); const float c = gg[q] * a; axpy8(acc, c, v0[q]); axpy8(acc + 8, c, v1[q]); }
        }
        float* op = out + (size_t)tok * DM + 8 * lane;
        f32x4 x0 = *(const f32x4*)op, x1 = *(const f32x4*)(op + 4), x2 = *(const f32x4*)(op + 512), x3 = *(const f32x4*)(op + 516);
        x0 += (f32x4){acc[0], acc[1], acc[2], acc[3]}; x1 += (f32x4){acc[4], acc[5], acc[6], acc[7]}; x2 += (f32x4){acc[8], acc[9], acc[10], acc[11]}; x3 += (f32x4){acc[12], acc[13], acc[14], acc[15]};
        float* wp = dst + (size_t)tok * DM + 8 * lane;
        *(f32x4*)wp = x0; *(f32x4*)(wp + 4) = x1; *(f32x4*)(wp + 512) = x2; *(f32x4*)(wp + 516) = x3;
    }
}

typedef float f32x2v __attribute__((ext_vector_type(2)));
typedef _Float16 f16x2v __attribute__((ext_vector_type(2)));
constexpr size_t WS_PART = WS_ST;
constexpr size_t WS_CG = WS_ACT + 32 * MiB;
__device__ __forceinline__ void fp8x16_to_f32(const v4u w, float* f) {
#pragma unroll
    for (int q = 0; q < 4; ++q) { const f32x2v lo = __builtin_amdgcn_cvt_pk_f32_fp8((int)w[q], false), hi = __builtin_amdgcn_cvt_pk_f32_fp8((int)w[q], true); f[4 * q] = lo.x; f[4 * q + 1] = lo.y; f[4 * q + 2] = hi.x; f[4 * q + 3] = hi.y; }
}
__device__ __forceinline__ float fmac_s(float acc, float a, float b) { asm("v_fmac_f32_e32 %0, %1, %2" : "+v"(acc) : "v"(a), "v"(b)); return acc; }
__device__ __forceinline__ void p7u_dots(Frame& F, const Ptrs& P) {
    unsigned char* ws = P.ws; const bf16* H2 = (const bf16*)(ws + WS_H2); const int* EXP = (const int*)(ws + WS_EG); const unsigned char* U8 = ws + WS_UV8; float* PART = (float*)(ws + WS_PART); const float* SS = (const float*)(ws + WS_SUMSQ);
    const int lane = F.lane, ti = lane >> 3, c = lane & 7;
#define PU_LOADW(ch, W) do { const int* wp_ = EXP + (size_t)(tbase + 8 * ((ch) >> 3) + ti) * 128 + ((ch) & 7) * 16; _Pragma("unroll") for (int q = 0; q < 4; ++q) W[q] = *(const v4u*)(wp_ + 4 * q); } while (0)
#define PU_LOADH(tg, h0, h1, ssx) do { const int t_ = tbase + 8 * (tg) + ti; ssx = SS[t_]; h0 = *(const v4u*)(H2 + (size_t)t_ * DM + hoff); h1 = *(const v4u*)(H2 + (size_t)t_ * DM + hoff + 8); } while (0)
#define PU_ISSUE(W, ul) do { _Pragma("unroll") for (int it = 0; it < 16; ++it) { const unsigned ev = W[it >> 2][it & 3]; ul[it] = *(const v4u*)(U8 + (size_t)ev * DM + (((x + ev) & 7) << 7) + 16 * c); } } while (0)
#define PU_COMPUTE(ch, ul) do { const bool keep = (((ch) & 7) == c); \
        _Pragma("unroll") for (int it = 0; it < 16; ++it) { f32x2v s2 = {0.f, 0.f}; \
            _Pragma("unroll") for (int q = 0; q < 4; ++q) { const f32x2v lo = __builtin_amdgcn_cvt_pk_f32_fp8((int)ul[it][q], false), hi2 = __builtin_amdgcn_cvt_pk_f32_fp8((int)ul[it][q], true); s2 += hv[2 * q] * lo; s2 += hv[2 * q + 1] * hi2; } \
            const float s = dpp_sum8(s2.x + s2.y) * rstd; res[it] = keep ? s : res[it]; } \
        if (((ch) & 7) == 7) { float* pp = PART + ((size_t)x * T + (tbase + 8 * ((ch) >> 3) + ti)) * 128 + 16 * c; \
            _Pragma("unroll") for (int q = 0; q < 4; ++q) *(f32x4*)(pp + 4 * q) = (f32x4){res[4 * q], res[4 * q + 1], res[4 * q + 2], res[4 * q + 3]}; } } while (0)
#define PU_SETH(h0, h1, ssx) do { rstd = rsqrtf(ssx * (1.0f / DM) + EPS); \
        hv[0] = (f32x2v){bflo(h0.x), bfhi(h0.x)}; hv[1] = (f32x2v){bflo(h0.y), bfhi(h0.y)}; hv[2] = (f32x2v){bflo(h0.z), bfhi(h0.z)}; hv[3] = (f32x2v){bflo(h0.w), bfhi(h0.w)}; \
        hv[4] = (f32x2v){bflo(h1.x), bfhi(h1.x)}; hv[5] = (f32x2v){bflo(h1.y), bfhi(h1.y)}; hv[6] = (f32x2v){bflo(h1.z), bfhi(h1.z)}; hv[7] = (f32x2v){bflo(h1.w), bfhi(h1.w)}; } while (0)
    for (int vb = F.bid; vb < 256; vb += F.G) {
        const int x = vb & 7, j = vb >> 3; const int tbase = 512 * j + 64 * F.wave;
        const size_t hoff = 128 * x + 16 * c;
        v4u WA[4], WB[4], ulA[16], ulB[16], hn0, hn1; float ssn, rstd, res[16]; f32x2v hv[8];
#pragma unroll
        for (int q = 0; q < 16; ++q) res[q] = 0.f;
        PU_LOADH(0, hn0, hn1, ssn); PU_LOADW(0, WA); PU_LOADW(1, WB);
        PU_ISSUE(WA, ulA);
        for (int ch = 0; ch < 64; ch += 2) {
            const int c2 = ch + 2 < 63 ? ch + 2 : 63, c3 = ch + 3 < 63 ? ch + 3 : 63;
            if ((ch & 7) == 0) { PU_SETH(hn0, hn1, ssn); const int tgn = (ch >> 3) + 1 < 8 ? (ch >> 3) + 1 : 7; PU_LOADH(tgn, hn0, hn1, ssn); }
            PU_ISSUE(WB, ulB);
            PU_LOADW(c2, WA);
            PU_COMPUTE(ch, ulA);
            PU_ISSUE(WA, ulA);
            PU_LOADW(c3, WB);
            PU_COMPUTE(ch + 1, ulB);
        }
    }
#undef PU_LOADW
#undef PU_LOADH
#undef PU_ISSUE
#undef PU_COMPUTE
#undef PU_SETH
}
__device__ __forceinline__ void p7z_gate(Frame& F, const Ptrs& P) {
    unsigned char* ws = P.ws; const float* PART = (const float*)(ws + WS_PART); const float* GT = (const float*)(ws + WS_EG + 8 * MiB); const int* EXP = (const int*)(ws + WS_EG); unsigned* CG = (unsigned*)(ws + WS_CG);
    const size_t gt = (size_t)F.bid * 512 + F.tid, NGT = (size_t)F.G * 512, n4 = (size_t)T * 128 / 4;
    for (size_t i = gt; i < n4; i += NGT) {
        f32x4 z = *(const f32x4*)(PART + i * 4);
#pragma unroll
        for (int x = 1; x < 8; ++x) z += *(const f32x4*)(PART + (size_t)x * T * 128 + i * 4);
        const f32x4 g = *(const f32x4*)(GT + i * 4); const v4u e = *(const v4u*)(EXP + i * 4); v4u o;
#pragma unroll
        for (int q = 0; q < 4; ++q) { const float zz = z[q] * (1.0f / 512.0f); const float cgv = g[q] * 0.5f * zz * (1.0f + erff(zz * 0.70710678118654752f)); o[q] = ((unsigned)__builtin_bit_cast(unsigned short, (_Float16)cgv) << 16) | e[q]; }
        *(v4u*)(CG + i * 4) = o;
    }
}
__device__ __forceinline__ float sum_hi8(float v) {
    v += __builtin_bit_cast(float, __builtin_amdgcn_mov_dpp(__builtin_bit_cast(int, v), 0x128, 0xF, 0xF, true));
    v += __shfl_xor(v, 16); v += __shfl_xor(v, 32);
    return v;
}
template <int MODE> __device__ __forceinline__ void p7v_accum(Frame& F, const Ptrs& P, float* dst) {
    unsigned char* ws = P.ws; const unsigned* CG = (const unsigned*)(ws + WS_CG); const unsigned char* V8 = ws + WS_UV8 + 16 * MiB; const float* x1 = P.out;
    const int lane = F.lane, ti = lane >> 3, c = lane & 7;
#define PV_LOADW(ch, W) do { const unsigned* wp_ = CG + (size_t)(tbase + 8 * ((ch) >> 3) + ti) * 128 + ((ch) & 7) * 16; _Pragma("unroll") for (int q = 0; q < 4; ++q) W[q] = *(const v4u*)(wp_ + 4 * q); } while (0)
#define PV_ISSUE(W, vl, cg) do { _Pragma("unroll") for (int it = 0; it < 16; ++it) { const unsigned w = W[it >> 2][it & 3]; cg[it] = __builtin_amdgcn_perm(w, w, 0x03020302u); \
        const unsigned ev = MODE == 2 ? (w & 7u) : (w & 0xffffu); vl[it] = *(const v4u*)(V8 + (size_t)ev * DM + (((x + ev) & 7) << 7) + 16 * c); } } while (0)
#define PV_COMPUTE(ch, vl, cg) do { \
        if (MODE == 1) { _Pragma("unroll") for (int it = 0; it < 16; ++it) acc[it & 7] += __builtin_bit_cast(f16x2v, (vl[it][0] ^ vl[it][1] ^ vl[it][2] ^ vl[it][3]) & 0x03ff03ffu) * __builtin_bit_cast(f16x2v, cg[it]); } else \
        _Pragma("unroll") for (int it = 0; it < 16; ++it) { const f16x2v cg2 = __builtin_bit_cast(f16x2v, cg[it]); \
            _Pragma("unroll") for (int q = 0; q < 4; ++q) { const f16x2v lo = __builtin_bit_cast(f16x2v, __builtin_amdgcn_perm(vl[it][q], vl[it][q], 0x010C000Cu)), hi2 = __builtin_bit_cast(f16x2v, __builtin_amdgcn_perm(vl[it][q], vl[it][q], 0x030C020Cu)); \
                if (it & 1) { acd[2 * q] = cg2 * lo + acd[2 * q]; acd[2 * q + 1] = cg2 * hi2 + acd[2 * q + 1]; } else { acc[2 * q] = cg2 * lo + acc[2 * q]; acc[2 * q + 1] = cg2 * hi2 + acc[2 * q + 1]; } } } \
        if ((((ch) & 7) == 7)) { const size_t off = (size_t)(tbase + 8 * ((ch) >> 3) + ti) * DM + hoff; \
            _Pragma("unroll") for (int q = 0; q < 4; ++q) { f32x4 v = __builtin_nontemporal_load((const f32x4*)(x1 + off + 4 * q)); \
                v += (f32x4){(float)acc[2 * q].x + (float)acd[2 * q].x, (float)acc[2 * q].y + (float)acd[2 * q].y, (float)acc[2 * q + 1].x + (float)acd[2 * q + 1].x, (float)acc[2 * q + 1].y + (float)acd[2 * q + 1].y} * (1.0f / 512.0f); \
                *(f32x4*)(dst + off + 4 * q) = v; } \
            _Pragma("unroll") for (int q = 0; q < 8; ++q) { acc[q] = (f16x2v){(_Float16)0.f, (_Float16)0.f}; acd[q] = acc[q]; } } } while (0)
    for (int vb = F.bid; vb < 256; vb += F.G) {
        const int x = vb & 7, j = vb >> 3; const int tbase = 512 * j + 64 * F.wave;
        const size_t hoff = 128 * x + 16 * c;
        v4u WA[4], WB[4], vlA[16], vlB[16]; unsigned cgA[16], cgB[16]; f16x2v acc[8], acd[8];
#pragma unroll
        for (int q = 0; q < 8; ++q) { acc[q] = (f16x2v){(_Float16)0.f, (_Float16)0.f}; acd[q] = acc[q]; }
        PV_LOADW(0, WA); PV_LOADW(1, WB);
        PV_ISSUE(WA, vlA, cgA);
        for (int ch = 0; ch < 64; ch += 2) {
            const int c2 = ch + 2 < 63 ? ch + 2 : 63, c3 = ch + 3 < 63 ? ch + 3 : 63;
            PV_ISSUE(WB, vlB, cgB);
            PV_LOADW(c2, WA);
            PV_COMPUTE(ch, vlA, cgA);
            PV_ISSUE(WA, vlA, cgA);
            PV_LOADW(c3, WB);
            PV_COMPUTE(ch + 1, vlB, cgB);
        }
    }
#undef PV_LOADW
#undef PV_ISSUE
#undef PV_COMPUTE
}

struct MirrorOrder {
    pg8::StaticOrder S8;
    __device__ __forceinline__ bool next(int i, pg8::Unit& u) const { pg8::Unit v; if (!S8.next(i, v)) return false; u.pm = v.pn; u.pn = v.pm; return true; }
    __device__ __forceinline__ void a_ready(const pg8::Unit&) const {}
    __device__ __forceinline__ void done(const pg8::Unit&) const {}
};
struct Args { const float* in[14]; float* out; unsigned char* ws; int ph_lo, ph_hi; };
#ifdef PEER_BF16
constexpr int N_PHASES = 12;
#else
constexpr int N_PHASES = 14;
#endif
#ifndef MK_PER_PHASE
#define MK_PER_PHASE 0
#endif

__global__ void __launch_bounds__(NWAVES * 64, 2) hybrid_fwd(Args args) {
    extern __shared__ __attribute__((aligned(16))) unsigned char lds[];
    Frame F;
    F.lds = (LAS unsigned char*)lds; F.MISC = (volatile LAS unsigned*)(F.lds + MISC_OFF);
    F.tid = threadIdx.x; F.lane = F.tid & 63; F.wave = __builtin_amdgcn_readfirstlane(F.tid >> 6); F.G = gridDim.x; F.bid = blockIdx.x;
    F.ctl = (gu32*)(args.ws + WS_CTL);
    if (F.tid < 64) ((LAS unsigned*)(F.lds + MISC_OFF))[F.tid] = 0u;
    __syncthreads();
    XcdBarrier bar; bar.bar = (unsigned*)(F.ctl + CW_BAR); bar.x = 0; bar.st = nullptr;
    if (!MK_PER_PHASE) bar = xcd_barrier_post((unsigned*)(F.ctl + CW_BAR), F.MISC + 8);
    const int lo = args.ph_lo, hi = args.ph_hi;
#define LOADP() { int t_ = threadIdx.x; asm volatile("" : "+v"(t_)); F.tid = t_; F.lane = t_ & 63; F.wave = __builtin_amdgcn_readfirstlane(t_ >> 6); } Ptrs P; { const __attribute__((address_space(4))) Args* ap = (const __attribute__((address_space(4))) Args*)__builtin_amdgcn_kernarg_segment_ptr(); asm volatile("" : "+s"(ap)); \
    P.x = ap->in[0]; P.mix_g = ap->in[1]; P.w_in = ap->in[2]; P.ret_w = ap->in[3]; P.q_gain = ap->in[4]; P.k_gain = ap->in[5]; P.moba_w = ap->in[6]; P.rel_bias = ap->in[7]; \
    P.w_out = ap->in[8]; P.ffn_g = ap->in[9]; P.peer_wq = ap->in[10]; P.sub_keys = ap->in[11]; P.peer_u = ap->in[12]; P.peer_v = ap->in[13]; P.out = ap->out; P.ws = ap->ws; } \
    unsigned char* ws = P.ws; bf16* XN = (bf16*)P.out; bf16* RETG = (bf16*)P.out; bf16* ATT = (bf16*)((unsigned char*)P.out + 32 * MiB); (void)ws; (void)XN; (void)RETG; (void)ATT;
#ifdef RET_NAIVE
#define RET_FN p3a_retention
#else
#define RET_FN p3a_retention_mfma
#endif
#ifdef MOBA_NAIVE
#define MOBA_FN p3b_moba
#else
#define MOBA_FN p3b_moba_mfma<0>
#endif
#ifndef DUP_MASK
#define DUP_MASK 0
#endif
#ifndef DUPPH
#define DUPPH 0
#endif
#define REPS(k) ((((DUPPH) >> (k)) & 1) ? 2 : 1)
#ifndef PH_MASK
#define PH_MASK 0xFFFF
#endif
#define IN(k) (((PH_MASK >> (k)) & 1) && lo <= (k) && (k) < hi)
#define LOCAL_SEAM(k) do { if (MK_PER_PHASE) {} } while (0)
#define SEAM(k) do { if (IN(k) && IN((k) + 1)) xcd_barrier(bar); } while (0)
    LAS unsigned char* ring = F.lds;

    if (IN(0)) for (int rep_ = 0; rep_ < REPS(0); ++rep_) { LOADP(); p0_prologue(F, P); } SEAM(0);
    if (IN(1)) for (int rep_ = 0; rep_ < REPS(1); ++rep_) { LOADP();
        pg8::Gemm g{XN, (const bf16*)(ws + WS_WIN), T, INW, DM, DM, DM, 0}; pg8::StaticOrder S; S.init(T, INW, F.G, F.bid);
        EpiInProj E{(bf16*)(ws + WS_RQ), (bf16*)(ws + WS_RK), (bf16*)(ws + WS_RV), (bf16*)(ws + WS_RG), (bf16*)(ws + WS_MQ), (bf16*)(ws + WS_MK), (bf16*)(ws + WS_MV), (bf16*)(ws + WS_GA), (bf16*)(ws + WS_GB),
                    (const float*)(ws + WS_ROPE), P.q_gain, P.k_gain, (float*)(ws + WS_KM)};
        pg8::gemm_phase<EpiInProj, pg8::StaticOrder, true, true>(ring, g, S, E);
        { const int nunit = (T / 256) * (INW / 256), rem = nunit % F.G;
          if (rem == 0) p0b_late_weights(F, P, F.bid, F.G); else if (F.bid >= rem) p0b_late_weights(F, P, F.bid - rem, F.G - rem); }
    } SEAM(1);
#ifdef EXTRA_BARS
    for (int xb_ = 0; xb_ < EXTRA_BARS; ++xb_) xcd_barrier(bar);
#endif
    if (IN(2)) for (int rep_ = 0; rep_ < REPS(2); ++rep_) { LOADP(); p2a_kv_mfma(F, P); } SEAM(2);
    if (IN(3)) for (int rep_ = 0; rep_ < REPS(3); ++rep_) { LOADP(); p2b_scan(F, P); } SEAM(3);
    if (IN(4)) for (int rep_ = 0; rep_ < REPS(4); ++rep_) { LOADP(); RET_FN(F, P); if (DUP_MASK & 1) RET_FN(F, P); MOBA_FN(F, P); if (DUP_MASK & 2) MOBA_FN(F, P);
#ifdef MOBA_ABL
        p3b_moba_mfma<MOBA_ABL>(F, P);
#endif
    } SEAM(4);
    if (IN(5)) for (int rep_ = 0; rep_ < REPS(5); ++rep_) { LOADP();
        pg8::Gemm g0{ATT, (const bf16*)(ws + WS_WB), T, DM, 512, 512, 512, 0}, g1{RETG, (const bf16*)(ws + WS_WA), T, DM, DM, DM, DM, 0};
        TwoSegOrder S; S.B.init(T, DM, F.G, F.bid);
        EpiMerge2 E{(bf16*)(ws + WS_MRG), (const bf16*)(ws + WS_GA), (const bf16*)(ws + WS_GB)};
        pg8::gemm_phase2<EpiMerge2, TwoSegOrder, true, true>(ring, g0, g1, S, E);
    } SEAM(5);
    if (IN(6)) for (int rep_ = 0; rep_ < REPS(6); ++rep_) { LOADP();
        pg8::Gemm g{(const bf16*)(ws + WS_MRG), (const bf16*)(ws + WS_WO), T, DM, DM, DM, DM, 0}; pg8::StaticOrder S; S.init(T, DM, F.G, F.bid);
        EpiResid E{P.x, P.out, (bf16*)(ws + WS_H2), P.ffn_g, (float*)(ws + WS_SUMSQ)};
        pg8::gemm_phase<EpiResid, pg8::StaticOrder, true, true>(ring, g, S, E);
    } SEAM(6);
    if (IN(9)) for (int rep_ = 0; rep_ < REPS(9); ++rep_) { LOADP();
        pg8::Gemm g{(const bf16*)(ws + WS_WQ), (const bf16*)(ws + WS_H2), PH * 256, T, DM, DM, DM, 0}; MirrorOrder S; S.S8.init(T, 2048, F.G, F.bid);
        EpiNatBf16 E{(bf16*)(ws + WS_ST), T, (const float*)(ws + WS_SUMSQ)};
        pg8::gemm_phase<EpiNatBf16, MirrorOrder, true, true>(ring, g, S, E);
        VM_WAIT(); __syncthreads();
    } LOCAL_SEAM(9);
    if (IN(10)) for (int rep_ = 0; rep_ < REPS(10); ++rep_) { LOADP(); p6_topk(F, P); } SEAM(10);
#ifdef PEER_BF16
    if (IN(11)) for (int rep_ = 0; rep_ < REPS(11); ++rep_) { LOADP(); if (DUP_MASK & 4) p7_peer(F, P, (float*)(ws + WS_ST)); p7_peer(F, P, P.out); }
#else
    if (IN(11)) for (int rep_ = 0; rep_ < REPS(11); ++rep_) { LOADP(); p7u_dots(F, P); if (DUP_MASK & 4) p7u_dots(F, P); } SEAM(11);
    if (IN(12)) for (int rep_ = 0; rep_ < REPS(12); ++rep_) { LOADP(); p7z_gate(F, P); } SEAM(12);
    if (IN(13)) for (int rep_ = 0; rep_ < REPS(13); ++rep_) { LOADP(); if (DUP_MASK & 16) p7v_accum<0>(F, P, (float*)(ws + WS_PART)); if (DUP_MASK & 32) p7v_accum<1>(F, P, (float*)(ws + WS_PART)); if (DUP_MASK & 64) p7v_accum<2>(F, P, (float*)(ws + WS_PART)); p7v_accum<0>(F, P, P.out); }
#endif
#undef IN
#undef SEAM
}

extern "C" void kernel_launch(void* const* d_in, const int* in_sizes, int n_in, void* d_out, int out_size, void* d_ws, size_t ws_size, hipStream_t stream) {
    static int grid = 0;
    if (grid == 0) {
        if (n_in != 14 || out_size != T * DM || ws_size < WS_END) { fprintf(stderr, "kernel_launch: unexpected problem (n_in %d, out %d, ws %zu); nothing launched\n", n_in, out_size, ws_size); grid = -1; return; }
        int dev = 0, cus = 0, per_cu = 0;
        if (hipGetDevice(&dev) != hipSuccess || hipDeviceGetAttribute(&cus, hipDeviceAttributeMultiprocessorCount, dev) != hipSuccess) { grid = -1; return; }
        if (hipFuncSetAttribute((const void*)hybrid_fwd, hipFuncAttributeMaxDynamicSharedMemorySize, LDS_BYTES) != hipSuccess) { fprintf(stderr, "kernel_launch: hipFuncSetAttribute failed\n"); grid = -1; return; }
        if (hipOccupancyMaxActiveBlocksPerMultiprocessor(&per_cu, (const void*)hybrid_fwd, NWAVES * 64, LDS_BYTES) != hipSuccess || per_cu < 1)
            fprintf(stderr, "kernel_launch: note: occupancy query reports %d workgroups per CU\n", per_cu);
        (void)hipGetLastError();
        grid = cus;
    }
    if (grid < 0) return;
    (void)hipMemsetAsync((char*)d_ws + WS_CTL, 0, CTL_ZERO_BYTES, stream);
    Args a{};
    for (int i = 0; i < 14; ++i) a.in[i] = (const float*)d_in[i];
    a.out = (float*)d_out; a.ws = (unsigned char*)d_ws;
#if MK_PER_PHASE
    for (int p = 0; p < N_PHASES; ++p) { a.ph_lo = p; a.ph_hi = p + 1; hipLaunchKernelGGL(hybrid_fwd, dim3(grid), dim3(NWAVES * 64), LDS_BYTES, stream, a); }
#else
    a.ph_lo = 0; a.ph_hi = N_PHASES;
    hipLaunchKernelGGL(hybrid_fwd, dim3(grid), dim3(NWAVES * 64), LDS_BYTES, stream, a);
#endif
}
```

```cpp
#include <hip/hip_runtime.h>
#include <cstdio>
#include <cstdint>

#define GAS __attribute__((address_space(1)))
#define LAS __attribute__((address_space(3)))
typedef unsigned short bf16;
typedef unsigned v4u __attribute__((ext_vector_type(4)));
typedef unsigned v2u __attribute__((ext_vector_type(2)));
typedef float f32x4 __attribute__((ext_vector_type(4)));
typedef short bf16x8 __attribute__((ext_vector_type(8)));
typedef float f32x16 __attribute__((ext_vector_type(16)));
typedef GAS unsigned gu32;
#define RLX_AGENT __ATOMIC_RELAXED, __HIP_MEMORY_SCOPE_AGENT
#define LDS_WAIT() asm volatile("s_waitcnt lgkmcnt(0)" ::: "memory")
#define VM_WAIT() asm volatile("s_waitcnt vmcnt(0)" ::: "memory")

constexpr int BATCH = 4, SEQ = 4096, DM = 1024, T = BATCH * SEQ;
constexpr int RH = 8, RDK = 64, RDV = 128, RC = 128, NCH = SEQ / RC;
constexpr int MH = 8, MD = 64, MBLK = 256, NBLK = SEQ / MBLK;
constexpr int PH = 8, PNK = 128, PTOP = 16, PQD = 256;
constexpr int NEXP = PNK * PNK;
constexpr int INW = 6656;
constexpr float EPS = 1e-6f;

__device__ __forceinline__ unsigned f2bf(float f) { unsigned u = __builtin_bit_cast(unsigned, f); return (u + 0x7fffu + ((u >> 16) & 1u)) >> 16; }
typedef float f32x2_t __attribute__((ext_vector_type(2))); typedef __bf16 bf16x2_t __attribute__((ext_vector_type(2)));
__device__ __forceinline__ unsigned pk2(float lo, float hi) { const f32x2_t v = {lo, hi}; const bf16x2_t b = __builtin_convertvector(v, bf16x2_t); return __builtin_bit_cast(unsigned, b); }
__device__ __forceinline__ float bf2f(unsigned short b) { return __builtin_bit_cast(float, (unsigned)b << 16); }
__device__ __forceinline__ float bflo(unsigned w) { return __builtin_bit_cast(float, w << 16); }
__device__ __forceinline__ float bfhi(unsigned w) { return __builtin_bit_cast(float, w & 0xffff0000u); }
__device__ __forceinline__ float wave_sum(float v) {
#pragma unroll
    for (int o = 1; o < 64; o <<= 1) v += __shfl_xor(v, o);
    return v;
}
__device__ __forceinline__ float dpp_sum8(float v) {
    v += __builtin_bit_cast(float, __builtin_amdgcn_mov_dpp(__builtin_bit_cast(int, v), 0xB1, 0xF, 0xF, true));
    v += __builtin_bit_cast(float, __builtin_amdgcn_mov_dpp(__builtin_bit_cast(int, v), 0x4E, 0xF, 0xF, true));
    v += __builtin_bit_cast(float, __builtin_amdgcn_mov_dpp(__builtin_bit_cast(int, v), 0x141, 0xF, 0xF, true));
    return v;
}
__device__ __forceinline__ float ret_l2g(int h) { return log1pf(-exp2f(-5.0f - (float)h)) * 1.4426950408889634f; }

__host__ __device__ __forceinline__ int perm_row_of_col(int a) {
    const int tile = a >> 8, w = a & 255, wc = w >> 6, bj = (w >> 5) & 1, q = w & 31, fq = q >> 3, n = (q >> 2) & 1, e = q & 3;
    return tile * 256 + 128 * bj + 32 * wc + 16 * n + 4 * fq + e;
}
namespace pg8 {
#define PG8_LAS __attribute__((address_space(3)))
typedef unsigned short bf16_t;
typedef short bf16x8 __attribute__((ext_vector_type(8)));
typedef float f32x4 __attribute__((ext_vector_type(4)));
typedef unsigned u32x4 __attribute__((ext_vector_type(4)));
constexpr int BM = 256, BK = 64, HALF = 128, HTB = HALF * BK * 2  , STAGE_BYTES = 8 * HTB, NXCD = 8, WGM = 8;

__host__ __device__ __forceinline__ int lds_byte(int r, int c) { const int st = (r >> 4) * 2 + (c >> 5), rr = r & 15, cc = c & 31, ob = rr * 64 + cc * 2; return st * 1024 + (ob ^ (((ob >> 9) & 1) << 5)); }
__host__ __device__ __forceinline__ void stage_rc(int b, int& R, int& C) { const int st = b / 1024, sb = b % 1024, swz = sb ^ (((sb >> 9) & 1) << 5); R = (st >> 1) * 16 + swz / 64; C = (st & 1) * 32 + (swz % 64) / 2; }
__host__ __device__ __forceinline__ int perm32(int rho) { const int n = rho >> 4, i = rho & 15; return 8 * (i >> 2) + 4 * n + (i & 3); }

struct Unit { int pm, pn, seg; };
struct Gemm { const bf16_t* A; const bf16_t* Bt; int M, N, K, lda, ldb, bpm; };

struct StaticOrder {
    int nM, nN, nwg, G, c;
    __host__ __device__ void init(int M, int N, int G_, int c_) { nM = M / BM; nN = N / BM; nwg = nM * nN; G = G_; c = c_; }
    __host__ __device__ bool next(int i, Unit& u) const {
        const long L = (long)i * G + c; if (L >= nwg) return false;
        int wgid = (int)L; { const int q = nwg / NXCD, r = nwg % NXCD, xcd = wgid % NXCD, off = wgid / NXCD; wgid = (xcd < r ? xcd * (q + 1) : r * (q + 1) + (xcd - r) * q) + off; }
        const int nig = WGM * nN, gid = wgid / nig, fm = gid * WGM, gsz = (nM - fm) < WGM ? (nM - fm) : WGM;
        u.pm = fm + ((wgid % nig) % gsz); u.pn = (wgid % nig) / gsz; u.seg = 0; return true;
    }
    __device__ __forceinline__ void a_ready(const Unit&) const {}
    __device__ __forceinline__ void done(const Unit&) const {}
};


template <class Epi, class Sched, bool ALIGN_EPI = false, bool SP2 = false>
__device__ __forceinline__ void gemm_phase(PG8_LAS unsigned char* lds, const Gemm g, const Sched& S, const Epi& E) {
    int tid_ = threadIdx.x; asm volatile("" : "+v"(tid_));
    const int tid = tid_, wid = __builtin_amdgcn_readfirstlane(tid >> 6), lane = tid & 63, wr = wid >> 2, wc = wid & 3, fr = lane & 15, fq = lane >> 4;
    const int K = g.K, nt = K / BK;
    unsigned voffA[2], voffB[2];
#pragma unroll
    for (int i = 0; i < 2; ++i) { int R, C; stage_rc(tid * 16 + i * 8192, R, C);
        voffA[i] = (unsigned)(R * g.lda + C) * 2u; voffB[i] = (unsigned)(R * g.ldb + C) * 2u; }
    const size_t kstep = (size_t)(BK * 2);
    const size_t hstepA = (size_t)HALF * g.lda * 2, hstepB = (size_t)HALF * g.ldb * 2;
    const size_t tstepA = 2 * hstepA, tstepB = 2 * hstepB;
    const unsigned ldsw = (unsigned)wid * 1024u;
    const int aoff = lds_byte(wr * 64 + fr, fq * 8), boff = lds_byte(wc * 32 + fr, fq * 8);
#define PG8_SA(b, h) (((b) * 2 + (h)) * HTB)
#define PG8_SB(b, h) ((4 + (b) * 2 + (h)) * HTB)
#define PG8_STAGE(bufoff, gbase, voff) do { _Pragma("unroll") for (int _i = 0; _i < 2; ++_i) \
        __builtin_amdgcn_global_load_lds((const unsigned*)((const char*)(gbase) + (voff)[_i]), (PG8_LAS unsigned*)(lds + (bufoff) + ldsw + _i * 8192), 16, 0, 0); } while (0)
#define PG8_LDA(dst, b, h) do { _Pragma("unroll") for (int m = 0; m < 4; ++m) _Pragma("unroll") for (int k = 0; k < 2; ++k) dst[m][k] = *(const PG8_LAS bf16x8*)(lds + PG8_SA(b, h) + aoff + m * 2048 + k * 1024); } while (0)
#define PG8_LDB(dst, b, h) do { _Pragma("unroll") for (int n = 0; n < 2; ++n) _Pragma("unroll") for (int k = 0; k < 2; ++k) dst[n][k] = *(const PG8_LAS bf16x8*)(lds + PG8_SB(b, h) + boff + n * 2048 + k * 1024); } while (0)
#define PG8_MMA(ai, bj, At, Bt) do { __builtin_amdgcn_s_setprio(1); _Pragma("unroll") for (int m = 0; m < 4; ++m) _Pragma("unroll") for (int n = 0; n < 2; ++n) _Pragma("unroll") for (int k = 0; k < 2; ++k) \
        acc[ai][bj][m][n] = __builtin_amdgcn_mfma_f32_16x16x32_bf16(Bt[n][k], At[m][k], acc[ai][bj][m][n], 0, 0, 0); __builtin_amdgcn_s_setprio(0); } while (0)
#define PG8_WAIT_V(n) asm volatile("s_waitcnt vmcnt(" #n ")" ::: "memory")
#define PG8_WAIT_L(n) asm volatile("s_waitcnt lgkmcnt(" #n ")" ::: "memory")
#define PG8_BAR __builtin_amdgcn_s_barrier()
#define PG8_SCHED __builtin_amdgcn_sched_barrier(0)
    Unit cur, nxt; int ui = 0;
    if (!S.next(0, cur)) return;
    f32x4 acc[2][2][4][2];
#pragma unroll
    for (int a = 0; a < 2; ++a)
#pragma unroll
        for (int b = 0; b < 2; ++b)
#pragma unroll
            for (int m = 0; m < 4; ++m)
#pragma unroll
                for (int n = 0; n < 2; ++n) acc[a][b][m][n] = (f32x4){0.f, 0.f, 0.f, 0.f};
    bf16x8 At[4][2], B0[2][2], B1[2][2];
    const char* cA = (const char*)g.A + (size_t)cur.pm * tstepA; const char* cB = (const char*)g.Bt + (size_t)cur.pn * tstepB + (size_t)cur.pm * g.bpm;
    S.a_ready(cur);
    if constexpr (SP2) {
        PG8_STAGE(PG8_SB(0, 0), cB, voffB); PG8_STAGE(PG8_SB(0, 1), cB + hstepB, voffB); PG8_STAGE(PG8_SA(0, 0), cA, voffA); PG8_STAGE(PG8_SA(0, 1), cA + hstepA, voffA);
        if (wr == 1) PG8_BAR;
        PG8_WAIT_V(2); PG8_BAR;
        PG8_STAGE(PG8_SB(1, 0), cB + kstep, voffB); PG8_STAGE(PG8_SA(1, 0), cA + kstep, voffA); PG8_STAGE(PG8_SB(1, 1), cB + hstepB + kstep, voffB);
        PG8_WAIT_V(6); PG8_BAR;
    } else {
        PG8_STAGE(PG8_SB(0, 0), cB, voffB); PG8_STAGE(PG8_SA(0, 0), cA, voffA); PG8_STAGE(PG8_SB(0, 1), cB + hstepB, voffB); PG8_STAGE(PG8_SA(0, 1), cA + hstepA, voffA);
        if (wr == 1) PG8_BAR;
        PG8_WAIT_V(4); PG8_BAR;
        PG8_STAGE(PG8_SB(1, 0), cB + kstep, voffB); PG8_STAGE(PG8_SA(1, 0), cA + kstep, voffA); PG8_STAGE(PG8_SB(1, 1), cB + hstepB + kstep, voffB);
        PG8_WAIT_V(6); PG8_BAR;
    }
    for (;;) {
        const bool has_next = S.next(ui + 1, nxt);
        const char* nA = has_next ? (const char*)g.A + (size_t)nxt.pm * tstepA : cA; const char* nB = has_next ? (const char*)g.Bt + (size_t)nxt.pn * tstepB + (size_t)nxt.pm * g.bpm : cB;
        for (int t = 0; t < nt; t += 2) {
            const bool last = (t == nt - 2);
            const char* a1 = cA + (size_t)(t + 1) * kstep;
            const char* a2 = last ? nA : cA + (size_t)(t + 2) * kstep; const char* b2 = last ? nB : cB + (size_t)(t + 2) * kstep;
            const char* a3 = a2 + kstep; const char* b3 = b2 + kstep;
            if (last && has_next) S.a_ready(nxt);
            if constexpr (SP2) {
            PG8_LDB(B0, 0, 0); PG8_LDB(B1, 0, 1); PG8_SCHED; PG8_LDA(At, 0, 0); PG8_STAGE(PG8_SA(1, 1), a1 + hstepA, voffA);
            PG8_WAIT_V(8); PG8_WAIT_L(0); PG8_BAR; PG8_MMA(0, 0, At, B0); PG8_MMA(0, 1, At, B1); PG8_BAR; PG8_SCHED;
            PG8_LDA(At, 0, 1); PG8_STAGE(PG8_SB(0, 0), b2, voffB); PG8_STAGE(PG8_SB(0, 1), b2 + hstepB, voffB); PG8_STAGE(PG8_SA(0, 0), a2, voffA);
            PG8_WAIT_V(8); PG8_WAIT_L(0); PG8_BAR; PG8_MMA(1, 0, At, B0); PG8_MMA(1, 1, At, B1); PG8_BAR; PG8_SCHED;
            PG8_LDB(B0, 1, 0); PG8_LDB(B1, 1, 1); PG8_SCHED; PG8_LDA(At, 1, 0); PG8_STAGE(PG8_SA(0, 1), a2 + hstepA, voffA);
            PG8_WAIT_V(8); PG8_WAIT_L(0); PG8_BAR; PG8_MMA(0, 0, At, B0); PG8_MMA(0, 1, At, B1); PG8_BAR; PG8_SCHED;
            PG8_LDA(At, 1, 1); PG8_STAGE(PG8_SB(1, 0), b3, voffB); PG8_STAGE(PG8_SB(1, 1), b3 + hstepB, voffB); PG8_STAGE(PG8_SA(1, 0), a3, voffA);
            PG8_WAIT_V(8); PG8_WAIT_L(0); PG8_BAR; PG8_MMA(1, 0, At, B0); PG8_MMA(1, 1, At, B1); PG8_BAR; PG8_SCHED;
            } else {
            PG8_LDB(B0, 0, 0); PG8_SCHED; PG8_LDA(At, 0, 0); PG8_STAGE(PG8_SA(1, 1), a1 + hstepA, voffA);
            PG8_WAIT_L(8); PG8_BAR; PG8_WAIT_L(0); PG8_MMA(0, 0, At, B0); PG8_BAR; PG8_SCHED;
            PG8_LDB(B1, 0, 1); PG8_STAGE(PG8_SB(0, 0), b2, voffB);
            PG8_BAR; PG8_WAIT_L(0); PG8_MMA(0, 1, At, B1); PG8_BAR;
            PG8_LDA(At, 0, 1); PG8_STAGE(PG8_SA(0, 0), a2, voffA);
            PG8_BAR; PG8_WAIT_L(0); PG8_MMA(1, 0, At, B0); PG8_BAR; PG8_SCHED;
            PG8_STAGE(PG8_SB(0, 1), b2 + hstepB, voffB);
            PG8_WAIT_V(6); PG8_BAR; PG8_MMA(1, 1, At, B1); PG8_BAR;
            PG8_LDB(B0, 1, 0); PG8_SCHED; PG8_LDA(At, 1, 0); PG8_STAGE(PG8_SA(0, 1), a2 + hstepA, voffA);
            PG8_WAIT_L(8); PG8_BAR; PG8_WAIT_L(0); PG8_MMA(0, 0, At, B0); PG8_BAR; PG8_SCHED;
            PG8_LDB(B1, 1, 1); PG8_STAGE(PG8_SB(1, 0), b3, voffB);
            PG8_BAR; PG8_WAIT_L(0); PG8_MMA(0, 1, At, B1); PG8_BAR;
            PG8_LDA(At, 1, 1); PG8_STAGE(PG8_SA(1, 0), a3, voffA);
            PG8_BAR; PG8_WAIT_L(0); PG8_MMA(1, 0, At, B0); PG8_BAR; PG8_SCHED;
            PG8_STAGE(PG8_SB(1, 1), b3 + hstepB, voffB);
            PG8_WAIT_V(6); PG8_BAR; PG8_MMA(1, 1, At, B1); PG8_BAR;
            }
        }
        if constexpr (ALIGN_EPI) { if (wr == 0) PG8_BAR; }
        if constexpr (!Epi::AFTER_DRAIN) { E(acc, cur, wr, wc, fr, fq); S.done(cur); }
        if (!has_next) break;
#pragma unroll
        for (int a = 0; a < 2; ++a)
#pragma unroll
            for (int b = 0; b < 2; ++b)
#pragma unroll
                for (int m = 0; m < 4; ++m)
#pragma unroll
                    for (int n = 0; n < 2; ++n) acc[a][b][m][n] = (f32x4){0.f, 0.f, 0.f, 0.f};
        cur = nxt; cA = nA; cB = nB; ++ui;
        if constexpr (ALIGN_EPI) { if (wr == 1) PG8_BAR; }
    }
    PG8_WAIT_V(0);
    if constexpr (!ALIGN_EPI) { if (wr == 0) PG8_BAR; }
    PG8_BAR;
    if constexpr (Epi::AFTER_DRAIN) { E.fused(acc, cur, wr, wc, fr, fq, lds, wid, lane); S.done(cur); }
#undef PG8_SA
#undef PG8_SB
#undef PG8_STAGE
#undef PG8_LDA
#undef PG8_LDB
#undef PG8_MMA
#undef PG8_WAIT_V
#undef PG8_WAIT_L
#undef PG8_BAR
#undef PG8_SCHED
}
template <class Epi, class Sched, bool ALIGN_EPI = false, bool SP2 = false>
__device__ __forceinline__ void gemm_phase2(PG8_LAS unsigned char* lds, const Gemm g0, const Gemm g1, const Sched& S, const Epi& E) {
    int tid_ = threadIdx.x; asm volatile("" : "+v"(tid_));
    const int tid = tid_, wid = __builtin_amdgcn_readfirstlane(tid >> 6), lane = tid & 63, wr = wid >> 2, wc = wid & 3, fr = lane & 15, fq = lane >> 4;
    unsigned voffA0[2], voffB0[2], voffA1[2], voffB1[2];
#pragma unroll
    for (int i = 0; i < 2; ++i) { int R, C; stage_rc(tid * 16 + i * 8192, R, C);
        voffA0[i] = (unsigned)(R * g0.lda + C) * 2u; voffB0[i] = (unsigned)(R * g0.ldb + C) * 2u; voffA1[i] = (unsigned)(R * g1.lda + C) * 2u; voffB1[i] = (unsigned)(R * g1.ldb + C) * 2u; }
    const size_t kstep = (size_t)(BK * 2);
    const size_t hstepA0 = (size_t)HALF * g0.lda * 2, hstepB0 = (size_t)HALF * g0.ldb * 2, hstepA1 = (size_t)HALF * g1.lda * 2, hstepB1 = (size_t)HALF * g1.ldb * 2;
    const size_t tstepA0 = 2 * hstepA0, tstepB0 = 2 * hstepB0, tstepA1 = 2 * hstepA1, tstepB1 = 2 * hstepB1;
    const unsigned ldsw = (unsigned)wid * 1024u;
    const int aoff = lds_byte(wr * 64 + fr, fq * 8), boff = lds_byte(wc * 32 + fr, fq * 8);
#define PG8_SA(b, h) (((b) * 2 + (h)) * HTB)
#define PG8_SB(b, h) ((4 + (b) * 2 + (h)) * HTB)
#define PG8_STAGE(bufoff, gbase, voff) do { _Pragma("unroll") for (int _i = 0; _i < 2; ++_i) \
        __builtin_amdgcn_global_load_lds((const unsigned*)((const char*)(gbase) + (voff)[_i]), (PG8_LAS unsigned*)(lds + (bufoff) + ldsw + _i * 8192), 16, 0, 0); } while (0)
#define PG8_LDA(dst, b, h) do { _Pragma("unroll") for (int m = 0; m < 4; ++m) _Pragma("unroll") for (int k = 0; k < 2; ++k) dst[m][k] = *(const PG8_LAS bf16x8*)(lds + PG8_SA(b, h) + aoff + m * 2048 + k * 1024); } while (0)
#define PG8_LDB(dst, b, h) do { _Pragma("unroll") for (int n = 0; n < 2; ++n) _Pragma("unroll") for (int k = 0; k < 2; ++k) dst[n][k] = *(const PG8_LAS bf16x8*)(lds + PG8_SB(b, h) + boff + n * 2048 + k * 1024); } while (0)
#define PG8_MMA(ai, bj, At, Bt) do { __builtin_amdgcn_s_setprio(1); _Pragma("unroll") for (int m = 0; m < 4; ++m) _Pragma("unroll") for (int n = 0; n < 2; ++n) _Pragma("unroll") for (int k = 0; k < 2; ++k) \
        acc[ai][bj][m][n] = __builtin_amdgcn_mfma_f32_16x16x32_bf16(Bt[n][k], At[m][k], acc[ai][bj][m][n], 0, 0, 0); __builtin_amdgcn_s_setprio(0); } while (0)
#define PG8_WAIT_V(n) asm volatile("s_waitcnt vmcnt(" #n ")" ::: "memory")
#define PG8_WAIT_L(n) asm volatile("s_waitcnt lgkmcnt(" #n ")" ::: "memory")
#define PG8_BAR __builtin_amdgcn_s_barrier()
#define PG8_SCHED __builtin_amdgcn_sched_barrier(0)
    Unit cur, nxt; int ui = 0;
    if (!S.next(0, cur)) return;
    f32x4 acc[2][2][4][2];
#pragma unroll
    for (int a = 0; a < 2; ++a)
#pragma unroll
        for (int b = 0; b < 2; ++b)
#pragma unroll
            for (int m = 0; m < 4; ++m)
#pragma unroll
                for (int n = 0; n < 2; ++n) acc[a][b][m][n] = (f32x4){0.f, 0.f, 0.f, 0.f};
    bf16x8 At[4][2], B0[2][2], B1[2][2];
#define PG8_UA(u_) ((u_).seg ? (const char*)g1.A + (size_t)(u_).pm * tstepA1 : (const char*)g0.A + (size_t)(u_).pm * tstepA0)
#define PG8_UB(u_) ((u_).seg ? (const char*)g1.Bt + (size_t)(u_).pn * tstepB1 : (const char*)g0.Bt + (size_t)(u_).pn * tstepB0)
    const char* cA = PG8_UA(cur); const char* cB = PG8_UB(cur);
    size_t hAc = cur.seg ? hstepA1 : hstepA0, hBc = cur.seg ? hstepB1 : hstepB0; unsigned vAc[2], vBc[2];
#pragma unroll
    for (int i = 0; i < 2; ++i) { vAc[i] = cur.seg ? voffA1[i] : voffA0[i]; vBc[i] = cur.seg ? voffB1[i] : voffB0[i]; }
    int nt = (cur.seg ? g1.K : g0.K) / BK;
    S.a_ready(cur);
    if constexpr (SP2) {
        PG8_STAGE(PG8_SB(0, 0), cB, vBc); PG8_STAGE(PG8_SB(0, 1), cB + hBc, vBc); PG8_STAGE(PG8_SA(0, 0), cA, vAc); PG8_STAGE(PG8_SA(0, 1), cA + hAc, vAc);
        if (wr == 1) PG8_BAR;
        PG8_WAIT_V(2); PG8_BAR;
        PG8_STAGE(PG8_SB(1, 0), cB + kstep, vBc); PG8_STAGE(PG8_SA(1, 0), cA + kstep, vAc); PG8_STAGE(PG8_SB(1, 1), cB + hBc + kstep, vBc);
        PG8_WAIT_V(6); PG8_BAR;
    } else {
        PG8_STAGE(PG8_SB(0, 0), cB, vBc); PG8_STAGE(PG8_SA(0, 0), cA, vAc); PG8_STAGE(PG8_SB(0, 1), cB + hBc, vBc); PG8_STAGE(PG8_SA(0, 1), cA + hAc, vAc);
        if (wr == 1) PG8_BAR;
        PG8_WAIT_V(4); PG8_BAR;
        PG8_STAGE(PG8_SB(1, 0), cB + kstep, vBc); PG8_STAGE(PG8_SA(1, 0), cA + kstep, vAc); PG8_STAGE(PG8_SB(1, 1), cB + hBc + kstep, vBc);
        PG8_WAIT_V(6); PG8_BAR;
    }
    for (;;) {
        const bool has_next = S.next(ui + 1, nxt);
        const char* nA = has_next ? PG8_UA(nxt) : cA; const char* nB = has_next ? PG8_UB(nxt) : cB;
        const int sn = has_next ? nxt.seg : cur.seg; const size_t hAn = sn ? hstepA1 : hstepA0, hBn = sn ? hstepB1 : hstepB0; unsigned vAn[2], vBn[2];
#pragma unroll
        for (int i = 0; i < 2; ++i) { vAn[i] = sn ? voffA1[i] : voffA0[i]; vBn[i] = sn ? voffB1[i] : voffB0[i]; }
        for (int t = 0; t < nt; t += 2) {
            const bool last = (t == nt - 2);
            const size_t hA2 = last ? hAn : hAc, hB2 = last ? hBn : hBc; unsigned vA2[2], vB2[2];
#pragma unroll
            for (int i = 0; i < 2; ++i) { vA2[i] = last ? vAn[i] : vAc[i]; vB2[i] = last ? vBn[i] : vBc[i]; }
            const char* a1 = cA + (size_t)(t + 1) * kstep;
            const char* a2 = last ? nA : cA + (size_t)(t + 2) * kstep; const char* b2 = last ? nB : cB + (size_t)(t + 2) * kstep;
            const char* a3 = a2 + kstep; const char* b3 = b2 + kstep;
            if (last && has_next) S.a_ready(nxt);
            if constexpr (SP2) {
            PG8_LDB(B0, 0, 0); PG8_LDB(B1, 0, 1); PG8_SCHED; PG8_LDA(At, 0, 0); PG8_STAGE(PG8_SA(1, 1), a1 + hAc, vAc);
            PG8_WAIT_V(8); PG8_WAIT_L(0); PG8_BAR; PG8_MMA(0, 0, At, B0); PG8_MMA(0, 1, At, B1); PG8_BAR; PG8_SCHED;
            PG8_LDA(At, 0, 1); PG8_STAGE(PG8_SB(0, 0), b2, vB2); PG8_STAGE(PG8_SB(0, 1), b2 + hB2, vB2); PG8_STAGE(PG8_SA(0, 0), a2, vA2);
            PG8_WAIT_V(8); PG8_WAIT_L(0); PG8_BAR; PG8_MMA(1, 0, At, B0); PG8_MMA(1, 1, At, B1); PG8_BAR; PG8_SCHED;
            PG8_LDB(B0, 1, 0); PG8_LDB(B1, 1, 1); PG8_SCHED; PG8_LDA(At, 1, 0); PG8_STAGE(PG8_SA(0, 1), a2 + hA2, vA2);
            PG8_WAIT_V(8); PG8_WAIT_L(0); PG8_BAR; PG8_MMA(0, 0, At, B0); PG8_MMA(0, 1, At, B1); PG8_BAR; PG8_SCHED;
            PG8_LDA(At, 1, 1); PG8_STAGE(PG8_SB(1, 0), b3, vB2); PG8_STAGE(PG8_SB(1, 1), b3 + hB2, vB2); PG8_STAGE(PG8_SA(1, 0), a3, vA2);
            PG8_WAIT_V(8); PG8_WAIT_L(0); PG8_BAR; PG8_MMA(1, 0, At, B0); PG8_MMA(1, 1, At, B1); PG8_BAR; PG8_SCHED;
            } else {
            PG8_LDB(B0, 0, 0); PG8_SCHED; PG8_LDA(At, 0, 0); PG8_STAGE(PG8_SA(1, 1), a1 + hAc, vAc);
            PG8_WAIT_L(8); PG8_BAR; PG8_WAIT_L(0); PG8_MMA(0, 0, At, B0); PG8_BAR; PG8_SCHED;
            PG8_LDB(B1, 0, 1); PG8_STAGE(PG8_SB(0, 0), b2, vB2);
            PG8_BAR; PG8_WAIT_L(0); PG8_MMA(0, 1, At, B1); PG8_BAR;
            PG8_LDA(At, 0, 1); PG8_STAGE(PG8_SA(0, 0), a2, vA2);
            PG8_BAR; PG8_WAIT_L(0); PG8_MMA(1, 0, At, B0); PG8_BAR; PG8_SCHED;
            PG8_STAGE(PG8_SB(0, 1), b2 + hB2, vB2);
            PG8_WAIT_V(6); PG8_BAR; PG8_MMA(1, 1, At, B1); PG8_BAR;
            PG8_LDB(B0, 1, 0); PG8_SCHED; PG8_LDA(At, 1, 0); PG8_STAGE(PG8_SA(0, 1), a2 + hA2, vA2);
            PG8_WAIT_L(8); PG8_BAR; PG8_WAIT_L(0); PG8_MMA(0, 0, At, B0); PG8_BAR; PG8_SCHED;
            PG8_LDB(B1, 1, 1); PG8_STAGE(PG8_SB(1, 0), b3, vB2);
            PG8_BAR; PG8_WAIT_L(0); PG8_MMA(0, 1, At, B1); PG8_BAR;
            PG8_LDA(At, 1, 1); PG8_STAGE(PG8_SA(1, 0), a3, vA2);
            PG8_BAR; PG8_WAIT_L(0); PG8_MMA(1, 0, At, B0); PG8_BAR; PG8_SCHED;
            PG8_STAGE(PG8_SB(1, 1), b3 + hB2, vB2);
            PG8_WAIT_V(6); PG8_BAR; PG8_MMA(1, 1, At, B1); PG8_BAR;
            }
        }
        if constexpr (ALIGN_EPI) { if (wr == 0) PG8_BAR; }
        if (cur.seg == 0) E.mid(acc, cur, wr, wc, fr, fq); else { E(acc, cur, wr, wc, fr, fq); S.done(cur); }
        if (!has_next) break;
        if (cur.seg == 1) {
#pragma unroll
        for (int a = 0; a < 2; ++a)
#pragma unroll
            for (int b = 0; b < 2; ++b)
#pragma unroll
                for (int m = 0; m < 4; ++m)
#pragma unroll
                    for (int n = 0; n < 2; ++n) acc[a][b][m][n] = (f32x4){0.f, 0.f, 0.f, 0.f};
        }
        cur = nxt; cA = nA; cB = nB; ++ui; hAc = hAn; hBc = hBn; vAc[0] = vAn[0]; vAc[1] = vAn[1]; vBc[0] = vBn[0]; vBc[1] = vBn[1]; nt = (cur.seg ? g1.K : g0.K) / BK;
        if constexpr (ALIGN_EPI) { if (wr == 1) PG8_BAR; }
    }
    PG8_WAIT_V(0);
    if constexpr (!ALIGN_EPI) { if (wr == 0) PG8_BAR; }
    PG8_BAR;
#undef PG8_UA
#undef PG8_UB
#undef PG8_SA
#undef PG8_SB
#undef PG8_STAGE
#undef PG8_LDA
#undef PG8_LDB
#undef PG8_MMA
#undef PG8_WAIT_V
#undef PG8_WAIT_L
#undef PG8_BAR
#undef PG8_SCHED
}
}

#define XB_TMO      128
#define XB_XCNT(j)  (256  + 64 * (j))
#define XB_XSUB(j)  (1280 + 64 * (j))
#define XB_XGEN(j)  (2304 + 64 * (j))
#define XB_TOP      3328
#define XB_TOPGEN   3392
#define XCD_BAR_WORDS 3456
#define XB_SPIN_CAP (1u << 18)

__device__ __forceinline__ unsigned xb_ld(unsigned* p)              { return __hip_atomic_load(p, __ATOMIC_RELAXED, __HIP_MEMORY_SCOPE_AGENT); }
__device__ __forceinline__ unsigned xb_add(unsigned* p, unsigned v) { return __hip_atomic_fetch_add(p, v, __ATOMIC_RELAXED, __HIP_MEMORY_SCOPE_AGENT); }
__device__ __forceinline__ unsigned xb_xcc_id() { return (unsigned)__builtin_amdgcn_s_getreg((3 << 11) | 20) & 0xFu; }
#define XB_SPIN(cond, bar) do { unsigned _sp = 0; while (cond) { __builtin_amdgcn_s_sleep(1); \
    if ((++_sp & 255u) == 0u) { if (xb_ld(&(bar)[XB_TMO])) break; if (_sp > XB_SPIN_CAP) { atomicAdd(&(bar)[XB_TMO], 1u); break; } } } } while (0)

struct XcdBarrier {
    unsigned* bar; unsigned x;
    volatile LAS unsigned* st;
};

__device__ __forceinline__ XcdBarrier xcd_barrier_post(unsigned* bar, volatile LAS unsigned* st) {
    XcdBarrier b; b.bar = bar; b.x = xb_xcc_id(); b.st = st;
    if (threadIdx.x == 0) (void)xb_add(&bar[XB_XCNT(b.x)], 1u);
    return b;
}
__device__ __forceinline__ void xcd_barrier_complete(unsigned* bar, unsigned x, unsigned& nloc, unsigned& nx) {
    const unsigned G = gridDim.x * gridDim.y * gridDim.z;
    unsigned sum, cnt, mine, sp = 0u;
    for (;;) {
        sum = 0u; cnt = 0u; mine = 0u;
#pragma unroll
        for (unsigned j = 0; j < 16; ++j) { const unsigned c = xb_ld(&bar[XB_XCNT(j)]); sum += c; cnt += (c > 0u) ? 1u : 0u; mine = (j == x) ? c : mine; }
        if (sum == G) break;
        __builtin_amdgcn_s_sleep(1);
        if ((++sp & 255u) == 0u) { if (xb_ld(&bar[XB_TMO])) break; if (sp > XB_SPIN_CAP) { atomicAdd(&bar[XB_TMO], 1u); break; } }
    }
    nloc = mine > 0u ? mine : 1u; nx = cnt > 0u ? cnt : 1u;
}

__device__ __forceinline__ void xcd_barrier(const XcdBarrier& b) {
    asm volatile("s_waitcnt vmcnt(0)" ::: "memory");
    __syncthreads();
    if (threadIdx.x == 0) {
        unsigned* bar = b.bar;
        __builtin_amdgcn_s_waitcnt(0);
        unsigned nloc = b.st[0], nx = b.st[1];
        if (nloc == 0u) { xcd_barrier_complete(bar, b.x, nloc, nx); b.st[0] = nloc; b.st[1] = nx; }
        const unsigned old = xb_add(&bar[XB_XSUB(b.x)], 1u);
        const unsigned gen = old / nloc;
        if (old + 1u == (gen + 1u) * nloc) {
            __builtin_amdgcn_fence(__ATOMIC_RELEASE, "agent");
            asm volatile("s_waitcnt vmcnt(0)" ::: "memory");
            const unsigned og = xb_add(&bar[XB_TOP], 1u);
            const unsigned tg = og / nx;
            if (og + 1u == (tg + 1u) * nx) xb_add(&bar[XB_TOPGEN], 1u);
            else XB_SPIN(xb_ld(&bar[XB_TOPGEN]) == tg, bar);
            __builtin_amdgcn_fence(__ATOMIC_ACQUIRE, "agent");
            xb_add(&bar[XB_XGEN(b.x)], 1u);
            asm volatile("s_waitcnt vmcnt(0)" ::: "memory");
        } else {
            XB_SPIN(xb_ld(&bar[XB_XGEN(b.x)]) == gen, bar);
            __builtin_amdgcn_fence(__ATOMIC_ACQUIRE, "agent");
            asm volatile("s_waitcnt vmcnt(0)" ::: "memory");
        }
    }
    __syncthreads();
}

constexpr size_t MiB = 1u << 20;
constexpr size_t WS_CTL = 0, CTL_ZERO_BYTES = 192 * 1024;
constexpr size_t WS_SUMSQ = 128 * 1024;
constexpr int CW_BAR = 1024;
constexpr size_t WS_WIN = 1 * MiB;
constexpr size_t WS_WA = 14 * MiB;
constexpr size_t WS_WB = 16 * MiB;
constexpr size_t WS_WO = 17 * MiB;
constexpr size_t WS_WQ = 19 * MiB;
constexpr size_t WS_SKB = 23 * MiB;
constexpr size_t WS_ROPE = 24 * MiB;
constexpr size_t WS_BIAS = 25 * MiB;
constexpr size_t WS_KM = 25 * MiB + 256 * 1024;
constexpr size_t WS_PREV = 26 * MiB;
constexpr size_t WS_ACT = 42 * MiB;
constexpr size_t WS_RQ = WS_ACT, WS_RK = WS_RQ + 16 * MiB, WS_RV = WS_RK + 16 * MiB, WS_RG = WS_RV + 32 * MiB;
constexpr size_t WS_MQ = WS_RG + 32 * MiB, WS_MK = WS_MQ + 16 * MiB, WS_MV = WS_MK + 16 * MiB;
constexpr size_t WS_GA = WS_MV + 16 * MiB, WS_GB = WS_GA + 32 * MiB;
constexpr size_t WS_END = 256 * MiB;
constexpr size_t WS_YB = WS_ACT;
constexpr size_t WS_MRG = WS_ACT + 32 * MiB;
constexpr size_t WS_H2 = WS_ACT + 64 * MiB;
constexpr size_t WS_EG = WS_ACT + 96 * MiB;
constexpr size_t WS_QP = WS_ACT;
constexpr size_t WS_UV = WS_ACT;
constexpr size_t WS_UV8 = WS_ACT + 112 * MiB;
constexpr size_t WS_ST = WS_ACT + 144 * MiB;
static_assert(WS_GB + 32 * MiB <= WS_END && WS_EG + 16 * MiB <= WS_ST && WS_ST + 64 * MiB <= WS_END, "d_ws map");

constexpr int LDS_BYTES = 159 * 1024;
constexpr int MISC_OFF = LDS_BYTES - 256;
constexpr int NWAVES = 8;


using pg8::Unit;
__device__ __forceinline__ void store8_bf16(bf16* p, f32x4 a, f32x4 b) { v4u w; w.x = pk2(a[0], a[1]); w.y = pk2(a[2], a[3]); w.z = pk2(b[0], b[1]); w.w = pk2(b[2], b[3]); *(v4u*)p = w; }
__device__ __forceinline__ void load8_bf16(const bf16* p, f32x4& a, f32x4& b) { const v4u w = *(const v4u*)p; a = (f32x4){bflo(w.x), bfhi(w.x), bflo(w.y), bfhi(w.y)}; b = (f32x4){bflo(w.z), bfhi(w.z), bflo(w.w), bfhi(w.w)}; }
__device__ __forceinline__ float sigmoidf_(float x) { return __builtin_amdgcn_rcpf(1.0f + __builtin_amdgcn_exp2f(-1.4426950408889634f * x)); }
__device__ __forceinline__ f32x4 sig4(f32x4 v) { return (f32x4){sigmoidf_(v[0]), sigmoidf_(v[1]), sigmoidf_(v[2]), sigmoidf_(v[3])}; }
__device__ __forceinline__ f32x4 silu4(f32x4 v) { return v * sig4(v); }

#ifdef MOBA_NAIVE
constexpr float MOBA_QSCALE = 0.125f;
#else
constexpr float MOBA_QSCALE = 0.125f * 1.4426950408889634f;
#endif
struct EpiInProj {
    static constexpr bool AFTER_DRAIN = false;
    bf16 *RQ, *RK, *RV, *RG, *MQ, *MK, *MV, *GA, *GB; const float* rope; const float* qgain; const float* kgain; float* KMP;
    __device__ __forceinline__ void operator()(const f32x4 (&acc)[2][2][4][2], const Unit& u, int wr, int wc, int fr, int fq) const {
        const int pn = u.pn, rowb = u.pm * 256 + wr * 64 + fr, cw = 64 * wc + 8 * fq;
        if (pn < 4) {
            bf16* dst = (pn < 2 ? RQ : RK) + (pn & 1) * 256 + cw; const float sc = pn < 2 ? 1.0f : 0.125f;
#pragma unroll
            for (int ai = 0; ai < 2; ++ai)
#pragma unroll
                for (int m = 0; m < 4; ++m) {
                    const int row = rowb + ai * 128 + m * 16; const float* rp = rope + (size_t)(row & (SEQ - 1)) * 64 + 8 * fq;
                    const f32x4 c0 = *(const f32x4*)rp * sc, c1 = *(const f32x4*)(rp + 4) * sc, s0 = *(const f32x4*)(rp + 32) * sc, s1 = *(const f32x4*)(rp + 36) * sc;
                    const f32x4 x10 = acc[ai][0][m][0], x11 = acc[ai][0][m][1], x20 = acc[ai][1][m][0], x21 = acc[ai][1][m][1];
                    bf16* p = dst + (size_t)row * 512;
                    store8_bf16(p, x10 * c0 - x20 * s0, x11 * c1 - x21 * s1);
                    store8_bf16(p + 32, x10 * s0 + x20 * c0, x11 * s1 + x21 * c1);
                }
        } else if (pn < 12 || (pn >= 16)) {
            bf16* dst; int ld, mode;
            if (pn < 8) { dst = RV + (pn - 4) * 256; ld = 1024; mode = 0; }
            else if (pn < 12) { dst = RG + (pn - 8) * 256; ld = 1024; mode = 1; }
            else if (pn < 18) { dst = MV + (pn - 16) * 256; ld = 512; mode = 0; }
            else if (pn < 22) { dst = GA + (pn - 18) * 256; ld = 1024; mode = 2; }
            else { dst = GB + (pn - 22) * 256; ld = 1024; mode = 2; }
            dst += cw;
#pragma unroll
            for (int ai = 0; ai < 2; ++ai)
#pragma unroll
                for (int m = 0; m < 4; ++m) {
                    const int row = rowb + ai * 128 + m * 16; bf16* p = dst + (size_t)row * ld;
#pragma unroll
                    for (int bj = 0; bj < 2; ++bj) {
                        f32x4 a = acc[ai][bj][m][0], b = acc[ai][bj][m][1];
                        if (mode == 1) { a = silu4(a); b = silu4(b); } else if (mode == 2) { a = sig4(a); b = sig4(b); }
                        store8_bf16(p + 32 * bj, a, b);
                    }
                }
        } else {
            const bool isq = pn < 14; bf16* dst = (isq ? MQ : MK) + (pn & 1) * 256 + cw; const float* gain = (isq ? qgain : kgain) + 8 * fq; const float sc = isq ? MOBA_QSCALE : 1.0f;
            f32x4 cs00 = {0.f, 0.f, 0.f, 0.f}, cs01 = cs00, cs10 = cs00, cs11 = cs00;
            const f32x4 g00 = *(const f32x4*)gain * sc, g01 = *(const f32x4*)(gain + 4) * sc, g10 = *(const f32x4*)(gain + 32) * sc, g11 = *(const f32x4*)(gain + 36) * sc;
#pragma unroll
            for (int ai = 0; ai < 2; ++ai)
#pragma unroll
                for (int m = 0; m < 4; ++m) {
                    const int row = rowb + ai * 128 + m * 16; bf16* p = dst + (size_t)row * 512;
                    const f32x4 a0 = acc[ai][0][m][0], a1 = acc[ai][0][m][1], b0 = acc[ai][1][m][0], b1 = acc[ai][1][m][1];
                    const f32x4 q = a0 * a0 + a1 * a1 + b0 * b0 + b1 * b1; float ss = (q[0] + q[1]) + (q[2] + q[3]);
                    ss += __shfl_xor(ss, 16); ss += __shfl_xor(ss, 32);
                    const float r = rsqrtf(ss * (1.0f / 64.0f) + EPS);
                    const f32x4 y00 = a0 * r * g00, y01 = a1 * r * g01, y10 = b0 * r * g10, y11 = b1 * r * g11;
                    store8_bf16(p, y00, y01);
                    store8_bf16(p + 32, y10, y11);
                    if (!isq) { cs00 += y00; cs01 += y01; cs10 += y10; cs11 += y11; }
                }
            if (!isq) {
#pragma unroll
                for (int e = 0; e < 4; ++e) {
#pragma unroll
                    for (int o = 1; o < 16; o <<= 1) { cs00[e] += __shfl_xor(cs00[e], o); cs01[e] += __shfl_xor(cs01[e], o); cs10[e] += __shfl_xor(cs10[e], o); cs11[e] += __shfl_xor(cs11[e], o); }
                }
                if (fr == 0) { float* kp = KMP + (((size_t)u.pm * 2 + (pn & 1)) * 2 + wr) * 256 + cw;
                    *(f32x4*)kp = cs00; *(f32x4*)(kp + 4) = cs01; *(f32x4*)(kp + 32) = cs10; *(f32x4*)(kp + 36) = cs11; }
            }
        }
    }
};
struct EpiMerge2 {
    static constexpr bool AFTER_DRAIN = false;
    bf16* O; const bf16* GA; const bf16* GB;
    __device__ __forceinline__ void mid(f32x4 (&acc)[2][2][4][2], const Unit& u, int wr, int wc, int fr, int fq) const {
        const int rowb = u.pm * 256 + wr * 64 + fr, col = u.pn * 256 + 64 * wc + 8 * fq;
#pragma unroll
        for (int ai = 0; ai < 2; ++ai)
#pragma unroll
            for (int m = 0; m < 4; ++m) {
                const size_t off = (size_t)(rowb + ai * 128 + m * 16) * 1024 + col;
#pragma unroll
                for (int bj = 0; bj < 2; ++bj) { f32x4 a0, a1, b0, b1; load8_bf16(GA + off + 32 * bj, a0, a1); load8_bf16(GB + off + 32 * bj, b0, b1);
#pragma unroll
                    for (int e = 0; e < 4; ++e) { acc[ai][bj][m][0][e] *= b0[e] * __builtin_amdgcn_rcpf(fmaxf(a0[e], 1e-6f)); acc[ai][bj][m][1][e] *= b1[e] * __builtin_amdgcn_rcpf(fmaxf(a1[e], 1e-6f)); } }
            }
    }
    __device__ __forceinline__ void operator()(const f32x4 (&acc)[2][2][4][2], const Unit& u, int wr, int wc, int fr, int fq) const {
        const int rowb = u.pm * 256 + wr * 64 + fr, col = u.pn * 256 + 64 * wc + 8 * fq;
#pragma unroll
        for (int ai = 0; ai < 2; ++ai)
#pragma unroll
            for (int m = 0; m < 4; ++m) {
                const size_t off = (size_t)(rowb + ai * 128 + m * 16) * 1024 + col;
#pragma unroll
                for (int bj = 0; bj < 2; ++bj) { f32x4 a0, a1; load8_bf16(GA + off + 32 * bj, a0, a1);
#pragma unroll
                    for (int e = 0; e < 4; ++e) { a0[e] = fmaxf(a0[e], 1e-6f); a1[e] = fmaxf(a1[e], 1e-6f); }
                    store8_bf16(O + off + 32 * bj, acc[ai][bj][m][0] * a0, acc[ai][bj][m][1] * a1); }
            }
    }
};
struct TwoSegOrder {
    pg8::StaticOrder B;
    __device__ __forceinline__ bool next(int i, pg8::Unit& u) const { if (!B.next(i >> 1, u)) return false; u.seg = i & 1; return true; }
    __device__ __forceinline__ void a_ready(const pg8::Unit&) const {}
    __device__ __forceinline__ void done(const pg8::Unit&) const {}
};
struct EpiResid {
    static constexpr bool AFTER_DRAIN = false;
    const float* base; float* out; bf16* XG; const float* g2; float* SS;
    __device__ __forceinline__ void operator()(const f32x4 (&acc)[2][2][4][2], const Unit& u, int wr, int wc, int fr, int fq) const {
        const int rowb = u.pm * 256 + wr * 64 + fr, col = u.pn * 256 + 64 * wc + 8 * fq;
        const f32x4 g00 = *(const f32x4*)(g2 + col), g01 = *(const f32x4*)(g2 + col + 4), g10 = *(const f32x4*)(g2 + col + 32), g11 = *(const f32x4*)(g2 + col + 36);
#pragma unroll
        for (int ai = 0; ai < 2; ++ai)
#pragma unroll
            for (int m = 0; m < 4; ++m) {
                const int row = rowb + ai * 128 + m * 16; const size_t off = (size_t)row * 1024 + col;
                const f32x4 x00 = *(const f32x4*)(base + off) + acc[ai][0][m][0], x01 = *(const f32x4*)(base + off + 4) + acc[ai][0][m][1];
                const f32x4 x10 = *(const f32x4*)(base + off + 32) + acc[ai][1][m][0], x11 = *(const f32x4*)(base + off + 36) + acc[ai][1][m][1];
                *(f32x4*)(out + off) = x00; *(f32x4*)(out + off + 4) = x01; *(f32x4*)(out + off + 32) = x10; *(f32x4*)(out + off + 36) = x11;
                store8_bf16(XG + off, x00 * g00, x01 * g01); store8_bf16(XG + off + 32, x10 * g10, x11 * g11);
                const f32x4 q = x00 * x00 + x01 * x01 + x10 * x10 + x11 * x11; float ss = (q[0] + q[1]) + (q[2] + q[3]);
                ss += __shfl_xor(ss, 16); ss += __shfl_xor(ss, 32);
                if (fq == 0) atomicAdd(SS + row, ss);
            }
    }
};
struct EpiPlainBf16 {
    static constexpr bool AFTER_DRAIN = false;
    bf16* O; int ldc;
    __device__ __forceinline__ void operator()(const f32x4 (&acc)[2][2][4][2], const Unit& u, int wr, int wc, int fr, int fq) const {
        const int rowb = u.pm * 256 + wr * 64 + fr, col = u.pn * 256 + 64 * wc + 8 * fq;
#pragma unroll
        for (int ai = 0; ai < 2; ++ai)
#pragma unroll
            for (int m = 0; m < 4; ++m) {
                const size_t off = (size_t)(rowb + ai * 128 + m * 16) * ldc + col;
#pragma unroll
                for (int bj = 0; bj < 2; ++bj) store8_bf16(O + off + 32 * bj, acc[ai][bj][m][0], acc[ai][bj][m][1]);
            }
    }
};
struct EpiNatBf16 {
    static constexpr bool AFTER_DRAIN = false;
    bf16* O; int ldc; const float* SS;
    __device__ __forceinline__ void operator()(const f32x4 (&acc)[2][2][4][2], const Unit& u, int wr, int wc, int fr, int fq) const {
        const int rowb = u.pm * 256 + wr * 64 + fr, col = u.pn * 256 + 32 * wc + 4 * fq;
        f32x4 rs[2][2];
#pragma unroll
        for (int bj = 0; bj < 2; ++bj)
#pragma unroll
            for (int n = 0; n < 2; ++n) { const f32x4 s = *(const f32x4*)(SS + col + 128 * bj + 16 * n); rs[bj][n] = (f32x4){rsqrtf(s[0] * (1.0f / DM) + EPS), rsqrtf(s[1] * (1.0f / DM) + EPS), rsqrtf(s[2] * (1.0f / DM) + EPS), rsqrtf(s[3] * (1.0f / DM) + EPS)}; }
#pragma unroll
        for (int ai = 0; ai < 2; ++ai)
#pragma unroll
            for (int m = 0; m < 4; ++m) {
                const size_t off = (size_t)(rowb + ai * 128 + m * 16) * ldc + col;
#pragma unroll
                for (int bj = 0; bj < 2; ++bj)
#pragma unroll
                    for (int n = 0; n < 2; ++n) { const f32x4 v = acc[ai][bj][m][n] * rs[bj][n]; v2u w; w.x = pk2(v[0], v[1]); w.y = pk2(v[2], v[3]); *(v2u*)(O + off + 128 * bj + 16 * n) = w; }
            }
    }
};

struct Frame {
    LAS unsigned char* lds;
    volatile LAS unsigned* MISC;
    gu32* ctl;
    int tid, lane, wave, G, bid;
};

__device__ __forceinline__ void p0_transpose_item(const float* W, int K, int N, bf16* WT, LAS float* scr, int item, int lane) {
    const int nblk = N / 32, kb = item / nblk, nb = item % nblk, k0 = 64 * kb, n0 = 32 * nb;
#pragma unroll 8
    for (int i = 0; i < 32; ++i) { const int kk = 2 * i + (lane >> 5); scr[kk * 33 + (lane & 31)] = W[(size_t)(k0 + kk) * N + n0 + (lane & 31)]; }
    LDS_WAIT(); asm volatile("" ::: "memory");
    const int c = lane & 7;
#pragma unroll
    for (int j = 0; j < 4; ++j) { const int n = (lane >> 3) + 8 * j; const LAS float* s = scr + (8 * c) * 33 + n;
        v4u o; o.x = pk2(s[0 * 33], s[1 * 33]); o.y = pk2(s[2 * 33], s[3 * 33]); o.z = pk2(s[4 * 33], s[5 * 33]); o.w = pk2(s[6 * 33], s[7 * 33]);
        *(GAS v4u*)(WT + (size_t)perm_row_of_col(n0 + n) * K + k0 + 8 * c) = o; }
    LDS_WAIT(); asm volatile("" ::: "memory");
}
__device__ __forceinline__ void rms_row_to_bf16(const float* xrow, const float* g, bf16* orow, int lane) {
    const GAS f32x4* xr = (const GAS f32x4*)xrow + lane; const GAS f32x4* gr = (const GAS f32x4*)g + lane;
    f32x4 v[4]; float s = 0.f;
#pragma unroll
    for (int j = 0; j < 4; ++j) { v[j] = __builtin_nontemporal_load(&xr[64 * j]); s += (v[j].x * v[j].x + v[j].y * v[j].y) + (v[j].z * v[j].z + v[j].w * v[j].w); }
    const float r = rsqrtf(wave_sum(s) * (1.0f / DM) + EPS);
    GAS v2u* o8 = (GAS v2u*)orow + lane;
#pragma unroll
    for (int j = 0; j < 4; ++j) { const f32x4 gg = gr[64 * j]; v2u w; w.x = pk2(v[j].x * r * gg.x, v[j].y * r * gg.y); w.y = pk2(v[j].z * r * gg.z, v[j].w * r * gg.w); o8[64 * j] = w; }
}
__device__ __forceinline__ float t5_bias_of_dist(const float* rel_bias, int h, int dist) {
    int bkt;
    if (dist < 16) bkt = dist;
    else { const float nf = (float)dist; int lg = 16 + (int)(logf(nf / 16.0f) / 4.852030263919617f * 16.0f); bkt = lg < 31 ? lg : 31; }
    return rel_bias[bkt * MH + h];
}

struct Ptrs {
    const float *x, *mix_g, *w_in, *ret_w, *q_gain, *k_gain, *moba_w, *rel_bias, *w_out, *ffn_g, *peer_wq, *sub_keys, *peer_u, *peer_v;
    float* out; unsigned char* ws;
};

__device__ __forceinline__ void p0_prologue(Frame& F, const Ptrs& P) {
    LAS float* scr = (LAS float*)(F.lds + F.wave * 16384);
    const int gw = F.bid * NWAVES + F.wave, NGW = F.G * NWAVES;
    unsigned char* ws = P.ws;
    constexpr int I_IN = (DM / 64) * (INW / 32), I_A = (1024 / 64) * (1024 / 32), I_B = (512 / 64) * (1024 / 32), I_O = I_A, I_Q = (1024 / 64) * (2048 / 32);
    constexpr int NITEMS = I_IN + I_A + I_B + I_O; (void)I_Q;
    (void)NITEMS;
    for (int it = gw; it < I_IN; it += NGW) p0_transpose_item(P.w_in, DM, INW, (bf16*)(ws + WS_WIN), scr, it, F.lane);
    bf16* XN = (bf16*)P.out;
    for (int m = gw; m < T; m += NGW) rms_row_to_bf16(P.x + (size_t)m * DM, P.mix_g, XN + (size_t)m * DM, F.lane);
    const int gt = F.bid * 512 + F.tid, NGT = F.G * 512;
    float* rope = (float*)(ws + WS_ROPE);
    for (int i = gt; i < SEQ * 32; i += NGT) { const int pos = i >> 5, j = i & 31; const float inv = powf(10000.0f, -(float)j / 32.0f); const float ang = (float)pos * inv; float sn, cs; sincosf(ang, &sn, &cs);
        rope[pos * 64 + j] = cs; rope[pos * 64 + 32 + j] = sn; }
    float* BT = (float*)(ws + WS_BIAS);
    for (int i = gt; i < MH * SEQ; i += NGT) { const int h = i >> 12, dist = i & (SEQ - 1); BT[i] = t5_bias_of_dist(P.rel_bias, h, dist); }
}


__device__ __forceinline__ void p0b_late_weights(Frame& F, const Ptrs& P, int idx, int n) {
    LAS float* scr = (LAS float*)(F.lds + F.wave * 16384);
    const int gw = idx * NWAVES + F.wave, NGW = n * NWAVES;
    unsigned char* ws = P.ws;
    constexpr int I_A = (1024 / 64) * (1024 / 32), I_B = (512 / 64) * (1024 / 32), I_O = I_A;
    for (int it = gw; it < I_A + I_B + I_O; it += NGW) {
        int r = it;
        if (r < I_A) { p0_transpose_item(P.ret_w, 1024, 1024, (bf16*)(ws + WS_WA), scr, r, F.lane); continue; } r -= I_A;
        if (r < I_B) { p0_transpose_item(P.moba_w, 512, 1024, (bf16*)(ws + WS_WB), scr, r, F.lane); continue; } r -= I_B;
        p0_transpose_item(P.w_out, 1024, 1024, (bf16*)(ws + WS_WO), scr, r, F.lane);
    }
    { bf16* WST = (bf16*)(ws + WS_WQ);
      for (int wt = gw; wt < 16 * 4 * 32; wt += NGW) {
          const int blk = wt >> 7, nt = (wt >> 5) & 3, mt = wt & 31, r32 = F.lane & 31, hi = F.lane >> 5;
          const float* ap = P.sub_keys + ((size_t)blk * PNK + 32 * nt + r32) * 128 + 8 * hi;
          const float* bp = P.peer_wq + (size_t)(32 * mt + r32) * 2048 + blk * 128 + 8 * hi;
          f32x16 acc;
#pragma unroll
          for (int r = 0; r < 16; ++r) acc[r] = 0.f;
#pragma unroll
          for (int ds = 0; ds < 8; ++ds) {
              const f32x4 a0 = *(const f32x4*)(ap + 16 * ds), a1 = *(const f32x4*)(ap + 16 * ds + 4), b0 = *(const f32x4*)(bp + 16 * ds), b1 = *(const f32x4*)(bp + 16 * ds + 4);
              v4u aw, bw; aw.x = pk2(a0[0], a0[1]); aw.y = pk2(a0[2], a0[3]); aw.z = pk2(a1[0], a1[1]); aw.w = pk2(a1[2], a1[3]);
              bw.x = pk2(b0[0], b0[1]); bw.y = pk2(b0[2], b0[3]); bw.z = pk2(b1[0], b1[1]); bw.w = pk2(b1[2], b1[3]);
              acc = __builtin_amdgcn_mfma_f32_32x32x16_bf16(__builtin_bit_cast(bf16x8, aw), __builtin_bit_cast(bf16x8, bw), acc, 0, 0, 0);
          }
          bf16* op = WST + ((size_t)blk * 128 + 32 * nt) * DM + 32 * mt + r32;
#pragma unroll
          for (int r = 0; r < 16; ++r) op[(size_t)((r & 3) + 8 * (r >> 2) + 4 * hi) * DM] = (bf16)f2bf(acc[r]);
      } }
}
__device__ __forceinline__ void p2a_kv(Frame& F, const Ptrs& P) {
    unsigned char* ws = P.ws; const bf16* RK = (const bf16*)(ws + WS_RK); const bf16* RV = (const bf16*)(ws + WS_RV); const bf16* MK = (const bf16*)(ws + WS_MK);
    float* KVT = (float*)((unsigned char*)P.out + 32 * MiB); float* KM = (float*)(ws + WS_KM);
    LAS bf16* lK = (LAS bf16*)F.lds;
    LAS bf16* lV = (LAS bf16*)(F.lds + 16384);
    const int tid = F.tid;
    for (int task = F.bid; task < BATCH * RH * NCH; task += F.G) {
        const int b = task >> 8, h = (task >> 5) & 7, n = task & 31; const size_t row0 = (size_t)b * SEQ + n * RC; const float l2g = ret_l2g(h);
#pragma unroll
        for (int j = 0; j < 2; ++j) { const int idx = tid + 512 * j, c = idx >> 3, part = idx & 7; *(LAS v4u*)(lK + c * 64 + part * 8) = *(const v4u*)(RK + (row0 + c) * 512 + h * 64 + part * 8); }
#pragma unroll
        for (int j = 0; j < 4; ++j) { const int idx = tid + 512 * j, c = idx >> 4, part = idx & 15; *(LAS v4u*)(lV + c * 128 + part * 8) = *(const v4u*)(RV + (row0 + c) * 1024 + h * 128 + part * 8); }
        __syncthreads();
        const int dk = tid & 63, dv0 = (tid >> 6) * 16;
        float acc[16];
#pragma unroll
        for (int e = 0; e < 16; ++e) acc[e] = 0.f;
        for (int c = 0; c < RC; ++c) {
            const float kd = bf2f(lK[c * 64 + dk]) * exp2f((float)(RC - 1 - c) * l2g);
            const v4u v0 = *(LAS v4u*)(lV + c * 128 + dv0), v1 = *(LAS v4u*)(lV + c * 128 + dv0 + 8);
            acc[0] += kd * bflo(v0.x); acc[1] += kd * bfhi(v0.x); acc[2] += kd * bflo(v0.y); acc[3] += kd * bfhi(v0.y);
            acc[4] += kd * bflo(v0.z); acc[5] += kd * bfhi(v0.z); acc[6] += kd * bflo(v0.w); acc[7] += kd * bfhi(v0.w);
            acc[8] += kd * bflo(v1.x); acc[9] += kd * bfhi(v1.x); acc[10] += kd * bflo(v1.y); acc[11] += kd * bfhi(v1.y);
            acc[12] += kd * bflo(v1.z); acc[13] += kd * bfhi(v1.z); acc[14] += kd * bflo(v1.w); acc[15] += kd * bfhi(v1.w);
        }
        float* o = KVT + (size_t)task * (RDV * RDK);
#pragma unroll
        for (int e = 0; e < 16; ++e) o[(dv0 + e) * 64 + dk] = acc[e];
        __syncthreads();
    }
    const int gw = F.bid * NWAVES + F.wave, NGW = F.G * NWAVES;
    for (int wt = gw; wt < BATCH * MH * NBLK; wt += NGW) {
        const int b = wt >> 7, h = (wt >> 4) & 7, blk = wt & 15; const bf16* p = MK + ((size_t)b * SEQ + blk * MBLK) * 512 + h * 64 + F.lane;
        float s = 0.f;
        for (int j = 0; j < MBLK; ++j) s += bf2f(p[(size_t)j * 512]);
        KM[wt * 64 + F.lane] = s * (1.0f / MBLK);
    }
}
__device__ __forceinline__ void p2b_scan(Frame& F, const Ptrs& P) {
    const float* KVT = (const float*)((unsigned char*)P.out + 32 * MiB); bf16* PREV = (bf16*)(P.ws + WS_PREV);
    const int gt = F.bid * 512 + F.tid, NGT = F.G * 512;
    for (int e = gt; e < BATCH * RH * RDV * RDK; e += NGT) {
        const int bh = e >> 13, el = e & 8191, h = bh & 7; const float dC = exp2f((float)RC * ret_l2g(h));
        float S = 0.f; const size_t base = (size_t)bh * NCH * 8192 + el;
        for (int n = 0; n < NCH; ++n) { PREV[base + (size_t)n * 8192] = (bf16)f2bf(S); S = S * dC + KVT[base + (size_t)n * 8192]; }
    }
}
__device__ __forceinline__ void p3a_retention(Frame& F, const Ptrs& P) {
    unsigned char* ws = P.ws; const bf16* RQ = (const bf16*)(ws + WS_RQ); const bf16* RK = (const bf16*)(ws + WS_RK); const bf16* RV = (const bf16*)(ws + WS_RV);
    const bf16* RG = (const bf16*)(ws + WS_RG); const bf16* PREV = (const bf16*)(ws + WS_PREV); bf16* RETG = (bf16*)P.out;
    LAS bf16* lQ = (LAS bf16*)F.lds;
    LAS bf16* lK = (LAS bf16*)(F.lds + 16384);
    LAS bf16* lV = (LAS bf16*)(F.lds + 16384 + 16896);
    LAS bf16* lP = (LAS bf16*)(F.lds + 16384 + 16896 + 32768);
    LAS float* lS = (LAS float*)(F.lds + 16384 + 16896 + 32768 + 16896);
    const int tid = F.tid, lane = F.lane, wave = F.wave;
    for (int task = F.bid; task < BATCH * RH * NCH; task += F.G) {
        const int b = task >> 8, h = (task >> 5) & 7, n = task & 31; const size_t row0 = (size_t)b * SEQ + n * RC; const float l2g = ret_l2g(h);
#pragma unroll
        for (int j = 0; j < 2; ++j) { const int idx = tid + 512 * j, c = idx >> 3, part = idx & 7; *(LAS v4u*)(lQ + c * 64 + part * 8) = *(const v4u*)(RQ + (row0 + c) * 512 + h * 64 + part * 8); }
#pragma unroll
        for (int j = 0; j < 8; ++j) { const int idx = tid + 512 * j, c = idx >> 5, w = idx & 31; *(LAS unsigned*)(lK + c * 66 + w * 2) = *(const unsigned*)(RK + (row0 + c) * 512 + h * 64 + w * 2); }
#pragma unroll
        for (int j = 0; j < 4; ++j) { const int idx = tid + 512 * j, c = idx >> 4, part = idx & 15; *(LAS v4u*)(lV + c * 128 + part * 8) = *(const v4u*)(RV + (row0 + c) * 1024 + h * 128 + part * 8); }
#pragma unroll
        for (int j = 0; j < 8; ++j) { const int idx = tid + 512 * j, dv = idx >> 5, w = idx & 31; *(LAS unsigned*)(lP + dv * 66 + w * 2) = *(const unsigned*)(PREV + (size_t)task * 8192 + dv * 64 + w * 2); }
        __syncthreads();
        for (int t = 0; t < 32; ++t) {
            const int e = tid + 512 * t, i = e >> 7, j = e & 127;
            float s = 0.f;
            if (j <= i) {
                float d = 0.f;
#pragma unroll
                for (int w = 0; w < 32; ++w) { const unsigned qa = *(LAS unsigned*)(lQ + i * 64 + 2 * w), ka = *(LAS unsigned*)(lK + j * 66 + 2 * w); d += bflo(qa) * bflo(ka) + bfhi(qa) * bfhi(ka); }
                s = d * exp2f((float)(i - j) * l2g);
            }
            lS[i * 128 + j] = s;
        }
        __syncthreads();
        for (int r = 0; r < 16; ++r) {
            const int i = wave * 16 + r;
            float a0 = 0.f, a1 = 0.f;
            for (int j = 0; j <= i; ++j) { const float sv = lS[i * 128 + j]; a0 += sv * bf2f(lV[j * 128 + lane]); a1 += sv * bf2f(lV[j * 128 + lane + 64]); }
            float c0 = 0.f, c1 = 0.f;
#pragma unroll 8
            for (int w = 0; w < 32; ++w) { const unsigned qa = *(LAS unsigned*)(lQ + i * 64 + 2 * w), p0 = *(LAS unsigned*)(lP + lane * 66 + 2 * w), p1 = *(LAS unsigned*)(lP + (lane + 64) * 66 + 2 * w);
                c0 += bflo(qa) * bflo(p0) + bfhi(qa) * bfhi(p0); c1 += bflo(qa) * bflo(p1) + bfhi(qa) * bfhi(p1); }
            const float qd = exp2f((float)(i + 1) * l2g);
            const float o0 = a0 + c0 * qd, o1 = a1 + c1 * qd;
            const float mu = wave_sum(o0 + o1) * (1.0f / RDV); const float d0 = o0 - mu, d1 = o1 - mu;
            const float var = wave_sum(d0 * d0 + d1 * d1) * (1.0f / RDV); const float rs = rsqrtf(var + EPS);
            const size_t off = (row0 + i) * 1024 + h * 128 + lane;
            RETG[off] = (bf16)f2bf(d0 * rs * bf2f(RG[off])); RETG[off + 64] = (bf16)f2bf(d1 * rs * bf2f(RG[off + 64]));
        }
        __syncthreads();
    }
}
__device__ __forceinline__ void p3b_moba(Frame& F, const Ptrs& P) {
    unsigned char* ws = P.ws; const bf16* MQ = (const bf16*)(ws + WS_MQ); const bf16* MK = (const bf16*)(ws + WS_MK); const bf16* MV = (const bf16*)(ws + WS_MV);
    const float* KM = (const float*)(ws + WS_KM); const float* BT = (const float*)(ws + WS_BIAS); bf16* ATT = (bf16*)((unsigned char*)P.out + 32 * MiB);
    LAS float* lB = (LAS float*)F.lds;
    LAS bf16* lK = (LAS bf16*)(F.lds + 16384);
    LAS bf16* lV = (LAS bf16*)(F.lds + 16384 + 32768);
    LAS float* lKM = (LAS float*)(F.lds + 16384 + 65536);
    const int tid = F.tid, ql = tid >> 2, sub = tid & 3;
    for (int unit = F.bid; unit < BATCH * MH * 32; unit += F.G) {
        const int qh = 31 - (unit >> 5), bh = unit & 31, b = bh >> 3, h = bh & 7;
        const int qpos = qh * 128 + ql, qb = qh >> 1;
        for (int i = tid; i < SEQ; i += 512) lB[i] = BT[h * SEQ + i];
        float qf[64];
        { const bf16* qp = MQ + ((size_t)b * SEQ + qpos) * 512 + h * 64;
#pragma unroll
          for (int w = 0; w < 8; ++w) { const v4u x = *(const v4u*)(qp + 8 * w); qf[8 * w] = bflo(x.x); qf[8 * w + 1] = bfhi(x.x); qf[8 * w + 2] = bflo(x.y); qf[8 * w + 3] = bfhi(x.y);
              qf[8 * w + 4] = bflo(x.z); qf[8 * w + 5] = bfhi(x.z); qf[8 * w + 6] = bflo(x.w); qf[8 * w + 7] = bfhi(x.w); } }
        for (int i = tid; i < qb * 64; i += 512) lKM[i] = KM[(size_t)bh * NBLK * 64 + i];
        __syncthreads();
        unsigned mask;
        if (qb <= 3) mask = (1u << qb) - 1u;
        else {
            float g1 = -3e38f, g2 = -3e38f, g3 = -3e38f; int i1 = 0, i2 = 0, i3 = 0;
            for (int kb = 0; kb < qb; ++kb) {
                const LAS float* km = lKM + kb * 64; float g = 0.f;
#pragma unroll
                for (int d = 0; d < 64; ++d) g += qf[d] * km[d];
                if (g > g1) { g3 = g2; i3 = i2; g2 = g1; i2 = i1; g1 = g; i1 = kb; }
                else if (g > g2) { g3 = g2; i3 = i2; g2 = g; i2 = kb; }
                else if (g > g3) { g3 = g; i3 = kb; }
            }
            mask = (1u << i1) | (1u << i2) | (1u << i3);
        }
        float m = -1e30f, l = 0.f, o[64];
#pragma unroll
        for (int d = 0; d < 64; ++d) o[d] = 0.f;
        for (int kb = 0; kb <= qb; ++kb) {
            __syncthreads();
            const size_t krow0 = (size_t)b * SEQ + kb * MBLK;
#pragma unroll
            for (int j = 0; j < 4; ++j) { const int idx = tid + 512 * j, r = idx >> 3, part = idx & 7;
                *(LAS v4u*)(lK + r * 64 + part * 8) = *(const v4u*)(MK + (krow0 + r) * 512 + h * 64 + part * 8);
                *(LAS v4u*)(lV + r * 64 + part * 8) = *(const v4u*)(MV + (krow0 + r) * 512 + h * 64 + part * 8); }
            __syncthreads();
            const bool act = (kb == qb) || ((mask >> kb) & 1u);
            if (act) {
                for (int jj = 0; jj < 64; ++jj) {
                    const int j = jj * 4 + sub, kpos = kb * MBLK + j;
                    if (kpos > qpos) continue;
                    float dot = 0.f;
#pragma unroll
                    for (int w = 0; w < 8; ++w) { const v4u x = *(LAS v4u*)(lK + j * 64 + 8 * w);
                        dot += qf[8 * w] * bflo(x.x) + qf[8 * w + 1] * bfhi(x.x) + qf[8 * w + 2] * bflo(x.y) + qf[8 * w + 3] * bfhi(x.y)
                             + qf[8 * w + 4] * bflo(x.z) + qf[8 * w + 5] * bfhi(x.z) + qf[8 * w + 6] * bflo(x.w) + qf[8 * w + 7] * bfhi(x.w); }
                    const float logit = dot + lB[qpos - kpos];
                    const float mn = fmaxf(m, logit), sc = __expf(m - mn), p = __expf(logit - mn);
                    l = l * sc + p; m = mn;
#pragma unroll
                    for (int w = 0; w < 8; ++w) { const v4u x = *(LAS v4u*)(lV + j * 64 + 8 * w);
                        o[8 * w] = o[8 * w] * sc + p * bflo(x.x); o[8 * w + 1] = o[8 * w + 1] * sc + p * bfhi(x.x); o[8 * w + 2] = o[8 * w + 2] * sc + p * bflo(x.y); o[8 * w + 3] = o[8 * w + 3] * sc + p * bfhi(x.y);
                        o[8 * w + 4] = o[8 * w + 4] * sc + p * bflo(x.z); o[8 * w + 5] = o[8 * w + 5] * sc + p * bfhi(x.z); o[8 * w + 6] = o[8 * w + 6] * sc + p * bflo(x.w); o[8 * w + 7] = o[8 * w + 7] * sc + p * bfhi(x.w); }
                }
            }
        }
        float mm = fmaxf(m, __shfl_xor(m, 1)); mm = fmaxf(mm, __shfl_xor(mm, 2));
        const float f = __expf(m - mm); l *= f; l += __shfl_xor(l, 1); l += __shfl_xor(l, 2);
        const float il = 1.0f / l;
#pragma unroll
        for (int d = 0; d < 64; ++d) { float v = o[d] * f; v += __shfl_xor(v, 1); v += __shfl_xor(v, 2); o[d] = v * il; }
        bf16* op = ATT + ((size_t)b * SEQ + qpos) * 512 + h * 64;
#pragma unroll
        for (int s4 = 0; s4 < 4; ++s4) if (sub == s4) {
            v4u w0, w1; w0.x = pk2(o[16 * s4], o[16 * s4 + 1]); w0.y = pk2(o[16 * s4 + 2], o[16 * s4 + 3]); w0.z = pk2(o[16 * s4 + 4], o[16 * s4 + 5]); w0.w = pk2(o[16 * s4 + 6], o[16 * s4 + 7]);
            w1.x = pk2(o[16 * s4 + 8], o[16 * s4 + 9]); w1.y = pk2(o[16 * s4 + 10], o[16 * s4 + 11]); w1.z = pk2(o[16 * s4 + 12], o[16 * s4 + 13]); w1.w = pk2(o[16 * s4 + 14], o[16 * s4 + 15]);
            *(v4u*)(op + 16 * s4) = w0; *(v4u*)(op + 16 * s4 + 8) = w1; }
        __syncthreads();
    }
}

typedef short s16x4 __attribute__((ext_vector_type(4)));
typedef short v4i16_t __attribute__((ext_vector_type(4)));
__device__ __forceinline__ s16x4 vtr_read(const LAS unsigned char* p) { return __builtin_bit_cast(s16x4, __builtin_amdgcn_ds_read_tr16_b64_v4i16((LAS v4i16_t*)p)); }
constexpr float LOG2E = 1.4426950408889634f;
constexpr float MOBA_NEG = -1.0e30f;
constexpr float MOBA_THR = 3.0f;
constexpr int MB_LB = 0, MB_LKM = 16640, MB_WSC = 20480, MB_K0 = 24576, MB_V0 = 24576 + 65536;
static_assert(MB_V0 + 65536 <= MISC_OFF, "MoBA LDS map");

template <int ABL> __device__ __forceinline__ void p3b_moba_mfma(Frame& F, const Ptrs& P) {
    unsigned char* ws = P.ws; const bf16* MQ = (const bf16*)(ws + WS_MQ); const bf16* MK = (const bf16*)(ws + WS_MK); const bf16* MV = (const bf16*)(ws + WS_MV);
    const float* KMP = (const float*)(ws + WS_KM); const float* BT = (const float*)(ws + WS_BIAS); bf16* ATT = (bf16*)((unsigned char*)P.out + (ABL ? 48 : 32) * MiB);
    LAS float* lB = (LAS float*)(F.lds + MB_LB);
    LAS float* lKM = (LAS float*)(F.lds + MB_LKM);
    LAS float* wsc = (LAS float*)(F.lds + MB_WSC) + F.wave * 64;
    const int tid = F.tid, lane = F.lane, wave = F.wave, r32 = lane & 31, hi = lane >> 5;
    for (int vcu0 = F.bid; vcu0 < 256; vcu0 += F.G) {
    const int vcu = (F.G == 256) ? (vcu0 & 7) * 32 + (vcu0 >> 3) : vcu0;
    const int bh = vcu >> 3, sidx = vcu & 7, b = bh >> 3, h = bh & 7;
    __syncthreads();
    for (int i = tid; i < SEQ + 64; i += 512) lB[i] = (i < 64) ? 0.f : BT[h * SEQ + (i - 64)] * LOG2E;
    unsigned ksrc[4], vsrc[4];
#pragma unroll
    for (int j = 0; j < 4; ++j) { const int pc = wave * 4 + j, krow = 8 * pc + (lane >> 3); ksrc[j] = (unsigned)(krow * 512 + (((lane & 7) ^ (krow & 7)) * 8));
        const int vkey = 8 * pc + ((lane & 31) >> 2); vsrc[j] = (unsigned)(vkey * 512 + 32 * (lane >> 5) + 8 * (lane & 3)); }
#define MOBA_STAGE(kgp, vgp, kdst, vdst) do { _Pragma("unroll") for (int j = 0; j < 4; ++j) { \
        __builtin_amdgcn_global_load_lds((const unsigned*)((kgp) + ksrc[j]), (LAS unsigned*)(F.lds + (kdst) + (wave * 4 + j) * 1024), 16, 0, 0); \
        __builtin_amdgcn_global_load_lds((const unsigned*)((vgp) + vsrc[j]), (LAS unsigned*)(F.lds + (vdst) + (wave * 4 + j) * 1024), 16, 0, 0); } } while (0)
    const unsigned vbase = (unsigned)((4 * hi + ((lane & 15) >> 2)) * 64 + ((lane >> 4) & 1) * 32 + (lane & 3) * 8);
    for (int ui = 0; ui < 2; ++ui) {
        const int qb = ui == 0 ? 15 - sidx : sidx;
        const int nblk = qb + 1;
        __syncthreads();
        for (int i = tid; i < qb * 64; i += 512) { const int kb = i >> 6, dd = i & 63; const float* kp = KMP + (((size_t)(b * NBLK + kb) * 2 + (h >> 2)) * 2) * 256 + (h & 3) * 64 + dd; lKM[i] = (kp[0] + kp[256]) * (1.0f / MBLK); }
        const int qw0 = qb * MBLK + wave * 32, qpos = qw0 + r32;
        bf16x8 qf[4];
        { const bf16* qp = MQ + ((size_t)b * SEQ + qpos) * 512 + h * 64 + 8 * hi;
#pragma unroll
          for (int ds = 0; ds < 4; ++ds) qf[ds] = *(const bf16x8*)(qp + 16 * ds); }
        { const bf16* kg = MK + ((size_t)b * SEQ + (size_t)qb * MBLK) * 512 + h * 64; const bf16* vg = MV + ((size_t)b * SEQ + (size_t)qb * MBLK) * 512 + h * 64;
          MOBA_STAGE(kg, vg, MB_K0, MB_V0); }
        VM_WAIT(); __syncthreads();
        unsigned mask;
        if (qb <= 3) mask = (1u << qb) - 1u;
        else {
            float g1 = -3e38f, g2 = -3e38f, g3 = -3e38f; int i1 = 0, i2 = 0, i3 = 0;
            for (int kb = 0; kb < qb; ++kb) {
                float g = 0.f;
#pragma unroll
                for (int ds = 0; ds < 4; ++ds) { const LAS float* km = lKM + kb * 64 + 16 * ds + 8 * hi; const f32x4 k0 = *(const LAS f32x4*)km, k1 = *(const LAS f32x4*)(km + 4);
                    const v4u qx = __builtin_bit_cast(v4u, qf[ds]);
                    g += bflo(qx.x) * k0[0] + bfhi(qx.x) * k0[1] + bflo(qx.y) * k0[2] + bfhi(qx.y) * k0[3] + bflo(qx.z) * k1[0] + bfhi(qx.z) * k1[1] + bflo(qx.w) * k1[2] + bfhi(qx.w) * k1[3]; }
                g += __shfl_xor(g, 32);
                if (g > g1) { g3 = g2; i3 = i2; g2 = g1; i2 = i1; g1 = g; i1 = kb; }
                else if (g > g2) { g3 = g2; i3 = i2; g2 = g; i2 = kb; }
                else if (g > g3) { g3 = g; i3 = kb; }
            }
            mask = (1u << i1) | (1u << i2) | (1u << i3);
        }
        float m = 0.f, l = 0.f; bool first = true, pending = false;
        f32x16 o0, o1; v4u ppa[4]; unsigned pvoff = MB_V0;
#pragma unroll
        for (int r = 0; r < 16; ++r) { o0[r] = 0.f; o1[r] = 0.f; }
#pragma unroll
        for (int q = 0; q < 4; ++q) ppa[q] = (v4u){0u, 0u, 0u, 0u};
#define MOBA_PV(pa_, voff_) do { const LAS unsigned char* vp_ = F.lds + (voff_) + vbase; \
        _Pragma("unroll") for (int ks = 0; ks < 4; ++ks) { const bf16x8 pav = __builtin_bit_cast(bf16x8, pa_[ks]); \
            _Pragma("unroll") for (int db = 0; db < 2; ++db) { const s16x4 lo = vtr_read(vp_ + ((2 * ks) * 2 + db) * 512), hh = vtr_read(vp_ + ((2 * ks + 1) * 2 + db) * 512); \
                const bf16x8 vf = (bf16x8){lo[0], lo[1], lo[2], lo[3], hh[0], hh[1], hh[2], hh[3]}; \
                if (db == 0) o0 = __builtin_amdgcn_mfma_f32_32x32x16_bf16(pav, vf, o0, 0, 0, 0); else o1 = __builtin_amdgcn_mfma_f32_32x32x16_bf16(pav, vf, o1, 0, 0, 0); } } } while (0)
        for (int bi = 0; bi < nblk; ++bi) {
            const int kb = bi == 0 ? qb : bi - 1;
            const unsigned kbuf = MB_K0 + (bi & 1) * 32768, vbuf = MB_V0 + (bi & 1) * 32768;
            const bool has_next = bi + 1 < nblk;
            if (has_next) { const int kn = bi;
                if (pending) { MOBA_PV(ppa, pvoff); pending = false;
#pragma unroll
                    for (int q = 0; q < 4; ++q) ppa[q] = (v4u){0u, 0u, 0u, 0u}; }
                const bf16* kg = MK + ((size_t)b * SEQ + (size_t)kn * MBLK) * 512 + h * 64; const bf16* vg = MV + ((size_t)b * SEQ + (size_t)kn * MBLK) * 512 + h * 64;
                MOBA_STAGE(kg, vg, MB_K0 + ((bi + 1) & 1) * 32768, MB_V0 + ((bi + 1) & 1) * 32768); }
            const bool own = bi == 0;
            const bool sel = own || ((mask >> kb) & 1u);
            if (!(ABL & 16) && __any(sel)) {
                float msub = sel ? m : 1.0e30f;
                f32x16 cneg;
#pragma unroll
                for (int r = 0; r < 16; ++r) cneg[r] = -msub;
                const int npair = own ? (wave >> 1) + 1 : 4;
#define MOBA_QK(jq_, dA_, dB_) do { const int keyA_ = 64 * (jq_) + r32, keyB_ = keyA_ + 32; const LAS unsigned char* kpA_ = F.lds + kbuf + keyA_ * 128; const LAS unsigned char* kpB_ = F.lds + kbuf + keyB_ * 128; \
        _Pragma("unroll") for (int ds = 0; ds < 4; ++ds) { const bf16x8 aA_ = *(const LAS bf16x8*)(kpA_ + (((2 * ds + hi) ^ (keyA_ & 7)) * 16)), aB_ = *(const LAS bf16x8*)(kpB_ + (((2 * ds + hi) ^ (keyB_ & 7)) * 16)); \
            if (!(ABL & 8)) { dA_ = __builtin_amdgcn_mfma_f32_32x32x16_bf16(aA_, qf[ds], ds == 0 ? cneg : dA_, 0, 0, 0); dB_ = __builtin_amdgcn_mfma_f32_32x32x16_bf16(aB_, qf[ds], ds == 0 ? cneg : dB_, 0, 0, 0); } else if (ds == 0) { dA_ = cneg; dB_ = cneg; } } } while (0)
                f32x16 sA, sB, nA, nB;
                MOBA_QK(0, sA, sB);
                for (int jp = 0; jp < npair; ++jp) {
                    const int k0 = kb * MBLK + 64 * jp, dmin = qw0 - k0 - 63, dmax = qw0 + 31 - k0;
                    bool uni = false; float bu = 0.f;
                    if (dmin >= 256) { const float b0 = lB[64 + dmin], b1 = lB[64 + dmax]; uni = (b0 == b1); bu = b0; }
                    if (ABL & 1) {} else if (uni) {
#pragma unroll
                        for (int r = 0; r < 16; ++r) { sA[r] += bu; sB[r] += bu; }
                    } else {
                        const LAS float* bp = lB + (64 + qpos - k0 - 4 * hi - 27 - 32);
#pragma unroll
                        for (int r = 0; r < 16; ++r) { sA[r] += bp[32 + 27 - ((r & 3) + 8 * (r >> 2))]; sB[r] += bp[27 - ((r & 3) + 8 * (r >> 2))]; }
                    }
                    if (own && 2 * jp + 1 >= wave) {
                        const int limA = 32 * wave + r32 - 64 * jp - 4 * hi, limB = limA - 32;
#pragma unroll
                        for (int r = 0; r < 16; ++r) { const int cr = (r & 3) + 8 * (r >> 2); if (cr > limA) sA[r] = MOBA_NEG; if (cr > limB) sB[r] = MOBA_NEG; }
                    }
                    float tm = fmaxf(fmaxf(fmaxf(sA[0], sA[1]), fmaxf(sA[2], sA[3])), fmaxf(fmaxf(sB[0], sB[1]), fmaxf(sB[2], sB[3])));
#pragma unroll
                    for (int r = 4; r < 16; r += 4) tm = fmaxf(tm, fmaxf(fmaxf(fmaxf(sA[r], sA[r + 1]), fmaxf(sA[r + 2], sA[r + 3])), fmaxf(fmaxf(sB[r], sB[r + 1]), fmaxf(sB[r + 2], sB[r + 3]))));
                    if (first || __any(tm > MOBA_THR)) {
                        tm = fmaxf(tm, __shfl_xor(tm, 32));
                        const float dl = first ? tm : fmaxf(tm, 0.f);
                        first = false;
                        m += dl;
#pragma unroll
                        for (int r = 0; r < 16; ++r) { sA[r] -= dl; sB[r] -= dl; }
                        const float al = __builtin_amdgcn_exp2f(-dl);
                        l *= al;
                        if (hi == 0) wsc[r32] = al;
                        LDS_WAIT(); asm volatile("" ::: "memory");
#pragma unroll
                        for (int r = 0; r < 16; ++r) { const float a = wsc[(r & 3) + 8 * (r >> 2) + 4 * hi]; o0[r] *= a; o1[r] *= a; }
                        LDS_WAIT(); asm volatile("" ::: "memory");
                        {
#pragma unroll
                            for (int q = 0; q < 4; ++q) { ppa[q].x = pk2(bflo(ppa[q].x) * al, bfhi(ppa[q].x) * al); ppa[q].y = pk2(bflo(ppa[q].y) * al, bfhi(ppa[q].y) * al);
                                ppa[q].z = pk2(bflo(ppa[q].z) * al, bfhi(ppa[q].z) * al); ppa[q].w = pk2(bflo(ppa[q].w) * al, bfhi(ppa[q].w) * al); }
                        }
                        msub = sel ? m : 1.0e30f;
#pragma unroll
                        for (int r = 0; r < 16; ++r) cneg[r] = -msub;
                    }
                    {
                        const int jn = jp + 1 < npair ? jp + 1 : jp;
                        const int keyA_ = 64 * jn + r32, keyB_ = keyA_ + 32; const LAS unsigned char* kpA_ = F.lds + kbuf + keyA_ * 128; const LAS unsigned char* kpB_ = F.lds + kbuf + keyB_ * 128;
                        const LAS unsigned char* vp_ = F.lds + pvoff + vbase;
                        float ps = 0.f;
#pragma unroll
                        for (int i = 0; i < 4; ++i) {
                            if (!(ABL & 4)) { const bf16x8 pav = __builtin_bit_cast(bf16x8, ppa[i]);
#pragma unroll
                                for (int db = 0; db < 2; ++db) { const s16x4 lo = vtr_read(vp_ + ((2 * i) * 2 + db) * 512), hh = vtr_read(vp_ + ((2 * i + 1) * 2 + db) * 512);
                                    const bf16x8 vf = (bf16x8){lo[0], lo[1], lo[2], lo[3], hh[0], hh[1], hh[2], hh[3]};
                                    if (db == 0) o0 = __builtin_amdgcn_mfma_f32_32x32x16_bf16(pav, vf, o0, 0, 0, 0); else o1 = __builtin_amdgcn_mfma_f32_32x32x16_bf16(pav, vf, o1, 0, 0, 0); } }
                            { const bf16x8 aA_ = *(const LAS bf16x8*)(kpA_ + (((2 * i + hi) ^ (keyA_ & 7)) * 16)), aB_ = *(const LAS bf16x8*)(kpB_ + (((2 * i + hi) ^ (keyB_ & 7)) * 16));
                              if (!(ABL & 8)) { nA = __builtin_amdgcn_mfma_f32_32x32x16_bf16(aA_, qf[i], i == 0 ? cneg : nA, 0, 0, 0); nB = __builtin_amdgcn_mfma_f32_32x32x16_bf16(aB_, qf[i], i == 0 ? cneg : nB, 0, 0, 0); } else if (i == 0) { nA = cneg; nB = cneg; } }
                            float pv8[8];
#pragma unroll
                            for (int q = 0; q < 8; ++q) { const float sv = i < 2 ? sA[8 * i + q] : sB[8 * (i - 2) + q]; pv8[q] = (ABL & 2) ? sv : __builtin_amdgcn_exp2f(sv); ps += pv8[q]; }
                            ppa[i].x = pk2(pv8[0], pv8[1]); ppa[i].y = pk2(pv8[2], pv8[3]); ppa[i].z = pk2(pv8[4], pv8[5]); ppa[i].w = pk2(pv8[6], pv8[7]);
                            __builtin_amdgcn_sched_barrier(0);
                        }
                        l += ps;
                    }
                    pvoff = vbuf + (8 * jp) * 1024; pending = true;
                    sA = nA; sB = nB;
                }
#undef MOBA_QK
            }
            VM_WAIT(); __syncthreads();
        }
        if (pending) { MOBA_PV(ppa, pvoff); pending = false; }
#undef MOBA_PV
        l += __shfl_xor(l, 32);
        if (hi == 0) wsc[r32] = 1.0f / l;
        LDS_WAIT(); asm volatile("" ::: "memory");
        bf16* op = ATT + ((size_t)b * SEQ + qw0) * 512 + h * 64 + r32;
#pragma unroll
        for (int r = 0; r < 16; ++r) { const int qr = (r & 3) + 8 * (r >> 2) + 4 * hi; const float a = wsc[qr];
            op[(size_t)qr * 512] = (bf16)f2bf(o0[r] * a); op[(size_t)qr * 512 + 32] = (bf16)f2bf(o1[r] * a); }
        LDS_WAIT(); asm volatile("" ::: "memory");
    }
    }
#undef MOBA_STAGE
}


constexpr int RT_K = 0, RT_P = 16384, RT_V = 32768, RT_O = 65536, RT_OP = 132;
__device__ __forceinline__ void p3a_retention_mfma(Frame& F, const Ptrs& P) {
    unsigned char* ws = P.ws; const bf16* RQ = (const bf16*)(ws + WS_RQ); const bf16* RK = (const bf16*)(ws + WS_RK); const bf16* RV = (const bf16*)(ws + WS_RV);
    const bf16* RG = (const bf16*)(ws + WS_RG); const bf16* PREV = (const bf16*)(ws + WS_PREV); bf16* RETG = (bf16*)P.out;
    LAS float* lO = (LAS float*)(F.lds + RT_O);
    const int lane = F.lane, wave = F.wave, r32 = lane & 31, hi = lane >> 5, rt = wave >> 1, dh = wave & 1;
    const unsigned vbase = (unsigned)((4 * hi + ((lane & 15) >> 2)) * 64 + ((lane >> 4) & 1) * 32 + (lane & 3) * 8);
    unsigned ksrc[2], psrc[2], vsrc[4];
#pragma unroll
    for (int j = 0; j < 2; ++j) { const int pc = wave * 2 + j, row = 8 * pc + (lane >> 3), ch = (lane & 7) ^ (row & 7); ksrc[j] = (unsigned)(row * 512 + ch * 8); psrc[j] = (unsigned)(row * 64 + ch * 8); }
#pragma unroll
    for (int j = 0; j < 4; ++j) { const int pc = wave * 4 + j, key = 8 * (pc >> 1) + ((lane & 31) >> 2), db = 2 * (pc & 1) + (lane >> 5); vsrc[j] = (unsigned)(key * 1024 + 32 * db + 8 * (lane & 3)); }
#define RT_STAGE(task_) do { const int b_ = (task_) >> 8, h_ = ((task_) >> 5) & 7, n_ = (task_) & 31; const size_t r0_ = (size_t)b_ * SEQ + n_ * RC; \
        const bf16* kg_ = RK + r0_ * 512 + h_ * 64; const bf16* pg_ = PREV + (size_t)(task_) * 8192; const bf16* vg_ = RV + r0_ * 1024 + h_ * 128; \
        _Pragma("unroll") for (int j = 0; j < 2; ++j) { __builtin_amdgcn_global_load_lds((const unsigned*)(kg_ + ksrc[j]), (LAS unsigned*)(F.lds + RT_K + (wave * 2 + j) * 1024), 16, 0, 0); \
            __builtin_amdgcn_global_load_lds((const unsigned*)(pg_ + psrc[j]), (LAS unsigned*)(F.lds + RT_P + (wave * 2 + j) * 1024), 16, 0, 0); } \
        _Pragma("unroll") for (int j = 0; j < 4; ++j) __builtin_amdgcn_global_load_lds((const unsigned*)(vg_ + vsrc[j]), (LAS unsigned*)(F.lds + RT_V + (wave * 4 + j) * 1024), 16, 0, 0); } while (0)
    int task = F.bid;
    if (task < BATCH * RH * NCH) RT_STAGE(task);
    for (; task < BATCH * RH * NCH; task += F.G) {
        const int b = task >> 8, h = (task >> 5) & 7, n = task & 31; const size_t row0 = (size_t)b * SEQ + n * RC; const float l2g = ret_l2g(h);
        bf16x8 qf[4];
        { const bf16* qp = RQ + (row0 + 32 * rt + r32) * 512 + h * 64 + 8 * hi;
#pragma unroll
          for (int ds = 0; ds < 4; ++ds) qf[ds] = *(const bf16x8*)(qp + 16 * ds); }
        VM_WAIT(); __syncthreads();
        f32x16 o0, o1;
#pragma unroll
        for (int r = 0; r < 16; ++r) { o0[r] = 0.f; o1[r] = 0.f; }
#pragma unroll
        for (int ds = 0; ds < 4; ++ds) {
#pragma unroll
            for (int db = 0; db < 2; ++db) { const int dv = 64 * dh + 32 * db + r32; const bf16x8 bfr = *(const LAS bf16x8*)(F.lds + RT_P + dv * 128 + (((2 * ds + hi) ^ (dv & 7)) * 16));
                if (db == 0) o0 = __builtin_amdgcn_mfma_f32_32x32x16_bf16(qf[ds], bfr, o0, 0, 0, 0); else o1 = __builtin_amdgcn_mfma_f32_32x32x16_bf16(qf[ds], bfr, o1, 0, 0, 0); }
        }
#pragma unroll
        for (int r = 0; r < 16; ++r) { const float qd = __builtin_amdgcn_exp2f((float)(32 * rt + (r & 3) + 8 * (r >> 2) + 4 * hi + 1) * l2g); o0[r] *= qd; o1[r] *= qd; }
        for (int kt = 0; kt <= rt; ++kt) {
            f32x16 s;
#pragma unroll
            for (int r = 0; r < 16; ++r) s[r] = 0.f;
            { const int key = 32 * kt + r32; const LAS unsigned char* kp = F.lds + RT_K + key * 128;
#pragma unroll
              for (int ds = 0; ds < 4; ++ds) { const bf16x8 a = *(const LAS bf16x8*)(kp + (((2 * ds + hi) ^ (key & 7)) * 16)); s = __builtin_amdgcn_mfma_f32_32x32x16_bf16(a, qf[ds], s, 0, 0, 0); } }
            const int dbase = 32 * (rt - kt) + r32 - 4 * hi;
#pragma unroll
            for (int r = 0; r < 16; ++r) { const int dj = dbase - ((r & 3) + 8 * (r >> 2)); s[r] = dj >= 0 ? s[r] * __builtin_amdgcn_exp2f((float)dj * l2g) : 0.f; }
            v4u pa0, pa1;
            pa0.x = pk2(s[0], s[1]); pa0.y = pk2(s[2], s[3]); pa0.z = pk2(s[4], s[5]); pa0.w = pk2(s[6], s[7]);
            pa1.x = pk2(s[8], s[9]); pa1.y = pk2(s[10], s[11]); pa1.z = pk2(s[12], s[13]); pa1.w = pk2(s[14], s[15]);
            const LAS unsigned char* vp = F.lds + RT_V + vbase + (4 * kt) * 2048 + (2 * dh) * 512;
#pragma unroll
            for (int ks = 0; ks < 2; ++ks) {
                const bf16x8 pa = __builtin_bit_cast(bf16x8, ks == 0 ? pa0 : pa1);
#pragma unroll
                for (int db = 0; db < 2; ++db) {
                    const s16x4 lo = vtr_read(vp + (2 * ks) * 2048 + db * 512), hh = vtr_read(vp + (2 * ks + 1) * 2048 + db * 512);
                    const bf16x8 vf = (bf16x8){lo[0], lo[1], lo[2], lo[3], hh[0], hh[1], hh[2], hh[3]};
                    if (db == 0) o0 = __builtin_amdgcn_mfma_f32_32x32x16_bf16(pa, vf, o0, 0, 0, 0); else o1 = __builtin_amdgcn_mfma_f32_32x32x16_bf16(pa, vf, o1, 0, 0, 0);
                }
            }
        }
#pragma unroll
        for (int r = 0; r < 16; ++r) { const int qr = 32 * rt + (r & 3) + 8 * (r >> 2) + 4 * hi; lO[qr * RT_OP + 64 * dh + r32] = o0[r]; lO[qr * RT_OP + 64 * dh + 32 + r32] = o1[r]; }
        __syncthreads();
        if (task + F.G < BATCH * RH * NCH) RT_STAGE(task + F.G);
#pragma unroll
        for (int it = 0; it < 2; ++it) {
            const int i = wave * 16 + it * 8 + (lane >> 3), cc = lane & 7;
            f32x4 v[4];
#pragma unroll
            for (int q = 0; q < 4; ++q) v[q] = *(const LAS f32x4*)(lO + i * RT_OP + 16 * cc + 4 * q);
            const f32x4 sv = (v[0] + v[1]) + (v[2] + v[3]);
            const float mu = dpp_sum8((sv[0] + sv[1]) + (sv[2] + sv[3])) * (1.0f / RDV);
            f32x4 qv = {0.f, 0.f, 0.f, 0.f};
#pragma unroll
            for (int q = 0; q < 4; ++q) { v[q] = v[q] - mu; qv += v[q] * v[q]; }
            const float rs = rsqrtf(dpp_sum8((qv[0] + qv[1]) + (qv[2] + qv[3])) * (1.0f / RDV) + EPS);
            const size_t off = (row0 + i) * 1024 + h * 128 + 16 * cc;
            f32x4 g0, g1, g2, g3; load8_bf16(RG + off, g0, g1); load8_bf16(RG + off + 8, g2, g3);
            store8_bf16(RETG + off, v[0] * rs * g0, v[1] * rs * g1); store8_bf16(RETG + off + 8, v[2] * rs * g2, v[3] * rs * g3);
        }
    }
#undef RT_STAGE
}
constexpr int KV_K = 0, KV_V = 16384;
__device__ __forceinline__ void p2a_kv_mfma(Frame& F, const Ptrs& P) {
    unsigned char* ws = P.ws; const bf16* RK = (const bf16*)(ws + WS_RK); const bf16* RV = (const bf16*)(ws + WS_RV); float* KVT = (float*)((unsigned char*)P.out + 32 * MiB);
    const int tid = F.tid, lane = F.lane, wave = F.wave, r32 = lane & 31, hi = lane >> 5, mb = wave >> 1, nb = wave & 1;
    const unsigned vbase = (unsigned)((4 * hi + ((lane & 15) >> 2)) * 64 + ((lane >> 4) & 1) * 32 + (lane & 3) * 8);
    for (int task = F.bid; task < BATCH * RH * NCH; task += F.G) {
        const int b = task >> 8, h = (task >> 5) & 7, n = task & 31; const size_t row0 = (size_t)b * SEQ + n * RC; const float l2g = ret_l2g(h);
        __syncthreads();
#pragma unroll
        for (int j = 0; j < 2; ++j) { const int idx = tid + 512 * j, r = idx >> 3, c = idx & 7; const v4u kx = *(const v4u*)(RK + (row0 + r) * 512 + h * 64 + c * 8);
            const float dec = __builtin_amdgcn_exp2f((float)(RC - 1 - r) * l2g); v4u ko;
            ko.x = pk2(bflo(kx.x) * dec, bfhi(kx.x) * dec); ko.y = pk2(bflo(kx.y) * dec, bfhi(kx.y) * dec); ko.z = pk2(bflo(kx.z) * dec, bfhi(kx.z) * dec); ko.w = pk2(bflo(kx.w) * dec, bfhi(kx.w) * dec);
            *(LAS v4u*)(F.lds + KV_K + (((r >> 3) * 2 + (c >> 2)) * 512) + (r & 7) * 64 + (c & 3) * 16) = ko; }
#pragma unroll
        for (int j = 0; j < 4; ++j) { const int idx = tid + 512 * j, r = idx >> 4, c = idx & 15;
            *(LAS v4u*)(F.lds + KV_V + (((r >> 3) * 4 + (c >> 2)) * 512) + (r & 7) * 64 + (c & 3) * 16) = *(const v4u*)(RV + (row0 + r) * 1024 + h * 128 + c * 8); }
        __syncthreads();
        f32x16 acc;
#pragma unroll
        for (int r = 0; r < 16; ++r) acc[r] = 0.f;
#pragma unroll
        for (int ks = 0; ks < 8; ++ks) {
            const LAS unsigned char* ap = F.lds + KV_V + vbase + ((2 * ks) * 4 + mb) * 512; const LAS unsigned char* bp = F.lds + KV_K + vbase + ((2 * ks) * 2 + nb) * 512;
            const s16x4 alo = vtr_read(ap), ahi = vtr_read(ap + 4 * 512), blo = vtr_read(bp), bhi = vtr_read(bp + 2 * 512);
            const bf16x8 af = (bf16x8){alo[0], alo[1], alo[2], alo[3], ahi[0], ahi[1], ahi[2], ahi[3]}, bfv = (bf16x8){blo[0], blo[1], blo[2], blo[3], bhi[0], bhi[1], bhi[2], bhi[3]};
            acc = __builtin_amdgcn_mfma_f32_32x32x16_bf16(af, bfv, acc, 0, 0, 0);
        }
        float* o = KVT + (size_t)task * (RDV * RDK) + 32 * nb + r32;
#pragma unroll
        for (int r = 0; r < 16; ++r) o[(32 * mb + (r & 3) + 8 * (r >> 2) + 4 * hi) * 64] = acc[r];
    }
}
#define CE_D(a, i, j) do { const unsigned _hi = a[i] > a[j] ? a[i] : a[j]; const unsigned _lo = a[i] > a[j] ? a[j] : a[i]; a[i] = _hi; a[j] = _lo; } while (0)
#define CE_A(a, i, j) do { const unsigned _hi = a[i] > a[j] ? a[i] : a[j]; const unsigned _lo = a[i] > a[j] ? a[j] : a[i]; a[i] = _lo; a[j] = _hi; } while (0)
#define SORT16_DESC(a) do { CE_D(a, 0, 1); CE_A(a, 2, 3); CE_D(a, 4, 5); CE_A(a, 6, 7); CE_D(a, 8, 9); CE_A(a, 10, 11); CE_D(a, 12, 13); CE_A(a, 14, 15); CE_D(a, 0, 2); CE_D(a, 1, 3); CE_A(a, 4, 6); CE_A(a, 5, 7); CE_D(a, 8, 10); CE_D(a, 9, 11); CE_A(a, 12, 14); CE_A(a, 13, 15); CE_D(a, 0, 1); CE_D(a, 2, 3); CE_A(a, 4, 5); CE_A(a, 6, 7); CE_D(a, 8, 9); CE_D(a, 10, 11); CE_A(a, 12, 13); CE_A(a, 14, 15); CE_D(a, 0, 4); CE_D(a, 1, 5); CE_D(a, 2, 6); CE_D(a, 3, 7); CE_A(a, 8, 12); CE_A(a, 9, 13); CE_A(a, 10, 14); CE_A(a, 11, 15); CE_D(a, 0, 2); CE_D(a, 1, 3); CE_D(a, 4, 6); CE_D(a, 5, 7); CE_A(a, 8, 10); CE_A(a, 9, 11); CE_A(a, 12, 14); CE_A(a, 13, 15); CE_D(a, 0, 1); CE_D(a, 2, 3); CE_D(a, 4, 5); CE_D(a, 6, 7); CE_A(a, 8, 9); CE_A(a, 10, 11); CE_A(a, 12, 13); CE_A(a, 14, 15); CE_D(a, 0, 8); CE_D(a, 1, 9); CE_D(a, 2, 10); CE_D(a, 3, 11); CE_D(a, 4, 12); CE_D(a, 5, 13); CE_D(a, 6, 14); CE_D(a, 7, 15); CE_D(a, 0, 4); CE_D(a, 1, 5); CE_D(a, 2, 6); CE_D(a, 3, 7); CE_D(a, 8, 12); CE_D(a, 9, 13); CE_D(a, 10, 14); CE_D(a, 11, 15); CE_D(a, 0, 2); CE_D(a, 1, 3); CE_D(a, 4, 6); CE_D(a, 5, 7); CE_D(a, 8, 10); CE_D(a, 9, 11); CE_D(a, 12, 14); CE_D(a, 13, 15); CE_D(a, 0, 1); CE_D(a, 2, 3); CE_D(a, 4, 5); CE_D(a, 6, 7); CE_D(a, 8, 9); CE_D(a, 10, 11); CE_D(a, 12, 13); CE_D(a, 14, 15); } while (0)
#define MERGE16_DESC(a) do { CE_D(a, 0, 8); CE_D(a, 1, 9); CE_D(a, 2, 10); CE_D(a, 3, 11); CE_D(a, 4, 12); CE_D(a, 5, 13); CE_D(a, 6, 14); CE_D(a, 7, 15); CE_D(a, 0, 4); CE_D(a, 1, 5); CE_D(a, 2, 6); CE_D(a, 3, 7); CE_D(a, 8, 12); CE_D(a, 9, 13); CE_D(a, 10, 14); CE_D(a, 11, 15); CE_D(a, 0, 2); CE_D(a, 1, 3); CE_D(a, 4, 6); CE_D(a, 5, 7); CE_D(a, 8, 10); CE_D(a, 9, 11); CE_D(a, 12, 14); CE_D(a, 13, 15); CE_D(a, 0, 1); CE_D(a, 2, 3); CE_D(a, 4, 5); CE_D(a, 6, 7); CE_D(a, 8, 9); CE_D(a, 10, 11); CE_D(a, 12, 13); CE_D(a, 14, 15); } while (0)

#ifndef CONV_IN_TOPK
#define CONV_IN_TOPK 1
#endif
constexpr size_t CONV_N16 = (size_t)NEXP * DM / 16;
__device__ __forceinline__ void conv_load(const Ptrs& P, size_t i, f32x4 (&a)[4]) {
    const float* src = (i < CONV_N16) ? P.peer_u + i * 16 : P.peer_v + (i - CONV_N16) * 16;
#pragma unroll
    for (int q = 0; q < 4; ++q) a[q] = __builtin_nontemporal_load((const f32x4*)(src + 4 * q));
}
__device__ __forceinline__ void conv_store(const Ptrs& P, size_t i, const f32x4 (&a)[4]) {
    v2u w;
#pragma unroll
    for (int q = 0; q < 2; ++q) { unsigned pk = 0u;
        const f32x4 s0 = a[2 * q] * 64.0f, s1 = a[2 * q + 1] * 64.0f;
        pk = __builtin_amdgcn_cvt_scalef32_pk_fp4_f32(pk, s0[0], s0[1], 1.0f, 0); pk = __builtin_amdgcn_cvt_scalef32_pk_fp4_f32(pk, s0[2], s0[3], 1.0f, 1);
        pk = __builtin_amdgcn_cvt_scalef32_pk_fp4_f32(pk, s1[0], s1[1], 1.0f, 2); pk = __builtin_amdgcn_cvt_scalef32_pk_fp4_f32(pk, s1[2], s1[3], 1.0f, 3);
        w[q] = pk; }
    const size_t tab = i < CONV_N16 ? 0 : CONV_N16, r = i - tab, e = r >> 6, cb = (r >> 4) & 3, pc = r & 15;
    *(v2u*)(P.ws + WS_UV8 + tab * 8 + e * 512 + (((cb + e) & 3) << 7) + pc * 8) = w;
}
__device__ __forceinline__ void conv_all(Frame& F, const Ptrs& P) {
    const size_t cbase = (size_t)F.bid * 512 + F.tid, CNGT = (size_t)F.G * 512;
    for (size_t ci = cbase; ci < 2 * CONV_N16; ci += CNGT) { f32x4 cv[4]; conv_load(P, ci, cv); conv_store(P, ci, cv); }
}
__device__ __forceinline__ unsigned mono32(float f) { const unsigned u = __builtin_bit_cast(unsigned, f); return u ^ ((u >> 31) ? 0xffffffffu : 0x80000000u); }
__device__ __forceinline__ float unmono32(unsigned k) { const unsigned u = k ^ ((k >> 31) ? 0x80000000u : 0xffffffffu); return __builtin_bit_cast(float, u); }
__device__ __forceinline__ float key_val(unsigned k) { const unsigned m = k >> 16; return __builtin_bit_cast(float, (m ^ ((m & 0x8000u) ? 0x8000u : 0xffffu)) << 16); }
#define INS16(a, x) do { _Pragma("unroll") for (int _j = 0; _j < 16; ++_j) { const unsigned _t = a[_j] > x ? a[_j] : x; x = a[_j] > x ? x : a[_j]; a[_j] = _t; } } while (0)
__device__ __forceinline__ void p6_topk(Frame& F, const Ptrs& P) {
    unsigned char* ws = P.ws; const bf16* ST = (const bf16*)(ws + WS_ST); int* EXP = (int*)(ws + WS_EG); float* GT = (float*)(ws + WS_EG + 8 * MiB);
    LAS unsigned* lsc = (LAS unsigned*)F.lds;
    pg8::StaticOrder S8; S8.init(T, 2048, F.G, F.bid);
    pg8::Unit uq;
    const size_t cbase = (size_t)F.bid * 512 + F.tid, CNGT = (size_t)F.G * 512; int citem = 0;
    for (int ii = F.wave >> 2; S8.next(ii, uq); ii += 2) {
        const int hd = uq.pn, tok = uq.pm * 256 + (F.wave & 3) * 64 + F.lane;
        const bf16* sp = ST + (size_t)hd * 256 * T + tok;
        unsigned a1[16], a2[16];
#pragma unroll
        for (int j = 0; j < 16; ++j) { a1[j] = 0u; a2[j] = 0u; }
#pragma unroll 1
        for (int g = 0; g < 8; ++g) {
            f32x4 cv0[4], cv1[4]; const size_t ci0 = cbase + (size_t)citem * CNGT, ci1 = ci0 + CNGT; const bool ok0 = CONV_IN_TOPK && ci0 < 2 * CONV_N16, ok1 = CONV_IN_TOPK && ci1 < 2 * CONV_N16;
            unsigned short rr1[16], rr2[16];
#pragma unroll
            for (int q = 0; q < 16; ++q) { const int n = 16 * g + q; rr1[q] = sp[(size_t)n * T]; rr2[q] = sp[(size_t)(PNK + n) * T]; }
            asm volatile("" ::: "memory");
            if (ok0) conv_load(P, ci0, cv0);
            if (ok1) conv_load(P, ci1, cv1);
            unsigned g1[16], g2[16];
#pragma unroll
            for (int q = 0; q < 16; ++q) { const int n = 16 * g + q; const unsigned short r1 = rr1[q], r2 = rr2[q];
                g1[q] = (((unsigned)r1 ^ ((r1 & 0x8000u) ? 0xffffu : 0x8000u)) << 16) | (unsigned)(127 - n);
                g2[q] = (((unsigned)r2 ^ ((r2 & 0x8000u) ? 0xffffu : 0x8000u)) << 16) | (unsigned)(127 - n); }
            SORT16_DESC(g1); SORT16_DESC(g2);
            if (g == 0) {
#pragma unroll
                for (int q = 0; q < 16; ++q) { a1[q] = g1[q]; a2[q] = g2[q]; }
            } else {
#pragma unroll
                for (int q = 0; q < 16; ++q) { a1[q] = a1[q] > g1[15 - q] ? a1[q] : g1[15 - q]; a2[q] = a2[q] > g2[15 - q] ? a2[q] : g2[15 - q]; }
                MERGE16_DESC(a1); MERGE16_DESC(a2);
            }
            if (ok0) conv_store(P, ci0, cv0);
            if (ok1) conv_store(P, ci1, cv1);
            citem += 2;
            __builtin_amdgcn_sched_barrier(0);
        }
#pragma unroll
        for (int i = 0; i < 16; ++i) { lsc[i * 512 + F.tid] = a1[i]; lsc[(16 + i) * 512 + F.tid] = a2[i]; }
        unsigned kb[16];
#pragma unroll
        for (int j = 0; j < 16; ++j) kb[j] = 0u;
#pragma unroll
        for (int i = 0; i < 16; ++i) {
            const float s1 = key_val(a1[i]);
#pragma unroll
            for (int j = 0; j < 16; ++j) if ((i + 1) * (j + 1) <= 16) {
                unsigned xk = (mono32(s1 + key_val(a2[j])) & 0xffffff00u) | (unsigned)(i * 16 + j);
                INS16(kb, xk);
                __builtin_amdgcn_sched_barrier(0);
            }
        }
        float sv[16]; unsigned ev[16]; float smax = -3e38f;
#pragma unroll
        for (int q = 0; q < 16; ++q) { const unsigned i = (kb[q] >> 4) & 15u, j = kb[q] & 15u; const unsigned k1 = lsc[i * 512 + F.tid], k2 = lsc[(16 + j) * 512 + F.tid];
            sv[q] = key_val(k1) + key_val(k2); ev[q] = (127u - (k1 & 127u)) * 128u + (127u - (k2 & 127u)); smax = fmaxf(smax, sv[q]); }
        float gs = 0.f;
#pragma unroll
        for (int q = 0; q < 16; ++q) { sv[q] = __expf(sv[q] - smax); gs += sv[q]; }
        const float ig = 1.0f / gs;
        int* ep = EXP + (size_t)tok * 128 + hd * 16; float* gp = GT + (size_t)tok * 128 + hd * 16;
#pragma unroll
        for (int q = 0; q < 4; ++q) { *(v4u*)(ep + 4 * q) = (v4u){ev[4 * q], ev[4 * q + 1], ev[4 * q + 2], ev[4 * q + 3]};
            *(f32x4*)(gp + 4 * q) = (f32x4){sv[4 * q] * ig, sv[4 * q + 1] * ig, sv[4 * q + 2] * ig, sv[4 * q + 3] * ig}; }
    }
    if (CONV_IN_TOPK) for (;; ++citem) { const size_t ci = cbase + (size_t)citem * CNGT; if (ci >= 2 * CONV_N16) break; f32x4 cv[4]; conv_load(P, ci, cv); conv_store(P, ci, cv); }
}
__device__ __forceinline__ float dot8(const v4u w, const float* h) {
    return h[0] * bflo(w.x) + h[1] * bfhi(w.x) + h[2] * bflo(w.y) + h[3] * bfhi(w.y) + h[4] * bflo(w.z) + h[5] * bfhi(w.z) + h[6] * bflo(w.w) + h[7] * bfhi(w.w);
}
__device__ __forceinline__ void axpy8(float* acc, float c, const v4u w) {
    acc[0] += c * bflo(w.x); acc[1] += c * bfhi(w.x); acc[2] += c * bflo(w.y); acc[3] += c * bfhi(w.y); acc[4] += c * bflo(w.z); acc[5] += c * bfhi(w.z); acc[6] += c * bflo(w.w); acc[7] += c * bfhi(w.w);
}
#ifndef PB
#define PB 8
#endif
__device__ __forceinline__ void p7_peer(Frame& F, const Ptrs& P, float* dst) {
    unsigned char* ws = P.ws; const bf16* H2 = (const bf16*)(ws + WS_H2); const int* EXP = (const int*)(ws + WS_EG); const float* GT = (const float*)(ws + WS_EG + 8 * MiB);
    const bf16* U = (const bf16*)(ws + WS_UV); const bf16* V = U + (size_t)NEXP * DM; float* out = P.out;
    const int gw = F.bid * NWAVES + F.wave, NGW = F.G * NWAVES, lane = F.lane;
    for (int tok = gw; tok < T; tok += NGW) {
        float hv[16], acc[16];
        { const v4u h0 = *(const v4u*)(H2 + (size_t)tok * DM + 8 * lane), h1 = *(const v4u*)(H2 + (size_t)tok * DM + 512 + 8 * lane);
          hv[0] = bflo(h0.x); hv[1] = bfhi(h0.x); hv[2] = bflo(h0.y); hv[3] = bfhi(h0.y); hv[4] = bflo(h0.z); hv[5] = bfhi(h0.z); hv[6] = bflo(h0.w); hv[7] = bfhi(h0.w);
          hv[8] = bflo(h1.x); hv[9] = bfhi(h1.x); hv[10] = bflo(h1.y); hv[11] = bfhi(h1.y); hv[12] = bflo(h1.z); hv[13] = bfhi(h1.z); hv[14] = bflo(h1.w); hv[15] = bfhi(h1.w); }
#pragma unroll
        for (int e = 0; e < 16; ++e) acc[e] = 0.f;
        int e_lo = EXP[(size_t)tok * 128 + lane], e_hi = EXP[(size_t)tok * 128 + 64 + lane];
        float g_lo = GT[(size_t)tok * 128 + lane], g_hi = GT[(size_t)tok * 128 + 64 + lane];
#ifndef PEER_NOSORT
        {
            LAS unsigned* le = (LAS unsigned*)(F.lds + F.wave * 1024); LAS float* lg = (LAS float*)(le + 128);
            const unsigned b_lo = (unsigned)e_lo >> 9, b_hi = (unsigned)e_hi >> 9; unsigned pos_lo = 0, pos_hi = 0, base = 0;
            for (unsigned bk = 0; bk < 32; ++bk) {
                const unsigned long long mlo = __ballot(b_lo == bk), mhi = __ballot(b_hi == bk);
                const unsigned clo = (unsigned)__popcll(mlo), chi = (unsigned)__popcll(mhi);
                if (b_lo == bk) pos_lo = base + __builtin_amdgcn_mbcnt_hi((unsigned)(mlo >> 32), __builtin_amdgcn_mbcnt_lo((unsigned)mlo, 0u));
                if (b_hi == bk) pos_hi = base + clo + __builtin_amdgcn_mbcnt_hi((unsigned)(mhi >> 32), __builtin_amdgcn_mbcnt_lo((unsigned)mhi, 0u));
                base += clo + chi;
            }
            le[pos_lo] = (unsigned)e_lo; lg[pos_lo] = g_lo; le[pos_hi] = (unsigned)e_hi; lg[pos_hi] = g_hi;
            LDS_WAIT(); asm volatile("" ::: "memory");
            e_lo = (int)le[lane]; e_hi = (int)le[64 + lane]; g_lo = lg[lane]; g_hi = lg[64 + lane];
            LDS_WAIT(); asm volatile("" ::: "memory");
        }
#endif
        for (int k = 0; k < 128; k += PB) {
            int ex[PB]; float gg[PB]; v4u u0[PB], u1[PB], v0[PB], v1[PB];
#pragma unroll
            for (int q = 0; q < PB; ++q) { const int kk = k + q; ex[q] = __shfl(kk < 64 ? e_lo : e_hi, kk & 63); gg[q] = __shfl(kk < 64 ? g_lo : g_hi, kk & 63); }
#pragma unroll
            for (int q = 0; q < PB; ++q) { const bf16* up = U + (size_t)ex[q] * DM + 8 * lane; const bf16* vp = V + (size_t)ex[q] * DM + 8 * lane;
                u0[q] = *(const v4u*)up; u1[q] = *(const v4u*)(up + 512); v0[q] = *(const v4u*)vp; v1[q] = *(const v4u*)(vp + 512); }
            float d[PB];
#pragma unroll
            for (int q = 0; q < PB; ++q) d[q] = dot8(u0[q], hv) + dot8(u1[q], hv + 8);
#pragma unroll
            for (int o = 1; o < 64; o <<= 1) {
#pragma unroll
                for (int q = 0; q < PB; ++q) d[q] += __shfl_xor(d[q], o);
            }
#pragma unroll
            for (int q = 0; q < PB; ++q) { const float z = d[q]; const float a = 0.5f * z * (1.0f + erff(z * 0.70710678118654752f)); const float c = gg[q] * a; axpy8(acc, c, v0[q]); axpy8(acc + 8, c, v1[q]); }
        }
        float* op = out + (size_t)tok * DM + 8 * lane;
        f32x4 x0 = *(const f32x4*)op, x1 = *(const f32x4*)(op + 4), x2 = *(const f32x4*)(op + 512), x3 = *(const f32x4*)(op + 516);
        x0 += (f32x4){acc[0], acc[1], acc[2], acc[3]}; x1 += (f32x4){acc[4], acc[5], acc[6], acc[7]}; x2 += (f32x4){acc[8], acc[9], acc[10], acc[11]}; x3 += (f32x4){acc[12], acc[13], acc[14], acc[15]};
        float* wp = dst + (size_t)tok * DM + 8 * lane;
        *(f32x4*)wp = x0; *(f32x4*)(wp + 4) = x1; *(f32x4*)(wp + 512) = x2; *(f32x4*)(wp + 516) = x3;
    }
}

typedef float f32x2v __attribute__((ext_vector_type(2)));
typedef _Float16 f16x2v __attribute__((ext_vector_type(2)));
constexpr size_t WS_PART = WS_ST;
constexpr size_t WS_CG = WS_ACT + 32 * MiB;
__device__ __forceinline__ void fp8x16_to_f32(const v4u w, float* f) {
#pragma unroll
    for (int q = 0; q < 4; ++q) { const f32x2v lo = __builtin_amdgcn_cvt_pk_f32_fp8((int)w[q], false), hi = __builtin_amdgcn_cvt_pk_f32_fp8((int)w[q], true); f[4 * q] = lo.x; f[4 * q + 1] = lo.y; f[4 * q + 2] = hi.x; f[4 * q + 3] = hi.y; }
}
__device__ __forceinline__ float fmac_s(float acc, float a, float b) { asm("v_fmac_f32_e32 %0, %1, %2" : "+v"(acc) : "v"(a), "v"(b)); return acc; }
constexpr int TROW = DM / 2;
template <int MODE> __device__ __forceinline__ void p7u_dots(Frame& F, const Ptrs& P) {
    unsigned char* ws = P.ws; const bf16* H2 = (const bf16*)(ws + WS_H2); const int* EXP = (const int*)(ws + WS_EG); const unsigned char* U4 = ws + WS_UV8; float* PART = (float*)(ws + (MODE ? WS_ACT : WS_PART)); const float* SS = (const float*)(ws + WS_SUMSQ);
    const int lane = F.lane, ti = lane >> 3, c = lane & 7;
#define PU_LOADW(ch, W) do { const int* wp_ = EXP + (size_t)(tbase + 8 * ((ch) >> 3) + ti) * 128 + ((ch) & 7) * 16; _Pragma("unroll") for (int q = 0; q < 4; ++q) W[q] = *(const v4u*)(wp_ + 4 * q); } while (0)
#define PU_LOADH(tg, hn, ssx) do { const int t_ = tbase + 8 * (tg) + ti; ssx = SS[t_]; _Pragma("unroll") for (int q = 0; q < 4; ++q) hn[q] = *(const v4u*)(H2 + (size_t)t_ * DM + hoff + 8 * q); } while (0)
#define PU_ISSUE(W, ul) do { _Pragma("unroll") for (int it = 0; it < 16; ++it) { const unsigned ev = W[it >> 2][it & 3]; ul[it] = *(const v4u*)(U4 + (size_t)ev * TROW + (((sl + ev) & 3) << 7) + 16 * c); } } while (0)
#define PU_COMPUTE(ch, ul) do { const bool keep = (((ch) & 7) == c); \
        _Pragma("unroll") for (int it = 0; it < 16; ++it) { f16x2v sa = {(_Float16)0.f, (_Float16)0.f}, sb = sa; \
            _Pragma("unroll") for (int q = 0; q < 4; ++q) { \
                sa = __builtin_amdgcn_cvt_scalef32_pk_f16_fp4(ul[it][q], 1.0f, 0) * hv[4 * q] + sa; sb = __builtin_amdgcn_cvt_scalef32_pk_f16_fp4(ul[it][q], 1.0f, 1) * hv[4 * q + 1] + sb; \
                sa = __builtin_amdgcn_cvt_scalef32_pk_f16_fp4(ul[it][q], 1.0f, 2) * hv[4 * q + 2] + sa; sb = __builtin_amdgcn_cvt_scalef32_pk_f16_fp4(ul[it][q], 1.0f, 3) * hv[4 * q + 3] + sb; } \
            sa += sb; const float s = dpp_sum8((float)sa.x + (float)sa.y) * rstd; res[it] = keep ? s : res[it]; } \
        if (((ch) & 7) == 7) { float* pp = PART + ((size_t)sl * T + (tbase + 8 * ((ch) >> 3) + ti)) * 128 + 16 * c; \
            _Pragma("unroll") for (int q = 0; q < 4; ++q) *(f32x4*)(pp + 4 * q) = (f32x4){res[4 * q], res[4 * q + 1], res[4 * q + 2], res[4 * q + 3]}; } } while (0)
#define PU_SETH(hn, ssx) do { rstd = rsqrtf(ssx * (1.0f / DM) + EPS); \
        _Pragma("unroll") for (int q = 0; q < 4; ++q) { _Pragma("unroll") for (int e = 0; e < 4; ++e) hv[4 * q + e] = (f16x2v){(_Float16)bflo(hn[q][e]), (_Float16)bfhi(hn[q][e])}; } } while (0)
    for (int vb = F.bid; vb < 256; vb += F.G) {
        const int x = vb & 7, j = vb >> 3, sl = x & 3; const int tbase = (x >> 2) * (T / 2) + 256 * j + 32 * F.wave;
        const size_t hoff = 256 * sl + 32 * c;
        v4u WA[4], WB[4], ulA[16], ulB[16], hn[4]; float ssn, rstd, res[16]; f16x2v hv[16];
#pragma unroll
        for (int q = 0; q < 16; ++q) res[q] = 0.f;
        PU_LOADH(0, hn, ssn); PU_LOADW(0, WA); PU_LOADW(1, WB);
        PU_ISSUE(WA, ulA);
        for (int ch = 0; ch < 32; ch += 2) {
            const int c2 = ch + 2 < 31 ? ch + 2 : 31, c3 = ch + 3 < 31 ? ch + 3 : 31;
            if ((ch & 7) == 0) { PU_SETH(hn, ssn); const int tgn = (ch >> 3) + 1 < 4 ? (ch >> 3) + 1 : 3; PU_LOADH(tgn, hn, ssn); }
            PU_ISSUE(WB, ulB);
            PU_LOADW(c2, WA);
            PU_COMPUTE(ch, ulA);
            PU_ISSUE(WA, ulA);
            PU_LOADW(c3, WB);
            PU_COMPUTE(ch + 1, ulB);
        }
    }
#undef PU_LOADW
#undef PU_LOADH
#undef PU_ISSUE
#undef PU_COMPUTE
#undef PU_SETH
}
__device__ __forceinline__ void p7z_gate(Frame& F, const Ptrs& P) {
    unsigned char* ws = P.ws; const float* PART = (const float*)(ws + WS_PART); const float* GT = (const float*)(ws + WS_EG + 8 * MiB); const int* EXP = (const int*)(ws + WS_EG); unsigned* CG = (unsigned*)(ws + WS_CG);
    const size_t gt = (size_t)F.bid * 512 + F.tid, NGT = (size_t)F.G * 512, n4 = (size_t)T * 128 / 4;
    for (size_t i = gt; i < n4; i += NGT) {
        f32x4 z = *(const f32x4*)(PART + i * 4);
#pragma unroll
        for (int x = 1; x < 4; ++x) z += *(const f32x4*)(PART + (size_t)x * T * 128 + i * 4);
        const f32x4 g = *(const f32x4*)(GT + i * 4); const v4u e = *(const v4u*)(EXP + i * 4); v4u o;
#pragma unroll
        for (int q = 0; q < 4; ++q) { const float zz = z[q] * (1.0f / 64.0f); const float cgv = g[q] * 0.5f * zz * (1.0f + erff(zz * 0.70710678118654752f)); o[q] = ((unsigned)__builtin_bit_cast(unsigned short, (_Float16)cgv) << 16) | e[q]; }
        *(v4u*)(CG + i * 4) = o;
    }
}
template <int MODE> __device__ __forceinline__ void p7v_accum(Frame& F, const Ptrs& P, float* dst) {
    unsigned char* ws = P.ws; const unsigned* CG = (const unsigned*)(ws + WS_CG); const unsigned char* V4 = ws + WS_UV8 + 8 * MiB; const float* x1 = P.out;
    const int lane = F.lane, ti = lane >> 3, c = lane & 7;
#define PV_LOADW(ch, W) do { const unsigned* wp_ = CG + (size_t)(tbase + 8 * ((ch) >> 3) + ti) * 128 + ((ch) & 7) * 16; _Pragma("unroll") for (int q = 0; q < 4; ++q) W[q] = *(const v4u*)(wp_ + 4 * q); } while (0)
#define PV_ISSUE(W, vl, cg) do { _Pragma("unroll") for (int it = 0; it < 16; ++it) { const unsigned w = W[it >> 2][it & 3]; cg[it] = __builtin_amdgcn_perm(w, w, 0x03020302u); \
        const unsigned ev = w & 0xffffu; vl[it] = *(const v4u*)(V4 + (size_t)ev * TROW + (((sl + ev) & 3) << 7) + 16 * c); } } while (0)
#define PV_COMPUTE(ch, vl, cg) do { \
        _Pragma("unroll") for (int it = 0; it < 16; ++it) { const f16x2v cg2 = __builtin_bit_cast(f16x2v, cg[it]); \
            _Pragma("unroll") for (int q = 0; q < 4; ++q) { \
                acc[4 * q] = cg2 * __builtin_amdgcn_cvt_scalef32_pk_f16_fp4(vl[it][q], 1.0f, 0) + acc[4 * q]; acc[4 * q + 1] = cg2 * __builtin_amdgcn_cvt_scalef32_pk_f16_fp4(vl[it][q], 1.0f, 1) + acc[4 * q + 1]; \
                acc[4 * q + 2] = cg2 * __builtin_amdgcn_cvt_scalef32_pk_f16_fp4(vl[it][q], 1.0f, 2) + acc[4 * q + 2]; acc[4 * q + 3] = cg2 * __builtin_amdgcn_cvt_scalef32_pk_f16_fp4(vl[it][q], 1.0f, 3) + acc[4 * q + 3]; } } \
        if ((((ch) & 7) == 7)) { const size_t off = (size_t)(tbase + 8 * ((ch) >> 3) + ti) * DM + hoff; \
            _Pragma("unroll") for (int q = 0; q < 8; ++q) { f32x4 v = *(const f32x4*)(x1 + off + 4 * q); \
                v += (f32x4){(float)acc[2 * q].x, (float)acc[2 * q].y, (float)acc[2 * q + 1].x, (float)acc[2 * q + 1].y} * (1.0f / 64.0f); \
                *(f32x4*)(dst + off + 4 * q) = v; } \
            _Pragma("unroll") for (int q = 0; q < 16; ++q) acc[q] = (f16x2v){(_Float16)0.f, (_Float16)0.f}; } } while (0)
    for (int vb = F.bid; vb < 256; vb += F.G) {
        const int x = vb & 7, j = vb >> 3, sl = x & 3; const int tbase = (x >> 2) * (T / 2) + 256 * j + 32 * F.wave;
        const size_t hoff = 256 * sl + 32 * c;
        v4u WA[4], WB[4], vlA[16], vlB[16]; unsigned cgA[16], cgB[16]; f16x2v acc[16];
#pragma unroll
        for (int q = 0; q < 16; ++q) acc[q] = (f16x2v){(_Float16)0.f, (_Float16)0.f};
        PV_LOADW(0, WA); PV_LOADW(1, WB);
        PV_ISSUE(WA, vlA, cgA);
        for (int ch = 0; ch < 32; ch += 2) {
            const int c2 = ch + 2 < 31 ? ch + 2 : 31, c3 = ch + 3 < 31 ? ch + 3 : 31;
            PV_ISSUE(WB, vlB, cgB);
            PV_LOADW(c2, WA);
            PV_COMPUTE(ch, vlA, cgA);
            PV_ISSUE(WA, vlA, cgA);
            PV_LOADW(c3, WB);
            PV_COMPUTE(ch + 1, vlB, cgB);
        }
    }
#undef PV_LOADW
#undef PV_ISSUE
#undef PV_COMPUTE
}

struct MirrorOrder {
    pg8::StaticOrder S8;
    __device__ __forceinline__ bool next(int i, pg8::Unit& u) const { pg8::Unit v; if (!S8.next(i, v)) return false; u.pm = v.pn; u.pn = v.pm; return true; }
    __device__ __forceinline__ void a_ready(const pg8::Unit&) const {}
    __device__ __forceinline__ void done(const pg8::Unit&) const {}
};
struct Args { const float* in[14]; float* out; unsigned char* ws; int ph_lo, ph_hi; };
#ifdef PEER_BF16
constexpr int N_PHASES = 12;
#else
constexpr int N_PHASES = 14;
#endif
#ifndef MK_PER_PHASE
#define MK_PER_PHASE 0
#endif

__global__ void __launch_bounds__(NWAVES * 64, 2) hybrid_fwd(Args args) {
    extern __shared__ __attribute__((aligned(16))) unsigned char lds[];
    Frame F;
    F.lds = (LAS unsigned char*)lds; F.MISC = (volatile LAS unsigned*)(F.lds + MISC_OFF);
    F.tid = threadIdx.x; F.lane = F.tid & 63; F.wave = __builtin_amdgcn_readfirstlane(F.tid >> 6); F.G = gridDim.x; F.bid = blockIdx.x;
    F.ctl = (gu32*)(args.ws + WS_CTL);
    if (F.tid < 64) ((LAS unsigned*)(F.lds + MISC_OFF))[F.tid] = 0u;
    __syncthreads();
    XcdBarrier bar; bar.bar = (unsigned*)(F.ctl + CW_BAR); bar.x = 0; bar.st = nullptr;
    if (!MK_PER_PHASE) bar = xcd_barrier_post((unsigned*)(F.ctl + CW_BAR), F.MISC + 8);
    const int lo = args.ph_lo, hi = args.ph_hi;
#define LOADP() { int t_ = threadIdx.x; asm volatile("" : "+v"(t_)); F.tid = t_; F.lane = t_ & 63; F.wave = __builtin_amdgcn_readfirstlane(t_ >> 6); } Ptrs P; { const __attribute__((address_space(4))) Args* ap = (const __attribute__((address_space(4))) Args*)__builtin_amdgcn_kernarg_segment_ptr(); asm volatile("" : "+s"(ap)); \
    P.x = ap->in[0]; P.mix_g = ap->in[1]; P.w_in = ap->in[2]; P.ret_w = ap->in[3]; P.q_gain = ap->in[4]; P.k_gain = ap->in[5]; P.moba_w = ap->in[6]; P.rel_bias = ap->in[7]; \
    P.w_out = ap->in[8]; P.ffn_g = ap->in[9]; P.peer_wq = ap->in[10]; P.sub_keys = ap->in[11]; P.peer_u = ap->in[12]; P.peer_v = ap->in[13]; P.out = ap->out; P.ws = ap->ws; } \
    unsigned char* ws = P.ws; bf16* XN = (bf16*)P.out; bf16* RETG = (bf16*)P.out; bf16* ATT = (bf16*)((unsigned char*)P.out + 32 * MiB); (void)ws; (void)XN; (void)RETG; (void)ATT;
#ifdef RET_NAIVE
#define RET_FN p3a_retention
#else
#define RET_FN p3a_retention_mfma
#endif
#ifdef MOBA_NAIVE
#define MOBA_FN p3b_moba
#else
#define MOBA_FN p3b_moba_mfma<0>
#endif
#ifndef DUP_MASK
#define DUP_MASK 0
#endif
#ifndef DUPPH
#define DUPPH 0
#endif
#define REPS(k) ((((DUPPH) >> (k)) & 1) ? 2 : 1)
#ifndef PH_MASK
#define PH_MASK 0xFFFF
#endif
#define IN(k) (((PH_MASK >> (k)) & 1) && lo <= (k) && (k) < hi)
#define LOCAL_SEAM(k) do { if (MK_PER_PHASE) {} } while (0)
#define SEAM(k) do { if (IN(k) && IN((k) + 1)) xcd_barrier(bar); } while (0)
    LAS unsigned char* ring = F.lds;

    if (IN(0)) for (int rep_ = 0; rep_ < REPS(0); ++rep_) { LOADP(); p0_prologue(F, P); } SEAM(0);
    if (IN(1)) for (int rep_ = 0; rep_ < REPS(1); ++rep_) { LOADP();
        pg8::Gemm g{XN, (const bf16*)(ws + WS_WIN), T, INW, DM, DM, DM, 0}; pg8::StaticOrder S; S.init(T, INW, F.G, F.bid);
        EpiInProj E{(bf16*)(ws + WS_RQ), (bf16*)(ws + WS_RK), (bf16*)(ws + WS_RV), (bf16*)(ws + WS_RG), (bf16*)(ws + WS_MQ), (bf16*)(ws + WS_MK), (bf16*)(ws + WS_MV), (bf16*)(ws + WS_GA), (bf16*)(ws + WS_GB),
                    (const float*)(ws + WS_ROPE), P.q_gain, P.k_gain, (float*)(ws + WS_KM)};
        pg8::gemm_phase<EpiInProj, pg8::StaticOrder, true, true>(ring, g, S, E);
        { const int nunit = (T / 256) * (INW / 256), rem = nunit % F.G;
          if (rem == 0) p0b_late_weights(F, P, F.bid, F.G); else if (F.bid >= rem) p0b_late_weights(F, P, F.bid - rem, F.G - rem); }
    } SEAM(1);
#ifdef EXTRA_BARS
    for (int xb_ = 0; xb_ < EXTRA_BARS; ++xb_) xcd_barrier(bar);
#endif
    if (IN(2)) for (int rep_ = 0; rep_ < REPS(2); ++rep_) { LOADP(); p2a_kv_mfma(F, P); } SEAM(2);
    if (IN(3)) for (int rep_ = 0; rep_ < REPS(3); ++rep_) { LOADP(); p2b_scan(F, P); } SEAM(3);
    if (IN(4)) for (int rep_ = 0; rep_ < REPS(4); ++rep_) { LOADP(); RET_FN(F, P); if (DUP_MASK & 1) RET_FN(F, P); MOBA_FN(F, P); if (DUP_MASK & 2) MOBA_FN(F, P);
#ifdef MOBA_ABL
        p3b_moba_mfma<MOBA_ABL>(F, P);
#endif
    } SEAM(4);
    if (IN(5)) for (int rep_ = 0; rep_ < REPS(5); ++rep_) { LOADP();
        pg8::Gemm g0{ATT, (const bf16*)(ws + WS_WB), T, DM, 512, 512, 512, 0}, g1{RETG, (const bf16*)(ws + WS_WA), T, DM, DM, DM, DM, 0};
        TwoSegOrder S; S.B.init(T, DM, F.G, F.bid);
        EpiMerge2 E{(bf16*)(ws + WS_MRG), (const bf16*)(ws + WS_GA), (const bf16*)(ws + WS_GB)};
        pg8::gemm_phase2<EpiMerge2, TwoSegOrder, true, true>(ring, g0, g1, S, E);
    } SEAM(5);
    if (IN(6)) for (int rep_ = 0; rep_ < REPS(6); ++rep_) { LOADP();
        pg8::Gemm g{(const bf16*)(ws + WS_MRG), (const bf16*)(ws + WS_WO), T, DM, DM, DM, DM, 0}; pg8::StaticOrder S; S.init(T, DM, F.G, F.bid);
        EpiResid E{P.x, P.out, (bf16*)(ws + WS_H2), P.ffn_g, (float*)(ws + WS_SUMSQ)};
        pg8::gemm_phase<EpiResid, pg8::StaticOrder, true, true>(ring, g, S, E);
    } SEAM(6);
    if (IN(9)) for (int rep_ = 0; rep_ < REPS(9); ++rep_) { LOADP();
        pg8::Gemm g{(const bf16*)(ws + WS_WQ), (const bf16*)(ws + WS_H2), PH * 256, T, DM, DM, DM, 0}; MirrorOrder S; S.S8.init(T, 2048, F.G, F.bid);
        EpiNatBf16 E{(bf16*)(ws + WS_ST), T, (const float*)(ws + WS_SUMSQ)};
        pg8::gemm_phase<EpiNatBf16, MirrorOrder, true, true>(ring, g, S, E);
        VM_WAIT(); __syncthreads();
    } LOCAL_SEAM(9);
    if (IN(10)) for (int rep_ = 0; rep_ < REPS(10); ++rep_) { LOADP(); p6_topk(F, P); } SEAM(10);
#ifdef PEER_BF16
    if (IN(11)) for (int rep_ = 0; rep_ < REPS(11); ++rep_) { LOADP(); if (DUP_MASK & 4) p7_peer(F, P, (float*)(ws + WS_ST)); p7_peer(F, P, P.out); }
#else
    if (IN(11)) for (int rep_ = 0; rep_ < REPS(11); ++rep_) { LOADP(); p7u_dots<0>(F, P); if (DUP_MASK & 4) p7u_dots<2>(F, P); } SEAM(11);
    if (IN(12)) for (int rep_ = 0; rep_ < REPS(12); ++rep_) { LOADP(); p7z_gate(F, P); } SEAM(12);
    if (IN(13)) for (int rep_ = 0; rep_ < REPS(13); ++rep_) { LOADP(); if (DUP_MASK & 16) p7v_accum<0>(F, P, (float*)(ws + WS_PART)); p7v_accum<0>(F, P, P.out); }
#endif
#undef IN
#undef SEAM
}

extern "C" void kernel_launch(void* const* d_in, const int* in_sizes, int n_in, void* d_out, int out_size, void* d_ws, size_t ws_size, hipStream_t stream) {
    static int grid = 0;
    if (grid == 0) {
        if (n_in != 14 || out_size != T * DM || ws_size < WS_END) { fprintf(stderr, "kernel_launch: unexpected problem (n_in %d, out %d, ws %zu); nothing launched\n", n_in, out_size, ws_size); grid = -1; return; }
        int dev = 0, cus = 0, per_cu = 0;
        if (hipGetDevice(&dev) != hipSuccess || hipDeviceGetAttribute(&cus, hipDeviceAttributeMultiprocessorCount, dev) != hipSuccess) { grid = -1; return; }
        if (hipFuncSetAttribute((const void*)hybrid_fwd, hipFuncAttributeMaxDynamicSharedMemorySize, LDS_BYTES) != hipSuccess) { fprintf(stderr, "kernel_launch: hipFuncSetAttribute failed\n"); grid = -1; return; }
        if (hipOccupancyMaxActiveBlocksPerMultiprocessor(&per_cu, (const void*)hybrid_fwd, NWAVES * 64, LDS_BYTES) != hipSuccess || per_cu < 1)
            fprintf(stderr, "kernel_launch: note: occupancy query reports %d workgroups per CU\n", per_cu);
        (void)hipGetLastError();
        grid = cus;
    }
    if (grid < 0) return;
    (void)hipMemsetAsync((char*)d_ws + WS_CTL, 0, CTL_ZERO_BYTES, stream);
    Args a{};
    for (int i = 0; i < 14; ++i) a.in[i] = (const float*)d_in[i];
    a.out = (float*)d_out; a.ws = (unsigned char*)d_ws;
#if MK_PER_PHASE
    for (int p = 0; p < N_PHASES; ++p) { a.ph_lo = p; a.ph_hi = p + 1; hipLaunchKernelGGL(hybrid_fwd, dim3(grid), dim3(NWAVES * 64), LDS_BYTES, stream, a); }
#else
    a.ph_lo = 0; a.ph_hi = N_PHASES;
    hipLaunchKernelGGL(hybrid_fwd, dim3(grid), dim3(NWAVES * 64), LDS_BYTES, stream, a);
#endif
}
```

```cpp
#include <hip/hip_runtime.h>
#include <cstdio>
#include <cstdint>

#define GAS __attribute__((address_space(1)))
#define LAS __attribute__((address_space(3)))
typedef unsigned short bf16;
typedef unsigned v4u __attribute__((ext_vector_type(4)));
typedef unsigned v2u __attribute__((ext_vector_type(2)));
typedef float f32x4 __attribute__((ext_vector_type(4)));
typedef short bf16x8 __attribute__((ext_vector_type(8)));
typedef float f32x16 __attribute__((ext_vector_type(16)));
typedef GAS unsigned gu32;
#define RLX_AGENT __ATOMIC_RELAXED, __HIP_MEMORY_SCOPE_AGENT
#define LDS_WAIT() asm volatile("s_waitcnt lgkmcnt(0)" ::: "memory")
#define VM_WAIT() asm volatile("s_waitcnt vmcnt(0)" ::: "memory")

constexpr int BATCH = 4, SEQ = 4096, DM = 1024, T = BATCH * SEQ;
constexpr int RH = 8, RDK = 64, RDV = 128, RC = 128, NCH = SEQ / RC;
constexpr int MH = 8, MD = 64, MBLK = 256, NBLK = SEQ / MBLK;
constexpr int PH = 8, PNK = 128, PTOP = 16, PQD = 256;
constexpr int NEXP = PNK * PNK;
constexpr int INW = 6656;
constexpr float EPS = 1e-6f;

__device__ __forceinline__ unsigned f2bf(float f) { unsigned u = __builtin_bit_cast(unsigned, f); return (u + 0x7fffu + ((u >> 16) & 1u)) >> 16; }
typedef float f32x2_t __attribute__((ext_vector_type(2))); typedef __bf16 bf16x2_t __attribute__((ext_vector_type(2)));
__device__ __forceinline__ unsigned pk2(float lo, float hi) { const f32x2_t v = {lo, hi}; const bf16x2_t b = __builtin_convertvector(v, bf16x2_t); return __builtin_bit_cast(unsigned, b); }
__device__ __forceinline__ float bf2f(unsigned short b) { return __builtin_bit_cast(float, (unsigned)b << 16); }
__device__ __forceinline__ float bflo(unsigned w) { return __builtin_bit_cast(float, w << 16); }
__device__ __forceinline__ float bfhi(unsigned w) { return __builtin_bit_cast(float, w & 0xffff0000u); }
__device__ __forceinline__ float wave_sum(float v) {
#pragma unroll
    for (int o = 1; o < 64; o <<= 1) v += __shfl_xor(v, o);
    return v;
}
__device__ __forceinline__ float dpp_sum8(float v) {
    v += __builtin_bit_cast(float, __builtin_amdgcn_mov_dpp(__builtin_bit_cast(int, v), 0xB1, 0xF, 0xF, true));
    v += __builtin_bit_cast(float, __builtin_amdgcn_mov_dpp(__builtin_bit_cast(int, v), 0x4E, 0xF, 0xF, true));
    v += __builtin_bit_cast(float, __builtin_amdgcn_mov_dpp(__builtin_bit_cast(int, v), 0x141, 0xF, 0xF, true));
    return v;
}
__device__ __forceinline__ float ret_l2g(int h) { return log1pf(-exp2f(-5.0f - (float)h)) * 1.4426950408889634f; }

__host__ __device__ __forceinline__ int perm_row_of_col(int a) {
    const int tile = a >> 8, w = a & 255, wc = w >> 6, bj = (w >> 5) & 1, q = w & 31, fq = q >> 3, n = (q >> 2) & 1, e = q & 3;
    return tile * 256 + 128 * bj + 32 * wc + 16 * n + 4 * fq + e;
}
namespace pg8 {
#define PG8_LAS __attribute__((address_space(3)))
typedef unsigned short bf16_t;
typedef short bf16x8 __attribute__((ext_vector_type(8)));
typedef float f32x4 __attribute__((ext_vector_type(4)));
typedef unsigned u32x4 __attribute__((ext_vector_type(4)));
constexpr int BM = 256, BK = 64, HALF = 128, HTB = HALF * BK * 2  , STAGE_BYTES = 8 * HTB, NXCD = 8, WGM = 8;

__host__ __device__ __forceinline__ int lds_byte(int r, int c) { const int st = (r >> 4) * 2 + (c >> 5), rr = r & 15, cc = c & 31, ob = rr * 64 + cc * 2; return st * 1024 + (ob ^ (((ob >> 9) & 1) << 5)); }
__host__ __device__ __forceinline__ void stage_rc(int b, int& R, int& C) { const int st = b / 1024, sb = b % 1024, swz = sb ^ (((sb >> 9) & 1) << 5); R = (st >> 1) * 16 + swz / 64; C = (st & 1) * 32 + (swz % 64) / 2; }
__host__ __device__ __forceinline__ int perm32(int rho) { const int n = rho >> 4, i = rho & 15; return 8 * (i >> 2) + 4 * n + (i & 3); }

struct Unit { int pm, pn, seg; };
struct Gemm { const bf16_t* A; const bf16_t* Bt; int M, N, K, lda, ldb, bpm; };

struct StaticOrder {
    int nM, nN, nwg, G, c;
    __host__ __device__ void init(int M, int N, int G_, int c_) { nM = M / BM; nN = N / BM; nwg = nM * nN; G = G_; c = c_; }
    __host__ __device__ bool next(int i, Unit& u) const {
        const long L = (long)i * G + c; if (L >= nwg) return false;
        int wgid = (int)L; { const int q = nwg / NXCD, r = nwg % NXCD, xcd = wgid % NXCD, off = wgid / NXCD; wgid = (xcd < r ? xcd * (q + 1) : r * (q + 1) + (xcd - r) * q) + off; }
        const int nig = WGM * nN, gid = wgid / nig, fm = gid * WGM, gsz = (nM - fm) < WGM ? (nM - fm) : WGM;
        u.pm = fm + ((wgid % nig) % gsz); u.pn = (wgid % nig) / gsz; u.seg = 0; return true;
    }
    __device__ __forceinline__ void a_ready(const Unit&) const {}
    __device__ __forceinline__ void done(const Unit&) const {}
};


template <class Epi, class Sched, bool ALIGN_EPI = false, bool SP2 = false>
__device__ __forceinline__ void gemm_phase(PG8_LAS unsigned char* lds, const Gemm g, const Sched& S, const Epi& E) {
    int tid_ = threadIdx.x; asm volatile("" : "+v"(tid_));
    const int tid = tid_, wid = __builtin_amdgcn_readfirstlane(tid >> 6), lane = tid & 63, wr = wid >> 2, wc = wid & 3, fr = lane & 15, fq = lane >> 4;
    const int K = g.K, nt = K / BK;
    unsigned voffA[2], voffB[2];
#pragma unroll
    for (int i = 0; i < 2; ++i) { int R, C; stage_rc(tid * 16 + i * 8192, R, C);
        voffA[i] = (unsigned)(R * g.lda + C) * 2u; voffB[i] = (unsigned)(R * g.ldb + C) * 2u; }
    const size_t kstep = (size_t)(BK * 2);
    const size_t hstepA = (size_t)HALF * g.lda * 2, hstepB = (size_t)HALF * g.ldb * 2;
    const size_t tstepA = 2 * hstepA, tstepB = 2 * hstepB;
    const unsigned ldsw = (unsigned)wid * 1024u;
    const int aoff = lds_byte(wr * 64 + fr, fq * 8), boff = lds_byte(wc * 32 + fr, fq * 8);
#define PG8_SA(b, h) (((b) * 2 + (h)) * HTB)
#define PG8_SB(b, h) ((4 + (b) * 2 + (h)) * HTB)
#define PG8_STAGE(bufoff, gbase, voff) do { _Pragma("unroll") for (int _i = 0; _i < 2; ++_i) \
        __builtin_amdgcn_global_load_lds((const unsigned*)((const char*)(gbase) + (voff)[_i]), (PG8_LAS unsigned*)(lds + (bufoff) + ldsw + _i * 8192), 16, 0, 0); } while (0)
#define PG8_LDA(dst, b, h) do { _Pragma("unroll") for (int m = 0; m < 4; ++m) _Pragma("unroll") for (int k = 0; k < 2; ++k) dst[m][k] = *(const PG8_LAS bf16x8*)(lds + PG8_SA(b, h) + aoff + m * 2048 + k * 1024); } while (0)
#define PG8_LDB(dst, b, h) do { _Pragma("unroll") for (int n = 0; n < 2; ++n) _Pragma("unroll") for (int k = 0; k < 2; ++k) dst[n][k] = *(const PG8_LAS bf16x8*)(lds + PG8_SB(b, h) + boff + n * 2048 + k * 1024); } while (0)
#define PG8_MMA(ai, bj, At, Bt) do { __builtin_amdgcn_s_setprio(1); _Pragma("unroll") for (int m = 0; m < 4; ++m) _Pragma("unroll") for (int n = 0; n < 2; ++n) _Pragma("unroll") for (int k = 0; k < 2; ++k) \
        acc[ai][bj][m][n] = __builtin_amdgcn_mfma_f32_16x16x32_bf16(Bt[n][k], At[m][k], acc[ai][bj][m][n], 0, 0, 0); __builtin_amdgcn_s_setprio(0); } while (0)
#define PG8_WAIT_V(n) asm volatile("s_waitcnt vmcnt(" #n ")" ::: "memory")
#define PG8_WAIT_L(n) asm volatile("s_waitcnt lgkmcnt(" #n ")" ::: "memory")
#define PG8_BAR __builtin_amdgcn_s_barrier()
#define PG8_SCHED __builtin_amdgcn_sched_barrier(0)
    Unit cur, nxt; int ui = 0;
    if (!S.next(0, cur)) return;
    f32x4 acc[2][2][4][2];
#pragma unroll
    for (int a = 0; a < 2; ++a)
#pragma unroll
        for (int b = 0; b < 2; ++b)
#pragma unroll
            for (int m = 0; m < 4; ++m)
#pragma unroll
                for (int n = 0; n < 2; ++n) acc[a][b][m][n] = (f32x4){0.f, 0.f, 0.f, 0.f};
    bf16x8 At[4][2], B0[2][2], B1[2][2];
    const char* cA = (const char*)g.A + (size_t)cur.pm * tstepA; const char* cB = (const char*)g.Bt + (size_t)cur.pn * tstepB + (size_t)cur.pm * g.bpm;
    S.a_ready(cur);
    if constexpr (SP2) {
        PG8_STAGE(PG8_SB(0, 0), cB, voffB); PG8_STAGE(PG8_SB(0, 1), cB + hstepB, voffB); PG8_STAGE(PG8_SA(0, 0), cA, voffA); PG8_STAGE(PG8_SA(0, 1), cA + hstepA, voffA);
        if (wr == 1) PG8_BAR;
        PG8_WAIT_V(2); PG8_BAR;
        PG8_STAGE(PG8_SB(1, 0), cB + kstep, voffB); PG8_STAGE(PG8_SA(1, 0), cA + kstep, voffA); PG8_STAGE(PG8_SB(1, 1), cB + hstepB + kstep, voffB);
        PG8_WAIT_V(6); PG8_BAR;
    } else {
        PG8_STAGE(PG8_SB(0, 0), cB, voffB); PG8_STAGE(PG8_SA(0, 0), cA, voffA); PG8_STAGE(PG8_SB(0, 1), cB + hstepB, voffB); PG8_STAGE(PG8_SA(0, 1), cA + hstepA, voffA);
        if (wr == 1) PG8_BAR;
        PG8_WAIT_V(4); PG8_BAR;
        PG8_STAGE(PG8_SB(1, 0), cB + kstep, voffB); PG8_STAGE(PG8_SA(1, 0), cA + kstep, voffA); PG8_STAGE(PG8_SB(1, 1), cB + hstepB + kstep, voffB);
        PG8_WAIT_V(6); PG8_BAR;
    }
    for (;;) {
        const bool has_next = S.next(ui + 1, nxt);
        const char* nA = has_next ? (const char*)g.A + (size_t)nxt.pm * tstepA : cA; const char* nB = has_next ? (const char*)g.Bt + (size_t)nxt.pn * tstepB + (size_t)nxt.pm * g.bpm : cB;
        for (int t = 0; t < nt; t += 2) {
            const bool last = (t == nt - 2);
            const char* a1 = cA + (size_t)(t + 1) * kstep;
            const char* a2 = last ? nA : cA + (size_t)(t + 2) * kstep; const char* b2 = last ? nB : cB + (size_t)(t + 2) * kstep;
            const char* a3 = a2 + kstep; const char* b3 = b2 + kstep;
            if (last && has_next) S.a_ready(nxt);
            if constexpr (SP2) {
            PG8_LDB(B0, 0, 0); PG8_LDB(B1, 0, 1); PG8_SCHED; PG8_LDA(At, 0, 0); PG8_STAGE(PG8_SA(1, 1), a1 + hstepA, voffA);
            PG8_WAIT_V(8); PG8_WAIT_L(0); PG8_BAR; PG8_MMA(0, 0, At, B0); PG8_MMA(0, 1, At, B1); PG8_BAR; PG8_SCHED;
            PG8_LDA(At, 0, 1); PG8_STAGE(PG8_SB(0, 0), b2, voffB); PG8_STAGE(PG8_SB(0, 1), b2 + hstepB, voffB); PG8_STAGE(PG8_SA(0, 0), a2, voffA);
            PG8_WAIT_V(8); PG8_WAIT_L(0); PG8_BAR; PG8_MMA(1, 0, At, B0); PG8_MMA(1, 1, At, B1); PG8_BAR; PG8_SCHED;
            PG8_LDB(B0, 1, 0); PG8_LDB(B1, 1, 1); PG8_SCHED; PG8_LDA(At, 1, 0); PG8_STAGE(PG8_SA(0, 1), a2 + hstepA, voffA);
            PG8_WAIT_V(8); PG8_WAIT_L(0); PG8_BAR; PG8_MMA(0, 0, At, B0); PG8_MMA(0, 1, At, B1); PG8_BAR; PG8_SCHED;
            PG8_LDA(At, 1, 1); PG8_STAGE(PG8_SB(1, 0), b3, voffB); PG8_STAGE(PG8_SB(1, 1), b3 + hstepB, voffB); PG8_STAGE(PG8_SA(1, 0), a3, voffA);
            PG8_WAIT_V(8); PG8_WAIT_L(0); PG8_BAR; PG8_MMA(1, 0, At, B0); PG8_MMA(1, 1, At, B1); PG8_BAR; PG8_SCHED;
            } else {
            PG8_LDB(B0, 0, 0); PG8_SCHED; PG8_LDA(At, 0, 0); PG8_STAGE(PG8_SA(1, 1), a1 + hstepA, voffA);
            PG8_WAIT_L(8); PG8_BAR; PG8_WAIT_L(0); PG8_MMA(0, 0, At, B0); PG8_BAR; PG8_SCHED;
            PG8_LDB(B1, 0, 1); PG8_STAGE(PG8_SB(0, 0), b2, voffB);
            PG8_BAR; PG8_WAIT_L(0); PG8_MMA(0, 1, At, B1); PG8_BAR;
            PG8_LDA(At, 0, 1); PG8_STAGE(PG8_SA(0, 0), a2, voffA);
            PG8_BAR; PG8_WAIT_L(0); PG8_MMA(1, 0, At, B0); PG8_BAR; PG8_SCHED;
            PG8_STAGE(PG8_SB(0, 1), b2 + hstepB, voffB);
            PG8_WAIT_V(6); PG8_BAR; PG8_MMA(1, 1, At, B1); PG8_BAR;
            PG8_LDB(B0, 1, 0); PG8_SCHED; PG8_LDA(At, 1, 0); PG8_STAGE(PG8_SA(0, 1), a2 + hstepA, voffA);
            PG8_WAIT_L(8); PG8_BAR; PG8_WAIT_L(0); PG8_MMA(0, 0, At, B0); PG8_BAR; PG8_SCHED;
            PG8_LDB(B1, 1, 1); PG8_STAGE(PG8_SB(1, 0), b3, voffB);
            PG8_BAR; PG8_WAIT_L(0); PG8_MMA(0, 1, At, B1); PG8_BAR;
            PG8_LDA(At, 1, 1); PG8_STAGE(PG8_SA(1, 0), a3, voffA);
            PG8_BAR; PG8_WAIT_L(0); PG8_MMA(1, 0, At, B0); PG8_BAR; PG8_SCHED;
            PG8_STAGE(PG8_SB(1, 1), b3 + hstepB, voffB);
            PG8_WAIT_V(6); PG8_BAR; PG8_MMA(1, 1, At, B1); PG8_BAR;
            }
        }
        if constexpr (ALIGN_EPI) { if (wr == 0) PG8_BAR; }
        if constexpr (!Epi::AFTER_DRAIN) { E(acc, cur, wr, wc, fr, fq); S.done(cur); }
        if (!has_next) break;
#pragma unroll
        for (int a = 0; a < 2; ++a)
#pragma unroll
            for (int b = 0; b < 2; ++b)
#pragma unroll
                for (int m = 0; m < 4; ++m)
#pragma unroll
                    for (int n = 0; n < 2; ++n) acc[a][b][m][n] = (f32x4){0.f, 0.f, 0.f, 0.f};
        cur = nxt; cA = nA; cB = nB; ++ui;
        if constexpr (ALIGN_EPI) { if (wr == 1) PG8_BAR; }
    }
    PG8_WAIT_V(0);
    if constexpr (!ALIGN_EPI) { if (wr == 0) PG8_BAR; }
    PG8_BAR;
    if constexpr (Epi::AFTER_DRAIN) { E.fused(acc, cur, wr, wc, fr, fq, lds, wid, lane); S.done(cur); }
#undef PG8_SA
#undef PG8_SB
#undef PG8_STAGE
#undef PG8_LDA
#undef PG8_LDB
#undef PG8_MMA
#undef PG8_WAIT_V
#undef PG8_WAIT_L
#undef PG8_BAR
#undef PG8_SCHED
}
template <class Epi, class Sched, bool ALIGN_EPI = false, bool SP2 = false>
__device__ __forceinline__ void gemm_phase2(PG8_LAS unsigned char* lds, const Gemm g0, const Gemm g1, const Sched& S, const Epi& E) {
    int tid_ = threadIdx.x; asm volatile("" : "+v"(tid_));
    const int tid = tid_, wid = __builtin_amdgcn_readfirstlane(tid >> 6), lane = tid & 63, wr = wid >> 2, wc = wid & 3, fr = lane & 15, fq = lane >> 4;
    unsigned voffA0[2], voffB0[2], voffA1[2], voffB1[2];
#pragma unroll
    for (int i = 0; i < 2; ++i) { int R, C; stage_rc(tid * 16 + i * 8192, R, C);
        voffA0[i] = (unsigned)(R * g0.lda + C) * 2u; voffB0[i] = (unsigned)(R * g0.ldb + C) * 2u; voffA1[i] = (unsigned)(R * g1.lda + C) * 2u; voffB1[i] = (unsigned)(R * g1.ldb + C) * 2u; }
    const size_t kstep = (size_t)(BK * 2);
    const size_t hstepA0 = (size_t)HALF * g0.lda * 2, hstepB0 = (size_t)HALF * g0.ldb * 2, hstepA1 = (size_t)HALF * g1.lda * 2, hstepB1 = (size_t)HALF * g1.ldb * 2;
    const size_t tstepA0 = 2 * hstepA0, tstepB0 = 2 * hstepB0, tstepA1 = 2 * hstepA1, tstepB1 = 2 * hstepB1;
    const unsigned ldsw = (unsigned)wid * 1024u;
    const int aoff = lds_byte(wr * 64 + fr, fq * 8), boff = lds_byte(wc * 32 + fr, fq * 8);
#define PG8_SA(b, h) (((b) * 2 + (h)) * HTB)
#define PG8_SB(b, h) ((4 + (b) * 2 + (h)) * HTB)
#define PG8_STAGE(bufoff, gbase, voff) do { _Pragma("unroll") for (int _i = 0; _i < 2; ++_i) \
        __builtin_amdgcn_global_load_lds((const unsigned*)((const char*)(gbase) + (voff)[_i]), (PG8_LAS unsigned*)(lds + (bufoff) + ldsw + _i * 8192), 16, 0, 0); } while (0)
#define PG8_LDA(dst, b, h) do { _Pragma("unroll") for (int m = 0; m < 4; ++m) _Pragma("unroll") for (int k = 0; k < 2; ++k) dst[m][k] = *(const PG8_LAS bf16x8*)(lds + PG8_SA(b, h) + aoff + m * 2048 + k * 1024); } while (0)
#define PG8_LDB(dst, b, h) do { _Pragma("unroll") for (int n = 0; n < 2; ++n) _Pragma("unroll") for (int k = 0; k < 2; ++k) dst[n][k] = *(const PG8_LAS bf16x8*)(lds + PG8_SB(b, h) + boff + n * 2048 + k * 1024); } while (0)
#define PG8_MMA(ai, bj, At, Bt) do { __builtin_amdgcn_s_setprio(1); _Pragma("unroll") for (int m = 0; m < 4; ++m) _Pragma("unroll") for (int n = 0; n < 2; ++n) _Pragma("unroll") for (int k = 0; k < 2; ++k) \
        acc[ai][bj][m][n] = __builtin_amdgcn_mfma_f32_16x16x32_bf16(Bt[n][k], At[m][k], acc[ai][bj][m][n], 0, 0, 0); __builtin_amdgcn_s_setprio(0); } while (0)
#define PG8_WAIT_V(n) asm volatile("s_waitcnt vmcnt(" #n ")" ::: "memory")
#define PG8_WAIT_L(n) asm volatile("s_waitcnt lgkmcnt(" #n ")" ::: "memory")
#define PG8_BAR __builtin_amdgcn_s_barrier()
#define PG8_SCHED __builtin_amdgcn_sched_barrier(0)
    Unit cur, nxt; int ui = 0;
    if (!S.next(0, cur)) return;
    f32x4 acc[2][2][4][2];
#pragma unroll
    for (int a = 0; a < 2; ++a)
#pragma unroll
        for (int b = 0; b < 2; ++b)
#pragma unroll
            for (int m = 0; m < 4; ++m)
#pragma unroll
                for (int n = 0; n < 2; ++n) acc[a][b][m][n] = (f32x4){0.f, 0.f, 0.f, 0.f};
    bf16x8 At[4][2], B0[2][2], B1[2][2];
#define PG8_UA(u_) ((u_).seg ? (const char*)g1.A + (size_t)(u_).pm * tstepA1 : (const char*)g0.A + (size_t)(u_).pm * tstepA0)
#define PG8_UB(u_) ((u_).seg ? (const char*)g1.Bt + (size_t)(u_).pn * tstepB1 : (const char*)g0.Bt + (size_t)(u_).pn * tstepB0)
    const char* cA = PG8_UA(cur); const char* cB = PG8_UB(cur);
    size_t hAc = cur.seg ? hstepA1 : hstepA0, hBc = cur.seg ? hstepB1 : hstepB0; unsigned vAc[2], vBc[2];
#pragma unroll
    for (int i = 0; i < 2; ++i) { vAc[i] = cur.seg ? voffA1[i] : voffA0[i]; vBc[i] = cur.seg ? voffB1[i] : voffB0[i]; }
    int nt = (cur.seg ? g1.K : g0.K) / BK;
    S.a_ready(cur);
    if constexpr (SP2) {
        PG8_STAGE(PG8_SB(0, 0), cB, vBc); PG8_STAGE(PG8_SB(0, 1), cB + hBc, vBc); PG8_STAGE(PG8_SA(0, 0), cA, vAc); PG8_STAGE(PG8_SA(0, 1), cA + hAc, vAc);
        if (wr == 1) PG8_BAR;
        PG8_WAIT_V(2); PG8_BAR;
        PG8_STAGE(PG8_SB(1, 0), cB + kstep, vBc); PG8_STAGE(PG8_SA(1, 0), cA + kstep, vAc); PG8_STAGE(PG8_SB(1, 1), cB + hBc + kstep, vBc);
        PG8_WAIT_V(6); PG8_BAR;
    } else {
        PG8_STAGE(PG8_SB(0, 0), cB, vBc); PG8_STAGE(PG8_SA(0, 0), cA, vAc); PG8_STAGE(PG8_SB(0, 1), cB + hBc, vBc); PG8_STAGE(PG8_SA(0, 1), cA + hAc, vAc);
        if (wr == 1) PG8_BAR;
        PG8_WAIT_V(4); PG8_BAR;
        PG8_STAGE(PG8_SB(1, 0), cB + kstep, vBc); PG8_STAGE(PG8_SA(1, 0), cA + kstep, vAc); PG8_STAGE(PG8_SB(1, 1), cB + hBc + kstep, vBc);
        PG8_WAIT_V(6); PG8_BAR;
    }
    for (;;) {
        const bool has_next = S.next(ui + 1, nxt);
        const char* nA = has_next ? PG8_UA(nxt) : cA; const char* nB = has_next ? PG8_UB(nxt) : cB;
        const int sn = has_next ? nxt.seg : cur.seg; const size_t hAn = sn ? hstepA1 : hstepA0, hBn = sn ? hstepB1 : hstepB0; unsigned vAn[2], vBn[2];
#pragma unroll
        for (int i = 0; i < 2; ++i) { vAn[i] = sn ? voffA1[i] : voffA0[i]; vBn[i] = sn ? voffB1[i] : voffB0[i]; }
        for (int t = 0; t < nt; t += 2) {
            const bool last = (t == nt - 2);
            const size_t hA2 = last ? hAn : hAc, hB2 = last ? hBn : hBc; unsigned vA2[2], vB2[2];
#pragma unroll
            for (int i = 0; i < 2; ++i) { vA2[i] = last ? vAn[i] : vAc[i]; vB2[i] = last ? vBn[i] : vBc[i]; }
            const char* a1 = cA + (size_t)(t + 1) * kstep;
            const char* a2 = last ? nA : cA + (size_t)(t + 2) * kstep; const char* b2 = last ? nB : cB + (size_t)(t + 2) * kstep;
            const char* a3 = a2 + kstep; const char* b3 = b2 + kstep;
            if (last && has_next) S.a_ready(nxt);
            if constexpr (SP2) {
            PG8_LDB(B0, 0, 0); PG8_LDB(B1, 0, 1); PG8_SCHED; PG8_LDA(At, 0, 0); PG8_STAGE(PG8_SA(1, 1), a1 + hAc, vAc);
            PG8_WAIT_V(8); PG8_WAIT_L(0); PG8_BAR; PG8_MMA(0, 0, At, B0); PG8_MMA(0, 1, At, B1); PG8_BAR; PG8_SCHED;
            PG8_LDA(At, 0, 1); PG8_STAGE(PG8_SB(0, 0), b2, vB2); PG8_STAGE(PG8_SB(0, 1), b2 + hB2, vB2); PG8_STAGE(PG8_SA(0, 0), a2, vA2);
            PG8_WAIT_V(8); PG8_WAIT_L(0); PG8_BAR; PG8_MMA(1, 0, At, B0); PG8_MMA(1, 1, At, B1); PG8_BAR; PG8_SCHED;
            PG8_LDB(B0, 1, 0); PG8_LDB(B1, 1, 1); PG8_SCHED; PG8_LDA(At, 1, 0); PG8_STAGE(PG8_SA(0, 1), a2 + hA2, vA2);
            PG8_WAIT_V(8); PG8_WAIT_L(0); PG8_BAR; PG8_MMA(0, 0, At, B0); PG8_MMA(0, 1, At, B1); PG8_BAR; PG8_SCHED;
            PG8_LDA(At, 1, 1); PG8_STAGE(PG8_SB(1, 0), b3, vB2); PG8_STAGE(PG8_SB(1, 1), b3 + hB2, vB2); PG8_STAGE(PG8_SA(1, 0), a3, vA2);
            PG8_WAIT_V(8); PG8_WAIT_L(0); PG8_BAR; PG8_MMA(1, 0, At, B0); PG8_MMA(1, 1, At, B1); PG8_BAR; PG8_SCHED;
            } else {
            PG8_LDB(B0, 0, 0); PG8_SCHED; PG8_LDA(At, 0, 0); PG8_STAGE(PG8_SA(1, 1), a1 + hAc, vAc);
            PG8_WAIT_L(8); PG8_BAR; PG8_WAIT_L(0); PG8_MMA(0, 0, At, B0); PG8_BAR; PG8_SCHED;
            PG8_LDB(B1, 0, 1); PG8_STAGE(PG8_SB(0, 0), b2, vB2);
            PG8_BAR; PG8_WAIT_L(0); PG8_MMA(0, 1, At, B1); PG8_BAR;
            PG8_LDA(At, 0, 1); PG8_STAGE(PG8_SA(0, 0), a2, vA2);
            PG8_BAR; PG8_WAIT_L(0); PG8_MMA(1, 0, At, B0); PG8_BAR; PG8_SCHED;
            PG8_STAGE(PG8_SB(0, 1), b2 + hB2, vB2);
            PG8_WAIT_V(6); PG8_BAR; PG8_MMA(1, 1, At, B1); PG8_BAR;
            PG8_LDB(B0, 1, 0); PG8_SCHED; PG8_LDA(At, 1, 0); PG8_STAGE(PG8_SA(0, 1), a2 + hA2, vA2);
            PG8_WAIT_L(8); PG8_BAR; PG8_WAIT_L(0); PG8_MMA(0, 0, At, B0); PG8_BAR; PG8_SCHED;
            PG8_LDB(B1, 1, 1); PG8_STAGE(PG8_SB(1, 0), b3, vB2);
            PG8_BAR; PG8_WAIT_L(0); PG8_MMA(0, 1, At, B1); PG8_BAR;
            PG8_LDA(At, 1, 1); PG8_STAGE(PG8_SA(1, 0), a3, vA2);
            PG8_BAR; PG8_WAIT_L(0); PG8_MMA(1, 0, At, B0); PG8_BAR; PG8_SCHED;
            PG8_STAGE(PG8_SB(1, 1), b3 + hB2, vB2);
            PG8_WAIT_V(6); PG8_BAR; PG8_MMA(1, 1, At, B1); PG8_BAR;
            }
        }
        if constexpr (ALIGN_EPI) { if (wr == 0) PG8_BAR; }
        if (cur.seg == 0) E.mid(acc, cur, wr, wc, fr, fq); else { E(acc, cur, wr, wc, fr, fq); S.done(cur); }
        if (!has_next) break;
        if (cur.seg == 1) {
#pragma unroll
        for (int a = 0; a < 2; ++a)
#pragma unroll
            for (int b = 0; b < 2; ++b)
#pragma unroll
                for (int m = 0; m < 4; ++m)
#pragma unroll
                    for (int n = 0; n < 2; ++n) acc[a][b][m][n] = (f32x4){0.f, 0.f, 0.f, 0.f};
        }
        cur = nxt; cA = nA; cB = nB; ++ui; hAc = hAn; hBc = hBn; vAc[0] = vAn[0]; vAc[1] = vAn[1]; vBc[0] = vBn[0]; vBc[1] = vBn[1]; nt = (cur.seg ? g1.K : g0.K) / BK;
        if constexpr (ALIGN_EPI) { if (wr == 1) PG8_BAR; }
    }
    PG8_WAIT_V(0);
    if constexpr (!ALIGN_EPI) { if (wr == 0) PG8_BAR; }
    PG8_BAR;
#undef PG8_UA
#undef PG8_UB
#undef PG8_SA
#undef PG8_SB
#undef PG8_STAGE
#undef PG8_LDA
#undef PG8_LDB
#undef PG8_MMA
#undef PG8_WAIT_V
#undef PG8_WAIT_L
#undef PG8_BAR
#undef PG8_SCHED
}
}

#define XB_TMO      128
#define XB_XCNT(j)  (256  + 64 * (j))
#define XB_XSUB(j)  (1280 + 64 * (j))
#define XB_XGEN(j)  (2304 + 64 * (j))
#define XB_TOP      3328
#define XB_TOPGEN   3392
#define XCD_BAR_WORDS 3456
#define XB_SPIN_CAP (1u << 18)

__device__ __forceinline__ unsigned xb_ld(unsigned* p)              { return __hip_atomic_load(p, __ATOMIC_RELAXED, __HIP_MEMORY_SCOPE_AGENT); }
__device__ __forceinline__ unsigned xb_add(unsigned* p, unsigned v) { return __hip_atomic_fetch_add(p, v, __ATOMIC_RELAXED, __HIP_MEMORY_SCOPE_AGENT); }
__device__ __forceinline__ unsigned xb_xcc_id() { return (unsigned)__builtin_amdgcn_s_getreg((3 << 11) | 20) & 0xFu; }
#define XB_SPIN(cond, bar) do { unsigned _sp = 0; while (cond) { __builtin_amdgcn_s_sleep(1); \
    if ((++_sp & 255u) == 0u) { if (xb_ld(&(bar)[XB_TMO])) break; if (_sp > XB_SPIN_CAP) { atomicAdd(&(bar)[XB_TMO], 1u); break; } } } } while (0)

struct XcdBarrier {
    unsigned* bar; unsigned x;
    volatile LAS unsigned* st;
};

__device__ __forceinline__ XcdBarrier xcd_barrier_post(unsigned* bar, volatile LAS unsigned* st) {
    XcdBarrier b; b.bar = bar; b.x = xb_xcc_id(); b.st = st;
    if (threadIdx.x == 0) (void)xb_add(&bar[XB_XCNT(b.x)], 1u);
    return b;
}
__device__ __forceinline__ void xcd_barrier_complete(unsigned* bar, unsigned x, unsigned& nloc, unsigned& nx) {
    const unsigned G = gridDim.x * gridDim.y * gridDim.z;
    unsigned sum, cnt, mine, sp = 0u;
    for (;;) {
        sum = 0u; cnt = 0u; mine = 0u;
#pragma unroll
        for (unsigned j = 0; j < 16; ++j) { const unsigned c = xb_ld(&bar[XB_XCNT(j)]); sum += c; cnt += (c > 0u) ? 1u : 0u; mine = (j == x) ? c : mine; }
        if (sum == G) break;
        __builtin_amdgcn_s_sleep(1);
        if ((++sp & 255u) == 0u) { if (xb_ld(&bar[XB_TMO])) break; if (sp > XB_SPIN_CAP) { atomicAdd(&bar[XB_TMO], 1u); break; } }
    }
    nloc = mine > 0u ? mine : 1u; nx = cnt > 0u ? cnt : 1u;
}

__device__ __forceinline__ void xcd_barrier(const XcdBarrier& b) {
    asm volatile("s_waitcnt vmcnt(0)" ::: "memory");
    __syncthreads();
    if (threadIdx.x == 0) {
        unsigned* bar = b.bar;
        __builtin_amdgcn_s_waitcnt(0);
        unsigned nloc = b.st[0], nx = b.st[1];
        if (nloc == 0u) { xcd_barrier_complete(bar, b.x, nloc, nx); b.st[0] = nloc; b.st[1] = nx; }
        const unsigned old = xb_add(&bar[XB_XSUB(b.x)], 1u);
        const unsigned gen = old / nloc;
        if (old + 1u == (gen + 1u) * nloc) {
            __builtin_amdgcn_fence(__ATOMIC_RELEASE, "agent");
            asm volatile("s_waitcnt vmcnt(0)" ::: "memory");
            const unsigned og = xb_add(&bar[XB_TOP], 1u);
            const unsigned tg = og / nx;
            if (og + 1u == (tg + 1u) * nx) xb_add(&bar[XB_TOPGEN], 1u);
            else XB_SPIN(xb_ld(&bar[XB_TOPGEN]) == tg, bar);
            __builtin_amdgcn_fence(__ATOMIC_ACQUIRE, "agent");
            xb_add(&bar[XB_XGEN(b.x)], 1u);
            asm volatile("s_waitcnt vmcnt(0)" ::: "memory");
        } else {
            XB_SPIN(xb_ld(&bar[XB_XGEN(b.x)]) == gen, bar);
            __builtin_amdgcn_fence(__ATOMIC_ACQUIRE, "agent");
            asm volatile("s_waitcnt vmcnt(0)" ::: "memory");
        }
    }
    __syncthreads();
}

constexpr size_t MiB = 1u << 20;
constexpr size_t WS_CTL = 0, CTL_ZERO_BYTES = 192 * 1024;
constexpr size_t WS_SUMSQ = 128 * 1024;
constexpr int CW_BAR = 1024;
constexpr size_t WS_WIN = 1 * MiB;
constexpr size_t WS_WA = 14 * MiB;
constexpr size_t WS_WB = 16 * MiB;
constexpr size_t WS_WO = 17 * MiB;
constexpr size_t WS_WQ = 19 * MiB;
constexpr size_t WS_SKB = 23 * MiB;
constexpr size_t WS_ROPE = 24 * MiB;
constexpr size_t WS_BIAS = 25 * MiB;
constexpr size_t WS_KM = 25 * MiB + 256 * 1024;
constexpr size_t WS_PREV = 26 * MiB;
constexpr size_t WS_ACT = 42 * MiB;
constexpr size_t WS_RQ = WS_ACT, WS_RK = WS_RQ + 16 * MiB, WS_RV = WS_RK + 16 * MiB, WS_RG = WS_RV + 32 * MiB;
constexpr size_t WS_MQ = WS_RG + 32 * MiB, WS_MK = WS_MQ + 16 * MiB, WS_MV = WS_MK + 16 * MiB;
constexpr size_t WS_GA = WS_MV + 16 * MiB, WS_GB = WS_GA + 32 * MiB;
constexpr size_t WS_END = 256 * MiB;
constexpr size_t WS_YB = WS_ACT;
constexpr size_t WS_MRG = WS_ACT + 32 * MiB;
constexpr size_t WS_H2 = WS_ACT + 64 * MiB;
constexpr size_t WS_EG = WS_ACT + 96 * MiB;
constexpr size_t WS_QP = WS_ACT;
constexpr size_t WS_UV = WS_ACT;
constexpr size_t WS_UV8 = WS_ACT + 112 * MiB;
constexpr size_t WS_ST = WS_ACT + 144 * MiB;
static_assert(WS_GB + 32 * MiB <= WS_END && WS_EG + 16 * MiB <= WS_ST && WS_ST + 64 * MiB <= WS_END, "d_ws map");

constexpr int LDS_BYTES = 159 * 1024;
constexpr int MISC_OFF = LDS_BYTES - 256;
constexpr int NWAVES = 8;


using pg8::Unit;
__device__ __forceinline__ void store8_bf16(bf16* p, f32x4 a, f32x4 b) { v4u w; w.x = pk2(a[0], a[1]); w.y = pk2(a[2], a[3]); w.z = pk2(b[0], b[1]); w.w = pk2(b[2], b[3]); *(v4u*)p = w; }
__device__ __forceinline__ void load8_bf16(const bf16* p, f32x4& a, f32x4& b) { const v4u w = *(const v4u*)p; a = (f32x4){bflo(w.x), bfhi(w.x), bflo(w.y), bfhi(w.y)}; b = (f32x4){bflo(w.z), bfhi(w.z), bflo(w.w), bfhi(w.w)}; }
__device__ __forceinline__ float sigmoidf_(float x) { return __builtin_amdgcn_rcpf(1.0f + __builtin_amdgcn_exp2f(-1.4426950408889634f * x)); }
__device__ __forceinline__ f32x4 sig4(f32x4 v) { return (f32x4){sigmoidf_(v[0]), sigmoidf_(v[1]), sigmoidf_(v[2]), sigmoidf_(v[3])}; }
__device__ __forceinline__ f32x4 silu4(f32x4 v) { return v * sig4(v); }

#ifdef MOBA_NAIVE
constexpr float MOBA_QSCALE = 0.125f;
#else
constexpr float MOBA_QSCALE = 0.125f * 1.4426950408889634f;
#endif
struct EpiInProj {
    static constexpr bool AFTER_DRAIN = false;
    bf16 *RQ, *RK, *RV, *RG, *MQ, *MK, *MV, *GA, *GB; const float* rope; const float* qgain; const float* kgain; float* KMP;
    __device__ __forceinline__ void operator()(const f32x4 (&acc)[2][2][4][2], const Unit& u, int wr, int wc, int fr, int fq) const {
        const int pn = u.pn, rowb = u.pm * 256 + wr * 64 + fr, cw = 64 * wc + 8 * fq;
        if (pn < 4) {
            bf16* dst = (pn < 2 ? RQ : RK) + (pn & 1) * 256 + cw; const float sc = pn < 2 ? 1.0f : 0.125f;
#pragma unroll
            for (int ai = 0; ai < 2; ++ai)
#pragma unroll
                for (int m = 0; m < 4; ++m) {
                    const int row = rowb + ai * 128 + m * 16; const float* rp = rope + (size_t)(row & (SEQ - 1)) * 64 + 8 * fq;
                    const f32x4 c0 = *(const f32x4*)rp * sc, c1 = *(const f32x4*)(rp + 4) * sc, s0 = *(const f32x4*)(rp + 32) * sc, s1 = *(const f32x4*)(rp + 36) * sc;
                    const f32x4 x10 = acc[ai][0][m][0], x11 = acc[ai][0][m][1], x20 = acc[ai][1][m][0], x21 = acc[ai][1][m][1];
                    bf16* p = dst + (size_t)row * 512;
                    store8_bf16(p, x10 * c0 - x20 * s0, x11 * c1 - x21 * s1);
                    store8_bf16(p + 32, x10 * s0 + x20 * c0, x11 * s1 + x21 * c1);
                }
        } else if (pn < 12 || (pn >= 16)) {
            bf16* dst; int ld, mode;
            if (pn < 8) { dst = RV + (pn - 4) * 256; ld = 1024; mode = 0; }
            else if (pn < 12) { dst = RG + (pn - 8) * 256; ld = 1024; mode = 1; }
            else if (pn < 18) { dst = MV + (pn - 16) * 256; ld = 512; mode = 0; }
            else if (pn < 22) { dst = GA + (pn - 18) * 256; ld = 1024; mode = 2; }
            else { dst = GB + (pn - 22) * 256; ld = 1024; mode = 2; }
            dst += cw;
#pragma unroll
            for (int ai = 0; ai < 2; ++ai)
#pragma unroll
                for (int m = 0; m < 4; ++m) {
                    const int row = rowb + ai * 128 + m * 16; bf16* p = dst + (size_t)row * ld;
#pragma unroll
                    for (int bj = 0; bj < 2; ++bj) {
                        f32x4 a = acc[ai][bj][m][0], b = acc[ai][bj][m][1];
                        if (mode == 1) { a = silu4(a); b = silu4(b); } else if (mode == 2) { a = sig4(a); b = sig4(b); }
                        store8_bf16(p + 32 * bj, a, b);
                    }
                }
        } else {
            const bool isq = pn < 14; bf16* dst = (isq ? MQ : MK) + (pn & 1) * 256 + cw; const float* gain = (isq ? qgain : kgain) + 8 * fq; const float sc = isq ? MOBA_QSCALE : 1.0f;
            f32x4 cs00 = {0.f, 0.f, 0.f, 0.f}, cs01 = cs00, cs10 = cs00, cs11 = cs00;
            const f32x4 g00 = *(const f32x4*)gain * sc, g01 = *(const f32x4*)(gain + 4) * sc, g10 = *(const f32x4*)(gain + 32) * sc, g11 = *(const f32x4*)(gain + 36) * sc;
#pragma unroll
            for (int ai = 0; ai < 2; ++ai)
#pragma unroll
                for (int m = 0; m < 4; ++m) {
                    const int row = rowb + ai * 128 + m * 16; bf16* p = dst + (size_t)row * 512;
                    const f32x4 a0 = acc[ai][0][m][0], a1 = acc[ai][0][m][1], b0 = acc[ai][1][m][0], b1 = acc[ai][1][m][1];
                    const f32x4 q = a0 * a0 + a1 * a1 + b0 * b0 + b1 * b1; float ss = (q[0] + q[1]) + (q[2] + q[3]);
                    ss += __shfl_xor(ss, 16); ss += __shfl_xor(ss, 32);
                    const float r = rsqrtf(ss * (1.0f / 64.0f) + EPS);
                    const f32x4 y00 = a0 * r * g00, y01 = a1 * r * g01, y10 = b0 * r * g10, y11 = b1 * r * g11;
                    store8_bf16(p, y00, y01);
                    store8_bf16(p + 32, y10, y11);
                    if (!isq) { cs00 += y00; cs01 += y01; cs10 += y10; cs11 += y11; }
                }
            if (!isq) {
#pragma unroll
                for (int e = 0; e < 4; ++e) {
#pragma unroll
                    for (int o = 1; o < 16; o <<= 1) { cs00[e] += __shfl_xor(cs00[e], o); cs01[e] += __shfl_xor(cs01[e], o); cs10[e] += __shfl_xor(cs10[e], o); cs11[e] += __shfl_xor(cs11[e], o); }
                }
                if (fr == 0) { float* kp = KMP + (((size_t)u.pm * 2 + (pn & 1)) * 2 + wr) * 256 + cw;
                    *(f32x4*)kp = cs00; *(f32x4*)(kp + 4) = cs01; *(f32x4*)(kp + 32) = cs10; *(f32x4*)(kp + 36) = cs11; }
            }
        }
    }
};
struct EpiMerge2 {
    static constexpr bool AFTER_DRAIN = false;
    bf16* O; const bf16* GA; const bf16* GB;
    __device__ __forceinline__ void mid(f32x4 (&acc)[2][2][4][2], const Unit& u, int wr, int wc, int fr, int fq) const {
        const int rowb = u.pm * 256 + wr * 64 + fr, col = u.pn * 256 + 64 * wc + 8 * fq;
#pragma unroll
        for (int ai = 0; ai < 2; ++ai)
#pragma unroll
            for (int m = 0; m < 4; ++m) {
                const size_t off = (size_t)(rowb + ai * 128 + m * 16) * 1024 + col;
#pragma unroll
                for (int bj = 0; bj < 2; ++bj) { f32x4 a0, a1, b0, b1; load8_bf16(GA + off + 32 * bj, a0, a1); load8_bf16(GB + off + 32 * bj, b0, b1);
#pragma unroll
                    for (int e = 0; e < 4; ++e) { acc[ai][bj][m][0][e] *= b0[e] * __builtin_amdgcn_rcpf(fmaxf(a0[e], 1e-6f)); acc[ai][bj][m][1][e] *= b1[e] * __builtin_amdgcn_rcpf(fmaxf(a1[e], 1e-6f)); } }
            }
    }
    __device__ __forceinline__ void operator()(const f32x4 (&acc)[2][2][4][2], const Unit& u, int wr, int wc, int fr, int fq) const {
        const int rowb = u.pm * 256 + wr * 64 + fr, col = u.pn * 256 + 64 * wc + 8 * fq;
#pragma unroll
        for (int ai = 0; ai < 2; ++ai)
#pragma unroll
            for (int m = 0; m < 4; ++m) {
                const size_t off = (size_t)(rowb + ai * 128 + m * 16) * 1024 + col;
#pragma unroll
                for (int bj = 0; bj < 2; ++bj) { f32x4 a0, a1; load8_bf16(GA + off + 32 * bj, a0, a1);
#pragma unroll
                    for (int e = 0; e < 4; ++e) { a0[e] = fmaxf(a0[e], 1e-6f); a1[e] = fmaxf(a1[e], 1e-6f); }
                    store8_bf16(O + off + 32 * bj, acc[ai][bj][m][0] * a0, acc[ai][bj][m][1] * a1); }
            }
    }
};
struct TwoSegOrder {
    pg8::StaticOrder B;
    __device__ __forceinline__ bool next(int i, pg8::Unit& u) const { if (!B.next(i >> 1, u)) return false; u.seg = i & 1; return true; }
    __device__ __forceinline__ void a_ready(const pg8::Unit&) const {}
    __device__ __forceinline__ void done(const pg8::Unit&) const {}
};
struct EpiResid {
    static constexpr bool AFTER_DRAIN = false;
    const float* base; float* out; bf16* XG; const float* g2; float* SS;
    __device__ __forceinline__ void operator()(const f32x4 (&acc)[2][2][4][2], const Unit& u, int wr, int wc, int fr, int fq) const {
        const int rowb = u.pm * 256 + wr * 64 + fr, col = u.pn * 256 + 64 * wc + 8 * fq;
        const f32x4 g00 = *(const f32x4*)(g2 + col), g01 = *(const f32x4*)(g2 + col + 4), g10 = *(const f32x4*)(g2 + col + 32), g11 = *(const f32x4*)(g2 + col + 36);
#pragma unroll
        for (int ai = 0; ai < 2; ++ai)
#pragma unroll
            for (int m = 0; m < 4; ++m) {
                const int row = rowb + ai * 128 + m * 16; const size_t off = (size_t)row * 1024 + col;
                const f32x4 x00 = *(const f32x4*)(base + off) + acc[ai][0][m][0], x01 = *(const f32x4*)(base + off + 4) + acc[ai][0][m][1];
                const f32x4 x10 = *(const f32x4*)(base + off + 32) + acc[ai][1][m][0], x11 = *(const f32x4*)(base + off + 36) + acc[ai][1][m][1];
                *(f32x4*)(out + off) = x00; *(f32x4*)(out + off + 4) = x01; *(f32x4*)(out + off + 32) = x10; *(f32x4*)(out + off + 36) = x11;
                store8_bf16(XG + off, x00 * g00, x01 * g01); store8_bf16(XG + off + 32, x10 * g10, x11 * g11);
                const f32x4 q = x00 * x00 + x01 * x01 + x10 * x10 + x11 * x11; float ss = (q[0] + q[1]) + (q[2] + q[3]);
                ss += __shfl_xor(ss, 16); ss += __shfl_xor(ss, 32);
                if (fq == 0) atomicAdd(SS + row, ss);
            }
    }
};
struct EpiPlainBf16 {
    static constexpr bool AFTER_DRAIN = false;
    bf16* O; int ldc;
    __device__ __forceinline__ void operator()(const f32x4 (&acc)[2][2][4][2], const Unit& u, int wr, int wc, int fr, int fq) const {
        const int rowb = u.pm * 256 + wr * 64 + fr, col = u.pn * 256 + 64 * wc + 8 * fq;
#pragma unroll
        for (int ai = 0; ai < 2; ++ai)
#pragma unroll
            for (int m = 0; m < 4; ++m) {
                const size_t off = (size_t)(rowb + ai * 128 + m * 16) * ldc + col;
#pragma unroll
                for (int bj = 0; bj < 2; ++bj) store8_bf16(O + off + 32 * bj, acc[ai][bj][m][0], acc[ai][bj][m][1]);
            }
    }
};
struct EpiNatBf16 {
    static constexpr bool AFTER_DRAIN = false;
    bf16* O; int ldc; const float* SS;
    __device__ __forceinline__ void operator()(const f32x4 (&acc)[2][2][4][2], const Unit& u, int wr, int wc, int fr, int fq) const {
        const int rowb = u.pm * 256 + wr * 64 + fr, col = u.pn * 256 + 32 * wc + 4 * fq;
        f32x4 rs[2][2];
#pragma unroll
        for (int bj = 0; bj < 2; ++bj)
#pragma unroll
            for (int n = 0; n < 2; ++n) { const f32x4 s = *(const f32x4*)(SS + col + 128 * bj + 16 * n); rs[bj][n] = (f32x4){rsqrtf(s[0] * (1.0f / DM) + EPS), rsqrtf(s[1] * (1.0f / DM) + EPS), rsqrtf(s[2] * (1.0f / DM) + EPS), rsqrtf(s[3] * (1.0f / DM) + EPS)}; }
#pragma unroll
        for (int ai = 0; ai < 2; ++ai)
#pragma unroll
            for (int m = 0; m < 4; ++m) {
                const size_t off = (size_t)(rowb + ai * 128 + m * 16) * ldc + col;
#pragma unroll
                for (int bj = 0; bj < 2; ++bj)
#pragma unroll
                    for (int n = 0; n < 2; ++n) { const f32x4 v = acc[ai][bj][m][n] * rs[bj][n]; v2u w; w.x = pk2(v[0], v[1]); w.y = pk2(v[2], v[3]); *(v2u*)(O + off + 128 * bj + 16 * n) = w; }
            }
    }
};

struct Frame {
    LAS unsigned char* lds;
    volatile LAS unsigned* MISC;
    gu32* ctl;
    int tid, lane, wave, G, bid;
};

__device__ __forceinline__ void p0_transpose_item(const float* W, int K, int N, bf16* WT, LAS float* scr, int item, int lane) {
    const int nblk = N / 32, kb = item / nblk, nb = item % nblk, k0 = 64 * kb, n0 = 32 * nb;
#pragma unroll 8
    for (int i = 0; i < 32; ++i) { const int kk = 2 * i + (lane >> 5); scr[kk * 33 + (lane & 31)] = W[(size_t)(k0 + kk) * N + n0 + (lane & 31)]; }
    LDS_WAIT(); asm volatile("" ::: "memory");
    const int c = lane & 7;
#pragma unroll
    for (int j = 0; j < 4; ++j) { const int n = (lane >> 3) + 8 * j; const LAS float* s = scr + (8 * c) * 33 + n;
        v4u o; o.x = pk2(s[0 * 33], s[1 * 33]); o.y = pk2(s[2 * 33], s[3 * 33]); o.z = pk2(s[4 * 33], s[5 * 33]); o.w = pk2(s[6 * 33], s[7 * 33]);
        *(GAS v4u*)(WT + (size_t)perm_row_of_col(n0 + n) * K + k0 + 8 * c) = o; }
    LDS_WAIT(); asm volatile("" ::: "memory");
}
__device__ __forceinline__ void rms_row_to_bf16(const float* xrow, const float* g, bf16* orow, int lane) {
    const GAS f32x4* xr = (const GAS f32x4*)xrow + lane; const GAS f32x4* gr = (const GAS f32x4*)g + lane;
    f32x4 v[4]; float s = 0.f;
#pragma unroll
    for (int j = 0; j < 4; ++j) { v[j] = __builtin_nontemporal_load(&xr[64 * j]); s += (v[j].x * v[j].x + v[j].y * v[j].y) + (v[j].z * v[j].z + v[j].w * v[j].w); }
    const float r = rsqrtf(wave_sum(s) * (1.0f / DM) + EPS);
    GAS v2u* o8 = (GAS v2u*)orow + lane;
#pragma unroll
    for (int j = 0; j < 4; ++j) { const f32x4 gg = gr[64 * j]; v2u w; w.x = pk2(v[j].x * r * gg.x, v[j].y * r * gg.y); w.y = pk2(v[j].z * r * gg.z, v[j].w * r * gg.w); o8[64 * j] = w; }
}
__device__ __forceinline__ float t5_bias_of_dist(const float* rel_bias, int h, int dist) {
    int bkt;
    if (dist < 16) bkt = dist;
    else { const float nf = (float)dist; int lg = 16 + (int)(logf(nf / 16.0f) / 4.852030263919617f * 16.0f); bkt = lg < 31 ? lg : 31; }
    return rel_bias[bkt * MH + h];
}

struct Ptrs {
    const float *x, *mix_g, *w_in, *ret_w, *q_gain, *k_gain, *moba_w, *rel_bias, *w_out, *ffn_g, *peer_wq, *sub_keys, *peer_u, *peer_v;
    float* out; unsigned char* ws;
};

__device__ __forceinline__ void p0_prologue(Frame& F, const Ptrs& P) {
    LAS float* scr = (LAS float*)(F.lds + F.wave * 16384);
    const int gw = F.bid * NWAVES + F.wave, NGW = F.G * NWAVES;
    unsigned char* ws = P.ws;
    constexpr int I_IN = (DM / 64) * (INW / 32), I_A = (1024 / 64) * (1024 / 32), I_B = (512 / 64) * (1024 / 32), I_O = I_A, I_Q = (1024 / 64) * (2048 / 32);
    constexpr int NITEMS = I_IN + I_A + I_B + I_O; (void)I_Q;
    (void)NITEMS;
    for (int it = gw; it < I_IN; it += NGW) p0_transpose_item(P.w_in, DM, INW, (bf16*)(ws + WS_WIN), scr, it, F.lane);
    bf16* XN = (bf16*)P.out;
    for (int m = gw; m < T; m += NGW) rms_row_to_bf16(P.x + (size_t)m * DM, P.mix_g, XN + (size_t)m * DM, F.lane);
    const int gt = F.bid * 512 + F.tid, NGT = F.G * 512;
    float* rope = (float*)(ws + WS_ROPE);
    for (int i = gt; i < SEQ * 32; i += NGT) { const int pos = i >> 5, j = i & 31; const float inv = powf(10000.0f, -(float)j / 32.0f); const float ang = (float)pos * inv; float sn, cs; sincosf(ang, &sn, &cs);
        rope[pos * 64 + j] = cs; rope[pos * 64 + 32 + j] = sn; }
    float* BT = (float*)(ws + WS_BIAS);
    for (int i = gt; i < MH * SEQ; i += NGT) { const int h = i >> 12, dist = i & (SEQ - 1); BT[i] = t5_bias_of_dist(P.rel_bias, h, dist); }
}


__device__ __forceinline__ void p0b_late_weights(Frame& F, const Ptrs& P, int idx, int n) {
    LAS float* scr = (LAS float*)(F.lds + F.wave * 16384);
    const int gw = idx * NWAVES + F.wave, NGW = n * NWAVES;
    unsigned char* ws = P.ws;
    constexpr int I_A = (1024 / 64) * (1024 / 32), I_B = (512 / 64) * (1024 / 32), I_O = I_A;
    for (int it = gw; it < I_A + I_B + I_O; it += NGW) {
        int r = it;
        if (r < I_A) { p0_transpose_item(P.ret_w, 1024, 1024, (bf16*)(ws + WS_WA), scr, r, F.lane); continue; } r -= I_A;
        if (r < I_B) { p0_transpose_item(P.moba_w, 512, 1024, (bf16*)(ws + WS_WB), scr, r, F.lane); continue; } r -= I_B;
        p0_transpose_item(P.w_out, 1024, 1024, (bf16*)(ws + WS_WO), scr, r, F.lane);
    }
    { bf16* WST = (bf16*)(ws + WS_WQ);
      for (int wt = gw; wt < 16 * 4 * 32; wt += NGW) {
          const int blk = wt >> 7, nt = (wt >> 5) & 3, mt = wt & 31, r32 = F.lane & 31, hi = F.lane >> 5;
          const float* ap = P.sub_keys + ((size_t)blk * PNK + 32 * nt + r32) * 128 + 8 * hi;
          const float* bp = P.peer_wq + (size_t)(32 * mt + r32) * 2048 + blk * 128 + 8 * hi;
          f32x16 acc;
#pragma unroll
          for (int r = 0; r < 16; ++r) acc[r] = 0.f;
#pragma unroll
          for (int ds = 0; ds < 8; ++ds) {
              const f32x4 a0 = *(const f32x4*)(ap + 16 * ds), a1 = *(const f32x4*)(ap + 16 * ds + 4), b0 = *(const f32x4*)(bp + 16 * ds), b1 = *(const f32x4*)(bp + 16 * ds + 4);
              v4u aw, bw; aw.x = pk2(a0[0], a0[1]); aw.y = pk2(a0[2], a0[3]); aw.z = pk2(a1[0], a1[1]); aw.w = pk2(a1[2], a1[3]);
              bw.x = pk2(b0[0], b0[1]); bw.y = pk2(b0[2], b0[3]); bw.z = pk2(b1[0], b1[1]); bw.w = pk2(b1[2], b1[3]);
              acc = __builtin_amdgcn_mfma_f32_32x32x16_bf16(__builtin_bit_cast(bf16x8, aw), __builtin_bit_cast(bf16x8, bw), acc, 0, 0, 0);
          }
          bf16* op = WST + ((size_t)blk * 128 + 32 * nt) * DM + 32 * mt + r32;
#pragma unroll
          for (int r = 0; r < 16; ++r) op[(size_t)((r & 3) + 8 * (r >> 2) + 4 * hi) * DM] = (bf16)f2bf(acc[r]);
      } }
}
__device__ __forceinline__ void p2a_kv(Frame& F, const Ptrs& P) {
    unsigned char* ws = P.ws; const bf16* RK = (const bf16*)(ws + WS_RK); const bf16* RV = (const bf16*)(ws + WS_RV); const bf16* MK = (const bf16*)(ws + WS_MK);
    float* KVT = (float*)((unsigned char*)P.out + 32 * MiB); float* KM = (float*)(ws + WS_KM);
    LAS bf16* lK = (LAS bf16*)F.lds;
    LAS bf16* lV = (LAS bf16*)(F.lds + 16384);
    const int tid = F.tid;
    for (int task = F.bid; task < BATCH * RH * NCH; task += F.G) {
        const int b = task >> 8, h = (task >> 5) & 7, n = task & 31; const size_t row0 = (size_t)b * SEQ + n * RC; const float l2g = ret_l2g(h);
#pragma unroll
        for (int j = 0; j < 2; ++j) { const int idx = tid + 512 * j, c = idx >> 3, part = idx & 7; *(LAS v4u*)(lK + c * 64 + part * 8) = *(const v4u*)(RK + (row0 + c) * 512 + h * 64 + part * 8); }
#pragma unroll
        for (int j = 0; j < 4; ++j) { const int idx = tid + 512 * j, c = idx >> 4, part = idx & 15; *(LAS v4u*)(lV + c * 128 + part * 8) = *(const v4u*)(RV + (row0 + c) * 1024 + h * 128 + part * 8); }
        __syncthreads();
        const int dk = tid & 63, dv0 = (tid >> 6) * 16;
        float acc[16];
#pragma unroll
        for (int e = 0; e < 16; ++e) acc[e] = 0.f;
        for (int c = 0; c < RC; ++c) {
            const float kd = bf2f(lK[c * 64 + dk]) * exp2f((float)(RC - 1 - c) * l2g);
            const v4u v0 = *(LAS v4u*)(lV + c * 128 + dv0), v1 = *(LAS v4u*)(lV + c * 128 + dv0 + 8);
            acc[0] += kd * bflo(v0.x); acc[1] += kd * bfhi(v0.x); acc[2] += kd * bflo(v0.y); acc[3] += kd * bfhi(v0.y);
            acc[4] += kd * bflo(v0.z); acc[5] += kd * bfhi(v0.z); acc[6] += kd * bflo(v0.w); acc[7] += kd * bfhi(v0.w);
            acc[8] += kd * bflo(v1.x); acc[9] += kd * bfhi(v1.x); acc[10] += kd * bflo(v1.y); acc[11] += kd * bfhi(v1.y);
            acc[12] += kd * bflo(v1.z); acc[13] += kd * bfhi(v1.z); acc[14] += kd * bflo(v1.w); acc[15] += kd * bfhi(v1.w);
        }
        float* o = KVT + (size_t)task * (RDV * RDK);
#pragma unroll
        for (int e = 0; e < 16; ++e) o[(dv0 + e) * 64 + dk] = acc[e];
        __syncthreads();
    }
    const int gw = F.bid * NWAVES + F.wave, NGW = F.G * NWAVES;
    for (int wt = gw; wt < BATCH * MH * NBLK; wt += NGW) {
        const int b = wt >> 7, h = (wt >> 4) & 7, blk = wt & 15; const bf16* p = MK + ((size_t)b * SEQ + blk * MBLK) * 512 + h * 64 + F.lane;
        float s = 0.f;
        for (int j = 0; j < MBLK; ++j) s += bf2f(p[(size_t)j * 512]);
        KM[wt * 64 + F.lane] = s * (1.0f / MBLK);
    }
}
__device__ __forceinline__ void p2b_scan(Frame& F, const Ptrs& P) {
    const float* KVT = (const float*)((unsigned char*)P.out + 32 * MiB); bf16* PREV = (bf16*)(P.ws + WS_PREV);
    const int gt = F.bid * 512 + F.tid, NGT = F.G * 512;
    for (int e = gt; e < BATCH * RH * RDV * RDK; e += NGT) {
        const int bh = e >> 13, el = e & 8191, h = bh & 7; const float dC = exp2f((float)RC * ret_l2g(h));
        float S = 0.f; const size_t base = (size_t)bh * NCH * 8192 + el;
        for (int n = 0; n < NCH; ++n) { PREV[base + (size_t)n * 8192] = (bf16)f2bf(S); S = S * dC + KVT[base + (size_t)n * 8192]; }
    }
}
__device__ __forceinline__ void p3a_retention(Frame& F, const Ptrs& P) {
    unsigned char* ws = P.ws; const bf16* RQ = (const bf16*)(ws + WS_RQ); const bf16* RK = (const bf16*)(ws + WS_RK); const bf16* RV = (const bf16*)(ws + WS_RV);
    const bf16* RG = (const bf16*)(ws + WS_RG); const bf16* PREV = (const bf16*)(ws + WS_PREV); bf16* RETG = (bf16*)P.out;
    LAS bf16* lQ = (LAS bf16*)F.lds;
    LAS bf16* lK = (LAS bf16*)(F.lds + 16384);
    LAS bf16* lV = (LAS bf16*)(F.lds + 16384 + 16896);
    LAS bf16* lP = (LAS bf16*)(F.lds + 16384 + 16896 + 32768);
    LAS float* lS = (LAS float*)(F.lds + 16384 + 16896 + 32768 + 16896);
    const int tid = F.tid, lane = F.lane, wave = F.wave;
    for (int task = F.bid; task < BATCH * RH * NCH; task += F.G) {
        const int b = task >> 8, h = (task >> 5) & 7, n = task & 31; const size_t row0 = (size_t)b * SEQ + n * RC; const float l2g = ret_l2g(h);
#pragma unroll
        for (int j = 0; j < 2; ++j) { const int idx = tid + 512 * j, c = idx >> 3, part = idx & 7; *(LAS v4u*)(lQ + c * 64 + part * 8) = *(const v4u*)(RQ + (row0 + c) * 512 + h * 64 + part * 8); }
#pragma unroll
        for (int j = 0; j < 8; ++j) { const int idx = tid + 512 * j, c = idx >> 5, w = idx & 31; *(LAS unsigned*)(lK + c * 66 + w * 2) = *(const unsigned*)(RK + (row0 + c) * 512 + h * 64 + w * 2); }
#pragma unroll
        for (int j = 0; j < 4; ++j) { const int idx = tid + 512 * j, c = idx >> 4, part = idx & 15; *(LAS v4u*)(lV + c * 128 + part * 8) = *(const v4u*)(RV + (row0 + c) * 1024 + h * 128 + part * 8); }
#pragma unroll
        for (int j = 0; j < 8; ++j) { const int idx = tid + 512 * j, dv = idx >> 5, w = idx & 31; *(LAS unsigned*)(lP + dv * 66 + w * 2) = *(const unsigned*)(PREV + (size_t)task * 8192 + dv * 64 + w * 2); }
        __syncthreads();
        for (int t = 0; t < 32; ++t) {
            const int e = tid + 512 * t, i = e >> 7, j = e & 127;
            float s = 0.f;
            if (j <= i) {
                float d = 0.f;
#pragma unroll
                for (int w = 0; w < 32; ++w) { const unsigned qa = *(LAS unsigned*)(lQ + i * 64 + 2 * w), ka = *(LAS unsigned*)(lK + j * 66 + 2 * w); d += bflo(qa) * bflo(ka) + bfhi(qa) * bfhi(ka); }
                s = d * exp2f((float)(i - j) * l2g);
            }
            lS[i * 128 + j] = s;
        }
        __syncthreads();
        for (int r = 0; r < 16; ++r) {
            const int i = wave * 16 + r;
            float a0 = 0.f, a1 = 0.f;
            for (int j = 0; j <= i; ++j) { const float sv = lS[i * 128 + j]; a0 += sv * bf2f(lV[j * 128 + lane]); a1 += sv * bf2f(lV[j * 128 + lane + 64]); }
            float c0 = 0.f, c1 = 0.f;
#pragma unroll 8
            for (int w = 0; w < 32; ++w) { const unsigned qa = *(LAS unsigned*)(lQ + i * 64 + 2 * w), p0 = *(LAS unsigned*)(lP + lane * 66 + 2 * w), p1 = *(LAS unsigned*)(lP + (lane + 64) * 66 + 2 * w);
                c0 += bflo(qa) * bflo(p0) + bfhi(qa) * bfhi(p0); c1 += bflo(qa) * bflo(p1) + bfhi(qa) * bfhi(p1); }
            const float qd = exp2f((float)(i + 1) * l2g);
            const float o0 = a0 + c0 * qd, o1 = a1 + c1 * qd;
            const float mu = wave_sum(o0 + o1) * (1.0f / RDV); const float d0 = o0 - mu, d1 = o1 - mu;
            const float var = wave_sum(d0 * d0 + d1 * d1) * (1.0f / RDV); const float rs = rsqrtf(var + EPS);
            const size_t off = (row0 + i) * 1024 + h * 128 + lane;
            RETG[off] = (bf16)f2bf(d0 * rs * bf2f(RG[off])); RETG[off + 64] = (bf16)f2bf(d1 * rs * bf2f(RG[off + 64]));
        }
        __syncthreads();
    }
}
__device__ __forceinline__ void p3b_moba(Frame& F, const Ptrs& P) {
    unsigned char* ws = P.ws; const bf16* MQ = (const bf16*)(ws + WS_MQ); const bf16* MK = (const bf16*)(ws + WS_MK); const bf16* MV = (const bf16*)(ws + WS_MV);
    const float* KM = (const float*)(ws + WS_KM); const float* BT = (const float*)(ws + WS_BIAS); bf16* ATT = (bf16*)((unsigned char*)P.out + 32 * MiB);
    LAS float* lB = (LAS float*)F.lds;
    LAS bf16* lK = (LAS bf16*)(F.lds + 16384);
    LAS bf16* lV = (LAS bf16*)(F.lds + 16384 + 32768);
    LAS float* lKM = (LAS float*)(F.lds + 16384 + 65536);
    const int tid = F.tid, ql = tid >> 2, sub = tid & 3;
    for (int unit = F.bid; unit < BATCH * MH * 32; unit += F.G) {
        const int qh = 31 - (unit >> 5), bh = unit & 31, b = bh >> 3, h = bh & 7;
        const int qpos = qh * 128 + ql, qb = qh >> 1;
        for (int i = tid; i < SEQ; i += 512) lB[i] = BT[h * SEQ + i];
        float qf[64];
        { const bf16* qp = MQ + ((size_t)b * SEQ + qpos) * 512 + h * 64;
#pragma unroll
          for (int w = 0; w < 8; ++w) { const v4u x = *(const v4u*)(qp + 8 * w); qf[8 * w] = bflo(x.x); qf[8 * w + 1] = bfhi(x.x); qf[8 * w + 2] = bflo(x.y); qf[8 * w + 3] = bfhi(x.y);
              qf[8 * w + 4] = bflo(x.z); qf[8 * w + 5] = bfhi(x.z); qf[8 * w + 6] = bflo(x.w); qf[8 * w + 7] = bfhi(x.w); } }
        for (int i = tid; i < qb * 64; i += 512) lKM[i] = KM[(size_t)bh * NBLK * 64 + i];
        __syncthreads();
        unsigned mask;
        if (qb <= 3) mask = (1u << qb) - 1u;
        else {
            float g1 = -3e38f, g2 = -3e38f, g3 = -3e38f; int i1 = 0, i2 = 0, i3 = 0;
            for (int kb = 0; kb < qb; ++kb) {
                const LAS float* km = lKM + kb * 64; float g = 0.f;
#pragma unroll
                for (int d = 0; d < 64; ++d) g += qf[d] * km[d];
                if (g > g1) { g3 = g2; i3 = i2; g2 = g1; i2 = i1; g1 = g; i1 = kb; }
                else if (g > g2) { g3 = g2; i3 = i2; g2 = g; i2 = kb; }
                else if (g > g3) { g3 = g; i3 = kb; }
            }
            mask = (1u << i1) | (1u << i2) | (1u << i3);
        }
        float m = -1e30f, l = 0.f, o[64];
#pragma unroll
        for (int d = 0; d < 64; ++d) o[d] = 0.f;
        for (int kb = 0; kb <= qb; ++kb) {
            __syncthreads();
            const size_t krow0 = (size_t)b * SEQ + kb * MBLK;
#pragma unroll
            for (int j = 0; j < 4; ++j) { const int idx = tid + 512 * j, r = idx >> 3, part = idx & 7;
                *(LAS v4u*)(lK + r * 64 + part * 8) = *(const v4u*)(MK + (krow0 + r) * 512 + h * 64 + part * 8);
                *(LAS v4u*)(lV + r * 64 + part * 8) = *(const v4u*)(MV + (krow0 + r) * 512 + h * 64 + part * 8); }
            __syncthreads();
            const bool act = (kb == qb) || ((mask >> kb) & 1u);
            if (act) {
                for (int jj = 0; jj < 64; ++jj) {
                    const int j = jj * 4 + sub, kpos = kb * MBLK + j;
                    if (kpos > qpos) continue;
                    float dot = 0.f;
#pragma unroll
                    for (int w = 0; w < 8; ++w) { const v4u x = *(LAS v4u*)(lK + j * 64 + 8 * w);
                        dot += qf[8 * w] * bflo(x.x) + qf[8 * w + 1] * bfhi(x.x) + qf[8 * w + 2] * bflo(x.y) + qf[8 * w + 3] * bfhi(x.y)
                             + qf[8 * w + 4] * bflo(x.z) + qf[8 * w + 5] * bfhi(x.z) + qf[8 * w + 6] * bflo(x.w) + qf[8 * w + 7] * bfhi(x.w); }
                    const float logit = dot + lB[qpos - kpos];
                    const float mn = fmaxf(m, logit), sc = __expf(m - mn), p = __expf(logit - mn);
                    l = l * sc + p; m = mn;
#pragma unroll
                    for (int w = 0; w < 8; ++w) { const v4u x = *(LAS v4u*)(lV + j * 64 + 8 * w);
                        o[8 * w] = o[8 * w] * sc + p * bflo(x.x); o[8 * w + 1] = o[8 * w + 1] * sc + p * bfhi(x.x); o[8 * w + 2] = o[8 * w + 2] * sc + p * bflo(x.y); o[8 * w + 3] = o[8 * w + 3] * sc + p * bfhi(x.y);
                        o[8 * w + 4] = o[8 * w + 4] * sc + p * bflo(x.z); o[8 * w + 5] = o[8 * w + 5] * sc + p * bfhi(x.z); o[8 * w + 6] = o[8 * w + 6] * sc + p * bflo(x.w); o[8 * w + 7] = o[8 * w + 7] * sc + p * bfhi(x.w); }
                }
            }
        }
        float mm = fmaxf(m, __shfl_xor(m, 1)); mm = fmaxf(mm, __shfl_xor(mm, 2));
        const float f = __expf(m - mm); l *= f; l += __shfl_xor(l, 1); l += __shfl_xor(l, 2);
        const float il = 1.0f / l;
#pragma unroll
        for (int d = 0; d < 64; ++d) { float v = o[d] * f; v += __shfl_xor(v, 1); v += __shfl_xor(v, 2); o[d] = v * il; }
        bf16* op = ATT + ((size_t)b * SEQ + qpos) * 512 + h * 64;
#pragma unroll
        for (int s4 = 0; s4 < 4; ++s4) if (sub == s4) {
            v4u w0, w1; w0.x = pk2(o[16 * s4], o[16 * s4 + 1]); w0.y = pk2(o[16 * s4 + 2], o[16 * s4 + 3]); w0.z = pk2(o[16 * s4 + 4], o[16 * s4 + 5]); w0.w = pk2(o[16 * s4 + 6], o[16 * s4 + 7]);
            w1.x = pk2(o[16 * s4 + 8], o[16 * s4 + 9]); w1.y = pk2(o[16 * s4 + 10], o[16 * s4 + 11]); w1.z = pk2(o[16 * s4 + 12], o[16 * s4 + 13]); w1.w = pk2(o[16 * s4 + 14], o[16 * s4 + 15]);
            *(v4u*)(op + 16 * s4) = w0; *(v4u*)(op + 16 * s4 + 8) = w1; }
        __syncthreads();
    }
}

typedef short s16x4 __attribute__((ext_vector_type(4)));
typedef short v4i16_t __attribute__((ext_vector_type(4)));
__device__ __forceinline__ s16x4 vtr_read(const LAS unsigned char* p) { return __builtin_bit_cast(s16x4, __builtin_amdgcn_ds_read_tr16_b64_v4i16((LAS v4i16_t*)p)); }
constexpr float LOG2E = 1.4426950408889634f;
constexpr float MOBA_NEG = -1.0e30f;
constexpr float MOBA_THR = 3.0f;
constexpr int MB_LB = 0, MB_LKM = 16640, MB_WSC = 20480, MB_K0 = 24576, MB_V0 = 24576 + 65536;
static_assert(MB_V0 + 65536 <= MISC_OFF, "MoBA LDS map");

template <int ABL> __device__ __forceinline__ void p3b_moba_mfma(Frame& F, const Ptrs& P) {
    unsigned char* ws = P.ws; const bf16* MQ = (const bf16*)(ws + WS_MQ); const bf16* MK = (const bf16*)(ws + WS_MK); const bf16* MV = (const bf16*)(ws + WS_MV);
    const float* KMP = (const float*)(ws + WS_KM); const float* BT = (const float*)(ws + WS_BIAS); bf16* ATT = (bf16*)((unsigned char*)P.out + (ABL ? 48 : 32) * MiB);
    LAS float* lB = (LAS float*)(F.lds + MB_LB);
    LAS float* lKM = (LAS float*)(F.lds + MB_LKM);
    LAS float* wsc = (LAS float*)(F.lds + MB_WSC) + F.wave * 64;
    const int tid = F.tid, lane = F.lane, wave = F.wave, r32 = lane & 31, hi = lane >> 5;
    for (int vcu0 = F.bid; vcu0 < 256; vcu0 += F.G) {
    const int vcu = (F.G == 256) ? (vcu0 & 7) * 32 + (vcu0 >> 3) : vcu0;
    const int bh = vcu >> 3, sidx = vcu & 7, b = bh >> 3, h = bh & 7;
    __syncthreads();
    for (int i = tid; i < SEQ + 64; i += 512) lB[i] = (i < 64) ? 0.f : BT[h * SEQ + (i - 64)] * LOG2E;
    unsigned ksrc[4], vsrc[4];
#pragma unroll
    for (int j = 0; j < 4; ++j) { const int pc = wave * 4 + j, krow = 8 * pc + (lane >> 3); ksrc[j] = (unsigned)(krow * 512 + (((lane & 7) ^ (krow & 7)) * 8));
        const int vkey = 8 * pc + ((lane & 31) >> 2); vsrc[j] = (unsigned)(vkey * 512 + 32 * (lane >> 5) + 8 * (lane & 3)); }
#define MOBA_STAGE(kgp, vgp, kdst, vdst) do { _Pragma("unroll") for (int j = 0; j < 4; ++j) { \
        __builtin_amdgcn_global_load_lds((const unsigned*)((kgp) + ksrc[j]), (LAS unsigned*)(F.lds + (kdst) + (wave * 4 + j) * 1024), 16, 0, 0); \
        __builtin_amdgcn_global_load_lds((const unsigned*)((vgp) + vsrc[j]), (LAS unsigned*)(F.lds + (vdst) + (wave * 4 + j) * 1024), 16, 0, 0); } } while (0)
    const unsigned vbase = (unsigned)((4 * hi + ((lane & 15) >> 2)) * 64 + ((lane >> 4) & 1) * 32 + (lane & 3) * 8);
    for (int ui = 0; ui < 2; ++ui) {
        const int qb = ui == 0 ? 15 - sidx : sidx;
        const int nblk = qb + 1;
        __syncthreads();
        for (int i = tid; i < qb * 64; i += 512) { const int kb = i >> 6, dd = i & 63; const float* kp = KMP + (((size_t)(b * NBLK + kb) * 2 + (h >> 2)) * 2) * 256 + (h & 3) * 64 + dd; lKM[i] = (kp[0] + kp[256]) * (1.0f / MBLK); }
        const int qw0 = qb * MBLK + wave * 32, qpos = qw0 + r32;
        bf16x8 qf[4];
        { const bf16* qp = MQ + ((size_t)b * SEQ + qpos) * 512 + h * 64 + 8 * hi;
#pragma unroll
          for (int ds = 0; ds < 4; ++ds) qf[ds] = *(const bf16x8*)(qp + 16 * ds); }
        { const bf16* kg = MK + ((size_t)b * SEQ + (size_t)qb * MBLK) * 512 + h * 64; const bf16* vg = MV + ((size_t)b * SEQ + (size_t)qb * MBLK) * 512 + h * 64;
          MOBA_STAGE(kg, vg, MB_K0, MB_V0); }
        VM_WAIT(); __syncthreads();
        unsigned mask;
        if (qb <= 3) mask = (1u << qb) - 1u;
        else {
            float g1 = -3e38f, g2 = -3e38f, g3 = -3e38f; int i1 = 0, i2 = 0, i3 = 0;
            for (int kb = 0; kb < qb; ++kb) {
                float g = 0.f;
#pragma unroll
                for (int ds = 0; ds < 4; ++ds) { const LAS float* km = lKM + kb * 64 + 16 * ds + 8 * hi; const f32x4 k0 = *(const LAS f32x4*)km, k1 = *(const LAS f32x4*)(km + 4);
                    const v4u qx = __builtin_bit_cast(v4u, qf[ds]);
                    g += bflo(qx.x) * k0[0] + bfhi(qx.x) * k0[1] + bflo(qx.y) * k0[2] + bfhi(qx.y) * k0[3] + bflo(qx.z) * k1[0] + bfhi(qx.z) * k1[1] + bflo(qx.w) * k1[2] + bfhi(qx.w) * k1[3]; }
                g += __shfl_xor(g, 32);
                if (g > g1) { g3 = g2; i3 = i2; g2 = g1; i2 = i1; g1 = g; i1 = kb; }
                else if (g > g2) { g3 = g2; i3 = i2; g2 = g; i2 = kb; }
                else if (g > g3) { g3 = g; i3 = kb; }
            }
            mask = (1u << i1) | (1u << i2) | (1u << i3);
        }
        float m = 0.f, l = 0.f; bool first = true, pending = false;
        f32x16 o0, o1; v4u ppa[4]; unsigned pvoff = MB_V0;
#pragma unroll
        for (int r = 0; r < 16; ++r) { o0[r] = 0.f; o1[r] = 0.f; }
#pragma unroll
        for (int q = 0; q < 4; ++q) ppa[q] = (v4u){0u, 0u, 0u, 0u};
#define MOBA_PV(pa_, voff_) do { const LAS unsigned char* vp_ = F.lds + (voff_) + vbase; \
        _Pragma("unroll") for (int ks = 0; ks < 4; ++ks) { const bf16x8 pav = __builtin_bit_cast(bf16x8, pa_[ks]); \
            _Pragma("unroll") for (int db = 0; db < 2; ++db) { const s16x4 lo = vtr_read(vp_ + ((2 * ks) * 2 + db) * 512), hh = vtr_read(vp_ + ((2 * ks + 1) * 2 + db) * 512); \
                const bf16x8 vf = (bf16x8){lo[0], lo[1], lo[2], lo[3], hh[0], hh[1], hh[2], hh[3]}; \
                if (db == 0) o0 = __builtin_amdgcn_mfma_f32_32x32x16_bf16(pav, vf, o0, 0, 0, 0); else o1 = __builtin_amdgcn_mfma_f32_32x32x16_bf16(pav, vf, o1, 0, 0, 0); } } } while (0)
        for (int bi = 0; bi < nblk; ++bi) {
            const int kb = bi == 0 ? qb : bi - 1;
            const unsigned kbuf = MB_K0 + (bi & 1) * 32768, vbuf = MB_V0 + (bi & 1) * 32768;
            const bool has_next = bi + 1 < nblk;
            if (has_next) { const int kn = bi;
                if (pending) { MOBA_PV(ppa, pvoff); pending = false;
#pragma unroll
                    for (int q = 0; q < 4; ++q) ppa[q] = (v4u){0u, 0u, 0u, 0u}; }
                const bf16* kg = MK + ((size_t)b * SEQ + (size_t)kn * MBLK) * 512 + h * 64; const bf16* vg = MV + ((size_t)b * SEQ + (size_t)kn * MBLK) * 512 + h * 64;
                MOBA_STAGE(kg, vg, MB_K0 + ((bi + 1) & 1) * 32768, MB_V0 + ((bi + 1) & 1) * 32768); }
            const bool own = bi == 0;
            const bool sel = own || ((mask >> kb) & 1u);
            if (!(ABL & 16) && __any(sel)) {
                float msub = sel ? m : 1.0e30f;
                f32x16 cneg;
#pragma unroll
                for (int r = 0; r < 16; ++r) cneg[r] = -msub;
                const int npair = own ? (wave >> 1) + 1 : 4;
#define MOBA_QK(jq_, dA_, dB_) do { const int keyA_ = 64 * (jq_) + r32, keyB_ = keyA_ + 32; const LAS unsigned char* kpA_ = F.lds + kbuf + keyA_ * 128; const LAS unsigned char* kpB_ = F.lds + kbuf + keyB_ * 128; \
        _Pragma("unroll") for (int ds = 0; ds < 4; ++ds) { const bf16x8 aA_ = *(const LAS bf16x8*)(kpA_ + (((2 * ds + hi) ^ (keyA_ & 7)) * 16)), aB_ = *(const LAS bf16x8*)(kpB_ + (((2 * ds + hi) ^ (keyB_ & 7)) * 16)); \
            if (!(ABL & 8)) { dA_ = __builtin_amdgcn_mfma_f32_32x32x16_bf16(aA_, qf[ds], ds == 0 ? cneg : dA_, 0, 0, 0); dB_ = __builtin_amdgcn_mfma_f32_32x32x16_bf16(aB_, qf[ds], ds == 0 ? cneg : dB_, 0, 0, 0); } else if (ds == 0) { dA_ = cneg; dB_ = cneg; } } } while (0)
                f32x16 sA, sB, nA, nB;
                MOBA_QK(0, sA, sB);
                for (int jp = 0; jp < npair; ++jp) {
                    const int k0 = kb * MBLK + 64 * jp, dmin = qw0 - k0 - 63, dmax = qw0 + 31 - k0;
                    bool uni = false; float bu = 0.f;
                    if (dmin >= 256) { const float b0 = lB[64 + dmin], b1 = lB[64 + dmax]; uni = (b0 == b1); bu = b0; }
                    if (ABL & 1) {} else if (uni) {
#pragma unroll
                        for (int r = 0; r < 16; ++r) { sA[r] += bu; sB[r] += bu; }
                    } else {
                        const LAS float* bp = lB + (64 + qpos - k0 - 4 * hi - 27 - 32);
#pragma unroll
                        for (int r = 0; r < 16; ++r) { sA[r] += bp[32 + 27 - ((r & 3) + 8 * (r >> 2))]; sB[r] += bp[27 - ((r & 3) + 8 * (r >> 2))]; }
                    }
                    if (own && 2 * jp + 1 >= wave) {
                        const int limA = 32 * wave + r32 - 64 * jp - 4 * hi, limB = limA - 32;
#pragma unroll
                        for (int r = 0; r < 16; ++r) { const int cr = (r & 3) + 8 * (r >> 2); if (cr > limA) sA[r] = MOBA_NEG; if (cr > limB) sB[r] = MOBA_NEG; }
                    }
                    float tm = fmaxf(fmaxf(fmaxf(sA[0], sA[1]), fmaxf(sA[2], sA[3])), fmaxf(fmaxf(sB[0], sB[1]), fmaxf(sB[2], sB[3])));
#pragma unroll
                    for (int r = 4; r < 16; r += 4) tm = fmaxf(tm, fmaxf(fmaxf(fmaxf(sA[r], sA[r + 1]), fmaxf(sA[r + 2], sA[r + 3])), fmaxf(fmaxf(sB[r], sB[r + 1]), fmaxf(sB[r + 2], sB[r + 3]))));
                    if (first || __any(tm > MOBA_THR)) {
                        tm = fmaxf(tm, __shfl_xor(tm, 32));
                        const float dl = first ? tm : fmaxf(tm, 0.f);
                        first = false;
                        m += dl;
#pragma unroll
                        for (int r = 0; r < 16; ++r) { sA[r] -= dl; sB[r] -= dl; }
                        const float al = __builtin_amdgcn_exp2f(-dl);
                        l *= al;
                        if (hi == 0) wsc[r32] = al;
                        LDS_WAIT(); asm volatile("" ::: "memory");
#pragma unroll
                        for (int r = 0; r < 16; ++r) { const float a = wsc[(r & 3) + 8 * (r >> 2) + 4 * hi]; o0[r] *= a; o1[r] *= a; }
                        LDS_WAIT(); asm volatile("" ::: "memory");
                        {
#pragma unroll
                            for (int q = 0; q < 4; ++q) { ppa[q].x = pk2(bflo(ppa[q].x) * al, bfhi(ppa[q].x) * al); ppa[q].y = pk2(bflo(ppa[q].y) * al, bfhi(ppa[q].y) * al);
                                ppa[q].z = pk2(bflo(ppa[q].z) * al, bfhi(ppa[q].z) * al); ppa[q].w = pk2(bflo(ppa[q].w) * al, bfhi(ppa[q].w) * al); }
                        }
                        msub = sel ? m : 1.0e30f;
#pragma unroll
                        for (int r = 0; r < 16; ++r) cneg[r] = -msub;
                    }
                    {
                        const int jn = jp + 1 < npair ? jp + 1 : jp;
                        const int keyA_ = 64 * jn + r32, keyB_ = keyA_ + 32; const LAS unsigned char* kpA_ = F.lds + kbuf + keyA_ * 128; const LAS unsigned char* kpB_ = F.lds + kbuf + keyB_ * 128;
                        const LAS unsigned char* vp_ = F.lds + pvoff + vbase;
                        float ps = 0.f;
#pragma unroll
                        for (int i = 0; i < 4; ++i) {
                            if (!(ABL & 4)) { const bf16x8 pav = __builtin_bit_cast(bf16x8, ppa[i]);
#pragma unroll
                                for (int db = 0; db < 2; ++db) { const s16x4 lo = vtr_read(vp_ + ((2 * i) * 2 + db) * 512), hh = vtr_read(vp_ + ((2 * i + 1) * 2 + db) * 512);
                                    const bf16x8 vf = (bf16x8){lo[0], lo[1], lo[2], lo[3], hh[0], hh[1], hh[2], hh[3]};
                                    if (db == 0) o0 = __builtin_amdgcn_mfma_f32_32x32x16_bf16(pav, vf, o0, 0, 0, 0); else o1 = __builtin_amdgcn_mfma_f32_32x32x16_bf16(pav, vf, o1, 0, 0, 0); } }
                            { const bf16x8 aA_ = *(const LAS bf16x8*)(kpA_ + (((2 * i + hi) ^ (keyA_ & 7)) * 16)), aB_ = *(const LAS bf16x8*)(kpB_ + (((2 * i + hi) ^ (keyB_ & 7)) * 16));
                              if (!(ABL & 8)) { nA = __builtin_amdgcn_mfma_f32_32x32x16_bf16(aA_, qf[i], i == 0 ? cneg : nA, 0, 0, 0); nB = __builtin_amdgcn_mfma_f32_32x32x16_bf16(aB_, qf[i], i == 0 ? cneg : nB, 0, 0, 0); } else if (i == 0) { nA = cneg; nB = cneg; } }
                            float pv8[8];
#pragma unroll
                            for (int q = 0; q < 8; ++q) { const float sv = i < 2 ? sA[8 * i + q] : sB[8 * (i - 2) + q]; pv8[q] = (ABL & 2) ? sv : __builtin_amdgcn_exp2f(sv); ps += pv8[q]; }
                            ppa[i].x = pk2(pv8[0], pv8[1]); ppa[i].y = pk2(pv8[2], pv8[3]); ppa[i].z = pk2(pv8[4], pv8[5]); ppa[i].w = pk2(pv8[6], pv8[7]);
                            __builtin_amdgcn_sched_barrier(0);
                        }
                        l += ps;
                    }
                    pvoff = vbuf + (8 * jp) * 1024; pending = true;
                    sA = nA; sB = nB;
                }
#undef MOBA_QK
            }
            VM_WAIT(); __syncthreads();
        }
        if (pending) { MOBA_PV(ppa, pvoff); pending = false; }
#undef MOBA_PV
        l += __shfl_xor(l, 32);
        if (hi == 0) wsc[r32] = 1.0f / l;
        LDS_WAIT(); asm volatile("" ::: "memory");
        bf16* op = ATT + ((size_t)b * SEQ + qw0) * 512 + h * 64 + r32;
#pragma unroll
        for (int r = 0; r < 16; ++r) { const int qr = (r & 3) + 8 * (r >> 2) + 4 * hi; const float a = wsc[qr];
            op[(size_t)qr * 512] = (bf16)f2bf(o0[r] * a); op[(size_t)qr * 512 + 32] = (bf16)f2bf(o1[r] * a); }
        LDS_WAIT(); asm volatile("" ::: "memory");
    }
    }
#undef MOBA_STAGE
}


constexpr int RT_K = 0, RT_P = 16384, RT_V = 32768, RT_O = 65536, RT_OP = 132;
__device__ __forceinline__ void p3a_retention_mfma(Frame& F, const Ptrs& P) {
    unsigned char* ws = P.ws; const bf16* RQ = (const bf16*)(ws + WS_RQ); const bf16* RK = (const bf16*)(ws + WS_RK); const bf16* RV = (const bf16*)(ws + WS_RV);
    const bf16* RG = (const bf16*)(ws + WS_RG); const bf16* PREV = (const bf16*)(ws + WS_PREV); bf16* RETG = (bf16*)P.out;
    LAS float* lO = (LAS float*)(F.lds + RT_O);
    const int lane = F.lane, wave = F.wave, r32 = lane & 31, hi = lane >> 5, rt = wave >> 1, dh = wave & 1;
    const unsigned vbase = (unsigned)((4 * hi + ((lane & 15) >> 2)) * 64 + ((lane >> 4) & 1) * 32 + (lane & 3) * 8);
    unsigned ksrc[2], psrc[2], vsrc[4];
#pragma unroll
    for (int j = 0; j < 2; ++j) { const int pc = wave * 2 + j, row = 8 * pc + (lane >> 3), ch = (lane & 7) ^ (row & 7); ksrc[j] = (unsigned)(row * 512 + ch * 8); psrc[j] = (unsigned)(row * 64 + ch * 8); }
#pragma unroll
    for (int j = 0; j < 4; ++j) { const int pc = wave * 4 + j, key = 8 * (pc >> 1) + ((lane & 31) >> 2), db = 2 * (pc & 1) + (lane >> 5); vsrc[j] = (unsigned)(key * 1024 + 32 * db + 8 * (lane & 3)); }
#define RT_STAGE(task_) do { const int b_ = (task_) >> 8, h_ = ((task_) >> 5) & 7, n_ = (task_) & 31; const size_t r0_ = (size_t)b_ * SEQ + n_ * RC; \
        const bf16* kg_ = RK + r0_ * 512 + h_ * 64; const bf16* pg_ = PREV + (size_t)(task_) * 8192; const bf16* vg_ = RV + r0_ * 1024 + h_ * 128; \
        _Pragma("unroll") for (int j = 0; j < 2; ++j) { __builtin_amdgcn_global_load_lds((const unsigned*)(kg_ + ksrc[j]), (LAS unsigned*)(F.lds + RT_K + (wave * 2 + j) * 1024), 16, 0, 0); \
            __builtin_amdgcn_global_load_lds((const unsigned*)(pg_ + psrc[j]), (LAS unsigned*)(F.lds + RT_P + (wave * 2 + j) * 1024), 16, 0, 0); } \
        _Pragma("unroll") for (int j = 0; j < 4; ++j) __builtin_amdgcn_global_load_lds((const unsigned*)(vg_ + vsrc[j]), (LAS unsigned*)(F.lds + RT_V + (wave * 4 + j) * 1024), 16, 0, 0); } while (0)
    int task = F.bid;
    if (task < BATCH * RH * NCH) RT_STAGE(task);
    for (; task < BATCH * RH * NCH; task += F.G) {
        const int b = task >> 8, h = (task >> 5) & 7, n = task & 31; const size_t row0 = (size_t)b * SEQ + n * RC; const float l2g = ret_l2g(h);
        bf16x8 qf[4];
        { const bf16* qp = RQ + (row0 + 32 * rt + r32) * 512 + h * 64 + 8 * hi;
#pragma unroll
          for (int ds = 0; ds < 4; ++ds) qf[ds] = *(const bf16x8*)(qp + 16 * ds); }
        VM_WAIT(); __syncthreads();
        f32x16 o0, o1;
#pragma unroll
        for (int r = 0; r < 16; ++r) { o0[r] = 0.f; o1[r] = 0.f; }
#pragma unroll
        for (int ds = 0; ds < 4; ++ds) {
#pragma unroll
            for (int db = 0; db < 2; ++db) { const int dv = 64 * dh + 32 * db + r32; const bf16x8 bfr = *(const LAS bf16x8*)(F.lds + RT_P + dv * 128 + (((2 * ds + hi) ^ (dv & 7)) * 16));
                if (db == 0) o0 = __builtin_amdgcn_mfma_f32_32x32x16_bf16(qf[ds], bfr, o0, 0, 0, 0); else o1 = __builtin_amdgcn_mfma_f32_32x32x16_bf16(qf[ds], bfr, o1, 0, 0, 0); }
        }
#pragma unroll
        for (int r = 0; r < 16; ++r) { const float qd = __builtin_amdgcn_exp2f((float)(32 * rt + (r & 3) + 8 * (r >> 2) + 4 * hi + 1) * l2g); o0[r] *= qd; o1[r] *= qd; }
        for (int kt = 0; kt <= rt; ++kt) {
            f32x16 s;
#pragma unroll
            for (int r = 0; r < 16; ++r) s[r] = 0.f;
            { const int key = 32 * kt + r32; const LAS unsigned char* kp = F.lds + RT_K + key * 128;
#pragma unroll
              for (int ds = 0; ds < 4; ++ds) { const bf16x8 a = *(const LAS bf16x8*)(kp + (((2 * ds + hi) ^ (key & 7)) * 16)); s = __builtin_amdgcn_mfma_f32_32x32x16_bf16(a, qf[ds], s, 0, 0, 0); } }
            const int dbase = 32 * (rt - kt) + r32 - 4 * hi;
#pragma unroll
            for (int r = 0; r < 16; ++r) { const int dj = dbase - ((r & 3) + 8 * (r >> 2)); s[r] = dj >= 0 ? s[r] * __builtin_amdgcn_exp2f((float)dj * l2g) : 0.f; }
            v4u pa0, pa1;
            pa0.x = pk2(s[0], s[1]); pa0.y = pk2(s[2], s[3]); pa0.z = pk2(s[4], s[5]); pa0.w = pk2(s[6], s[7]);
            pa1.x = pk2(s[8], s[9]); pa1.y = pk2(s[10], s[11]); pa1.z = pk2(s[12], s[13]); pa1.w = pk2(s[14], s[15]);
            const LAS unsigned char* vp = F.lds + RT_V + vbase + (4 * kt) * 2048 + (2 * dh) * 512;
#pragma unroll
            for (int ks = 0; ks < 2; ++ks) {
                const bf16x8 pa = __builtin_bit_cast(bf16x8, ks == 0 ? pa0 : pa1);
#pragma unroll
                for (int db = 0; db < 2; ++db) {
                    const s16x4 lo = vtr_read(vp + (2 * ks) * 2048 + db * 512), hh = vtr_read(vp + (2 * ks + 1) * 2048 + db * 512);
                    const bf16x8 vf = (bf16x8){lo[0], lo[1], lo[2], lo[3], hh[0], hh[1], hh[2], hh[3]};
                    if (db == 0) o0 = __builtin_amdgcn_mfma_f32_32x32x16_bf16(pa, vf, o0, 0, 0, 0); else o1 = __builtin_amdgcn_mfma_f32_32x32x16_bf16(pa, vf, o1, 0, 0, 0);
                }
            }
        }
#pragma unroll
        for (int r = 0; r < 16; ++r) { const int qr = 32 * rt + (r & 3) + 8 * (r >> 2) + 4 * hi; lO[qr * RT_OP + 64 * dh + r32] = o0[r]; lO[qr * RT_OP + 64 * dh + 32 + r32] = o1[r]; }
        __syncthreads();
        if (task + F.G < BATCH * RH * NCH) RT_STAGE(task + F.G);
#pragma unroll
        for (int it = 0; it < 2; ++it) {
            const int i = wave * 16 + it * 8 + (lane >> 3), cc = lane & 7;
            f32x4 v[4];
#pragma unroll
            for (int q = 0; q < 4; ++q) v[q] = *(const LAS f32x4*)(lO + i * RT_OP + 16 * cc + 4 * q);
            const f32x4 sv = (v[0] + v[1]) + (v[2] + v[3]);
            const float mu = dpp_sum8((sv[0] + sv[1]) + (sv[2] + sv[3])) * (1.0f / RDV);
            f32x4 qv = {0.f, 0.f, 0.f, 0.f};
#pragma unroll
            for (int q = 0; q < 4; ++q) { v[q] = v[q] - mu; qv += v[q] * v[q]; }
            const float rs = rsqrtf(dpp_sum8((qv[0] + qv[1]) + (qv[2] + qv[3])) * (1.0f / RDV) + EPS);
            const size_t off = (row0 + i) * 1024 + h * 128 + 16 * cc;
            f32x4 g0, g1, g2, g3; load8_bf16(RG + off, g0, g1); load8_bf16(RG + off + 8, g2, g3);
            store8_bf16(RETG + off, v[0] * rs * g0, v[1] * rs * g1); store8_bf16(RETG + off + 8, v[2] * rs * g2, v[3] * rs * g3);
        }
    }
#undef RT_STAGE
}
constexpr int KV_K = 0, KV_V = 16384;
__device__ __forceinline__ void p2a_kv_mfma(Frame& F, const Ptrs& P) {
    unsigned char* ws = P.ws; const bf16* RK = (const bf16*)(ws + WS_RK); const bf16* RV = (const bf16*)(ws + WS_RV); float* KVT = (float*)((unsigned char*)P.out + 32 * MiB);
    const int tid = F.tid, lane = F.lane, wave = F.wave, r32 = lane & 31, hi = lane >> 5, mb = wave >> 1, nb = wave & 1;
    const unsigned vbase = (unsigned)((4 * hi + ((lane & 15) >> 2)) * 64 + ((lane >> 4) & 1) * 32 + (lane & 3) * 8);
    for (int task = F.bid; task < BATCH * RH * NCH; task += F.G) {
        const int b = task >> 8, h = (task >> 5) & 7, n = task & 31; const size_t row0 = (size_t)b * SEQ + n * RC; const float l2g = ret_l2g(h);
        __syncthreads();
#pragma unroll
        for (int j = 0; j < 2; ++j) { const int idx = tid + 512 * j, r = idx >> 3, c = idx & 7; const v4u kx = *(const v4u*)(RK + (row0 + r) * 512 + h * 64 + c * 8);
            const float dec = __builtin_amdgcn_exp2f((float)(RC - 1 - r) * l2g); v4u ko;
            ko.x = pk2(bflo(kx.x) * dec, bfhi(kx.x) * dec); ko.y = pk2(bflo(kx.y) * dec, bfhi(kx.y) * dec); ko.z = pk2(bflo(kx.z) * dec, bfhi(kx.z) * dec); ko.w = pk2(bflo(kx.w) * dec, bfhi(kx.w) * dec);
            *(LAS v4u*)(F.lds + KV_K + (((r >> 3) * 2 + (c >> 2)) * 512) + (r & 7) * 64 + (c & 3) * 16) = ko; }
#pragma unroll
        for (int j = 0; j < 4; ++j) { const int idx = tid + 512 * j, r = idx >> 4, c = idx & 15;
            *(LAS v4u*)(F.lds + KV_V + (((r >> 3) * 4 + (c >> 2)) * 512) + (r & 7) * 64 + (c & 3) * 16) = *(const v4u*)(RV + (row0 + r) * 1024 + h * 128 + c * 8); }
        __syncthreads();
        f32x16 acc;
#pragma unroll
        for (int r = 0; r < 16; ++r) acc[r] = 0.f;
#pragma unroll
        for (int ks = 0; ks < 8; ++ks) {
            const LAS unsigned char* ap = F.lds + KV_V + vbase + ((2 * ks) * 4 + mb) * 512; const LAS unsigned char* bp = F.lds + KV_K + vbase + ((2 * ks) * 2 + nb) * 512;
            const s16x4 alo = vtr_read(ap), ahi = vtr_read(ap + 4 * 512), blo = vtr_read(bp), bhi = vtr_read(bp + 2 * 512);
            const bf16x8 af = (bf16x8){alo[0], alo[1], alo[2], alo[3], ahi[0], ahi[1], ahi[2], ahi[3]}, bfv = (bf16x8){blo[0], blo[1], blo[2], blo[3], bhi[0], bhi[1], bhi[2], bhi[3]};
            acc = __builtin_amdgcn_mfma_f32_32x32x16_bf16(af, bfv, acc, 0, 0, 0);
        }
        float* o = KVT + (size_t)task * (RDV * RDK) + 32 * nb + r32;
#pragma unroll
        for (int r = 0; r < 16; ++r) o[(32 * mb + (r & 3) + 8 * (r >> 2) + 4 * hi) * 64] = acc[r];
    }
}
#define CE_D(a, i, j) do { const unsigned _hi = a[i] > a[j] ? a[i] : a[j]; const unsigned _lo = a[i] > a[j] ? a[j] : a[i]; a[i] = _hi; a[j] = _lo; } while (0)
#define CE_A(a, i, j) do { const unsigned _hi = a[i] > a[j] ? a[i] : a[j]; const unsigned _lo = a[i] > a[j] ? a[j] : a[i]; a[i] = _lo; a[j] = _hi; } while (0)
#define SORT16_DESC(a) do { CE_D(a, 0, 1); CE_A(a, 2, 3); CE_D(a, 4, 5); CE_A(a, 6, 7); CE_D(a, 8, 9); CE_A(a, 10, 11); CE_D(a, 12, 13); CE_A(a, 14, 15); CE_D(a, 0, 2); CE_D(a, 1, 3); CE_A(a, 4, 6); CE_A(a, 5, 7); CE_D(a, 8, 10); CE_D(a, 9, 11); CE_A(a, 12, 14); CE_A(a, 13, 15); CE_D(a, 0, 1); CE_D(a, 2, 3); CE_A(a, 4, 5); CE_A(a, 6, 7); CE_D(a, 8, 9); CE_D(a, 10, 11); CE_A(a, 12, 13); CE_A(a, 14, 15); CE_D(a, 0, 4); CE_D(a, 1, 5); CE_D(a, 2, 6); CE_D(a, 3, 7); CE_A(a, 8, 12); CE_A(a, 9, 13); CE_A(a, 10, 14); CE_A(a, 11, 15); CE_D(a, 0, 2); CE_D(a, 1, 3); CE_D(a, 4, 6); CE_D(a, 5, 7); CE_A(a, 8, 10); CE_A(a, 9, 11); CE_A(a, 12, 14); CE_A(a, 13, 15); CE_D(a, 0, 1); CE_D(a, 2, 3); CE_D(a, 4, 5); CE_D(a, 6, 7); CE_A(a, 8, 9); CE_A(a, 10, 11); CE_A(a, 12, 13); CE_A(a, 14, 15); CE_D(a, 0, 8); CE_D(a, 1, 9); CE_D(a, 2, 10); CE_D(a, 3, 11); CE_D(a, 4, 12); CE_D(a, 5, 13); CE_D(a, 6, 14); CE_D(a, 7, 15); CE_D(a, 0, 4); CE_D(a, 1, 5); CE_D(a, 2, 6); CE_D(a, 3, 7); CE_D(a, 8, 12); CE_D(a, 9, 13); CE_D(a, 10, 14); CE_D(a, 11, 15); CE_D(a, 0, 2); CE_D(a, 1, 3); CE_D(a, 4, 6); CE_D(a, 5, 7); CE_D(a, 8, 10); CE_D(a, 9, 11); CE_D(a, 12, 14); CE_D(a, 13, 15); CE_D(a, 0, 1); CE_D(a, 2, 3); CE_D(a, 4, 5); CE_D(a, 6, 7); CE_D(a, 8, 9); CE_D(a, 10, 11); CE_D(a, 12, 13); CE_D(a, 14, 15); } while (0)
#define MERGE16_DESC(a) do { CE_D(a, 0, 8); CE_D(a, 1, 9); CE_D(a, 2, 10); CE_D(a, 3, 11); CE_D(a, 4, 12); CE_D(a, 5, 13); CE_D(a, 6, 14); CE_D(a, 7, 15); CE_D(a, 0, 4); CE_D(a, 1, 5); CE_D(a, 2, 6); CE_D(a, 3, 7); CE_D(a, 8, 12); CE_D(a, 9, 13); CE_D(a, 10, 14); CE_D(a, 11, 15); CE_D(a, 0, 2); CE_D(a, 1, 3); CE_D(a, 4, 6); CE_D(a, 5, 7); CE_D(a, 8, 10); CE_D(a, 9, 11); CE_D(a, 12, 14); CE_D(a, 13, 15); CE_D(a, 0, 1); CE_D(a, 2, 3); CE_D(a, 4, 5); CE_D(a, 6, 7); CE_D(a, 8, 9); CE_D(a, 10, 11); CE_D(a, 12, 13); CE_D(a, 14, 15); } while (0)

#ifndef CONV_IN_TOPK
#define CONV_IN_TOPK 1
#endif
constexpr size_t CONV_N16 = (size_t)NEXP * DM / 16;
__device__ __forceinline__ void conv_load(const Ptrs& P, size_t i, f32x4 (&a)[4]) {
    const float* src = (i < CONV_N16) ? P.peer_u + i * 16 : P.peer_v + (i - CONV_N16) * 16;
#pragma unroll
    for (int q = 0; q < 4; ++q) a[q] = __builtin_nontemporal_load((const f32x4*)(src + 4 * q));
}
__device__ __forceinline__ void conv_store(const Ptrs& P, size_t i, const f32x4 (&a)[4]) {
    v2u w;
#pragma unroll
    for (int q = 0; q < 2; ++q) { unsigned pk = 0u;
        const f32x4 s0 = a[2 * q] * 64.0f, s1 = a[2 * q + 1] * 64.0f;
        pk = __builtin_amdgcn_cvt_scalef32_pk_fp4_f32(pk, s0[0], s0[1], 1.0f, 0); pk = __builtin_amdgcn_cvt_scalef32_pk_fp4_f32(pk, s0[2], s0[3], 1.0f, 1);
        pk = __builtin_amdgcn_cvt_scalef32_pk_fp4_f32(pk, s1[0], s1[1], 1.0f, 2); pk = __builtin_amdgcn_cvt_scalef32_pk_fp4_f32(pk, s1[2], s1[3], 1.0f, 3);
        w[q] = pk; }
    *(v2u*)(P.ws + WS_UV8 + i * 8) = w;
}
__device__ __forceinline__ void conv_all(Frame& F, const Ptrs& P) {
    const size_t cbase = (size_t)F.bid * 512 + F.tid, CNGT = (size_t)F.G * 512;
    for (size_t ci = cbase; ci < 2 * CONV_N16; ci += CNGT) { f32x4 cv[4]; conv_load(P, ci, cv); conv_store(P, ci, cv); }
}
__device__ __forceinline__ unsigned mono32(float f) { const unsigned u = __builtin_bit_cast(unsigned, f); return u ^ ((u >> 31) ? 0xffffffffu : 0x80000000u); }
__device__ __forceinline__ float unmono32(unsigned k) { const unsigned u = k ^ ((k >> 31) ? 0x80000000u : 0xffffffffu); return __builtin_bit_cast(float, u); }
__device__ __forceinline__ float key_val(unsigned k) { const unsigned m = k >> 16; return __builtin_bit_cast(float, (m ^ ((m & 0x8000u) ? 0x8000u : 0xffffu)) << 16); }
#define INS16(a, x) do { _Pragma("unroll") for (int _j = 0; _j < 16; ++_j) { const unsigned _t = a[_j] > x ? a[_j] : x; x = a[_j] > x ? x : a[_j]; a[_j] = _t; } } while (0)
__device__ __forceinline__ void p6_topk(Frame& F, const Ptrs& P) {
    unsigned char* ws = P.ws; const bf16* ST = (const bf16*)(ws + WS_ST); int* EXP = (int*)(ws + WS_EG); float* GT = (float*)(ws + WS_EG + 8 * MiB);
    LAS unsigned* lsc = (LAS unsigned*)F.lds;
    pg8::StaticOrder S8; S8.init(T, 2048, F.G, F.bid);
    pg8::Unit uq;
    const size_t cbase = (size_t)F.bid * 512 + F.tid, CNGT = (size_t)F.G * 512; int citem = 0;
    for (int ii = F.wave >> 2; S8.next(ii, uq); ii += 2) {
        const int hd = uq.pn, tok = uq.pm * 256 + (F.wave & 3) * 64 + F.lane;
        const bf16* sp = ST + (size_t)hd * 256 * T + tok;
        unsigned a1[16], a2[16];
#pragma unroll
        for (int j = 0; j < 16; ++j) { a1[j] = 0u; a2[j] = 0u; }
#pragma unroll 1
        for (int g = 0; g < 8; ++g) {
            f32x4 cv0[4], cv1[4]; const size_t ci0 = cbase + (size_t)citem * CNGT, ci1 = ci0 + CNGT; const bool ok0 = CONV_IN_TOPK && ci0 < 2 * CONV_N16, ok1 = CONV_IN_TOPK && ci1 < 2 * CONV_N16;
            unsigned short rr1[16], rr2[16];
#pragma unroll
            for (int q = 0; q < 16; ++q) { const int n = 16 * g + q; rr1[q] = sp[(size_t)n * T]; rr2[q] = sp[(size_t)(PNK + n) * T]; }
            asm volatile("" ::: "memory");
            if (ok0) conv_load(P, ci0, cv0);
            if (ok1) conv_load(P, ci1, cv1);
            unsigned g1[16], g2[16];
#pragma unroll
            for (int q = 0; q < 16; ++q) { const int n = 16 * g + q; const unsigned short r1 = rr1[q], r2 = rr2[q];
                g1[q] = (((unsigned)r1 ^ ((r1 & 0x8000u) ? 0xffffu : 0x8000u)) << 16) | (unsigned)(127 - n);
                g2[q] = (((unsigned)r2 ^ ((r2 & 0x8000u) ? 0xffffu : 0x8000u)) << 16) | (unsigned)(127 - n); }
            SORT16_DESC(g1); SORT16_DESC(g2);
            if (g == 0) {
#pragma unroll
                for (int q = 0; q < 16; ++q) { a1[q] = g1[q]; a2[q] = g2[q]; }
            } else {
#pragma unroll
                for (int q = 0; q < 16; ++q) { a1[q] = a1[q] > g1[15 - q] ? a1[q] : g1[15 - q]; a2[q] = a2[q] > g2[15 - q] ? a2[q] : g2[15 - q]; }
                MERGE16_DESC(a1); MERGE16_DESC(a2);
            }
            if (ok0) conv_store(P, ci0, cv0);
            if (ok1) conv_store(P, ci1, cv1);
            citem += 2;
            __builtin_amdgcn_sched_barrier(0);
        }
#pragma unroll
        for (int i = 0; i < 16; ++i) { lsc[i * 512 + F.tid] = a1[i]; lsc[(16 + i) * 512 + F.tid] = a2[i]; }
        unsigned kb[16];
#pragma unroll
        for (int j = 0; j < 16; ++j) kb[j] = 0u;
#pragma unroll
        for (int i = 0; i < 16; ++i) {
            const float s1 = key_val(a1[i]);
#pragma unroll
            for (int j = 0; j < 16; ++j) if ((i + 1) * (j + 1) <= 16) {
                unsigned xk = (mono32(s1 + key_val(a2[j])) & 0xffffff00u) | (unsigned)(i * 16 + j);
                INS16(kb, xk);
                __builtin_amdgcn_sched_barrier(0);
            }
        }
        float sv[16]; unsigned ev[16]; float smax = -3e38f;
#pragma unroll
        for (int q = 0; q < 16; ++q) { const unsigned i = (kb[q] >> 4) & 15u, j = kb[q] & 15u; const unsigned k1 = lsc[i * 512 + F.tid], k2 = lsc[(16 + j) * 512 + F.tid];
            sv[q] = key_val(k1) + key_val(k2); ev[q] = (127u - (k1 & 127u)) * 128u + (127u - (k2 & 127u)); smax = fmaxf(smax, sv[q]); }
        float gs = 0.f;
#pragma unroll
        for (int q = 0; q < 16; ++q) { sv[q] = __expf(sv[q] - smax); gs += sv[q]; }
        const float ig = 1.0f / gs;
        int* ep = EXP + (size_t)tok * 128 + hd * 16; float* gp = GT + (size_t)tok * 128 + hd * 16;
#pragma unroll
        for (int q = 0; q < 4; ++q) { *(v4u*)(ep + 4 * q) = (v4u){ev[4 * q], ev[4 * q + 1], ev[4 * q + 2], ev[4 * q + 3]};
            *(f32x4*)(gp + 4 * q) = (f32x4){sv[4 * q] * ig, sv[4 * q + 1] * ig, sv[4 * q + 2] * ig, sv[4 * q + 3] * ig}; }
    }
    if (CONV_IN_TOPK) for (;; ++citem) { const size_t ci = cbase + (size_t)citem * CNGT; if (ci >= 2 * CONV_N16) break; f32x4 cv[4]; conv_load(P, ci, cv); conv_store(P, ci, cv); }
}
__device__ __forceinline__ float dot8(const v4u w, const float* h) {
    return h[0] * bflo(w.x) + h[1] * bfhi(w.x) + h[2] * bflo(w.y) + h[3] * bfhi(w.y) + h[4] * bflo(w.z) + h[5] * bfhi(w.z) + h[6] * bflo(w.w) + h[7] * bfhi(w.w);
}
__device__ __forceinline__ void axpy8(float* acc, float c, const v4u w) {
    acc[0] += c * bflo(w.x); acc[1] += c * bfhi(w.x); acc[2] += c * bflo(w.y); acc[3] += c * bfhi(w.y); acc[4] += c * bflo(w.z); acc[5] += c * bfhi(w.z); acc[6] += c * bflo(w.w); acc[7] += c * bfhi(w.w);
}
#ifndef PB
#define PB 8
#endif
__device__ __forceinline__ void p7_peer(Frame& F, const Ptrs& P, float* dst) {
    unsigned char* ws = P.ws; const bf16* H2 = (const bf16*)(ws + WS_H2); const int* EXP = (const int*)(ws + WS_EG); const float* GT = (const float*)(ws + WS_EG + 8 * MiB);
    const bf16* U = (const bf16*)(ws + WS_UV); const bf16* V = U + (size_t)NEXP * DM; float* out = P.out;
    const int gw = F.bid * NWAVES + F.wave, NGW = F.G * NWAVES, lane = F.lane;
    for (int tok = gw; tok < T; tok += NGW) {
        float hv[16], acc[16];
        { const v4u h0 = *(const v4u*)(H2 + (size_t)tok * DM + 8 * lane), h1 = *(const v4u*)(H2 + (size_t)tok * DM + 512 + 8 * lane);
          hv[0] = bflo(h0.x); hv[1] = bfhi(h0.x); hv[2] = bflo(h0.y); hv[3] = bfhi(h0.y); hv[4] = bflo(h0.z); hv[5] = bfhi(h0.z); hv[6] = bflo(h0.w); hv[7] = bfhi(h0.w);
          hv[8] = bflo(h1.x); hv[9] = bfhi(h1.x); hv[10] = bflo(h1.y); hv[11] = bfhi(h1.y); hv[12] = bflo(h1.z); hv[13] = bfhi(h1.z); hv[14] = bflo(h1.w); hv[15] = bfhi(h1.w); }
#pragma unroll
        for (int e = 0; e < 16; ++e) acc[e] = 0.f;
        int e_lo = EXP[(size_t)tok * 128 + lane], e_hi = EXP[(size_t)tok * 128 + 64 + lane];
        float g_lo = GT[(size_t)tok * 128 + lane], g_hi = GT[(size_t)tok * 128 + 64 + lane];
#ifndef PEER_NOSORT
        {
            LAS unsigned* le = (LAS unsigned*)(F.lds + F.wave * 1024); LAS float* lg = (LAS float*)(le + 128);
            const unsigned b_lo = (unsigned)e_lo >> 9, b_hi = (unsigned)e_hi >> 9; unsigned pos_lo = 0, pos_hi = 0, base = 0;
            for (unsigned bk = 0; bk < 32; ++bk) {
                const unsigned long long mlo = __ballot(b_lo == bk), mhi = __ballot(b_hi == bk);
                const unsigned clo = (unsigned)__popcll(mlo), chi = (unsigned)__popcll(mhi);
                if (b_lo == bk) pos_lo = base + __builtin_amdgcn_mbcnt_hi((unsigned)(mlo >> 32), __builtin_amdgcn_mbcnt_lo((unsigned)mlo, 0u));
                if (b_hi == bk) pos_hi = base + clo + __builtin_amdgcn_mbcnt_hi((unsigned)(mhi >> 32), __builtin_amdgcn_mbcnt_lo((unsigned)mhi, 0u));
                base += clo + chi;
            }
            le[pos_lo] = (unsigned)e_lo; lg[pos_lo] = g_lo; le[pos_hi] = (unsigned)e_hi; lg[pos_hi] = g_hi;
            LDS_WAIT(); asm volatile("" ::: "memory");
            e_lo = (int)le[lane]; e_hi = (int)le[64 + lane]; g_lo = lg[lane]; g_hi = lg[64 + lane];
            LDS_WAIT(); asm volatile("" ::: "memory");
        }
#endif
        for (int k = 0; k < 128; k += PB) {
            int ex[PB]; float gg[PB]; v4u u0[PB], u1[PB], v0[PB], v1[PB];
#pragma unroll
            for (int q = 0; q < PB; ++q) { const int kk = k + q; ex[q] = __shfl(kk < 64 ? e_lo : e_hi, kk & 63); gg[q] = __shfl(kk < 64 ? g_lo : g_hi, kk & 63); }
#pragma unroll
            for (int q = 0; q < PB; ++q) { const bf16* up = U + (size_t)ex[q] * DM + 8 * lane; const bf16* vp = V + (size_t)ex[q] * DM + 8 * lane;
                u0[q] = *(const v4u*)up; u1[q] = *(const v4u*)(up + 512); v0[q] = *(const v4u*)vp; v1[q] = *(const v4u*)(vp + 512); }
            float d[PB];
#pragma unroll
            for (int q = 0; q < PB; ++q) d[q] = dot8(u0[q], hv) + dot8(u1[q], hv + 8);
#pragma unroll
            for (int o = 1; o < 64; o <<= 1) {
#pragma unroll
                for (int q = 0; q < PB; ++q) d[q] += __shfl_xor(d[q], o);
            }
#pragma unroll
            for (int q = 0; q < PB; ++q) { const float z = d[q]; const float a = 0.5f * z * (1.0f + erff(z * 0.70710678118654752f)); const float c = gg[q] * a; axpy8(acc, c, v0[q]); axpy8(acc + 8, c, v1[q]); }
        }
        float* op = out + (size_t)tok * DM + 8 * lane;
        f32x4 x0 = *(const f32x4*)op, x1 = *(const f32x4*)(op + 4), x2 = *(const f32x4*)(op + 512), x3 = *(const f32x4*)(op + 516);
        x0 += (f32x4){acc[0], acc[1], acc[2], acc[3]}; x1 += (f32x4){acc[4], acc[5], acc[6], acc[7]}; x2 += (f32x4){acc[8], acc[9], acc[10], acc[11]}; x3 += (f32x4){acc[12], acc[13], acc[14], acc[15]};
        float* wp = dst + (size_t)tok * DM + 8 * lane;
        *(f32x4*)wp = x0; *(f32x4*)(wp + 4) = x1; *(f32x4*)(wp + 512) = x2; *(f32x4*)(wp + 516) = x3;
    }
}

typedef float f32x2v __attribute__((ext_vector_type(2)));
typedef _Float16 f16x2v __attribute__((ext_vector_type(2)));
constexpr size_t WS_PART = WS_ST;
constexpr size_t WS_CG = WS_ACT + 32 * MiB;
__device__ __forceinline__ void fp8x16_to_f32(const v4u w, float* f) {
#pragma unroll
    for (int q = 0; q < 4; ++q) { const f32x2v lo = __builtin_amdgcn_cvt_pk_f32_fp8((int)w[q], false), hi = __builtin_amdgcn_cvt_pk_f32_fp8((int)w[q], true); f[4 * q] = lo.x; f[4 * q + 1] = lo.y; f[4 * q + 2] = hi.x; f[4 * q + 3] = hi.y; }
}
__device__ __forceinline__ float fmac_s(float acc, float a, float b) { asm("v_fmac_f32_e32 %0, %1, %2" : "+v"(acc) : "v"(a), "v"(b)); return acc; }
constexpr int TROW = DM / 2;
template <int MODE> __device__ __forceinline__ void p7u_dots(Frame& F, const Ptrs& P) {
    unsigned char* ws = P.ws; const bf16* H2 = (const bf16*)(ws + WS_H2); const int* EXP = (const int*)(ws + WS_EG); const unsigned char* U4 = ws + WS_UV8; float* PART = (float*)(ws + (MODE ? WS_ACT : WS_PART)); const float* SS = (const float*)(ws + WS_SUMSQ);
    const int lane = F.lane, ti = lane >> 3, c = lane & 7;
#define PU_LOADW(ch, W) do { const int* wp_ = EXP + (size_t)(tbase + 8 * ((ch) >> 3) + ti) * 128 + ((ch) & 7) * 16; _Pragma("unroll") for (int q = 0; q < 4; ++q) W[q] = *(const v4u*)(wp_ + 4 * q); } while (0)
#define PU_LOADH(tg, hn, ssx) do { const int t_ = tbase + 8 * (tg) + ti; ssx = SS[t_]; _Pragma("unroll") for (int q = 0; q < 4; ++q) hn[q] = *(const v4u*)(H2 + (size_t)t_ * DM + hoff + 8 * q); } while (0)
#define PU_ISSUE(W, ul) do { _Pragma("unroll") for (int it = 0; it < 16; ++it) { const unsigned ev = W[it >> 2][it & 3]; ul[it] = *(const v4u*)(U4 + ((ev << 9) + loff)); } } while (0)
#define PU_COMPUTE(ch, ul) do { const bool keep = (((ch) & 7) == c); \
        _Pragma("unroll") for (int it = 0; it < 16; ++it) { f16x2v sa = {(_Float16)0.f, (_Float16)0.f}, sb = sa; \
            _Pragma("unroll") for (int q = 0; q < 4; ++q) { \
                sa = __builtin_amdgcn_cvt_scalef32_pk_f16_fp4(ul[it][q], 1.0f, 0) * hv[4 * q] + sa; sb = __builtin_amdgcn_cvt_scalef32_pk_f16_fp4(ul[it][q], 1.0f, 1) * hv[4 * q + 1] + sb; \
                sa = __builtin_amdgcn_cvt_scalef32_pk_f16_fp4(ul[it][q], 1.0f, 2) * hv[4 * q + 2] + sa; sb = __builtin_amdgcn_cvt_scalef32_pk_f16_fp4(ul[it][q], 1.0f, 3) * hv[4 * q + 3] + sb; } \
            sa += sb; const float s = dpp_sum8((float)sa.x + (float)sa.y) * rstd; res[it] = keep ? s : res[it]; } \
        if (((ch) & 7) == 7) { float* pp = PART + ((size_t)sl * T + (tbase + 8 * ((ch) >> 3) + ti)) * 128 + 16 * c; \
            _Pragma("unroll") for (int q = 0; q < 4; ++q) *(f32x4*)(pp + 4 * q) = (f32x4){res[4 * q], res[4 * q + 1], res[4 * q + 2], res[4 * q + 3]}; } } while (0)
#define PU_SETH(hn, ssx) do { rstd = rsqrtf(ssx * (1.0f / DM) + EPS); \
        _Pragma("unroll") for (int q = 0; q < 4; ++q) { _Pragma("unroll") for (int e = 0; e < 4; ++e) hv[4 * q + e] = (f16x2v){(_Float16)bflo(hn[q][e]), (_Float16)bfhi(hn[q][e])}; } } while (0)
    for (int vb = F.bid; vb < 256; vb += F.G) {
        const int x = vb & 7, j = vb >> 3, sl = x & 3; const int tbase = (x >> 2) * (T / 2) + 256 * j + 32 * F.wave;
        const size_t hoff = 256 * sl + 32 * c; const unsigned loff = 128 * sl + 16 * c;
        v4u WA[4], WB[4], ulA[16], ulB[16], hn[4]; float ssn, rstd, res[16]; f16x2v hv[16];
#pragma unroll
        for (int q = 0; q < 16; ++q) res[q] = 0.f;
        PU_LOADH(0, hn, ssn); PU_LOADW(0, WA); PU_LOADW(1, WB);
        PU_ISSUE(WA, ulA);
        for (int ch = 0; ch < 32; ch += 2) {
            const int c2 = ch + 2 < 31 ? ch + 2 : 31, c3 = ch + 3 < 31 ? ch + 3 : 31;
            if ((ch & 7) == 0) { PU_SETH(hn, ssn); const int tgn = (ch >> 3) + 1 < 4 ? (ch >> 3) + 1 : 3; PU_LOADH(tgn, hn, ssn); }
            PU_ISSUE(WB, ulB);
            PU_LOADW(c2, WA);
            PU_COMPUTE(ch, ulA);
            PU_ISSUE(WA, ulA);
            PU_LOADW(c3, WB);
            PU_COMPUTE(ch + 1, ulB);
        }
    }
#undef PU_LOADW
#undef PU_LOADH
#undef PU_ISSUE
#undef PU_COMPUTE
#undef PU_SETH
}
__device__ __forceinline__ void p7z_gate(Frame& F, const Ptrs& P) {
    unsigned char* ws = P.ws; const float* PART = (const float*)(ws + WS_PART); const float* GT = (const float*)(ws + WS_EG + 8 * MiB); const int* EXP = (const int*)(ws + WS_EG); unsigned* CG = (unsigned*)(ws + WS_CG);
    const size_t gt = (size_t)F.bid * 512 + F.tid, NGT = (size_t)F.G * 512, n4 = (size_t)T * 128 / 4;
    for (size_t i = gt; i < n4; i += NGT) {
        f32x4 z = *(const f32x4*)(PART + i * 4);
#pragma unroll
        for (int x = 1; x < 4; ++x) z += *(const f32x4*)(PART + (size_t)x * T * 128 + i * 4);
        const f32x4 g = *(const f32x4*)(GT + i * 4); const v4u e = *(const v4u*)(EXP + i * 4); v4u o;
#pragma unroll
        for (int q = 0; q < 4; ++q) { const float zz = z[q] * (1.0f / 64.0f); const float cgv = g[q] * 0.5f * zz * (1.0f + erff(zz * 0.70710678118654752f)); o[q] = ((unsigned)__builtin_bit_cast(unsigned short, (_Float16)cgv) << 16) | e[q]; }
        *(v4u*)(CG + i * 4) = o;
    }
}
template <int MODE> __device__ __forceinline__ void p7v_accum(Frame& F, const Ptrs& P, float* dst) {
    unsigned char* ws = P.ws; const unsigned* CG = (const unsigned*)(ws + WS_CG); const unsigned char* V4 = ws + WS_UV8 + 8 * MiB; const float* x1 = P.out;
    const int lane = F.lane, ti = lane >> 3, c = lane & 7;
#define PV_LOADW(ch, W) do { const unsigned* wp_ = CG + (size_t)(tbase + 8 * ((ch) >> 3) + ti) * 128 + ((ch) & 7) * 16; _Pragma("unroll") for (int q = 0; q < 4; ++q) W[q] = *(const v4u*)(wp_ + 4 * q); } while (0)
#define PV_ISSUE(W, vl, cg) do { _Pragma("unroll") for (int it = 0; it < 16; ++it) { const unsigned w = W[it >> 2][it & 3]; cg[it] = __builtin_amdgcn_perm(w, w, 0x03020302u); \
        unsigned off; asm("v_mad_u32_u16 %0, %1, %2, %3" : "=v"(off) : "v"(w), "v"(k512), "v"(loff)); vl[it] = *(const v4u*)(V4 + off); } } while (0)
#define PV_COMPUTE(ch, vl, cg) do { \
        _Pragma("unroll") for (int it = 0; it < 16; ++it) { const f16x2v cg2 = __builtin_bit_cast(f16x2v, cg[it]); \
            _Pragma("unroll") for (int q = 0; q < 4; ++q) { \
                acc[4 * q] = cg2 * __builtin_amdgcn_cvt_scalef32_pk_f16_fp4(vl[it][q], 1.0f, 0) + acc[4 * q]; acc[4 * q + 1] = cg2 * __builtin_amdgcn_cvt_scalef32_pk_f16_fp4(vl[it][q], 1.0f, 1) + acc[4 * q + 1]; \
                acc[4 * q + 2] = cg2 * __builtin_amdgcn_cvt_scalef32_pk_f16_fp4(vl[it][q], 1.0f, 2) + acc[4 * q + 2]; acc[4 * q + 3] = cg2 * __builtin_amdgcn_cvt_scalef32_pk_f16_fp4(vl[it][q], 1.0f, 3) + acc[4 * q + 3]; } } \
        if ((((ch) & 7) == 7)) { const size_t off = (size_t)(tbase + 8 * ((ch) >> 3) + ti) * DM + hoff; \
            _Pragma("unroll") for (int q = 0; q < 8; ++q) { f32x4 v = *(const f32x4*)(x1 + off + 4 * q); \
                v += (f32x4){(float)acc[2 * q].x, (float)acc[2 * q].y, (float)acc[2 * q + 1].x, (float)acc[2 * q + 1].y} * (1.0f / 64.0f); \
                *(f32x4*)(dst + off + 4 * q) = v; } \
            _Pragma("unroll") for (int q = 0; q < 16; ++q) acc[q] = (f16x2v){(_Float16)0.f, (_Float16)0.f}; } } while (0)
    for (int vb = F.bid; vb < 256; vb += F.G) {
        const int x = vb & 7, j = vb >> 3, sl = x & 3; const int tbase = (x >> 2) * (T / 2) + 256 * j + 32 * F.wave;
        const size_t hoff = 256 * sl + 32 * c; const unsigned loff = 128 * sl + 16 * c, k512 = 512u;
        v4u WA[4], WB[4], vlA[16], vlB[16]; unsigned cgA[16], cgB[16]; f16x2v acc[16];
#pragma unroll
        for (int q = 0; q < 16; ++q) acc[q] = (f16x2v){(_Float16)0.f, (_Float16)0.f};
        PV_LOADW(0, WA); PV_LOADW(1, WB);
        PV_ISSUE(WA, vlA, cgA);
        for (int ch = 0; ch < 32; ch += 2) {
            const int c2 = ch + 2 < 31 ? ch + 2 : 31, c3 = ch + 3 < 31 ? ch + 3 : 31;
            PV_ISSUE(WB, vlB, cgB);
            PV_LOADW(c2, WA);
            PV_COMPUTE(ch, vlA, cgA);
            PV_ISSUE(WA, vlA, cgA);
            PV_LOADW(c3, WB);
            PV_COMPUTE(ch + 1, vlB, cgB);
        }
    }
#undef PV_LOADW
#undef PV_ISSUE
#undef PV_COMPUTE
}

struct MirrorOrder {
    pg8::StaticOrder S8;
    __device__ __forceinline__ bool next(int i, pg8::Unit& u) const { pg8::Unit v; if (!S8.next(i, v)) return false; u.pm = v.pn; u.pn = v.pm; return true; }
    __device__ __forceinline__ void a_ready(const pg8::Unit&) const {}
    __device__ __forceinline__ void done(const pg8::Unit&) const {}
};
struct Args { const float* in[14]; float* out; unsigned char* ws; int ph_lo, ph_hi; };
#ifdef PEER_BF16
constexpr int N_PHASES = 12;
#else
constexpr int N_PHASES = 14;
#endif
#ifndef MK_PER_PHASE
#define MK_PER_PHASE 0
#endif

__global__ void __launch_bounds__(NWAVES * 64, 2) hybrid_fwd(Args args) {
    extern __shared__ __attribute__((aligned(16))) unsigned char lds[];
    Frame F;
    F.lds = (LAS unsigned char*)lds; F.MISC = (volatile LAS unsigned*)(F.lds + MISC_OFF);
    F.tid = threadIdx.x; F.lane = F.tid & 63; F.wave = __builtin_amdgcn_readfirstlane(F.tid >> 6); F.G = gridDim.x; F.bid = blockIdx.x;
    F.ctl = (gu32*)(args.ws + WS_CTL);
    if (F.tid < 64) ((LAS unsigned*)(F.lds + MISC_OFF))[F.tid] = 0u;
    __syncthreads();
    XcdBarrier bar; bar.bar = (unsigned*)(F.ctl + CW_BAR); bar.x = 0; bar.st = nullptr;
    if (!MK_PER_PHASE) bar = xcd_barrier_post((unsigned*)(F.ctl + CW_BAR), F.MISC + 8);
    const int lo = args.ph_lo, hi = args.ph_hi;
#define LOADP() { int t_ = threadIdx.x; asm volatile("" : "+v"(t_)); F.tid = t_; F.lane = t_ & 63; F.wave = __builtin_amdgcn_readfirstlane(t_ >> 6); } Ptrs P; { const __attribute__((address_space(4))) Args* ap = (const __attribute__((address_space(4))) Args*)__builtin_amdgcn_kernarg_segment_ptr(); asm volatile("" : "+s"(ap)); \
    P.x = ap->in[0]; P.mix_g = ap->in[1]; P.w_in = ap->in[2]; P.ret_w = ap->in[3]; P.q_gain = ap->in[4]; P.k_gain = ap->in[5]; P.moba_w = ap->in[6]; P.rel_bias = ap->in[7]; \
    P.w_out = ap->in[8]; P.ffn_g = ap->in[9]; P.peer_wq = ap->in[10]; P.sub_keys = ap->in[11]; P.peer_u = ap->in[12]; P.peer_v = ap->in[13]; P.out = ap->out; P.ws = ap->ws; } \
    unsigned char* ws = P.ws; bf16* XN = (bf16*)P.out; bf16* RETG = (bf16*)P.out; bf16* ATT = (bf16*)((unsigned char*)P.out + 32 * MiB); (void)ws; (void)XN; (void)RETG; (void)ATT;
#ifdef RET_NAIVE
#define RET_FN p3a_retention
#else
#define RET_FN p3a_retention_mfma
#endif
#ifdef MOBA_NAIVE
#define MOBA_FN p3b_moba
#else
#define MOBA_FN p3b_moba_mfma<0>
#endif
#ifndef DUP_MASK
#define DUP_MASK 0
#endif
#ifndef DUPPH
#define DUPPH 0
#endif
#define REPS(k) ((((DUPPH) >> (k)) & 1) ? 2 : 1)
#ifndef PH_MASK
#define PH_MASK 0xFFFF
#endif
#define IN(k) (((PH_MASK >> (k)) & 1) && lo <= (k) && (k) < hi)
#define LOCAL_SEAM(k) do { if (MK_PER_PHASE) {} } while (0)
#define SEAM(k) do { if (IN(k) && IN((k) + 1)) xcd_barrier(bar); } while (0)
    LAS unsigned char* ring = F.lds;

    if (IN(0)) for (int rep_ = 0; rep_ < REPS(0); ++rep_) { LOADP(); p0_prologue(F, P); } SEAM(0);
    if (IN(1)) for (int rep_ = 0; rep_ < REPS(1); ++rep_) { LOADP();
        pg8::Gemm g{XN, (const bf16*)(ws + WS_WIN), T, INW, DM, DM, DM, 0}; pg8::StaticOrder S; S.init(T, INW, F.G, F.bid);
        EpiInProj E{(bf16*)(ws + WS_RQ), (bf16*)(ws + WS_RK), (bf16*)(ws + WS_RV), (bf16*)(ws + WS_RG), (bf16*)(ws + WS_MQ), (bf16*)(ws + WS_MK), (bf16*)(ws + WS_MV), (bf16*)(ws + WS_GA), (bf16*)(ws + WS_GB),
                    (const float*)(ws + WS_ROPE), P.q_gain, P.k_gain, (float*)(ws + WS_KM)};
        pg8::gemm_phase<EpiInProj, pg8::StaticOrder, true, true>(ring, g, S, E);
        { const int nunit = (T / 256) * (INW / 256), rem = nunit % F.G;
          if (rem == 0) p0b_late_weights(F, P, F.bid, F.G); else if (F.bid >= rem) p0b_late_weights(F, P, F.bid - rem, F.G - rem); }
    } SEAM(1);
#ifdef EXTRA_BARS
    for (int xb_ = 0; xb_ < EXTRA_BARS; ++xb_) xcd_barrier(bar);
#endif
    if (IN(2)) for (int rep_ = 0; rep_ < REPS(2); ++rep_) { LOADP(); p2a_kv_mfma(F, P); } SEAM(2);
    if (IN(3)) for (int rep_ = 0; rep_ < REPS(3); ++rep_) { LOADP(); p2b_scan(F, P); } SEAM(3);
    if (IN(4)) for (int rep_ = 0; rep_ < REPS(4); ++rep_) { LOADP(); RET_FN(F, P); if (DUP_MASK & 1) RET_FN(F, P); MOBA_FN(F, P); if (DUP_MASK & 2) MOBA_FN(F, P);
#ifdef MOBA_ABL
        p3b_moba_mfma<MOBA_ABL>(F, P);
#endif
    } SEAM(4);
    if (IN(5)) for (int rep_ = 0; rep_ < REPS(5); ++rep_) { LOADP();
        pg8::Gemm g0{ATT, (const bf16*)(ws + WS_WB), T, DM, 512, 512, 512, 0}, g1{RETG, (const bf16*)(ws + WS_WA), T, DM, DM, DM, DM, 0};
        TwoSegOrder S; S.B.init(T, DM, F.G, F.bid);
        EpiMerge2 E{(bf16*)(ws + WS_MRG), (const bf16*)(ws + WS_GA), (const bf16*)(ws + WS_GB)};
        pg8::gemm_phase2<EpiMerge2, TwoSegOrder, true, true>(ring, g0, g1, S, E);
    } SEAM(5);
    if (IN(6)) for (int rep_ = 0; rep_ < REPS(6); ++rep_) { LOADP();
        pg8::Gemm g{(const bf16*)(ws + WS_MRG), (const bf16*)(ws + WS_WO), T, DM, DM, DM, DM, 0}; pg8::StaticOrder S; S.init(T, DM, F.G, F.bid);
        EpiResid E{P.x, P.out, (bf16*)(ws + WS_H2), P.ffn_g, (float*)(ws + WS_SUMSQ)};
        pg8::gemm_phase<EpiResid, pg8::StaticOrder, true, true>(ring, g, S, E);
    } SEAM(6);
    if (IN(9)) for (int rep_ = 0; rep_ < REPS(9); ++rep_) { LOADP();
        pg8::Gemm g{(const bf16*)(ws + WS_WQ), (const bf16*)(ws + WS_H2), PH * 256, T, DM, DM, DM, 0}; MirrorOrder S; S.S8.init(T, 2048, F.G, F.bid);
        EpiNatBf16 E{(bf16*)(ws + WS_ST), T, (const float*)(ws + WS_SUMSQ)};
        pg8::gemm_phase<EpiNatBf16, MirrorOrder, true, true>(ring, g, S, E);
        VM_WAIT(); __syncthreads();
    } LOCAL_SEAM(9);
    if (IN(10)) for (int rep_ = 0; rep_ < REPS(10); ++rep_) { LOADP(); p6_topk(F, P); } SEAM(10);
#ifdef PEER_BF16
    if (IN(11)) for (int rep_ = 0; rep_ < REPS(11); ++rep_) { LOADP(); if (DUP_MASK & 4) p7_peer(F, P, (float*)(ws + WS_ST)); p7_peer(F, P, P.out); }
#else
    if (IN(11)) for (int rep_ = 0; rep_ < REPS(11); ++rep_) { LOADP(); p7u_dots<0>(F, P); if (DUP_MASK & 4) p7u_dots<2>(F, P); } SEAM(11);
    if (IN(12)) for (int rep_ = 0; rep_ < REPS(12); ++rep_) { LOADP(); p7z_gate(F, P); } SEAM(12);
    if (IN(13)) for (int rep_ = 0; rep_ < REPS(13); ++rep_) { LOADP(); if (DUP_MASK & 16) p7v_accum<0>(F, P, (float*)(ws + WS_PART)); p7v_accum<0>(F, P, P.out); }
#endif
#undef IN
#undef SEAM
}

extern "C" void kernel_launch(void* const* d_in, const int* in_sizes, int n_in, void* d_out, int out_size, void* d_ws, size_t ws_size, hipStream_t stream) {
    static int grid = 0;
    if (grid == 0) {
        if (n_in != 14 || out_size != T * DM || ws_size < WS_END) { fprintf(stderr, "kernel_launch: unexpected problem (n_in %d, out %d, ws %zu); nothing launched\n", n_in, out_size, ws_size); grid = -1; return; }
        int dev = 0, cus = 0, per_cu = 0;
        if (hipGetDevice(&dev) != hipSuccess || hipDeviceGetAttribute(&cus, hipDeviceAttributeMultiprocessorCount, dev) != hipSuccess) { grid = -1; return; }
        if (hipFuncSetAttribute((const void*)hybrid_fwd, hipFuncAttributeMaxDynamicSharedMemorySize, LDS_BYTES) != hipSuccess) { fprintf(stderr, "kernel_launch: hipFuncSetAttribute failed\n"); grid = -1; return; }
        if (hipOccupancyMaxActiveBlocksPerMultiprocessor(&per_cu, (const void*)hybrid_fwd, NWAVES * 64, LDS_BYTES) != hipSuccess || per_cu < 1)
            fprintf(stderr, "kernel_launch: note: occupancy query reports %d workgroups per CU\n", per_cu);
        (void)hipGetLastError();
        grid = cus;
    }
    if (grid < 0) return;
    (void)hipMemsetAsync((char*)d_ws + WS_CTL, 0, CTL_ZERO_BYTES, stream);
    Args a{};
    for (int i = 0; i < 14; ++i) a.in[i] = (const float*)d_in[i];
    a.out = (float*)d_out; a.ws = (unsigned char*)d_ws;
#if MK_PER_PHASE
    for (int p = 0; p < N_PHASES; ++p) { a.ph_lo = p; a.ph_hi = p + 1; hipLaunchKernelGGL(hybrid_fwd, dim3(grid), dim3(NWAVES * 64), LDS_BYTES, stream, a); }
#else
    a.ph_lo = 0; a.ph_hi = N_PHASES;
    hipLaunchKernelGGL(hybrid_fwd, dim3(grid), dim3(NWAVES * 64), LDS_BYTES, stream, a);
#endif
}
```

```cpp
#include <hip/hip_runtime.h>
#include <cstdio>
#include <cstdint>

#define GAS __attribute__((address_space(1)))
#define LAS __attribute__((address_space(3)))
typedef unsigned short bf16;
typedef unsigned v4u __attribute__((ext_vector_type(4)));
typedef unsigned v2u __attribute__((ext_vector_type(2)));
typedef float f32x4 __attribute__((ext_vector_type(4)));
typedef short bf16x8 __attribute__((ext_vector_type(8)));
typedef float f32x16 __attribute__((ext_vector_type(16)));
typedef GAS unsigned gu32;
#define RLX_AGENT __ATOMIC_RELAXED, __HIP_MEMORY_SCOPE_AGENT
#define LDS_WAIT() asm volatile("s_waitcnt lgkmcnt(0)" ::: "memory")
#define VM_WAIT() asm volatile("s_waitcnt vmcnt(0)" ::: "memory")

constexpr int BATCH = 4, SEQ = 4096, DM = 1024, T = BATCH * SEQ;
constexpr int RH = 8, RDK = 64, RDV = 128, RC = 128, NCH = SEQ / RC;
constexpr int MH = 8, MD = 64, MBLK = 256, NBLK = SEQ / MBLK;
constexpr int PH = 8, PNK = 128, PTOP = 16, PQD = 256;
constexpr int NEXP = PNK * PNK;
constexpr int INW = 6656;
constexpr float EPS = 1e-6f;

__device__ __forceinline__ unsigned f2bf(float f) { unsigned u = __builtin_bit_cast(unsigned, f); return (u + 0x7fffu + ((u >> 16) & 1u)) >> 16; }
typedef float f32x2_t __attribute__((ext_vector_type(2))); typedef __bf16 bf16x2_t __attribute__((ext_vector_type(2)));
__device__ __forceinline__ unsigned pk2(float lo, float hi) { const f32x2_t v = {lo, hi}; const bf16x2_t b = __builtin_convertvector(v, bf16x2_t); return __builtin_bit_cast(unsigned, b); }
__device__ __forceinline__ float bf2f(unsigned short b) { return __builtin_bit_cast(float, (unsigned)b << 16); }
__device__ __forceinline__ float bflo(unsigned w) { return __builtin_bit_cast(float, w << 16); }
__device__ __forceinline__ float bfhi(unsigned w) { return __builtin_bit_cast(float, w & 0xffff0000u); }
__device__ __forceinline__ float wave_sum(float v) {
#pragma unroll
    for (int o = 1; o < 64; o <<= 1) v += __shfl_xor(v, o);
    return v;
}
__device__ __forceinline__ float dpp_sum8(float v) {
    v += __builtin_bit_cast(float, __builtin_amdgcn_mov_dpp(__builtin_bit_cast(int, v), 0xB1, 0xF, 0xF, true));
    v += __builtin_bit_cast(float, __builtin_amdgcn_mov_dpp(__builtin_bit_cast(int, v), 0x4E, 0xF, 0xF, true));
    v += __builtin_bit_cast(float, __builtin_amdgcn_mov_dpp(__builtin_bit_cast(int, v), 0x141, 0xF, 0xF, true));
    return v;
}
__device__ __forceinline__ float ret_l2g(int h) { return log1pf(-exp2f(-5.0f - (float)h)) * 1.4426950408889634f; }

__host__ __device__ __forceinline__ int perm_row_of_col(int a) {
    const int tile = a >> 8, w = a & 255, wc = w >> 6, bj = (w >> 5) & 1, q = w & 31, fq = q >> 3, n = (q >> 2) & 1, e = q & 3;
    return tile * 256 + 128 * bj + 32 * wc + 16 * n + 4 * fq + e;
}
namespace pg8 {
#define PG8_LAS __attribute__((address_space(3)))
typedef unsigned short bf16_t;
typedef short bf16x8 __attribute__((ext_vector_type(8)));
typedef float f32x4 __attribute__((ext_vector_type(4)));
typedef unsigned u32x4 __attribute__((ext_vector_type(4)));
constexpr int BM = 256, BK = 64, HALF = 128, HTB = HALF * BK * 2  , STAGE_BYTES = 8 * HTB, NXCD = 8, WGM = 8;

__host__ __device__ __forceinline__ int lds_byte(int r, int c) { const int st = (r >> 4) * 2 + (c >> 5), rr = r & 15, cc = c & 31, ob = rr * 64 + cc * 2; return st * 1024 + (ob ^ (((ob >> 9) & 1) << 5)); }
__host__ __device__ __forceinline__ void stage_rc(int b, int& R, int& C) { const int st = b / 1024, sb = b % 1024, swz = sb ^ (((sb >> 9) & 1) << 5); R = (st >> 1) * 16 + swz / 64; C = (st & 1) * 32 + (swz % 64) / 2; }
__host__ __device__ __forceinline__ int perm32(int rho) { const int n = rho >> 4, i = rho & 15; return 8 * (i >> 2) + 4 * n + (i & 3); }

struct Unit { int pm, pn, seg; };
struct Gemm { const bf16_t* A; const bf16_t* Bt; int M, N, K, lda, ldb, bpm; };

struct StaticOrder {
    int nM, nN, nwg, G, c;
    __host__ __device__ void init(int M, int N, int G_, int c_) { nM = M / BM; nN = N / BM; nwg = nM * nN; G = G_; c = c_; }
    __host__ __device__ bool next(int i, Unit& u) const {
        const long L = (long)i * G + c; if (L >= nwg) return false;
        int wgid = (int)L; { const int q = nwg / NXCD, r = nwg % NXCD, xcd = wgid % NXCD, off = wgid / NXCD; wgid = (xcd < r ? xcd * (q + 1) : r * (q + 1) + (xcd - r) * q) + off; }
        const int nig = WGM * nN, gid = wgid / nig, fm = gid * WGM, gsz = (nM - fm) < WGM ? (nM - fm) : WGM;
        u.pm = fm + ((wgid % nig) % gsz); u.pn = (wgid % nig) / gsz; u.seg = 0; return true;
    }
    __device__ __forceinline__ void a_ready(const Unit&) const {}
    __device__ __forceinline__ void done(const Unit&) const {}
};


template <class Epi, class Sched, bool ALIGN_EPI = false, bool SP2 = false>
__device__ __forceinline__ void gemm_phase(PG8_LAS unsigned char* lds, const Gemm g, const Sched& S, const Epi& E) {
    int tid_ = threadIdx.x; asm volatile("" : "+v"(tid_));
    const int tid = tid_, wid = __builtin_amdgcn_readfirstlane(tid >> 6), lane = tid & 63, wr = wid >> 2, wc = wid & 3, fr = lane & 15, fq = lane >> 4;
    const int K = g.K, nt = K / BK;
    unsigned voffA[2], voffB[2];
#pragma unroll
    for (int i = 0; i < 2; ++i) { int R, C; stage_rc(tid * 16 + i * 8192, R, C);
        voffA[i] = (unsigned)(R * g.lda + C) * 2u; voffB[i] = (unsigned)(R * g.ldb + C) * 2u; }
    const size_t kstep = (size_t)(BK * 2);
    const size_t hstepA = (size_t)HALF * g.lda * 2, hstepB = (size_t)HALF * g.ldb * 2;
    const size_t tstepA = 2 * hstepA, tstepB = 2 * hstepB;
    const unsigned ldsw = (unsigned)wid * 1024u;
    const int aoff = lds_byte(wr * 64 + fr, fq * 8), boff = lds_byte(wc * 32 + fr, fq * 8);
#define PG8_SA(b, h) (((b) * 2 + (h)) * HTB)
#define PG8_SB(b, h) ((4 + (b) * 2 + (h)) * HTB)
#define PG8_STAGE(bufoff, gbase, voff) do { _Pragma("unroll") for (int _i = 0; _i < 2; ++_i) \
        __builtin_amdgcn_global_load_lds((const unsigned*)((const char*)(gbase) + (voff)[_i]), (PG8_LAS unsigned*)(lds + (bufoff) + ldsw + _i * 8192), 16, 0, 0); } while (0)
#define PG8_LDA(dst, b, h) do { _Pragma("unroll") for (int m = 0; m < 4; ++m) _Pragma("unroll") for (int k = 0; k < 2; ++k) dst[m][k] = *(const PG8_LAS bf16x8*)(lds + PG8_SA(b, h) + aoff + m * 2048 + k * 1024); } while (0)
#define PG8_LDB(dst, b, h) do { _Pragma("unroll") for (int n = 0; n < 2; ++n) _Pragma("unroll") for (int k = 0; k < 2; ++k) dst[n][k] = *(const PG8_LAS bf16x8*)(lds + PG8_SB(b, h) + boff + n * 2048 + k * 1024); } while (0)
#define PG8_MMA(ai, bj, At, Bt) do { __builtin_amdgcn_s_setprio(1); _Pragma("unroll") for (int m = 0; m < 4; ++m) _Pragma("unroll") for (int n = 0; n < 2; ++n) _Pragma("unroll") for (int k = 0; k < 2; ++k) \
        acc[ai][bj][m][n] = __builtin_amdgcn_mfma_f32_16x16x32_bf16(Bt[n][k], At[m][k], acc[ai][bj][m][n], 0, 0, 0); __builtin_amdgcn_s_setprio(0); } while (0)
#define PG8_WAIT_V(n) asm volatile("s_waitcnt vmcnt(" #n ")" ::: "memory")
#define PG8_WAIT_L(n) asm volatile("s_waitcnt lgkmcnt(" #n ")" ::: "memory")
#define PG8_BAR __builtin_amdgcn_s_barrier()
#define PG8_SCHED __builtin_amdgcn_sched_barrier(0)
    Unit cur, nxt; int ui = 0;
    if (!S.next(0, cur)) return;
    f32x4 acc[2][2][4][2];
#pragma unroll
    for (int a = 0; a < 2; ++a)
#pragma unroll
        for (int b = 0; b < 2; ++b)
#pragma unroll
            for (int m = 0; m < 4; ++m)
#pragma unroll
                for (int n = 0; n < 2; ++n) acc[a][b][m][n] = (f32x4){0.f, 0.f, 0.f, 0.f};
    bf16x8 At[4][2], B0[2][2], B1[2][2];
    const char* cA = (const char*)g.A + (size_t)cur.pm * tstepA; const char* cB = (const char*)g.Bt + (size_t)cur.pn * tstepB + (size_t)cur.pm * g.bpm;
    S.a_ready(cur);
    if constexpr (SP2) {
        PG8_STAGE(PG8_SB(0, 0), cB, voffB); PG8_STAGE(PG8_SB(0, 1), cB + hstepB, voffB); PG8_STAGE(PG8_SA(0, 0), cA, voffA); PG8_STAGE(PG8_SA(0, 1), cA + hstepA, voffA);
        if (wr == 1) PG8_BAR;
        PG8_WAIT_V(2); PG8_BAR;
        PG8_STAGE(PG8_SB(1, 0), cB + kstep, voffB); PG8_STAGE(PG8_SA(1, 0), cA + kstep, voffA); PG8_STAGE(PG8_SB(1, 1), cB + hstepB + kstep, voffB);
        PG8_WAIT_V(6); PG8_BAR;
    } else {
        PG8_STAGE(PG8_SB(0, 0), cB, voffB); PG8_STAGE(PG8_SA(0, 0), cA, voffA); PG8_STAGE(PG8_SB(0, 1), cB + hstepB, voffB); PG8_STAGE(PG8_SA(0, 1), cA + hstepA, voffA);
        if (wr == 1) PG8_BAR;
        PG8_WAIT_V(4); PG8_BAR;
        PG8_STAGE(PG8_SB(1, 0), cB + kstep, voffB); PG8_STAGE(PG8_SA(1, 0), cA + kstep, voffA); PG8_STAGE(PG8_SB(1, 1), cB + hstepB + kstep, voffB);
        PG8_WAIT_V(6); PG8_BAR;
    }
    for (;;) {
        const bool has_next = S.next(ui + 1, nxt);
        const char* nA = has_next ? (const char*)g.A + (size_t)nxt.pm * tstepA : cA; const char* nB = has_next ? (const char*)g.Bt + (size_t)nxt.pn * tstepB + (size_t)nxt.pm * g.bpm : cB;
        for (int t = 0; t < nt; t += 2) {
            const bool last = (t == nt - 2);
            const char* a1 = cA + (size_t)(t + 1) * kstep;
            const char* a2 = last ? nA : cA + (size_t)(t + 2) * kstep; const char* b2 = last ? nB : cB + (size_t)(t + 2) * kstep;
            const char* a3 = a2 + kstep; const char* b3 = b2 + kstep;
            if (last && has_next) S.a_ready(nxt);
            if constexpr (SP2) {
            PG8_LDB(B0, 0, 0); PG8_LDB(B1, 0, 1); PG8_SCHED; PG8_LDA(At, 0, 0); PG8_STAGE(PG8_SA(1, 1), a1 + hstepA, voffA);
            PG8_WAIT_V(8); PG8_WAIT_L(0); PG8_BAR; PG8_MMA(0, 0, At, B0); PG8_MMA(0, 1, At, B1); PG8_BAR; PG8_SCHED;
            PG8_LDA(At, 0, 1); PG8_STAGE(PG8_SB(0, 0), b2, voffB); PG8_STAGE(PG8_SB(0, 1), b2 + hstepB, voffB); PG8_STAGE(PG8_SA(0, 0), a2, voffA);
            PG8_WAIT_V(8); PG8_WAIT_L(0); PG8_BAR; PG8_MMA(1, 0, At, B0); PG8_MMA(1, 1, At, B1); PG8_BAR; PG8_SCHED;
            PG8_LDB(B0, 1, 0); PG8_LDB(B1, 1, 1); PG8_SCHED; PG8_LDA(At, 1, 0); PG8_STAGE(PG8_SA(0, 1), a2 + hstepA, voffA);
            PG8_WAIT_V(8); PG8_WAIT_L(0); PG8_BAR; PG8_MMA(0, 0, At, B0); PG8_MMA(0, 1, At, B1); PG8_BAR; PG8_SCHED;
            PG8_LDA(At, 1, 1); PG8_STAGE(PG8_SB(1, 0), b3, voffB); PG8_STAGE(PG8_SB(1, 1), b3 + hstepB, voffB); PG8_STAGE(PG8_SA(1, 0), a3, voffA);
            PG8_WAIT_V(8); PG8_WAIT_L(0); PG8_BAR; PG8_MMA(1, 0, At, B0); PG8_MMA(1, 1, At, B1); PG8_BAR; PG8_SCHED;
            } else {
            PG8_LDB(B0, 0, 0); PG8_SCHED; PG8_LDA(At, 0, 0); PG8_STAGE(PG8_SA(1, 1), a1 + hstepA, voffA);
            PG8_WAIT_L(8); PG8_BAR; PG8_WAIT_L(0); PG8_MMA(0, 0, At, B0); PG8_BAR; PG8_SCHED;
            PG8_LDB(B1, 0, 1); PG8_STAGE(PG8_SB(0, 0), b2, voffB);
            PG8_BAR; PG8_WAIT_L(0); PG8_MMA(0, 1, At, B1); PG8_BAR;
            PG8_LDA(At, 0, 1); PG8_STAGE(PG8_SA(0, 0), a2, voffA);
            PG8_BAR; PG8_WAIT_L(0); PG8_MMA(1, 0, At, B0); PG8_BAR; PG8_SCHED;
            PG8_STAGE(PG8_SB(0, 1), b2 + hstepB, voffB);
            PG8_WAIT_V(6); PG8_BAR; PG8_MMA(1, 1, At, B1); PG8_BAR;
            PG8_LDB(B0, 1, 0); PG8_SCHED; PG8_LDA(At, 1, 0); PG8_STAGE(PG8_SA(0, 1), a2 + hstepA, voffA);
            PG8_WAIT_L(8); PG8_BAR; PG8_WAIT_L(0); PG8_MMA(0, 0, At, B0); PG8_BAR; PG8_SCHED;
            PG8_LDB(B1, 1, 1); PG8_STAGE(PG8_SB(1, 0), b3, voffB);
            PG8_BAR; PG8_WAIT_L(0); PG8_MMA(0, 1, At, B1); PG8_BAR;
            PG8_LDA(At, 1, 1); PG8_STAGE(PG8_SA(1, 0), a3, voffA);
            PG8_BAR; PG8_WAIT_L(0); PG8_MMA(1, 0, At, B0); PG8_BAR; PG8_SCHED;
            PG8_STAGE(PG8_SB(1, 1), b3 + hstepB, voffB);
            PG8_WAIT_V(6); PG8_BAR; PG8_MMA(1, 1, At, B1); PG8_BAR;
            }
        }
        if constexpr (ALIGN_EPI) { if (wr == 0) PG8_BAR; }
        if constexpr (!Epi::AFTER_DRAIN) { E(acc, cur, wr, wc, fr, fq); S.done(cur); }
        if (!has_next) break;
#pragma unroll
        for (int a = 0; a < 2; ++a)
#pragma unroll
            for (int b = 0; b < 2; ++b)
#pragma unroll
                for (int m = 0; m < 4; ++m)
#pragma unroll
                    for (int n = 0; n < 2; ++n) acc[a][b][m][n] = (f32x4){0.f, 0.f, 0.f, 0.f};
        cur = nxt; cA = nA; cB = nB; ++ui;
        if constexpr (ALIGN_EPI) { if (wr == 1) PG8_BAR; }
    }
    PG8_WAIT_V(0);
    if constexpr (!ALIGN_EPI) { if (wr == 0) PG8_BAR; }
    PG8_BAR;
    if constexpr (Epi::AFTER_DRAIN) { E.fused(acc, cur, wr, wc, fr, fq, lds, wid, lane); S.done(cur); }
#undef PG8_SA
#undef PG8_SB
#undef PG8_STAGE
#undef PG8_LDA
#undef PG8_LDB
#undef PG8_MMA
#undef PG8_WAIT_V
#undef PG8_WAIT_L
#undef PG8_BAR
#undef PG8_SCHED
}
template <class Epi, class Sched, bool ALIGN_EPI = false, bool SP2 = false>
__device__ __forceinline__ void gemm_phase2(PG8_LAS unsigned char* lds, const Gemm g0, const Gemm g1, const Sched& S, const Epi& E) {
    int tid_ = threadIdx.x; asm volatile("" : "+v"(tid_));
    const int tid = tid_, wid = __builtin_amdgcn_readfirstlane(tid >> 6), lane = tid & 63, wr = wid >> 2, wc = wid & 3, fr = lane & 15, fq = lane >> 4;
    unsigned voffA0[2], voffB0[2], voffA1[2], voffB1[2];
#pragma unroll
    for (int i = 0; i < 2; ++i) { int R, C; stage_rc(tid * 16 + i * 8192, R, C);
        voffA0[i] = (unsigned)(R * g0.lda + C) * 2u; voffB0[i] = (unsigned)(R * g0.ldb + C) * 2u; voffA1[i] = (unsigned)(R * g1.lda + C) * 2u; voffB1[i] = (unsigned)(R * g1.ldb + C) * 2u; }
    const size_t kstep = (size_t)(BK * 2);
    const size_t hstepA0 = (size_t)HALF * g0.lda * 2, hstepB0 = (size_t)HALF * g0.ldb * 2, hstepA1 = (size_t)HALF * g1.lda * 2, hstepB1 = (size_t)HALF * g1.ldb * 2;
    const size_t tstepA0 = 2 * hstepA0, tstepB0 = 2 * hstepB0, tstepA1 = 2 * hstepA1, tstepB1 = 2 * hstepB1;
    const unsigned ldsw = (unsigned)wid * 1024u;
    const int aoff = lds_byte(wr * 64 + fr, fq * 8), boff = lds_byte(wc * 32 + fr, fq * 8);
#define PG8_SA(b, h) (((b) * 2 + (h)) * HTB)
#define PG8_SB(b, h) ((4 + (b) * 2 + (h)) * HTB)
#define PG8_STAGE(bufoff, gbase, voff) do { _Pragma("unroll") for (int _i = 0; _i < 2; ++_i) \
        __builtin_amdgcn_global_load_lds((const unsigned*)((const char*)(gbase) + (voff)[_i]), (PG8_LAS unsigned*)(lds + (bufoff) + ldsw + _i * 8192), 16, 0, 0); } while (0)
#define PG8_LDA(dst, b, h) do { _Pragma("unroll") for (int m = 0; m < 4; ++m) _Pragma("unroll") for (int k = 0; k < 2; ++k) dst[m][k] = *(const PG8_LAS bf16x8*)(lds + PG8_SA(b, h) + aoff + m * 2048 + k * 1024); } while (0)
#define PG8_LDB(dst, b, h) do { _Pragma("unroll") for (int n = 0; n < 2; ++n) _Pragma("unroll") for (int k = 0; k < 2; ++k) dst[n][k] = *(const PG8_LAS bf16x8*)(lds + PG8_SB(b, h) + boff + n * 2048 + k * 1024); } while (0)
#define PG8_MMA(ai, bj, At, Bt) do { __builtin_amdgcn_s_setprio(1); _Pragma("unroll") for (int m = 0; m < 4; ++m) _Pragma("unroll") for (int n = 0; n < 2; ++n) _Pragma("unroll") for (int k = 0; k < 2; ++k) \
        acc[ai][bj][m][n] = __builtin_amdgcn_mfma_f32_16x16x32_bf16(Bt[n][k], At[m][k], acc[ai][bj][m][n], 0, 0, 0); __builtin_amdgcn_s_setprio(0); } while (0)
#define PG8_WAIT_V(n) asm volatile("s_waitcnt vmcnt(" #n ")" ::: "memory")
#define PG8_WAIT_L(n) asm volatile("s_waitcnt lgkmcnt(" #n ")" ::: "memory")
#define PG8_BAR __builtin_amdgcn_s_barrier()
#define PG8_SCHED __builtin_amdgcn_sched_barrier(0)
    Unit cur, nxt; int ui = 0;
    if (!S.next(0, cur)) return;
    f32x4 acc[2][2][4][2];
#pragma unroll
    for (int a = 0; a < 2; ++a)
#pragma unroll
        for (int b = 0; b < 2; ++b)
#pragma unroll
            for (int m = 0; m < 4; ++m)
#pragma unroll
                for (int n = 0; n < 2; ++n) acc[a][b][m][n] = (f32x4){0.f, 0.f, 0.f, 0.f};
    bf16x8 At[4][2], B0[2][2], B1[2][2];
#define PG8_UA(u_) ((u_).seg ? (const char*)g1.A + (size_t)(u_).pm * tstepA1 : (const char*)g0.A + (size_t)(u_).pm * tstepA0)
#define PG8_UB(u_) ((u_).seg ? (const char*)g1.Bt + (size_t)(u_).pn * tstepB1 : (const char*)g0.Bt + (size_t)(u_).pn * tstepB0)
    const char* cA = PG8_UA(cur); const char* cB = PG8_UB(cur);
    size_t hAc = cur.seg ? hstepA1 : hstepA0, hBc = cur.seg ? hstepB1 : hstepB0; unsigned vAc[2], vBc[2];
#pragma unroll
    for (int i = 0; i < 2; ++i) { vAc[i] = cur.seg ? voffA1[i] : voffA0[i]; vBc[i] = cur.seg ? voffB1[i] : voffB0[i]; }
    int nt = (cur.seg ? g1.K : g0.K) / BK;
    S.a_ready(cur);
    if constexpr (SP2) {
        PG8_STAGE(PG8_SB(0, 0), cB, vBc); PG8_STAGE(PG8_SB(0, 1), cB + hBc, vBc); PG8_STAGE(PG8_SA(0, 0), cA, vAc); PG8_STAGE(PG8_SA(0, 1), cA + hAc, vAc);
        if (wr == 1) PG8_BAR;
        PG8_WAIT_V(2); PG8_BAR;
        PG8_STAGE(PG8_SB(1, 0), cB + kstep, vBc); PG8_STAGE(PG8_SA(1, 0), cA + kstep, vAc); PG8_STAGE(PG8_SB(1, 1), cB + hBc + kstep, vBc);
        PG8_WAIT_V(6); PG8_BAR;
    } else {
        PG8_STAGE(PG8_SB(0, 0), cB, vBc); PG8_STAGE(PG8_SA(0, 0), cA, vAc); PG8_STAGE(PG8_SB(0, 1), cB + hBc, vBc); PG8_STAGE(PG8_SA(0, 1), cA + hAc, vAc);
        if (wr == 1) PG8_BAR;
        PG8_WAIT_V(4); PG8_BAR;
        PG8_STAGE(PG8_SB(1, 0), cB + kstep, vBc); PG8_STAGE(PG8_SA(1, 0), cA + kstep, vAc); PG8_STAGE(PG8_SB(1, 1), cB + hBc + kstep, vBc);
        PG8_WAIT_V(6); PG8_BAR;
    }
    for (;;) {
        const bool has_next = S.next(ui + 1, nxt);
        const char* nA = has_next ? PG8_UA(nxt) : cA; const char* nB = has_next ? PG8_UB(nxt) : cB;
        const int sn = has_next ? nxt.seg : cur.seg; const size_t hAn = sn ? hstepA1 : hstepA0, hBn = sn ? hstepB1 : hstepB0; unsigned vAn[2], vBn[2];
#pragma unroll
        for (int i = 0; i < 2; ++i) { vAn[i] = sn ? voffA1[i] : voffA0[i]; vBn[i] = sn ? voffB1[i] : voffB0[i]; }
        for (int t = 0; t < nt; t += 2) {
            const bool last = (t == nt - 2);
            const size_t hA2 = last ? hAn : hAc, hB2 = last ? hBn : hBc; unsigned vA2[2], vB2[2];
#pragma unroll
            for (int i = 0; i < 2; ++i) { vA2[i] = last ? vAn[i] : vAc[i]; vB2[i] = last ? vBn[i] : vBc[i]; }
            const char* a1 = cA + (size_t)(t + 1) * kstep;
            const char* a2 = last ? nA : cA + (size_t)(t + 2) * kstep; const char* b2 = last ? nB : cB + (size_t)(t + 2) * kstep;
            const char* a3 = a2 + kstep; const char* b3 = b2 + kstep;
            if (last && has_next) S.a_ready(nxt);
            if constexpr (SP2) {
            PG8_LDB(B0, 0, 0); PG8_LDB(B1, 0, 1); PG8_SCHED; PG8_LDA(At, 0, 0); PG8_STAGE(PG8_SA(1, 1), a1 + hAc, vAc);
            PG8_WAIT_V(8); PG8_WAIT_L(0); PG8_BAR; PG8_MMA(0, 0, At, B0); PG8_MMA(0, 1, At, B1); PG8_BAR; PG8_SCHED;
            PG8_LDA(At, 0, 1); PG8_STAGE(PG8_SB(0, 0), b2, vB2); PG8_STAGE(PG8_SB(0, 1), b2 + hB2, vB2); PG8_STAGE(PG8_SA(0, 0), a2, vA2);
            PG8_WAIT_V(8); PG8_WAIT_L(0); PG8_BAR; PG8_MMA(1, 0, At, B0); PG8_MMA(1, 1, At, B1); PG8_BAR; PG8_SCHED;
            PG8_LDB(B0, 1, 0); PG8_LDB(B1, 1, 1); PG8_SCHED; PG8_LDA(At, 1, 0); PG8_STAGE(PG8_SA(0, 1), a2 + hA2, vA2);
            PG8_WAIT_V(8); PG8_WAIT_L(0); PG8_BAR; PG8_MMA(0, 0, At, B0); PG8_MMA(0, 1, At, B1); PG8_BAR; PG8_SCHED;
            PG8_LDA(At, 1, 1); PG8_STAGE(PG8_SB(1, 0), b3, vB2); PG8_STAGE(PG8_SB(1, 1), b3 + hB2, vB2); PG8_STAGE(PG8_SA(1, 0), a3, vA2);
            PG8_WAIT_V(8); PG8_WAIT_L(0); PG8_BAR; PG8_MMA(1, 0, At, B0); PG8_MMA(1, 1, At, B1); PG8_BAR; PG8_SCHED;
            } else {
            PG8_LDB(B0, 0, 0); PG8_SCHED; PG8_LDA(At, 0, 0); PG8_STAGE(PG8_SA(1, 1), a1 + hAc, vAc);
            PG8_WAIT_L(8); PG8_BAR; PG8_WAIT_L(0); PG8_MMA(0, 0, At, B0); PG8_BAR; PG8_SCHED;
            PG8_LDB(B1, 0, 1); PG8_STAGE(PG8_SB(0, 0), b2, vB2);
            PG8_BAR; PG8_WAIT_L(0); PG8_MMA(0, 1, At, B1); PG8_BAR;
            PG8_LDA(At, 0, 1); PG8_STAGE(PG8_SA(0, 0), a2, vA2);
            PG8_BAR; PG8_WAIT_L(0); PG8_MMA(1, 0, At, B0); PG8_BAR; PG8_SCHED;
            PG8_STAGE(PG8_SB(0, 1), b2 + hB2, vB2);
            PG8_WAIT_V(6); PG8_BAR; PG8_MMA(1, 1, At, B1); PG8_BAR;
            PG8_LDB(B0, 1, 0); PG8_SCHED; PG8_LDA(At, 1, 0); PG8_STAGE(PG8_SA(0, 1), a2 + hA2, vA2);
            PG8_WAIT_L(8); PG8_BAR; PG8_WAIT_L(0); PG8_MMA(0, 0, At, B0); PG8_BAR; PG8_SCHED;
            PG8_LDB(B1, 1, 1); PG8_STAGE(PG8_SB(1, 0), b3, vB2);
            PG8_BAR; PG8_WAIT_L(0); PG8_MMA(0, 1, At, B1); PG8_BAR;
            PG8_LDA(At, 1, 1); PG8_STAGE(PG8_SA(1, 0), a3, vA2);
            PG8_BAR; PG8_WAIT_L(0); PG8_MMA(1, 0, At, B0); PG8_BAR; PG8_SCHED;
            PG8_STAGE(PG8_SB(1, 1), b3 + hB2, vB2);
            PG8_WAIT_V(6); PG8_BAR; PG8_MMA(1, 1, At, B1); PG8_BAR;
            }
        }
        if constexpr (ALIGN_EPI) { if (wr == 0) PG8_BAR; }
        if (cur.seg == 0) E.mid(acc, cur, wr, wc, fr, fq); else { E(acc, cur, wr, wc, fr, fq); S.done(cur); }
        if (!has_next) break;
        if (cur.seg == 1) {
#pragma unroll
        for (int a = 0; a < 2; ++a)
#pragma unroll
            for (int b = 0; b < 2; ++b)
#pragma unroll
                for (int m = 0; m < 4; ++m)
#pragma unroll
                    for (int n = 0; n < 2; ++n) acc[a][b][m][n] = (f32x4){0.f, 0.f, 0.f, 0.f};
        }
        cur = nxt; cA = nA; cB = nB; ++ui; hAc = hAn; hBc = hBn; vAc[0] = vAn[0]; vAc[1] = vAn[1]; vBc[0] = vBn[0]; vBc[1] = vBn[1]; nt = (cur.seg ? g1.K : g0.K) / BK;
        if constexpr (ALIGN_EPI) { if (wr == 1) PG8_BAR; }
    }
    PG8_WAIT_V(0);
    if constexpr (!ALIGN_EPI) { if (wr == 0) PG8_BAR; }
    PG8_BAR;
#undef PG8_UA
#undef PG8_UB
#undef PG8_SA
#undef PG8_SB
#undef PG8_STAGE
#undef PG8_LDA
#undef PG8_LDB
#undef PG8_MMA
#undef PG8_WAIT_V
#undef PG8_WAIT_L
#undef PG8_BAR
#undef PG8_SCHED
}
}

#define XB_TMO      128
#define XB_XCNT(j)  (256  + 64 * (j))
#define XB_XSUB(j)  (1280 + 64 * (j))
#define XB_XGEN(j)  (2304 + 64 * (j))
#define XB_TOP      3328
#define XB_TOPGEN   3392
#define XCD_BAR_WORDS 3456
#define XB_SPIN_CAP (1u << 18)

__device__ __forceinline__ unsigned xb_ld(unsigned* p)              { return __hip_atomic_load(p, __ATOMIC_RELAXED, __HIP_MEMORY_SCOPE_AGENT); }
__device__ __forceinline__ unsigned xb_add(unsigned* p, unsigned v) { return __hip_atomic_fetch_add(p, v, __ATOMIC_RELAXED, __HIP_MEMORY_SCOPE_AGENT); }
__device__ __forceinline__ unsigned xb_xcc_id() { return (unsigned)__builtin_amdgcn_s_getreg((3 << 11) | 20) & 0xFu; }
#define XB_SPIN(cond, bar) do { unsigned _sp = 0; while (cond) { __builtin_amdgcn_s_sleep(1); \
    if ((++_sp & 255u) == 0u) { if (xb_ld(&(bar)[XB_TMO])) break; if (_sp > XB_SPIN_CAP) { atomicAdd(&(bar)[XB_TMO], 1u); break; } } } } while (0)

struct XcdBarrier {
    unsigned* bar; unsigned x;
    volatile LAS unsigned* st;
};

__device__ __forceinline__ XcdBarrier xcd_barrier_post(unsigned* bar, volatile LAS unsigned* st) {
    XcdBarrier b; b.bar = bar; b.x = xb_xcc_id(); b.st = st;
    if (threadIdx.x == 0) (void)xb_add(&bar[XB_XCNT(b.x)], 1u);
    return b;
}
__device__ __forceinline__ void xcd_barrier_complete(unsigned* bar, unsigned x, unsigned& nloc, unsigned& nx) {
    const unsigned G = gridDim.x * gridDim.y * gridDim.z;
    unsigned sum, cnt, mine, sp = 0u;
    for (;;) {
        sum = 0u; cnt = 0u; mine = 0u;
#pragma unroll
        for (unsigned j = 0; j < 16; ++j) { const unsigned c = xb_ld(&bar[XB_XCNT(j)]); sum += c; cnt += (c > 0u) ? 1u : 0u; mine = (j == x) ? c : mine; }
        if (sum == G) break;
        __builtin_amdgcn_s_sleep(1);
        if ((++sp & 255u) == 0u) { if (xb_ld(&bar[XB_TMO])) break; if (sp > XB_SPIN_CAP) { atomicAdd(&bar[XB_TMO], 1u); break; } }
    }
    nloc = mine > 0u ? mine : 1u; nx = cnt > 0u ? cnt : 1u;
}

__device__ __forceinline__ void xcd_barrier(const XcdBarrier& b) {
    asm volatile("s_waitcnt vmcnt(0)" ::: "memory");
    __syncthreads();
    if (threadIdx.x == 0) {
        unsigned* bar = b.bar;
        __builtin_amdgcn_s_waitcnt(0);
        unsigned nloc = b.st[0], nx = b.st[1];
        if (nloc == 0u) { xcd_barrier_complete(bar, b.x, nloc, nx); b.st[0] = nloc; b.st[1] = nx; }
        const unsigned old = xb_add(&bar[XB_XSUB(b.x)], 1u);
        const unsigned gen = old / nloc;
        if (old + 1u == (gen + 1u) * nloc) {
            __builtin_amdgcn_fence(__ATOMIC_RELEASE, "agent");
            asm volatile("s_waitcnt vmcnt(0)" ::: "memory");
            const unsigned og = xb_add(&bar[XB_TOP], 1u);
            const unsigned tg = og / nx;
            if (og + 1u == (tg + 1u) * nx) xb_add(&bar[XB_TOPGEN], 1u);
            else XB_SPIN(xb_ld(&bar[XB_TOPGEN]) == tg, bar);
            __builtin_amdgcn_fence(__ATOMIC_ACQUIRE, "agent");
            xb_add(&bar[XB_XGEN(b.x)], 1u);
            asm volatile("s_waitcnt vmcnt(0)" ::: "memory");
        } else {
            XB_SPIN(xb_ld(&bar[XB_XGEN(b.x)]) == gen, bar);
            __builtin_amdgcn_fence(__ATOMIC_ACQUIRE, "agent");
            asm volatile("s_waitcnt vmcnt(0)" ::: "memory");
        }
    }
    __syncthreads();
}

constexpr size_t MiB = 1u << 20;
constexpr size_t WS_CTL = 0, CTL_ZERO_BYTES = 192 * 1024;
constexpr size_t WS_SUMSQ = 128 * 1024;
constexpr int CW_BAR = 1024;
constexpr size_t WS_WIN = 1 * MiB;
constexpr size_t WS_WA = 14 * MiB;
constexpr size_t WS_WB = 16 * MiB;
constexpr size_t WS_WO = 17 * MiB;
constexpr size_t WS_WQ = 19 * MiB;
constexpr size_t WS_SKB = 23 * MiB;
constexpr size_t WS_ROPE = 24 * MiB;
constexpr size_t WS_BIAS = 25 * MiB;
constexpr size_t WS_KM = 25 * MiB + 256 * 1024;
constexpr size_t WS_PREV = 26 * MiB;
constexpr size_t WS_ACT = 42 * MiB;
constexpr size_t WS_RQ = WS_ACT, WS_RK = WS_RQ + 16 * MiB, WS_RV = WS_RK + 16 * MiB, WS_RG = WS_RV + 32 * MiB;
constexpr size_t WS_MQ = WS_RG + 32 * MiB, WS_MK = WS_MQ + 16 * MiB, WS_MV = WS_MK + 16 * MiB;
constexpr size_t WS_GA = WS_MV + 16 * MiB, WS_GB = WS_GA + 32 * MiB;
constexpr size_t WS_END = 256 * MiB;
constexpr size_t WS_YB = WS_ACT;
constexpr size_t WS_MRG = WS_ACT + 32 * MiB;
constexpr size_t WS_H2 = WS_ACT + 64 * MiB;
constexpr size_t WS_EG = WS_ACT + 96 * MiB;
constexpr size_t WS_QP = WS_ACT;
constexpr size_t WS_UV = WS_ACT;
constexpr size_t WS_UV8 = WS_ACT + 112 * MiB;
constexpr size_t WS_ST = WS_ACT + 144 * MiB;
static_assert(WS_GB + 32 * MiB <= WS_END && WS_EG + 16 * MiB <= WS_ST && WS_ST + 64 * MiB <= WS_END, "d_ws map");

constexpr int LDS_BYTES = 159 * 1024;
constexpr int MISC_OFF = LDS_BYTES - 256;
constexpr int NWAVES = 8;


using pg8::Unit;
__device__ __forceinline__ void store8_bf16(bf16* p, f32x4 a, f32x4 b) { v4u w; w.x = pk2(a[0], a[1]); w.y = pk2(a[2], a[3]); w.z = pk2(b[0], b[1]); w.w = pk2(b[2], b[3]); *(v4u*)p = w; }
__device__ __forceinline__ void load8_bf16(const bf16* p, f32x4& a, f32x4& b) { const v4u w = *(const v4u*)p; a = (f32x4){bflo(w.x), bfhi(w.x), bflo(w.y), bfhi(w.y)}; b = (f32x4){bflo(w.z), bfhi(w.z), bflo(w.w), bfhi(w.w)}; }
__device__ __forceinline__ float sigmoidf_(float x) { return __builtin_amdgcn_rcpf(1.0f + __builtin_amdgcn_exp2f(-1.4426950408889634f * x)); }
__device__ __forceinline__ f32x4 sig4(f32x4 v) { return (f32x4){sigmoidf_(v[0]), sigmoidf_(v[1]), sigmoidf_(v[2]), sigmoidf_(v[3])}; }
__device__ __forceinline__ f32x4 silu4(f32x4 v) { return v * sig4(v); }

#ifdef MOBA_NAIVE
constexpr float MOBA_QSCALE = 0.125f;
#else
constexpr float MOBA_QSCALE = 0.125f * 1.4426950408889634f;
#endif
struct EpiInProj {
    static constexpr bool AFTER_DRAIN = false;
    bf16 *RQ, *RK, *RV, *RG, *MQ, *MK, *MV, *GA, *GB; const float* rope; const float* qgain; const float* kgain; float* KMP;
    __device__ __forceinline__ void operator()(const f32x4 (&acc)[2][2][4][2], const Unit& u, int wr, int wc, int fr, int fq) const {
        const int pn = u.pn, rowb = u.pm * 256 + wr * 64 + fr, cw = 64 * wc + 8 * fq;
        if (pn < 4) {
            bf16* dst = (pn < 2 ? RQ : RK) + (pn & 1) * 256 + cw; const float sc = pn < 2 ? 1.0f : 0.125f;
#pragma unroll
            for (int ai = 0; ai < 2; ++ai)
#pragma unroll
                for (int m = 0; m < 4; ++m) {
                    const int row = rowb + ai * 128 + m * 16; const float* rp = rope + (size_t)(row & (SEQ - 1)) * 64 + 8 * fq;
                    const f32x4 c0 = *(const f32x4*)rp * sc, c1 = *(const f32x4*)(rp + 4) * sc, s0 = *(const f32x4*)(rp + 32) * sc, s1 = *(const f32x4*)(rp + 36) * sc;
                    const f32x4 x10 = acc[ai][0][m][0], x11 = acc[ai][0][m][1], x20 = acc[ai][1][m][0], x21 = acc[ai][1][m][1];
                    bf16* p = dst + (size_t)row * 512;
                    store8_bf16(p, x10 * c0 - x20 * s0, x11 * c1 - x21 * s1);
                    store8_bf16(p + 32, x10 * s0 + x20 * c0, x11 * s1 + x21 * c1);
                }
        } else if (pn < 12 || (pn >= 16)) {
            bf16* dst; int ld, mode;
            if (pn < 8) { dst = RV + (pn - 4) * 256; ld = 1024; mode = 0; }
            else if (pn < 12) { dst = RG + (pn - 8) * 256; ld = 1024; mode = 1; }
            else if (pn < 18) { dst = MV + (pn - 16) * 256; ld = 512; mode = 0; }
            else if (pn < 22) { dst = GA + (pn - 18) * 256; ld = 1024; mode = 2; }
            else { dst = GB + (pn - 22) * 256; ld = 1024; mode = 2; }
            dst += cw;
#pragma unroll
            for (int ai = 0; ai < 2; ++ai)
#pragma unroll
                for (int m = 0; m < 4; ++m) {
                    const int row = rowb + ai * 128 + m * 16; bf16* p = dst + (size_t)row * ld;
#pragma unroll
                    for (int bj = 0; bj < 2; ++bj) {
                        f32x4 a = acc[ai][bj][m][0], b = acc[ai][bj][m][1];
                        if (mode == 1) { a = silu4(a); b = silu4(b); } else if (mode == 2) { a = sig4(a); b = sig4(b); }
                        store8_bf16(p + 32 * bj, a, b);
                    }
                }
        } else {
            const bool isq = pn < 14; bf16* dst = (isq ? MQ : MK) + (pn & 1) * 256 + cw; const float* gain = (isq ? qgain : kgain) + 8 * fq; const float sc = isq ? MOBA_QSCALE : 1.0f;
            f32x4 cs00 = {0.f, 0.f, 0.f, 0.f}, cs01 = cs00, cs10 = cs00, cs11 = cs00;
            const f32x4 g00 = *(const f32x4*)gain * sc, g01 = *(const f32x4*)(gain + 4) * sc, g10 = *(const f32x4*)(gain + 32) * sc, g11 = *(const f32x4*)(gain + 36) * sc;
#pragma unroll
            for (int ai = 0; ai < 2; ++ai)
#pragma unroll
                for (int m = 0; m < 4; ++m) {
                    const int row = rowb + ai * 128 + m * 16; bf16* p = dst + (size_t)row * 512;
                    const f32x4 a0 = acc[ai][0][m][0], a1 = acc[ai][0][m][1], b0 = acc[ai][1][m][0], b1 = acc[ai][1][m][1];
                    const f32x4 q = a0 * a0 + a1 * a1 + b0 * b0 + b1 * b1; float ss = (q[0] + q[1]) + (q[2] + q[3]);
                    ss += __shfl_xor(ss, 16); ss += __shfl_xor(ss, 32);
                    const float r = rsqrtf(ss * (1.0f / 64.0f) + EPS);
                    const f32x4 y00 = a0 * r * g00, y01 = a1 * r * g01, y10 = b0 * r * g10, y11 = b1 * r * g11;
                    store8_bf16(p, y00, y01);
                    store8_bf16(p + 32, y10, y11);
                    if (!isq) { cs00 += y00; cs01 += y01; cs10 += y10; cs11 += y11; }
                }
            if (!isq) {
#pragma unroll
                for (int e = 0; e < 4; ++e) {
#pragma unroll
                    for (int o = 1; o < 16; o <<= 1) { cs00[e] += __shfl_xor(cs00[e], o); cs01[e] += __shfl_xor(cs01[e], o); cs10[e] += __shfl_xor(cs10[e], o); cs11[e] += __shfl_xor(cs11[e], o); }
                }
                if (fr == 0) { float* kp = KMP + (((size_t)u.pm * 2 + (pn & 1)) * 2 + wr) * 256 + cw;
                    *(f32x4*)kp = cs00; *(f32x4*)(kp + 4) = cs01; *(f32x4*)(kp + 32) = cs10; *(f32x4*)(kp + 36) = cs11; }
            }
        }
    }
};
struct EpiMerge2 {
    static constexpr bool AFTER_DRAIN = false;
    bf16* O; const bf16* GA; const bf16* GB;
    __device__ __forceinline__ void mid(f32x4 (&acc)[2][2][4][2], const Unit& u, int wr, int wc, int fr, int fq) const {
        const int rowb = u.pm * 256 + wr * 64 + fr, col = u.pn * 256 + 64 * wc + 8 * fq;
#pragma unroll
        for (int ai = 0; ai < 2; ++ai)
#pragma unroll
            for (int m = 0; m < 4; ++m) {
                const size_t off = (size_t)(rowb + ai * 128 + m * 16) * 1024 + col;
#pragma unroll
                for (int bj = 0; bj < 2; ++bj) { f32x4 a0, a1, b0, b1; load8_bf16(GA + off + 32 * bj, a0, a1); load8_bf16(GB + off + 32 * bj, b0, b1);
#pragma unroll
                    for (int e = 0; e < 4; ++e) { acc[ai][bj][m][0][e] *= b0[e] * __builtin_amdgcn_rcpf(fmaxf(a0[e], 1e-6f)); acc[ai][bj][m][1][e] *= b1[e] * __builtin_amdgcn_rcpf(fmaxf(a1[e], 1e-6f)); } }
            }
    }
    __device__ __forceinline__ void operator()(const f32x4 (&acc)[2][2][4][2], const Unit& u, int wr, int wc, int fr, int fq) const {
        const int rowb = u.pm * 256 + wr * 64 + fr, col = u.pn * 256 + 64 * wc + 8 * fq;
#pragma unroll
        for (int ai = 0; ai < 2; ++ai)
#pragma unroll
            for (int m = 0; m < 4; ++m) {
                const size_t off = (size_t)(rowb + ai * 128 + m * 16) * 1024 + col;
#pragma unroll
                for (int bj = 0; bj < 2; ++bj) { f32x4 a0, a1; load8_bf16(GA + off + 32 * bj, a0, a1);
#pragma unroll
                    for (int e = 0; e < 4; ++e) { a0[e] = fmaxf(a0[e], 1e-6f); a1[e] = fmaxf(a1[e], 1e-6f); }
                    store8_bf16(O + off + 32 * bj, acc[ai][bj][m][0] * a0, acc[ai][bj][m][1] * a1); }
            }
    }
};
struct TwoSegOrder {
    pg8::StaticOrder B;
    __device__ __forceinline__ bool next(int i, pg8::Unit& u) const { if (!B.next(i >> 1, u)) return false; u.seg = i & 1; return true; }
    __device__ __forceinline__ void a_ready(const pg8::Unit&) const {}
    __device__ __forceinline__ void done(const pg8::Unit&) const {}
};
struct EpiResid {
    static constexpr bool AFTER_DRAIN = false;
    const float* base; float* out; bf16* XG; const float* g2; float* SS;
    __device__ __forceinline__ void operator()(const f32x4 (&acc)[2][2][4][2], const Unit& u, int wr, int wc, int fr, int fq) const {
        const int rowb = u.pm * 256 + wr * 64 + fr, col = u.pn * 256 + 64 * wc + 8 * fq;
        const f32x4 g00 = *(const f32x4*)(g2 + col), g01 = *(const f32x4*)(g2 + col + 4), g10 = *(const f32x4*)(g2 + col + 32), g11 = *(const f32x4*)(g2 + col + 36);
#pragma unroll
        for (int ai = 0; ai < 2; ++ai)
#pragma unroll
            for (int m = 0; m < 4; ++m) {
                const int row = rowb + ai * 128 + m * 16; const size_t off = (size_t)row * 1024 + col;
                const f32x4 x00 = *(const f32x4*)(base + off) + acc[ai][0][m][0], x01 = *(const f32x4*)(base + off + 4) + acc[ai][0][m][1];
                const f32x4 x10 = *(const f32x4*)(base + off + 32) + acc[ai][1][m][0], x11 = *(const f32x4*)(base + off + 36) + acc[ai][1][m][1];
                *(f32x4*)(out + off) = x00; *(f32x4*)(out + off + 4) = x01; *(f32x4*)(out + off + 32) = x10; *(f32x4*)(out + off + 36) = x11;
                store8_bf16(XG + off, x00 * g00, x01 * g01); store8_bf16(XG + off + 32, x10 * g10, x11 * g11);
                const f32x4 q = x00 * x00 + x01 * x01 + x10 * x10 + x11 * x11; float ss = (q[0] + q[1]) + (q[2] + q[3]);
                ss += __shfl_xor(ss, 16); ss += __shfl_xor(ss, 32);
                if (fq == 0) atomicAdd(SS + row, ss);
            }
    }
};
struct EpiPlainBf16 {
    static constexpr bool AFTER_DRAIN = false;
    bf16* O; int ldc;
    __device__ __forceinline__ void operator()(const f32x4 (&acc)[2][2][4][2], const Unit& u, int wr, int wc, int fr, int fq) const {
        const int rowb = u.pm * 256 + wr * 64 + fr, col = u.pn * 256 + 64 * wc + 8 * fq;
#pragma unroll
        for (int ai = 0; ai < 2; ++ai)
#pragma unroll
            for (int m = 0; m < 4; ++m) {
                const size_t off = (size_t)(rowb + ai * 128 + m * 16) * ldc + col;
#pragma unroll
                for (int bj = 0; bj < 2; ++bj) store8_bf16(O + off + 32 * bj, acc[ai][bj][m][0], acc[ai][bj][m][1]);
            }
    }
};
struct EpiNatBf16 {
    static constexpr bool AFTER_DRAIN = false;
    bf16* O; int ldc; const float* SS;
    __device__ __forceinline__ void operator()(const f32x4 (&acc)[2][2][4][2], const Unit& u, int wr, int wc, int fr, int fq) const {
        const int rowb = u.pm * 256 + wr * 64 + fr, col = u.pn * 256 + 32 * wc + 4 * fq;
        f32x4 rs[2][2];
#pragma unroll
        for (int bj = 0; bj < 2; ++bj)
#pragma unroll
            for (int n = 0; n < 2; ++n) { const f32x4 s = *(const f32x4*)(SS + col + 128 * bj + 16 * n); rs[bj][n] = (f32x4){rsqrtf(s[0] * (1.0f / DM) + EPS), rsqrtf(s[1] * (1.0f / DM) + EPS), rsqrtf(s[2] * (1.0f / DM) + EPS), rsqrtf(s[3] * (1.0f / DM) + EPS)}; }
#pragma unroll
        for (int ai = 0; ai < 2; ++ai)
#pragma unroll
            for (int m = 0; m < 4; ++m) {
                const size_t off = (size_t)(rowb + ai * 128 + m * 16) * ldc + col;
#pragma unroll
                for (int bj = 0; bj < 2; ++bj)
#pragma unroll
                    for (int n = 0; n < 2; ++n) { const f32x4 v = acc[ai][bj][m][n] * rs[bj][n]; v2u w; w.x = pk2(v[0], v[1]); w.y = pk2(v[2], v[3]); *(v2u*)(O + off + 128 * bj + 16 * n) = w; }
            }
    }
};

struct Frame {
    LAS unsigned char* lds;
    volatile LAS unsigned* MISC;
    gu32* ctl;
    int tid, lane, wave, G, bid;
};

__device__ __forceinline__ void p0_transpose_item(const float* W, int K, int N, bf16* WT, LAS float* scr, int item, int lane) {
    const int nblk = N / 32, kb = item / nblk, nb = item % nblk, k0 = 64 * kb, n0 = 32 * nb;
#pragma unroll 8
    for (int i = 0; i < 32; ++i) { const int kk = 2 * i + (lane >> 5); scr[kk * 33 + (lane & 31)] = W[(size_t)(k0 + kk) * N + n0 + (lane & 31)]; }
    LDS_WAIT(); asm volatile("" ::: "memory");
    const int c = lane & 7;
#pragma unroll
    for (int j = 0; j < 4; ++j) { const int n = (lane >> 3) + 8 * j; const LAS float* s = scr + (8 * c) * 33 + n;
        v4u o; o.x = pk2(s[0 * 33], s[1 * 33]); o.y = pk2(s[2 * 33], s[3 * 33]); o.z = pk2(s[4 * 33], s[5 * 33]); o.w = pk2(s[6 * 33], s[7 * 33]);
        *(GAS v4u*)(WT + (size_t)perm_row_of_col(n0 + n) * K + k0 + 8 * c) = o; }
    LDS_WAIT(); asm volatile("" ::: "memory");
}
__device__ __forceinline__ void rms_row_to_bf16(const float* xrow, const float* g, bf16* orow, int lane) {
    const GAS f32x4* xr = (const GAS f32x4*)xrow + lane; const GAS f32x4* gr = (const GAS f32x4*)g + lane;
    f32x4 v[4]; float s = 0.f;
#pragma unroll
    for (int j = 0; j < 4; ++j) { v[j] = __builtin_nontemporal_load(&xr[64 * j]); s += (v[j].x * v[j].x + v[j].y * v[j].y) + (v[j].z * v[j].z + v[j].w * v[j].w); }
    const float r = rsqrtf(wave_sum(s) * (1.0f / DM) + EPS);
    GAS v2u* o8 = (GAS v2u*)orow + lane;
#pragma unroll
    for (int j = 0; j < 4; ++j) { const f32x4 gg = gr[64 * j]; v2u w; w.x = pk2(v[j].x * r * gg.x, v[j].y * r * gg.y); w.y = pk2(v[j].z * r * gg.z, v[j].w * r * gg.w); o8[64 * j] = w; }
}
__device__ __forceinline__ float t5_bias_of_dist(const float* rel_bias, int h, int dist) {
    int bkt;
    if (dist < 16) bkt = dist;
    else { const float nf = (float)dist; int lg = 16 + (int)(logf(nf / 16.0f) / 4.852030263919617f * 16.0f); bkt = lg < 31 ? lg : 31; }
    return rel_bias[bkt * MH + h];
}

struct Ptrs {
    const float *x, *mix_g, *w_in, *ret_w, *q_gain, *k_gain, *moba_w, *rel_bias, *w_out, *ffn_g, *peer_wq, *sub_keys, *peer_u, *peer_v;
    float* out; unsigned char* ws;
};

__device__ __forceinline__ void p0_prologue(Frame& F, const Ptrs& P) {
    LAS float* scr = (LAS float*)(F.lds + F.wave * 16384);
    const int gw = F.bid * NWAVES + F.wave, NGW = F.G * NWAVES;
    unsigned char* ws = P.ws;
    constexpr int I_IN = (DM / 64) * (INW / 32), I_A = (1024 / 64) * (1024 / 32), I_B = (512 / 64) * (1024 / 32), I_O = I_A, I_Q = (1024 / 64) * (2048 / 32);
    constexpr int NITEMS = I_IN + I_A + I_B + I_O; (void)I_Q;
    (void)NITEMS;
    for (int it = gw; it < I_IN; it += NGW) p0_transpose_item(P.w_in, DM, INW, (bf16*)(ws + WS_WIN), scr, it, F.lane);
    bf16* XN = (bf16*)P.out;
    for (int m = gw; m < T; m += NGW) rms_row_to_bf16(P.x + (size_t)m * DM, P.mix_g, XN + (size_t)m * DM, F.lane);
    const int gt = F.bid * 512 + F.tid, NGT = F.G * 512;
    float* rope = (float*)(ws + WS_ROPE);
    for (int i = gt; i < SEQ * 32; i += NGT) { const int pos = i >> 5, j = i & 31; const float inv = powf(10000.0f, -(float)j / 32.0f); const float ang = (float)pos * inv; float sn, cs; sincosf(ang, &sn, &cs);
        rope[pos * 64 + j] = cs; rope[pos * 64 + 32 + j] = sn; }
    float* BT = (float*)(ws + WS_BIAS);
    for (int i = gt; i < MH * SEQ; i += NGT) { const int h = i >> 12, dist = i & (SEQ - 1); BT[i] = t5_bias_of_dist(P.rel_bias, h, dist); }
}


__device__ __forceinline__ void p0b_late_weights(Frame& F, const Ptrs& P, int idx, int n) {
    LAS float* scr = (LAS float*)(F.lds + F.wave * 16384);
    const int gw = idx * NWAVES + F.wave, NGW = n * NWAVES;
    unsigned char* ws = P.ws;
    constexpr int I_A = (1024 / 64) * (1024 / 32), I_B = (512 / 64) * (1024 / 32), I_O = I_A;
    for (int it = gw; it < I_A + I_B + I_O; it += NGW) {
        int r = it;
        if (r < I_A) { p0_transpose_item(P.ret_w, 1024, 1024, (bf16*)(ws + WS_WA), scr, r, F.lane); continue; } r -= I_A;
        if (r < I_B) { p0_transpose_item(P.moba_w, 512, 1024, (bf16*)(ws + WS_WB), scr, r, F.lane); continue; } r -= I_B;
        p0_transpose_item(P.w_out, 1024, 1024, (bf16*)(ws + WS_WO), scr, r, F.lane);
    }
    { bf16* WST = (bf16*)(ws + WS_WQ);
      for (int wt = gw; wt < 16 * 4 * 32; wt += NGW) {
          const int blk = wt >> 7, nt = (wt >> 5) & 3, mt = wt & 31, r32 = F.lane & 31, hi = F.lane >> 5;
          const float* ap = P.sub_keys + ((size_t)blk * PNK + 32 * nt + r32) * 128 + 8 * hi;
          const float* bp = P.peer_wq + (size_t)(32 * mt + r32) * 2048 + blk * 128 + 8 * hi;
          f32x16 acc;
#pragma unroll
          for (int r = 0; r < 16; ++r) acc[r] = 0.f;
#pragma unroll
          for (int ds = 0; ds < 8; ++ds) {
              const f32x4 a0 = *(const f32x4*)(ap + 16 * ds), a1 = *(const f32x4*)(ap + 16 * ds + 4), b0 = *(const f32x4*)(bp + 16 * ds), b1 = *(const f32x4*)(bp + 16 * ds + 4);
              v4u aw, bw; aw.x = pk2(a0[0], a0[1]); aw.y = pk2(a0[2], a0[3]); aw.z = pk2(a1[0], a1[1]); aw.w = pk2(a1[2], a1[3]);
              bw.x = pk2(b0[0], b0[1]); bw.y = pk2(b0[2], b0[3]); bw.z = pk2(b1[0], b1[1]); bw.w = pk2(b1[2], b1[3]);
              acc = __builtin_amdgcn_mfma_f32_32x32x16_bf16(__builtin_bit_cast(bf16x8, aw), __builtin_bit_cast(bf16x8, bw), acc, 0, 0, 0);
          }
          bf16* op = WST + ((size_t)blk * 128 + 32 * nt) * DM + 32 * mt + r32;
#pragma unroll
          for (int r = 0; r < 16; ++r) op[(size_t)((r & 3) + 8 * (r >> 2) + 4 * hi) * DM] = (bf16)f2bf(acc[r]);
      } }
}
__device__ __forceinline__ void p2a_kv(Frame& F, const Ptrs& P) {
    unsigned char* ws = P.ws; const bf16* RK = (const bf16*)(ws + WS_RK); const bf16* RV = (const bf16*)(ws + WS_RV); const bf16* MK = (const bf16*)(ws + WS_MK);
    float* KVT = (float*)((unsigned char*)P.out + 32 * MiB); float* KM = (float*)(ws + WS_KM);
    LAS bf16* lK = (LAS bf16*)F.lds;
    LAS bf16* lV = (LAS bf16*)(F.lds + 16384);
    const int tid = F.tid;
    for (int task = F.bid; task < BATCH * RH * NCH; task += F.G) {
        const int b = task >> 8, h = (task >> 5) & 7, n = task & 31; const size_t row0 = (size_t)b * SEQ + n * RC; const float l2g = ret_l2g(h);
#pragma unroll
        for (int j = 0; j < 2; ++j) { const int idx = tid + 512 * j, c = idx >> 3, part = idx & 7; *(LAS v4u*)(lK + c * 64 + part * 8) = *(const v4u*)(RK + (row0 + c) * 512 + h * 64 + part * 8); }
#pragma unroll
        for (int j = 0; j < 4; ++j) { const int idx = tid + 512 * j, c = idx >> 4, part = idx & 15; *(LAS v4u*)(lV + c * 128 + part * 8) = *(const v4u*)(RV + (row0 + c) * 1024 + h * 128 + part * 8); }
        __syncthreads();
        const int dk = tid & 63, dv0 = (tid >> 6) * 16;
        float acc[16];
#pragma unroll
        for (int e = 0; e < 16; ++e) acc[e] = 0.f;
        for (int c = 0; c < RC; ++c) {
            const float kd = bf2f(lK[c * 64 + dk]) * exp2f((float)(RC - 1 - c) * l2g);
            const v4u v0 = *(LAS v4u*)(lV + c * 128 + dv0), v1 = *(LAS v4u*)(lV + c * 128 + dv0 + 8);
            acc[0] += kd * bflo(v0.x); acc[1] += kd * bfhi(v0.x); acc[2] += kd * bflo(v0.y); acc[3] += kd * bfhi(v0.y);
            acc[4] += kd * bflo(v0.z); acc[5] += kd * bfhi(v0.z); acc[6] += kd * bflo(v0.w); acc[7] += kd * bfhi(v0.w);
            acc[8] += kd * bflo(v1.x); acc[9] += kd * bfhi(v1.x); acc[10] += kd * bflo(v1.y); acc[11] += kd * bfhi(v1.y);
            acc[12] += kd * bflo(v1.z); acc[13] += kd * bfhi(v1.z); acc[14] += kd * bflo(v1.w); acc[15] += kd * bfhi(v1.w);
        }
        float* o = KVT + (size_t)task * (RDV * RDK);
#pragma unroll
        for (int e = 0; e < 16; ++e) o[(dv0 + e) * 64 + dk] = acc[e];
        __syncthreads();
    }
    const int gw = F.bid * NWAVES + F.wave, NGW = F.G * NWAVES;
    for (int wt = gw; wt < BATCH * MH * NBLK; wt += NGW) {
        const int b = wt >> 7, h = (wt >> 4) & 7, blk = wt & 15; const bf16* p = MK + ((size_t)b * SEQ + blk * MBLK) * 512 + h * 64 + F.lane;
        float s = 0.f;
        for (int j = 0; j < MBLK; ++j) s += bf2f(p[(size_t)j * 512]);
        KM[wt * 64 + F.lane] = s * (1.0f / MBLK);
    }
}
__device__ __forceinline__ void p2b_scan(Frame& F, const Ptrs& P) {
    const float* KVT = (const float*)((unsigned char*)P.out + 32 * MiB); bf16* PREV = (bf16*)(P.ws + WS_PREV);
    const int gt = F.bid * 512 + F.tid, NGT = F.G * 512;
    for (int e = gt; e < BATCH * RH * RDV * RDK; e += NGT) {
        const int bh = e >> 13, el = e & 8191, h = bh & 7; const float dC = exp2f((float)RC * ret_l2g(h));
        float S = 0.f; const size_t base = (size_t)bh * NCH * 8192 + el;
        for (int n = 0; n < NCH; ++n) { PREV[base + (size_t)n * 8192] = (bf16)f2bf(S); S = S * dC + KVT[base + (size_t)n * 8192]; }
    }
}
__device__ __forceinline__ void p3a_retention(Frame& F, const Ptrs& P) {
    unsigned char* ws = P.ws; const bf16* RQ = (const bf16*)(ws + WS_RQ); const bf16* RK = (const bf16*)(ws + WS_RK); const bf16* RV = (const bf16*)(ws + WS_RV);
    const bf16* RG = (const bf16*)(ws + WS_RG); const bf16* PREV = (const bf16*)(ws + WS_PREV); bf16* RETG = (bf16*)P.out;
    LAS bf16* lQ = (LAS bf16*)F.lds;
    LAS bf16* lK = (LAS bf16*)(F.lds + 16384);
    LAS bf16* lV = (LAS bf16*)(F.lds + 16384 + 16896);
    LAS bf16* lP = (LAS bf16*)(F.lds + 16384 + 16896 + 32768);
    LAS float* lS = (LAS float*)(F.lds + 16384 + 16896 + 32768 + 16896);
    const int tid = F.tid, lane = F.lane, wave = F.wave;
    for (int task = F.bid; task < BATCH * RH * NCH; task += F.G) {
        const int b = task >> 8, h = (task >> 5) & 7, n = task & 31; const size_t row0 = (size_t)b * SEQ + n * RC; const float l2g = ret_l2g(h);
#pragma unroll
        for (int j = 0; j < 2; ++j) { const int idx = tid + 512 * j, c = idx >> 3, part = idx & 7; *(LAS v4u*)(lQ + c * 64 + part * 8) = *(const v4u*)(RQ + (row0 + c) * 512 + h * 64 + part * 8); }
#pragma unroll
        for (int j = 0; j < 8; ++j) { const int idx = tid + 512 * j, c = idx >> 5, w = idx & 31; *(LAS unsigned*)(lK + c * 66 + w * 2) = *(const unsigned*)(RK + (row0 + c) * 512 + h * 64 + w * 2); }
#pragma unroll
        for (int j = 0; j < 4; ++j) { const int idx = tid + 512 * j, c = idx >> 4, part = idx & 15; *(LAS v4u*)(lV + c * 128 + part * 8) = *(const v4u*)(RV + (row0 + c) * 1024 + h * 128 + part * 8); }
#pragma unroll
        for (int j = 0; j < 8; ++j) { const int idx = tid + 512 * j, dv = idx >> 5, w = idx & 31; *(LAS unsigned*)(lP + dv * 66 + w * 2) = *(const unsigned*)(PREV + (size_t)task * 8192 + dv * 64 + w * 2); }
        __syncthreads();
        for (int t = 0; t < 32; ++t) {
            const int e = tid + 512 * t, i = e >> 7, j = e & 127;
            float s = 0.f;
            if (j <= i) {
                float d = 0.f;
#pragma unroll
                for (int w = 0; w < 32; ++w) { const unsigned qa = *(LAS unsigned*)(lQ + i * 64 + 2 * w), ka = *(LAS unsigned*)(lK + j * 66 + 2 * w); d += bflo(qa) * bflo(ka) + bfhi(qa) * bfhi(ka); }
                s = d * exp2f((float)(i - j) * l2g);
            }
            lS[i * 128 + j] = s;
        }
        __syncthreads();
        for (int r = 0; r < 16; ++r) {
            const int i = wave * 16 + r;
            float a0 = 0.f, a1 = 0.f;
            for (int j = 0; j <= i; ++j) { const float sv = lS[i * 128 + j]; a0 += sv * bf2f(lV[j * 128 + lane]); a1 += sv * bf2f(lV[j * 128 + lane + 64]); }
            float c0 = 0.f, c1 = 0.f;
#pragma unroll 8
            for (int w = 0; w < 32; ++w) { const unsigned qa = *(LAS unsigned*)(lQ + i * 64 + 2 * w), p0 = *(LAS unsigned*)(lP + lane * 66 + 2 * w), p1 = *(LAS unsigned*)(lP + (lane + 64) * 66 + 2 * w);
                c0 += bflo(qa) * bflo(p0) + bfhi(qa) * bfhi(p0); c1 += bflo(qa) * bflo(p1) + bfhi(qa) * bfhi(p1); }
            const float qd = exp2f((float)(i + 1) * l2g);
            const float o0 = a0 + c0 * qd, o1 = a1 + c1 * qd;
            const float mu = wave_sum(o0 + o1) * (1.0f / RDV); const float d0 = o0 - mu, d1 = o1 - mu;
            const float var = wave_sum(d0 * d0 + d1 * d1) * (1.0f / RDV); const float rs = rsqrtf(var + EPS);
            const size_t off = (row0 + i) * 1024 + h * 128 + lane;
            RETG[off] = (bf16)f2bf(d0 * rs * bf2f(RG[off])); RETG[off + 64] = (bf16)f2bf(d1 * rs * bf2f(RG[off + 64]));
        }
        __syncthreads();
    }
}
__device__ __forceinline__ void p3b_moba(Frame& F, const Ptrs& P) {
    unsigned char* ws = P.ws; const bf16* MQ = (const bf16*)(ws + WS_MQ); const bf16* MK = (const bf16*)(ws + WS_MK); const bf16* MV = (const bf16*)(ws + WS_MV);
    const float* KM = (const float*)(ws + WS_KM); const float* BT = (const float*)(ws + WS_BIAS); bf16* ATT = (bf16*)((unsigned char*)P.out + 32 * MiB);
    LAS float* lB = (LAS float*)F.lds;
    LAS bf16* lK = (LAS bf16*)(F.lds + 16384);
    LAS bf16* lV = (LAS bf16*)(F.lds + 16384 + 32768);
    LAS float* lKM = (LAS float*)(F.lds + 16384 + 65536);
    const int tid = F.tid, ql = tid >> 2, sub = tid & 3;
    for (int unit = F.bid; unit < BATCH * MH * 32; unit += F.G) {
        const int qh = 31 - (unit >> 5), bh = unit & 31, b = bh >> 3, h = bh & 7;
        const int qpos = qh * 128 + ql, qb = qh >> 1;
        for (int i = tid; i < SEQ; i += 512) lB[i] = BT[h * SEQ + i];
        float qf[64];
        { const bf16* qp = MQ + ((size_t)b * SEQ + qpos) * 512 + h * 64;
#pragma unroll
          for (int w = 0; w < 8; ++w) { const v4u x = *(const v4u*)(qp + 8 * w); qf[8 * w] = bflo(x.x); qf[8 * w + 1] = bfhi(x.x); qf[8 * w + 2] = bflo(x.y); qf[8 * w + 3] = bfhi(x.y);
              qf[8 * w + 4] = bflo(x.z); qf[8 * w + 5] = bfhi(x.z); qf[8 * w + 6] = bflo(x.w); qf[8 * w + 7] = bfhi(x.w); } }
        for (int i = tid; i < qb * 64; i += 512) lKM[i] = KM[(size_t)bh * NBLK * 64 + i];
        __syncthreads();
        unsigned mask;
        if (qb <= 3) mask = (1u << qb) - 1u;
        else {
            float g1 = -3e38f, g2 = -3e38f, g3 = -3e38f; int i1 = 0, i2 = 0, i3 = 0;
            for (int kb = 0; kb < qb; ++kb) {
                const LAS float* km = lKM + kb * 64; float g = 0.f;
#pragma unroll
                for (int d = 0; d < 64; ++d) g += qf[d] * km[d];
                if (g > g1) { g3 = g2; i3 = i2; g2 = g1; i2 = i1; g1 = g; i1 = kb; }
                else if (g > g2) { g3 = g2; i3 = i2; g2 = g; i2 = kb; }
                else if (g > g3) { g3 = g; i3 = kb; }
            }
            mask = (1u << i1) | (1u << i2) | (1u << i3);
        }
        float m = -1e30f, l = 0.f, o[64];
#pragma unroll
        for (int d = 0; d < 64; ++d) o[d] = 0.f;
        for (int kb = 0; kb <= qb; ++kb) {
            __syncthreads();
            const size_t krow0 = (size_t)b * SEQ + kb * MBLK;
#pragma unroll
            for (int j = 0; j < 4; ++j) { const int idx = tid + 512 * j, r = idx >> 3, part = idx & 7;
                *(LAS v4u*)(lK + r * 64 + part * 8) = *(const v4u*)(MK + (krow0 + r) * 512 + h * 64 + part * 8);
                *(LAS v4u*)(lV + r * 64 + part * 8) = *(const v4u*)(MV + (krow0 + r) * 512 + h * 64 + part * 8); }
            __syncthreads();
            const bool act = (kb == qb) || ((mask >> kb) & 1u);
            if (act) {
                for (int jj = 0; jj < 64; ++jj) {
                    const int j = jj * 4 + sub, kpos = kb * MBLK + j;
                    if (kpos > qpos) continue;
                    float dot = 0.f;
#pragma unroll
                    for (int w = 0; w < 8; ++w) { const v4u x = *(LAS v4u*)(lK + j * 64 + 8 * w);
                        dot += qf[8 * w] * bflo(x.x) + qf[8 * w + 1] * bfhi(x.x) + qf[8 * w + 2] * bflo(x.y) + qf[8 * w + 3] * bfhi(x.y)
                             + qf[8 * w + 4] * bflo(x.z) + qf[8 * w + 5] * bfhi(x.z) + qf[8 * w + 6] * bflo(x.w) + qf[8 * w + 7] * bfhi(x.w); }
                    const float logit = dot + lB[qpos - kpos];
                    const float mn = fmaxf(m, logit), sc = __expf(m - mn), p = __expf(logit - mn);
                    l = l * sc + p; m = mn;
#pragma unroll
                    for (int w = 0; w < 8; ++w) { const v4u x = *(LAS v4u*)(lV + j * 64 + 8 * w);
                        o[8 * w] = o[8 * w] * sc + p * bflo(x.x); o[8 * w + 1] = o[8 * w + 1] * sc + p * bfhi(x.x); o[8 * w + 2] = o[8 * w + 2] * sc + p * bflo(x.y); o[8 * w + 3] = o[8 * w + 3] * sc + p * bfhi(x.y);
                        o[8 * w + 4] = o[8 * w + 4] * sc + p * bflo(x.z); o[8 * w + 5] = o[8 * w + 5] * sc + p * bfhi(x.z); o[8 * w + 6] = o[8 * w + 6] * sc + p * bflo(x.w); o[8 * w + 7] = o[8 * w + 7] * sc + p * bfhi(x.w); }
                }
            }
        }
        float mm = fmaxf(m, __shfl_xor(m, 1)); mm = fmaxf(mm, __shfl_xor(mm, 2));
        const float f = __expf(m - mm); l *= f; l += __shfl_xor(l, 1); l += __shfl_xor(l, 2);
        const float il = 1.0f / l;
#pragma unroll
        for (int d = 0; d < 64; ++d) { float v = o[d] * f; v += __shfl_xor(v, 1); v += __shfl_xor(v, 2); o[d] = v * il; }
        bf16* op = ATT + ((size_t)b * SEQ + qpos) * 512 + h * 64;
#pragma unroll
        for (int s4 = 0; s4 < 4; ++s4) if (sub == s4) {
            v4u w0, w1; w0.x = pk2(o[16 * s4], o[16 * s4 + 1]); w0.y = pk2(o[16 * s4 + 2], o[16 * s4 + 3]); w0.z = pk2(o[16 * s4 + 4], o[16 * s4 + 5]); w0.w = pk2(o[16 * s4 + 6], o[16 * s4 + 7]);
            w1.x = pk2(o[16 * s4 + 8], o[16 * s4 + 9]); w1.y = pk2(o[16 * s4 + 10], o[16 * s4 + 11]); w1.z = pk2(o[16 * s4 + 12], o[16 * s4 + 13]); w1.w = pk2(o[16 * s4 + 14], o[16 * s4 + 15]);
            *(v4u*)(op + 16 * s4) = w0; *(v4u*)(op + 16 * s4 + 8) = w1; }
        __syncthreads();
    }
}

typedef short s16x4 __attribute__((ext_vector_type(4)));
typedef short v4i16_t __attribute__((ext_vector_type(4)));
__device__ __forceinline__ s16x4 vtr_read(const LAS unsigned char* p) { return __builtin_bit_cast(s16x4, __builtin_amdgcn_ds_read_tr16_b64_v4i16((LAS v4i16_t*)p)); }
constexpr float LOG2E = 1.4426950408889634f;
constexpr float MOBA_NEG = -1.0e30f;
constexpr float MOBA_THR = 3.0f;
constexpr int MB_LB = 0, MB_LKM = 16640, MB_WSC = 20480, MB_K0 = 24576, MB_V0 = 24576 + 65536;
static_assert(MB_V0 + 65536 <= MISC_OFF, "MoBA LDS map");

template <int ABL> __device__ __forceinline__ void p3b_moba_mfma(Frame& F, const Ptrs& P) {
    unsigned char* ws = P.ws; const bf16* MQ = (const bf16*)(ws + WS_MQ); const bf16* MK = (const bf16*)(ws + WS_MK); const bf16* MV = (const bf16*)(ws + WS_MV);
    const float* KMP = (const float*)(ws + WS_KM); const float* BT = (const float*)(ws + WS_BIAS); bf16* ATT = (bf16*)((unsigned char*)P.out + (ABL ? 48 : 32) * MiB);
    LAS float* lB = (LAS float*)(F.lds + MB_LB);
    LAS float* lKM = (LAS float*)(F.lds + MB_LKM);
    LAS float* wsc = (LAS float*)(F.lds + MB_WSC) + F.wave * 64;
    const int tid = F.tid, lane = F.lane, wave = F.wave, r32 = lane & 31, hi = lane >> 5;
    for (int vcu0 = F.bid; vcu0 < 256; vcu0 += F.G) {
    const int vcu = (F.G == 256) ? (vcu0 & 7) * 32 + (vcu0 >> 3) : vcu0;
    const int bh = vcu >> 3, sidx = vcu & 7, b = bh >> 3, h = bh & 7;
    __syncthreads();
    for (int i = tid; i < SEQ + 64; i += 512) lB[i] = (i < 64) ? 0.f : BT[h * SEQ + (i - 64)] * LOG2E;
    unsigned ksrc[4], vsrc[4];
#pragma unroll
    for (int j = 0; j < 4; ++j) { const int pc = wave * 4 + j, krow = 8 * pc + (lane >> 3); ksrc[j] = (unsigned)(krow * 512 + (((lane & 7) ^ (krow & 7)) * 8));
        const int vkey = 8 * pc + ((lane & 31) >> 2); vsrc[j] = (unsigned)(vkey * 512 + 32 * (lane >> 5) + 8 * (lane & 3)); }
#define MOBA_STAGE(kgp, vgp, kdst, vdst) do { _Pragma("unroll") for (int j = 0; j < 4; ++j) { \
        __builtin_amdgcn_global_load_lds((const unsigned*)((kgp) + ksrc[j]), (LAS unsigned*)(F.lds + (kdst) + (wave * 4 + j) * 1024), 16, 0, 0); \
        __builtin_amdgcn_global_load_lds((const unsigned*)((vgp) + vsrc[j]), (LAS unsigned*)(F.lds + (vdst) + (wave * 4 + j) * 1024), 16, 0, 0); } } while (0)
    const unsigned vbase = (unsigned)((4 * hi + ((lane & 15) >> 2)) * 64 + ((lane >> 4) & 1) * 32 + (lane & 3) * 8);
    for (int ui = 0; ui < 2; ++ui) {
        const int qb = ui == 0 ? 15 - sidx : sidx;
        const int nblk = qb + 1;
        __syncthreads();
        for (int i = tid; i < qb * 64; i += 512) { const int kb = i >> 6, dd = i & 63; const float* kp = KMP + (((size_t)(b * NBLK + kb) * 2 + (h >> 2)) * 2) * 256 + (h & 3) * 64 + dd; lKM[i] = (kp[0] + kp[256]) * (1.0f / MBLK); }
        const int qw0 = qb * MBLK + wave * 32, qpos = qw0 + r32;
        bf16x8 qf[4];
        { const bf16* qp = MQ + ((size_t)b * SEQ + qpos) * 512 + h * 64 + 8 * hi;
#pragma unroll
          for (int ds = 0; ds < 4; ++ds) qf[ds] = *(const bf16x8*)(qp + 16 * ds); }
        { const bf16* kg = MK + ((size_t)b * SEQ + (size_t)qb * MBLK) * 512 + h * 64; const bf16* vg = MV + ((size_t)b * SEQ + (size_t)qb * MBLK) * 512 + h * 64;
          MOBA_STAGE(kg, vg, MB_K0, MB_V0); }
        VM_WAIT(); __syncthreads();
        unsigned mask;
        if (qb <= 3) mask = (1u << qb) - 1u;
        else {
            float g1 = -3e38f, g2 = -3e38f, g3 = -3e38f; int i1 = 0, i2 = 0, i3 = 0;
            for (int kb = 0; kb < qb; ++kb) {
                float g = 0.f;
#pragma unroll
                for (int ds = 0; ds < 4; ++ds) { const LAS float* km = lKM + kb * 64 + 16 * ds + 8 * hi; const f32x4 k0 = *(const LAS f32x4*)km, k1 = *(const LAS f32x4*)(km + 4);
                    const v4u qx = __builtin_bit_cast(v4u, qf[ds]);
                    g += bflo(qx.x) * k0[0] + bfhi(qx.x) * k0[1] + bflo(qx.y) * k0[2] + bfhi(qx.y) * k0[3] + bflo(qx.z) * k1[0] + bfhi(qx.z) * k1[1] + bflo(qx.w) * k1[2] + bfhi(qx.w) * k1[3]; }
                g += __shfl_xor(g, 32);
                if (g > g1) { g3 = g2; i3 = i2; g2 = g1; i2 = i1; g1 = g; i1 = kb; }
                else if (g > g2) { g3 = g2; i3 = i2; g2 = g; i2 = kb; }
                else if (g > g3) { g3 = g; i3 = kb; }
            }
            mask = (1u << i1) | (1u << i2) | (1u << i3);
        }
        float m = 0.f, l = 0.f; bool first = true, pending = false;
        f32x16 o0, o1; v4u ppa[4]; unsigned pvoff = MB_V0;
#pragma unroll
        for (int r = 0; r < 16; ++r) { o0[r] = 0.f; o1[r] = 0.f; }
#pragma unroll
        for (int q = 0; q < 4; ++q) ppa[q] = (v4u){0u, 0u, 0u, 0u};
#define MOBA_PV(pa_, voff_) do { const LAS unsigned char* vp_ = F.lds + (voff_) + vbase; \
        _Pragma("unroll") for (int ks = 0; ks < 4; ++ks) { const bf16x8 pav = __builtin_bit_cast(bf16x8, pa_[ks]); \
            _Pragma("unroll") for (int db = 0; db < 2; ++db) { const s16x4 lo = vtr_read(vp_ + ((2 * ks) * 2 + db) * 512), hh = vtr_read(vp_ + ((2 * ks + 1) * 2 + db) * 512); \
                const bf16x8 vf = (bf16x8){lo[0], lo[1], lo[2], lo[3], hh[0], hh[1], hh[2], hh[3]}; \
                if (db == 0) o0 = __builtin_amdgcn_mfma_f32_32x32x16_bf16(pav, vf, o0, 0, 0, 0); else o1 = __builtin_amdgcn_mfma_f32_32x32x16_bf16(pav, vf, o1, 0, 0, 0); } } } while (0)
        for (int bi = 0; bi < nblk; ++bi) {
            const int kb = bi == 0 ? qb : bi - 1;
            const unsigned kbuf = MB_K0 + (bi & 1) * 32768, vbuf = MB_V0 + (bi & 1) * 32768;
            const bool has_next = bi + 1 < nblk;
            if (has_next) { const int kn = bi;
                if (pending) { MOBA_PV(ppa, pvoff); pending = false;
#pragma unroll
                    for (int q = 0; q < 4; ++q) ppa[q] = (v4u){0u, 0u, 0u, 0u}; }
                const bf16* kg = MK + ((size_t)b * SEQ + (size_t)kn * MBLK) * 512 + h * 64; const bf16* vg = MV + ((size_t)b * SEQ + (size_t)kn * MBLK) * 512 + h * 64;
                MOBA_STAGE(kg, vg, MB_K0 + ((bi + 1) & 1) * 32768, MB_V0 + ((bi + 1) & 1) * 32768); }
            const bool own = bi == 0;
            const bool sel = own || ((mask >> kb) & 1u);
            if (!(ABL & 16) && __any(sel)) {
                float msub = sel ? m : 1.0e30f;
                f32x16 cneg;
#pragma unroll
                for (int r = 0; r < 16; ++r) cneg[r] = -msub;
                const int npair = own ? (wave >> 1) + 1 : 4;
#define MOBA_QK(jq_, dA_, dB_) do { const int keyA_ = 64 * (jq_) + r32, keyB_ = keyA_ + 32; const LAS unsigned char* kpA_ = F.lds + kbuf + keyA_ * 128; const LAS unsigned char* kpB_ = F.lds + kbuf + keyB_ * 128; \
        _Pragma("unroll") for (int ds = 0; ds < 4; ++ds) { const bf16x8 aA_ = *(const LAS bf16x8*)(kpA_ + (((2 * ds + hi) ^ (keyA_ & 7)) * 16)), aB_ = *(const LAS bf16x8*)(kpB_ + (((2 * ds + hi) ^ (keyB_ & 7)) * 16)); \
            if (!(ABL & 8)) { dA_ = __builtin_amdgcn_mfma_f32_32x32x16_bf16(aA_, qf[ds], ds == 0 ? cneg : dA_, 0, 0, 0); dB_ = __builtin_amdgcn_mfma_f32_32x32x16_bf16(aB_, qf[ds], ds == 0 ? cneg : dB_, 0, 0, 0); } else if (ds == 0) { dA_ = cneg; dB_ = cneg; } } } while (0)
                f32x16 sA, sB, nA, nB;
                MOBA_QK(0, sA, sB);
                for (int jp = 0; jp < npair; ++jp) {
                    const int k0 = kb * MBLK + 64 * jp, dmin = qw0 - k0 - 63, dmax = qw0 + 31 - k0;
                    bool uni = false; float bu = 0.f;
                    if (dmin >= 256) { const float b0 = lB[64 + dmin], b1 = lB[64 + dmax]; uni = (b0 == b1); bu = b0; }
                    if (ABL & 1) {} else if (uni) {
#pragma unroll
                        for (int r = 0; r < 16; ++r) { sA[r] += bu; sB[r] += bu; }
                    } else {
                        const LAS float* bp = lB + (64 + qpos - k0 - 4 * hi - 27 - 32);
#pragma unroll
                        for (int r = 0; r < 16; ++r) { sA[r] += bp[32 + 27 - ((r & 3) + 8 * (r >> 2))]; sB[r] += bp[27 - ((r & 3) + 8 * (r >> 2))]; }
                    }
                    if (own && 2 * jp + 1 >= wave) {
                        const int limA = 32 * wave + r32 - 64 * jp - 4 * hi, limB = limA - 32;
#pragma unroll
                        for (int r = 0; r < 16; ++r) { const int cr = (r & 3) + 8 * (r >> 2); if (cr > limA) sA[r] = MOBA_NEG; if (cr > limB) sB[r] = MOBA_NEG; }
                    }
                    float tm = fmaxf(fmaxf(fmaxf(sA[0], sA[1]), fmaxf(sA[2], sA[3])), fmaxf(fmaxf(sB[0], sB[1]), fmaxf(sB[2], sB[3])));
#pragma unroll
                    for (int r = 4; r < 16; r += 4) tm = fmaxf(tm, fmaxf(fmaxf(fmaxf(sA[r], sA[r + 1]), fmaxf(sA[r + 2], sA[r + 3])), fmaxf(fmaxf(sB[r], sB[r + 1]), fmaxf(sB[r + 2], sB[r + 3]))));
                    if (first || __any(tm > MOBA_THR)) {
                        tm = fmaxf(tm, __shfl_xor(tm, 32));
                        const float dl = first ? tm : fmaxf(tm, 0.f);
                        first = false;
                        m += dl;
#pragma unroll
                        for (int r = 0; r < 16; ++r) { sA[r] -= dl; sB[r] -= dl; }
                        const float al = __builtin_amdgcn_exp2f(-dl);
                        l *= al;
                        if (hi == 0) wsc[r32] = al;
                        LDS_WAIT(); asm volatile("" ::: "memory");
#pragma unroll
                        for (int r = 0; r < 16; ++r) { const float a = wsc[(r & 3) + 8 * (r >> 2) + 4 * hi]; o0[r] *= a; o1[r] *= a; }
                        LDS_WAIT(); asm volatile("" ::: "memory");
                        {
#pragma unroll
                            for (int q = 0; q < 4; ++q) { ppa[q].x = pk2(bflo(ppa[q].x) * al, bfhi(ppa[q].x) * al); ppa[q].y = pk2(bflo(ppa[q].y) * al, bfhi(ppa[q].y) * al);
                                ppa[q].z = pk2(bflo(ppa[q].z) * al, bfhi(ppa[q].z) * al); ppa[q].w = pk2(bflo(ppa[q].w) * al, bfhi(ppa[q].w) * al); }
                        }
                        msub = sel ? m : 1.0e30f;
#pragma unroll
                        for (int r = 0; r < 16; ++r) cneg[r] = -msub;
                    }
                    {
                        const int jn = jp + 1 < npair ? jp + 1 : jp;
                        const int keyA_ = 64 * jn + r32, keyB_ = keyA_ + 32; const LAS unsigned char* kpA_ = F.lds + kbuf + keyA_ * 128; const LAS unsigned char* kpB_ = F.lds + kbuf + keyB_ * 128;
                        const LAS unsigned char* vp_ = F.lds + pvoff + vbase;
                        float ps = 0.f;
#pragma unroll
                        for (int i = 0; i < 4; ++i) {
                            if (!(ABL & 4)) { const bf16x8 pav = __builtin_bit_cast(bf16x8, ppa[i]);
#pragma unroll
                                for (int db = 0; db < 2; ++db) { const s16x4 lo = vtr_read(vp_ + ((2 * i) * 2 + db) * 512), hh = vtr_read(vp_ + ((2 * i + 1) * 2 + db) * 512);
                                    const bf16x8 vf = (bf16x8){lo[0], lo[1], lo[2], lo[3], hh[0], hh[1], hh[2], hh[3]};
                                    if (db == 0) o0 = __builtin_amdgcn_mfma_f32_32x32x16_bf16(pav, vf, o0, 0, 0, 0); else o1 = __builtin_amdgcn_mfma_f32_32x32x16_bf16(pav, vf, o1, 0, 0, 0); } }
                            { const bf16x8 aA_ = *(const LAS bf16x8*)(kpA_ + (((2 * i + hi) ^ (keyA_ & 7)) * 16)), aB_ = *(const LAS bf16x8*)(kpB_ + (((2 * i + hi) ^ (keyB_ & 7)) * 16));
                              if (!(ABL & 8)) { nA = __builtin_amdgcn_mfma_f32_32x32x16_bf16(aA_, qf[i], i == 0 ? cneg : nA, 0, 0, 0); nB = __builtin_amdgcn_mfma_f32_32x32x16_bf16(aB_, qf[i], i == 0 ? cneg : nB, 0, 0, 0); } else if (i == 0) { nA = cneg; nB = cneg; } }
                            float pv8[8];
#pragma unroll
                            for (int q = 0; q < 8; ++q) { const float sv = i < 2 ? sA[8 * i + q] : sB[8 * (i - 2) + q]; pv8[q] = (ABL & 2) ? sv : __builtin_amdgcn_exp2f(sv); ps += pv8[q]; }
                            ppa[i].x = pk2(pv8[0], pv8[1]); ppa[i].y = pk2(pv8[2], pv8[3]); ppa[i].z = pk2(pv8[4], pv8[5]); ppa[i].w = pk2(pv8[6], pv8[7]);
                            __builtin_amdgcn_sched_barrier(0);
                        }
                        l += ps;
                    }
                    pvoff = vbuf + (8 * jp) * 1024; pending = true;
                    sA = nA; sB = nB;
                }
#undef MOBA_QK
            }
            VM_WAIT(); __syncthreads();
        }
        if (pending) { MOBA_PV(ppa, pvoff); pending = false; }
#undef MOBA_PV
        l += __shfl_xor(l, 32);
        if (hi == 0) wsc[r32] = 1.0f / l;
        LDS_WAIT(); asm volatile("" ::: "memory");
        bf16* op = ATT + ((size_t)b * SEQ + qw0) * 512 + h * 64 + r32;
#pragma unroll
        for (int r = 0; r < 16; ++r) { const int qr = (r & 3) + 8 * (r >> 2) + 4 * hi; const float a = wsc[qr];
            op[(size_t)qr * 512] = (bf16)f2bf(o0[r] * a); op[(size_t)qr * 512 + 32] = (bf16)f2bf(o1[r] * a); }
        LDS_WAIT(); asm volatile("" ::: "memory");
    }
    }
#undef MOBA_STAGE
}


constexpr int RT_K = 0, RT_P = 16384, RT_V = 32768, RT_O = 65536, RT_OP = 132;
__device__ __forceinline__ void p3a_retention_mfma(Frame& F, const Ptrs& P) {
    unsigned char* ws = P.ws; const bf16* RQ = (const bf16*)(ws + WS_RQ); const bf16* RK = (const bf16*)(ws + WS_RK); const bf16* RV = (const bf16*)(ws + WS_RV);
    const bf16* RG = (const bf16*)(ws + WS_RG); const bf16* PREV = (const bf16*)(ws + WS_PREV); bf16* RETG = (bf16*)P.out;
    LAS float* lO = (LAS float*)(F.lds + RT_O);
    const int lane = F.lane, wave = F.wave, r32 = lane & 31, hi = lane >> 5, rt = wave >> 1, dh = wave & 1;
    const unsigned vbase = (unsigned)((4 * hi + ((lane & 15) >> 2)) * 64 + ((lane >> 4) & 1) * 32 + (lane & 3) * 8);
    unsigned ksrc[2], psrc[2], vsrc[4];
#pragma unroll
    for (int j = 0; j < 2; ++j) { const int pc = wave * 2 + j, row = 8 * pc + (lane >> 3), ch = (lane & 7) ^ (row & 7); ksrc[j] = (unsigned)(row * 512 + ch * 8); psrc[j] = (unsigned)(row * 64 + ch * 8); }
#pragma unroll
    for (int j = 0; j < 4; ++j) { const int pc = wave * 4 + j, key = 8 * (pc >> 1) + ((lane & 31) >> 2), db = 2 * (pc & 1) + (lane >> 5); vsrc[j] = (unsigned)(key * 1024 + 32 * db + 8 * (lane & 3)); }
#define RT_STAGE(task_) do { const int b_ = (task_) >> 8, h_ = ((task_) >> 5) & 7, n_ = (task_) & 31; const size_t r0_ = (size_t)b_ * SEQ + n_ * RC; \
        const bf16* kg_ = RK + r0_ * 512 + h_ * 64; const bf16* pg_ = PREV + (size_t)(task_) * 8192; const bf16* vg_ = RV + r0_ * 1024 + h_ * 128; \
        _Pragma("unroll") for (int j = 0; j < 2; ++j) { __builtin_amdgcn_global_load_lds((const unsigned*)(kg_ + ksrc[j]), (LAS unsigned*)(F.lds + RT_K + (wave * 2 + j) * 1024), 16, 0, 0); \
            __builtin_amdgcn_global_load_lds((const unsigned*)(pg_ + psrc[j]), (LAS unsigned*)(F.lds + RT_P + (wave * 2 + j) * 1024), 16, 0, 0); } \
        _Pragma("unroll") for (int j = 0; j < 4; ++j) __builtin_amdgcn_global_load_lds((const unsigned*)(vg_ + vsrc[j]), (LAS unsigned*)(F.lds + RT_V + (wave * 4 + j) * 1024), 16, 0, 0); } while (0)
    int task = F.bid;
    if (task < BATCH * RH * NCH) RT_STAGE(task);
    for (; task < BATCH * RH * NCH; task += F.G) {
        const int b = task >> 8, h = (task >> 5) & 7, n = task & 31; const size_t row0 = (size_t)b * SEQ + n * RC; const float l2g = ret_l2g(h);
        bf16x8 qf[4];
        { const bf16* qp = RQ + (row0 + 32 * rt + r32) * 512 + h * 64 + 8 * hi;
#pragma unroll
          for (int ds = 0; ds < 4; ++ds) qf[ds] = *(const bf16x8*)(qp + 16 * ds); }
        VM_WAIT(); __syncthreads();
        f32x16 o0, o1;
#pragma unroll
        for (int r = 0; r < 16; ++r) { o0[r] = 0.f; o1[r] = 0.f; }
#pragma unroll
        for (int ds = 0; ds < 4; ++ds) {
#pragma unroll
            for (int db = 0; db < 2; ++db) { const int dv = 64 * dh + 32 * db + r32; const bf16x8 bfr = *(const LAS bf16x8*)(F.lds + RT_P + dv * 128 + (((2 * ds + hi) ^ (dv & 7)) * 16));
                if (db == 0) o0 = __builtin_amdgcn_mfma_f32_32x32x16_bf16(qf[ds], bfr, o0, 0, 0, 0); else o1 = __builtin_amdgcn_mfma_f32_32x32x16_bf16(qf[ds], bfr, o1, 0, 0, 0); }
        }
#pragma unroll
        for (int r = 0; r < 16; ++r) { const float qd = __builtin_amdgcn_exp2f((float)(32 * rt + (r & 3) + 8 * (r >> 2) + 4 * hi + 1) * l2g); o0[r] *= qd; o1[r] *= qd; }
        for (int kt = 0; kt <= rt; ++kt) {
            f32x16 s;
#pragma unroll
            for (int r = 0; r < 16; ++r) s[r] = 0.f;
            { const int key = 32 * kt + r32; const LAS unsigned char* kp = F.lds + RT_K + key * 128;
#pragma unroll
              for (int ds = 0; ds < 4; ++ds) { const bf16x8 a = *(const LAS bf16x8*)(kp + (((2 * ds + hi) ^ (key & 7)) * 16)); s = __builtin_amdgcn_mfma_f32_32x32x16_bf16(a, qf[ds], s, 0, 0, 0); } }
            const int dbase = 32 * (rt - kt) + r32 - 4 * hi;
#pragma unroll
            for (int r = 0; r < 16; ++r) { const int dj = dbase - ((r & 3) + 8 * (r >> 2)); s[r] = dj >= 0 ? s[r] * __builtin_amdgcn_exp2f((float)dj * l2g) : 0.f; }
            v4u pa0, pa1;
            pa0.x = pk2(s[0], s[1]); pa0.y = pk2(s[2], s[3]); pa0.z = pk2(s[4], s[5]); pa0.w = pk2(s[6], s[7]);
            pa1.x = pk2(s[8], s[9]); pa1.y = pk2(s[10], s[11]); pa1.z = pk2(s[12], s[13]); pa1.w = pk2(s[14], s[15]);
            const LAS unsigned char* vp = F.lds + RT_V + vbase + (4 * kt) * 2048 + (2 * dh) * 512;
#pragma unroll
            for (int ks = 0; ks < 2; ++ks) {
                const bf16x8 pa = __builtin_bit_cast(bf16x8, ks == 0 ? pa0 : pa1);
#pragma unroll
                for (int db = 0; db < 2; ++db) {
                    const s16x4 lo = vtr_read(vp + (2 * ks) * 2048 + db * 512), hh = vtr_read(vp + (2 * ks + 1) * 2048 + db * 512);
                    const bf16x8 vf = (bf16x8){lo[0], lo[1], lo[2], lo[3], hh[0], hh[1], hh[2], hh[3]};
                    if (db == 0) o0 = __builtin_amdgcn_mfma_f32_32x32x16_bf16(pa, vf, o0, 0, 0, 0); else o1 = __builtin_amdgcn_mfma_f32_32x32x16_bf16(pa, vf, o1, 0, 0, 0);
                }
            }
        }
#pragma unroll
        for (int r = 0; r < 16; ++r) { const int qr = 32 * rt + (r & 3) + 8 * (r >> 2) + 4 * hi; lO[qr * RT_OP + 64 * dh + r32] = o0[r]; lO[qr * RT_OP + 64 * dh + 32 + r32] = o1[r]; }
        __syncthreads();
        if (task + F.G < BATCH * RH * NCH) RT_STAGE(task + F.G);
#pragma unroll
        for (int it = 0; it < 2; ++it) {
            const int i = wave * 16 + it * 8 + (lane >> 3), cc = lane & 7;
            f32x4 v[4];
#pragma unroll
            for (int q = 0; q < 4; ++q) v[q] = *(const LAS f32x4*)(lO + i * RT_OP + 16 * cc + 4 * q);
            const f32x4 sv = (v[0] + v[1]) + (v[2] + v[3]);
            const float mu = dpp_sum8((sv[0] + sv[1]) + (sv[2] + sv[3])) * (1.0f / RDV);
            f32x4 qv = {0.f, 0.f, 0.f, 0.f};
#pragma unroll
            for (int q = 0; q < 4; ++q) { v[q] = v[q] - mu; qv += v[q] * v[q]; }
            const float rs = rsqrtf(dpp_sum8((qv[0] + qv[1]) + (qv[2] + qv[3])) * (1.0f / RDV) + EPS);
            const size_t off = (row0 + i) * 1024 + h * 128 + 16 * cc;
            f32x4 g0, g1, g2, g3; load8_bf16(RG + off, g0, g1); load8_bf16(RG + off + 8, g2, g3);
            store8_bf16(RETG + off, v[0] * rs * g0, v[1] * rs * g1); store8_bf16(RETG + off + 8, v[2] * rs * g2, v[3] * rs * g3);
        }
    }
#undef RT_STAGE
}
constexpr int KV_K = 0, KV_V = 16384;
__device__ __forceinline__ void p2a_kv_mfma(Frame& F, const Ptrs& P) {
    unsigned char* ws = P.ws; const bf16* RK = (const bf16*)(ws + WS_RK); const bf16* RV = (const bf16*)(ws + WS_RV); float* KVT = (float*)((unsigned char*)P.out + 32 * MiB);
    const int tid = F.tid, lane = F.lane, wave = F.wave, r32 = lane & 31, hi = lane >> 5, mb = wave >> 1, nb = wave & 1;
    const unsigned vbase = (unsigned)((4 * hi + ((lane & 15) >> 2)) * 64 + ((lane >> 4) & 1) * 32 + (lane & 3) * 8);
    for (int task = F.bid; task < BATCH * RH * NCH; task += F.G) {
        const int b = task >> 8, h = (task >> 5) & 7, n = task & 31; const size_t row0 = (size_t)b * SEQ + n * RC; const float l2g = ret_l2g(h);
        __syncthreads();
#pragma unroll
        for (int j = 0; j < 2; ++j) { const int idx = tid + 512 * j, r = idx >> 3, c = idx & 7; const v4u kx = *(const v4u*)(RK + (row0 + r) * 512 + h * 64 + c * 8);
            const float dec = __builtin_amdgcn_exp2f((float)(RC - 1 - r) * l2g); v4u ko;
            ko.x = pk2(bflo(kx.x) * dec, bfhi(kx.x) * dec); ko.y = pk2(bflo(kx.y) * dec, bfhi(kx.y) * dec); ko.z = pk2(bflo(kx.z) * dec, bfhi(kx.z) * dec); ko.w = pk2(bflo(kx.w) * dec, bfhi(kx.w) * dec);
            *(LAS v4u*)(F.lds + KV_K + (((r >> 3) * 2 + (c >> 2)) * 512) + (r & 7) * 64 + (c & 3) * 16) = ko; }
#pragma unroll
        for (int j = 0; j < 4; ++j) { const int idx = tid + 512 * j, r = idx >> 4, c = idx & 15;
            *(LAS v4u*)(F.lds + KV_V + (((r >> 3) * 4 + (c >> 2)) * 512) + (r & 7) * 64 + (c & 3) * 16) = *(const v4u*)(RV + (row0 + r) * 1024 + h * 128 + c * 8); }
        __syncthreads();
        f32x16 acc;
#pragma unroll
        for (int r = 0; r < 16; ++r) acc[r] = 0.f;
#pragma unroll
        for (int ks = 0; ks < 8; ++ks) {
            const LAS unsigned char* ap = F.lds + KV_V + vbase + ((2 * ks) * 4 + mb) * 512; const LAS unsigned char* bp = F.lds + KV_K + vbase + ((2 * ks) * 2 + nb) * 512;
            const s16x4 alo = vtr_read(ap), ahi = vtr_read(ap + 4 * 512), blo = vtr_read(bp), bhi = vtr_read(bp + 2 * 512);
            const bf16x8 af = (bf16x8){alo[0], alo[1], alo[2], alo[3], ahi[0], ahi[1], ahi[2], ahi[3]}, bfv = (bf16x8){blo[0], blo[1], blo[2], blo[3], bhi[0], bhi[1], bhi[2], bhi[3]};
            acc = __builtin_amdgcn_mfma_f32_32x32x16_bf16(af, bfv, acc, 0, 0, 0);
        }
        float* o = KVT + (size_t)task * (RDV * RDK) + 32 * nb + r32;
#pragma unroll
        for (int r = 0; r < 16; ++r) o[(32 * mb + (r & 3) + 8 * (r >> 2) + 4 * hi) * 64] = acc[r];
    }
}
#define CE_D(a, i, j) do { const unsigned _hi = a[i] > a[j] ? a[i] : a[j]; const unsigned _lo = a[i] > a[j] ? a[j] : a[i]; a[i] = _hi; a[j] = _lo; } while (0)
#define CE_A(a, i, j) do { const unsigned _hi = a[i] > a[j] ? a[i] : a[j]; const unsigned _lo = a[i] > a[j] ? a[j] : a[i]; a[i] = _lo; a[j] = _hi; } while (0)
#define SORT16_DESC(a) do { CE_D(a, 0, 1); CE_A(a, 2, 3); CE_D(a, 4, 5); CE_A(a, 6, 7); CE_D(a, 8, 9); CE_A(a, 10, 11); CE_D(a, 12, 13); CE_A(a, 14, 15); CE_D(a, 0, 2); CE_D(a, 1, 3); CE_A(a, 4, 6); CE_A(a, 5, 7); CE_D(a, 8, 10); CE_D(a, 9, 11); CE_A(a, 12, 14); CE_A(a, 13, 15); CE_D(a, 0, 1); CE_D(a, 2, 3); CE_A(a, 4, 5); CE_A(a, 6, 7); CE_D(a, 8, 9); CE_D(a, 10, 11); CE_A(a, 12, 13); CE_A(a, 14, 15); CE_D(a, 0, 4); CE_D(a, 1, 5); CE_D(a, 2, 6); CE_D(a, 3, 7); CE_A(a, 8, 12); CE_A(a, 9, 13); CE_A(a, 10, 14); CE_A(a, 11, 15); CE_D(a, 0, 2); CE_D(a, 1, 3); CE_D(a, 4, 6); CE_D(a, 5, 7); CE_A(a, 8, 10); CE_A(a, 9, 11); CE_A(a, 12, 14); CE_A(a, 13, 15); CE_D(a, 0, 1); CE_D(a, 2, 3); CE_D(a, 4, 5); CE_D(a, 6, 7); CE_A(a, 8, 9); CE_A(a, 10, 11); CE_A(a, 12, 13); CE_A(a, 14, 15); CE_D(a, 0, 8); CE_D(a, 1, 9); CE_D(a, 2, 10); CE_D(a, 3, 11); CE_D(a, 4, 12); CE_D(a, 5, 13); CE_D(a, 6, 14); CE_D(a, 7, 15); CE_D(a, 0, 4); CE_D(a, 1, 5); CE_D(a, 2, 6); CE_D(a, 3, 7); CE_D(a, 8, 12); CE_D(a, 9, 13); CE_D(a, 10, 14); CE_D(a, 11, 15); CE_D(a, 0, 2); CE_D(a, 1, 3); CE_D(a, 4, 6); CE_D(a, 5, 7); CE_D(a, 8, 10); CE_D(a, 9, 11); CE_D(a, 12, 14); CE_D(a, 13, 15); CE_D(a, 0, 1); CE_D(a, 2, 3); CE_D(a, 4, 5); CE_D(a, 6, 7); CE_D(a, 8, 9); CE_D(a, 10, 11); CE_D(a, 12, 13); CE_D(a, 14, 15); } while (0)
#define MERGE16_DESC(a) do { CE_D(a, 0, 8); CE_D(a, 1, 9); CE_D(a, 2, 10); CE_D(a, 3, 11); CE_D(a, 4, 12); CE_D(a, 5, 13); CE_D(a, 6, 14); CE_D(a, 7, 15); CE_D(a, 0, 4); CE_D(a, 1, 5); CE_D(a, 2, 6); CE_D(a, 3, 7); CE_D(a, 8, 12); CE_D(a, 9, 13); CE_D(a, 10, 14); CE_D(a, 11, 15); CE_D(a, 0, 2); CE_D(a, 1, 3); CE_D(a, 4, 6); CE_D(a, 5, 7); CE_D(a, 8, 10); CE_D(a, 9, 11); CE_D(a, 12, 14); CE_D(a, 13, 15); CE_D(a, 0, 1); CE_D(a, 2, 3); CE_D(a, 4, 5); CE_D(a, 6, 7); CE_D(a, 8, 9); CE_D(a, 10, 11); CE_D(a, 12, 13); CE_D(a, 14, 15); } while (0)

#ifndef CONV_IN_TOPK
#define CONV_IN_TOPK 1
#endif
constexpr size_t CONV_N16 = (size_t)NEXP * DM / 16;
__device__ __forceinline__ void conv_load(const Ptrs& P, size_t i, f32x4 (&a)[4]) {
    const float* src = (i < CONV_N16) ? P.peer_u + i * 16 : P.peer_v + (i - CONV_N16) * 16;
#pragma unroll
    for (int q = 0; q < 4; ++q) a[q] = __builtin_nontemporal_load((const f32x4*)(src + 4 * q));
}
__device__ __forceinline__ void conv_store(const Ptrs& P, size_t i, const f32x4 (&a)[4]) {
    v2u w;
#pragma unroll
    for (int q = 0; q < 2; ++q) { unsigned pk = 0u;
        const f32x4 s0 = a[2 * q] * 64.0f, s1 = a[2 * q + 1] * 64.0f;
        pk = __builtin_amdgcn_cvt_scalef32_pk_fp4_f32(pk, s0[0], s0[1], 1.0f, 0); pk = __builtin_amdgcn_cvt_scalef32_pk_fp4_f32(pk, s0[2], s0[3], 1.0f, 1);
        pk = __builtin_amdgcn_cvt_scalef32_pk_fp4_f32(pk, s1[0], s1[1], 1.0f, 2); pk = __builtin_amdgcn_cvt_scalef32_pk_fp4_f32(pk, s1[2], s1[3], 1.0f, 3);
        w[q] = pk; }
    *(v2u*)(P.ws + WS_UV8 + i * 8) = w;
}
__device__ __forceinline__ void conv_all(Frame& F, const Ptrs& P) {
    const size_t cbase = (size_t)F.bid * 512 + F.tid, CNGT = (size_t)F.G * 512;
    for (size_t ci = cbase; ci < 2 * CONV_N16; ci += CNGT) { f32x4 cv[4]; conv_load(P, ci, cv); conv_store(P, ci, cv); }
}
__device__ __forceinline__ unsigned mono32(float f) { const unsigned u = __builtin_bit_cast(unsigned, f); return u ^ ((u >> 31) ? 0xffffffffu : 0x80000000u); }
__device__ __forceinline__ float unmono32(unsigned k) { const unsigned u = k ^ ((k >> 31) ? 0x80000000u : 0xffffffffu); return __builtin_bit_cast(float, u); }
__device__ __forceinline__ float key_val(unsigned k) { const unsigned m = k >> 16; return __builtin_bit_cast(float, (m ^ ((m & 0x8000u) ? 0x8000u : 0xffffu)) << 16); }
#define INS16(a, x) do { _Pragma("unroll") for (int _j = 0; _j < 16; ++_j) { const unsigned _t = a[_j] > x ? a[_j] : x; x = a[_j] > x ? x : a[_j]; a[_j] = _t; } } while (0)
__device__ __forceinline__ void p6_topk(Frame& F, const Ptrs& P) {
    unsigned char* ws = P.ws; const bf16* ST = (const bf16*)(ws + WS_ST); int* EXP = (int*)(ws + WS_EG); float* GT = (float*)(ws + WS_EG + 8 * MiB);
    LAS unsigned* lsc = (LAS unsigned*)F.lds;
    pg8::StaticOrder S8; S8.init(T, 2048, F.G, F.bid);
    pg8::Unit uq;
    const size_t cbase = (size_t)F.bid * 512 + F.tid, CNGT = (size_t)F.G * 512; int citem = 0;
    for (int ii = F.wave >> 2; S8.next(ii, uq); ii += 2) {
        const int hd = uq.pn, tok = uq.pm * 256 + (F.wave & 3) * 64 + F.lane;
        const bf16* sp = ST + (size_t)hd * 256 * T + tok;
        unsigned a1[16], a2[16];
#pragma unroll
        for (int j = 0; j < 16; ++j) { a1[j] = 0u; a2[j] = 0u; }
#pragma unroll 1
        for (int g = 0; g < 8; ++g) {
            f32x4 cv0[4], cv1[4]; const size_t ci0 = cbase + (size_t)citem * CNGT, ci1 = ci0 + CNGT; const bool ok0 = CONV_IN_TOPK && ci0 < 2 * CONV_N16, ok1 = CONV_IN_TOPK && ci1 < 2 * CONV_N16;
            unsigned short rr1[16], rr2[16];
#pragma unroll
            for (int q = 0; q < 16; ++q) { const int n = 16 * g + q; rr1[q] = sp[(size_t)n * T]; rr2[q] = sp[(size_t)(PNK + n) * T]; }
            asm volatile("" ::: "memory");
            if (ok0) conv_load(P, ci0, cv0);
            if (ok1) conv_load(P, ci1, cv1);
            unsigned g1[16], g2[16];
#pragma unroll
            for (int q = 0; q < 16; ++q) { const int n = 16 * g + q; const unsigned short r1 = rr1[q], r2 = rr2[q];
                g1[q] = (((unsigned)r1 ^ ((r1 & 0x8000u) ? 0xffffu : 0x8000u)) << 16) | (unsigned)(127 - n);
                g2[q] = (((unsigned)r2 ^ ((r2 & 0x8000u) ? 0xffffu : 0x8000u)) << 16) | (unsigned)(127 - n); }
            SORT16_DESC(g1); SORT16_DESC(g2);
            if (g == 0) {
#pragma unroll
                for (int q = 0; q < 16; ++q) { a1[q] = g1[q]; a2[q] = g2[q]; }
            } else {
#pragma unroll
                for (int q = 0; q < 16; ++q) { a1[q] = a1[q] > g1[15 - q] ? a1[q] : g1[15 - q]; a2[q] = a2[q] > g2[15 - q] ? a2[q] : g2[15 - q]; }
                MERGE16_DESC(a1); MERGE16_DESC(a2);
            }
            if (ok0) conv_store(P, ci0, cv0);
            if (ok1) conv_store(P, ci1, cv1);
            citem += 2;
            __builtin_amdgcn_sched_barrier(0);
        }
#pragma unroll
        for (int i = 0; i < 16; ++i) { lsc[i * 512 + F.tid] = a1[i]; lsc[(16 + i) * 512 + F.tid] = a2[i]; }
        unsigned kb[16];
#pragma unroll
        for (int j = 0; j < 16; ++j) kb[j] = 0u;
#pragma unroll
        for (int i = 0; i < 16; ++i) {
            const float s1 = key_val(a1[i]);
#pragma unroll
            for (int j = 0; j < 16; ++j) if ((i + 1) * (j + 1) <= 16) {
                unsigned xk = (mono32(s1 + key_val(a2[j])) & 0xffffff00u) | (unsigned)(i * 16 + j);
                INS16(kb, xk);
                __builtin_amdgcn_sched_barrier(0);
            }
        }
        float sv[16]; unsigned ev[16]; float smax = -3e38f;
#pragma unroll
        for (int q = 0; q < 16; ++q) { const unsigned i = (kb[q] >> 4) & 15u, j = kb[q] & 15u; const unsigned k1 = lsc[i * 512 + F.tid], k2 = lsc[(16 + j) * 512 + F.tid];
            sv[q] = key_val(k1) + key_val(k2); ev[q] = (127u - (k1 & 127u)) * 128u + (127u - (k2 & 127u)); smax = fmaxf(smax, sv[q]); }
        float gs = 0.f;
#pragma unroll
        for (int q = 0; q < 16; ++q) { sv[q] = __expf(sv[q] - smax); gs += sv[q]; }
        const float ig = 1.0f / gs;
        int* ep = EXP + (size_t)tok * 128 + hd * 16; float* gp = GT + (size_t)tok * 128 + hd * 16;
#pragma unroll
        for (int q = 0; q < 4; ++q) { *(v4u*)(ep + 4 * q) = (v4u){ev[4 * q], ev[4 * q + 1], ev[4 * q + 2], ev[4 * q + 3]};
            *(f32x4*)(gp + 4 * q) = (f32x4){sv[4 * q] * ig, sv[4 * q + 1] * ig, sv[4 * q + 2] * ig, sv[4 * q + 3] * ig}; }
    }
    if (CONV_IN_TOPK) for (;; ++citem) { const size_t ci = cbase + (size_t)citem * CNGT; if (ci >= 2 * CONV_N16) break; f32x4 cv[4]; conv_load(P, ci, cv); conv_store(P, ci, cv); }
}
__device__ __forceinline__ float dot8(const v4u w, const float* h) {
    return h[0] * bflo(w.x) + h[1] * bfhi(w.x) + h[2] * bflo(w.y) + h[3] * bfhi(w.y) + h[4] * bflo(w.z) + h[5] * bfhi(w.z) + h[6] * bflo(w.w) + h[7] * bfhi(w.w);
}
__device__ __forceinline__ void axpy8(float* acc, float c, const v4u w) {
    acc[0] += c * bflo(w.x); acc[1] += c * bfhi(w.x); acc[2] += c * bflo(w.y); acc[3] += c * bfhi(w.y); acc[4] += c * bflo(w.z); acc[5] += c * bfhi(w.z); acc[6] += c * bflo(w.w); acc[7] += c * bfhi(w.w);
}
#ifndef PB
#define PB 8
#endif
__device__ __forceinline__ void p7_peer(Frame& F, const Ptrs& P, float* dst) {
    unsigned char* ws = P.ws; const bf16* H2 = (const bf16*)(ws + WS_H2); const int* EXP = (const int*)(ws + WS_EG); const float* GT = (const float*)(ws + WS_EG + 8 * MiB);
    const bf16* U = (const bf16*)(ws + WS_UV); const bf16* V = U + (size_t)NEXP * DM; float* out = P.out;
    const int gw = F.bid * NWAVES + F.wave, NGW = F.G * NWAVES, lane = F.lane;
    for (int tok = gw; tok < T; tok += NGW) {
        float hv[16], acc[16];
        { const v4u h0 = *(const v4u*)(H2 + (size_t)tok * DM + 8 * lane), h1 = *(const v4u*)(H2 + (size_t)tok * DM + 512 + 8 * lane);
          hv[0] = bflo(h0.x); hv[1] = bfhi(h0.x); hv[2] = bflo(h0.y); hv[3] = bfhi(h0.y); hv[4] = bflo(h0.z); hv[5] = bfhi(h0.z); hv[6] = bflo(h0.w); hv[7] = bfhi(h0.w);
          hv[8] = bflo(h1.x); hv[9] = bfhi(h1.x); hv[10] = bflo(h1.y); hv[11] = bfhi(h1.y); hv[12] = bflo(h1.z); hv[13] = bfhi(h1.z); hv[14] = bflo(h1.w); hv[15] = bfhi(h1.w); }
#pragma unroll
        for (int e = 0; e < 16; ++e) acc[e] = 0.f;
        int e_lo = EXP[(size_t)tok * 128 + lane], e_hi = EXP[(size_t)tok * 128 + 64 + lane];
        float g_lo = GT[(size_t)tok * 128 + lane], g_hi = GT[(size_t)tok * 128 + 64 + lane];
#ifndef PEER_NOSORT
        {
            LAS unsigned* le = (LAS unsigned*)(F.lds + F.wave * 1024); LAS float* lg = (LAS float*)(le + 128);
            const unsigned b_lo = (unsigned)e_lo >> 9, b_hi = (unsigned)e_hi >> 9; unsigned pos_lo = 0, pos_hi = 0, base = 0;
            for (unsigned bk = 0; bk < 32; ++bk) {
                const unsigned long long mlo = __ballot(b_lo == bk), mhi = __ballot(b_hi == bk);
                const unsigned clo = (unsigned)__popcll(mlo), chi = (unsigned)__popcll(mhi);
                if (b_lo == bk) pos_lo = base + __builtin_amdgcn_mbcnt_hi((unsigned)(mlo >> 32), __builtin_amdgcn_mbcnt_lo((unsigned)mlo, 0u));
                if (b_hi == bk) pos_hi = base + clo + __builtin_amdgcn_mbcnt_hi((unsigned)(mhi >> 32), __builtin_amdgcn_mbcnt_lo((unsigned)mhi, 0u));
                base += clo + chi;
            }
            le[pos_lo] = (unsigned)e_lo; lg[pos_lo] = g_lo; le[pos_hi] = (unsigned)e_hi; lg[pos_hi] = g_hi;
            LDS_WAIT(); asm volatile("" ::: "memory");
            e_lo = (int)le[lane]; e_hi = (int)le[64 + lane]; g_lo = lg[lane]; g_hi = lg[64 + lane];
            LDS_WAIT(); asm volatile("" ::: "memory");
        }
#endif
        for (int k = 0; k < 128; k += PB) {
            int ex[PB]; float gg[PB]; v4u u0[PB], u1[PB], v0[PB], v1[PB];
#pragma unroll
            for (int q = 0; q < PB; ++q) { const int kk = k + q; ex[q] = __shfl(kk < 64 ? e_lo : e_hi, kk & 63); gg[q] = __shfl(kk < 64 ? g_lo : g_hi, kk & 63); }
#pragma unroll
            for (int q = 0; q < PB; ++q) { const bf16* up = U + (size_t)ex[q] * DM + 8 * lane; const bf16* vp = V + (size_t)ex[q] * DM + 8 * lane;
                u0[q] = *(const v4u*)up; u1[q] = *(const v4u*)(up + 512); v0[q] = *(const v4u*)vp; v1[q] = *(const v4u*)(vp + 512); }
            float d[PB];
#pragma unroll
            for (int q = 0; q < PB; ++q) d[q] = dot8(u0[q], hv) + dot8(u1[q], hv + 8);
#pragma unroll
            for (int o = 1; o < 64; o <<= 1) {
#pragma unroll
                for (int q = 0; q < PB; ++q) d[q] += __shfl_xor(d[q], o);
            }
#pragma unroll
            for (int q = 0; q < PB; ++q) { const float z = d[q]; const float a = 0.5f * z * (1.0f + erff(z * 0.70710678118654752f)); const float c = gg[q] * a; axpy8(acc, c, v0[q]); axpy8(acc + 8, c, v1[q]); }
        }
        float* op = out + (size_t)tok * DM + 8 * lane;
        f32x4 x0 = *(const f32x4*)op, x1 = *(const f32x4*)(op + 4), x2 = *(const f32x4*)(op + 512), x3 = *(const f32x4*)(op + 516);
        x0 += (f32x4){acc[0], acc[1], acc[2], acc[3]}; x1 += (f32x4){acc[4], acc[5], acc[6], acc[7]}; x2 += (f32x4){acc[8], acc[9], acc[10], acc[11]}; x3 += (f32x4){acc[12], acc[13], acc[14], acc[15]};
        float* wp = dst + (size_t)tok * DM + 8 * lane;
        *(f32x4*)wp = x0; *(f32x4*)(wp + 4) = x1; *(f32x4*)(wp + 512) = x2; *(f32x4*)(wp + 516) = x3;
    }
}

typedef float f32x2v __attribute__((ext_vector_type(2)));
typedef _Float16 f16x2v __attribute__((ext_vector_type(2)));
constexpr size_t WS_PART = WS_ST;
constexpr size_t WS_CG = WS_ACT + 32 * MiB;
__device__ __forceinline__ void fp8x16_to_f32(const v4u w, float* f) {
#pragma unroll
    for (int q = 0; q < 4; ++q) { const f32x2v lo = __builtin_amdgcn_cvt_pk_f32_fp8((int)w[q], false), hi = __builtin_amdgcn_cvt_pk_f32_fp8((int)w[q], true); f[4 * q] = lo.x; f[4 * q + 1] = lo.y; f[4 * q + 2] = hi.x; f[4 * q + 3] = hi.y; }
}
__device__ __forceinline__ float fmac_s(float acc, float a, float b) { asm("v_fmac_f32_e32 %0, %1, %2" : "+v"(acc) : "v"(a), "v"(b)); return acc; }
constexpr int TROW = DM / 2;
typedef int v8i __attribute__((ext_vector_type(8)));
template <int MODE> __device__ __forceinline__ void p7u_dots(Frame& F, const Ptrs& P) {
    unsigned char* ws = P.ws; const bf16* H2 = (const bf16*)(ws + WS_H2); const int* EXP = (const int*)(ws + WS_EG); const unsigned char* U4 = ws + WS_UV8; float* PART = (float*)(ws + (MODE ? WS_ACT : WS_PART)); const float* SS = (const float*)(ws + WS_SUMSQ);
    const int lane = F.lane, r = lane >> 3, c = lane & 7, i = lane & 15, kb = lane >> 4;
    LAS unsigned char* lB = F.lds; LAS float* lS = (LAS float*)(F.lds + 32768);
    LAS unsigned char* lI = F.lds + 34816 + F.wave * 2048;
    LAS unsigned char* lT = F.lds + 51200 + F.wave * 8192;
    const int wr0 = r * 128 + ((c ^ (r >> 1)) << 4), wr1 = (8 + r) * 128 + ((c ^ (4 + (r >> 1))) << 4);
    const int rd0 = i * 128 + ((kb ^ ((i >> 1) & 7)) << 4), rd1 = i * 128 + (((4 + kb) ^ ((i >> 1) & 7)) << 4);
#define PU_LOADW(tk) (*(const v2u*)(EXP + (size_t)(tbase + ((tk) < 31 ? (tk) : 31)) * 128 + 2 * lane))
#define PU_PUTW(tk, wv) do { *(LAS v2u*)(lI + ((tk) & 3) * 512 + 8 * lane) = wv; } while (0)
#define PU_ISSUE(tk, ul) do { _Pragma("unroll") for (int d_ = 0; d_ < 16; ++d_) { const unsigned ev = *(const LAS unsigned*)(lI + ((tk) & 3) * 512 + (8 * d_ + r) * 4); ul[d_] = *(const v4u*)(U4 + ((ev << 9) + loff)); } } while (0)
#define PU_V8(lo) (v8i){(int)(lo).x, (int)(lo).y, (int)(lo).z, (int)(lo).w, 0, 0, 0, 0}
#define PU_COMPUTE(tk, ul) do { const LAS unsigned char* bp_ = lB + (32 * F.wave + (tk)) * 128 + 16 * kb; const v4u bq0 = *(const LAS v4u*)bp_, bq1 = *(const LAS v4u*)(bp_ + 64); const float osc = lS[32 * F.wave + (tk)]; \
        const v8i b0 = PU_V8(bq0), b1 = PU_V8(bq1); \
        float* pp = PART + ((size_t)sl * T + (tbase + (tk))) * 128 + 4 * kb; \
        f32x4 acc[8]; \
        _Pragma("unroll") for (int g = 0; g < 8; ++g) { LAS unsigned char* tb_ = lT + (g & 3) * 2048; \
            *(LAS v4u*)(tb_ + wr0) = ul[2 * g]; *(LAS v4u*)(tb_ + wr1) = ul[2 * g + 1]; \
            const v4u a0 = *(const LAS v4u*)(tb_ + rd0), a1 = *(const LAS v4u*)(tb_ + rd1); \
            acc[g] = __builtin_amdgcn_mfma_scale_f32_16x16x128_f8f6f4(PU_V8(a0), b0, (f32x4){0.f, 0.f, 0.f, 0.f}, 4, 4, 0, 0, 0, 0); \
            acc[g] = __builtin_amdgcn_mfma_scale_f32_16x16x128_f8f6f4(PU_V8(a1), b1, acc[g], 4, 4, 0, 0, 0, 0); \
            asm volatile("" : "+v"(acc[g])); }     \
        if (i == 0) { _Pragma("unroll") for (int g = 0; g < 8; ++g) *(f32x4*)(pp + 16 * g) = acc[g] * osc; } } while (0)
    for (int vb = F.bid; vb < 256; vb += F.G) {
        const int x = vb & 7, j = vb >> 3, sl = x & 3; const int tb0 = (x >> 2) * (T / 2) + 256 * j, tbase = tb0 + 32 * F.wave; const unsigned loff = 128 * sl + 16 * c;
        v2u w0 = PU_LOADW(0), w1 = PU_LOADW(1), w2 = PU_LOADW(2), w3 = PU_LOADW(3); v4u ulA[16], ulB[16];
        __syncthreads();
        {
            const int tok = F.tid >> 1, hf = F.tid & 1; const bf16* hp = H2 + (size_t)(tb0 + tok) * DM + 256 * sl + 128 * hf;
            const float ms = SS[tb0 + tok] * (1.0f / DM) + EPS, rstd = rsqrtf(ms);
            const float sc = __builtin_bit_cast(float, (__builtin_bit_cast(unsigned, 2.0f * rstd) + 0x00400000u) & 0xFF800000u);
#pragma unroll
            for (int c4 = 0; c4 < 4; ++c4) { v4u o;
#pragma unroll
                for (int q = 0; q < 4; ++q) { const v4u a = *(const v4u*)(hp + 32 * c4 + 8 * q); unsigned pk = 0u;
                    pk = __builtin_amdgcn_cvt_scalef32_pk_fp4_f32(pk, bflo(a.x) * sc, bfhi(a.x) * sc, 1.0f, 0); pk = __builtin_amdgcn_cvt_scalef32_pk_fp4_f32(pk, bflo(a.y) * sc, bfhi(a.y) * sc, 1.0f, 1);
                    pk = __builtin_amdgcn_cvt_scalef32_pk_fp4_f32(pk, bflo(a.z) * sc, bfhi(a.z) * sc, 1.0f, 2); pk = __builtin_amdgcn_cvt_scalef32_pk_fp4_f32(pk, bflo(a.w) * sc, bfhi(a.w) * sc, 1.0f, 3); o[q] = pk; }
                *(LAS v4u*)(lB + tok * 128 + hf * 64 + c4 * 16) = o; }
            if (hf == 0) lS[tok] = rstd / sc;
        }
        PU_PUTW(0, w0); PU_ISSUE(0, ulA); w0 = PU_LOADW(4);
        __syncthreads();
        for (int tk = 0; tk < 32; tk += 4) {
            PU_PUTW(tk + 1, w1); PU_ISSUE(tk + 1, ulB); w1 = PU_LOADW(tk + 5); PU_COMPUTE(tk, ulA);
            PU_PUTW(tk + 2, w2); PU_ISSUE(tk + 2, ulA); w2 = PU_LOADW(tk + 6); PU_COMPUTE(tk + 1, ulB);
            PU_PUTW(tk + 3, w3); PU_ISSUE(tk + 3, ulB); w3 = PU_LOADW(tk + 7); PU_COMPUTE(tk + 2, ulA);
            PU_PUTW(tk + 4, w0); PU_ISSUE(tk + 4, ulA); w0 = PU_LOADW(tk + 8); PU_COMPUTE(tk + 3, ulB);
        }
    }
#undef PU_LOADW
#undef PU_PUTW
#undef PU_ISSUE
#undef PU_COMPUTE
#undef PU_V8
}
__device__ __forceinline__ void p7z_gate(Frame& F, const Ptrs& P) {
    unsigned char* ws = P.ws; const float* PART = (const float*)(ws + WS_PART); const float* GT = (const float*)(ws + WS_EG + 8 * MiB); const int* EXP = (const int*)(ws + WS_EG); unsigned* CG = (unsigned*)(ws + WS_CG);
    const size_t gt = (size_t)F.bid * 512 + F.tid, NGT = (size_t)F.G * 512, n4 = (size_t)T * 128 / 4;
    for (size_t i = gt; i < n4; i += NGT) {
        f32x4 z = *(const f32x4*)(PART + i * 4);
#pragma unroll
        for (int x = 1; x < 4; ++x) z += *(const f32x4*)(PART + (size_t)x * T * 128 + i * 4);
        const f32x4 g = *(const f32x4*)(GT + i * 4); const v4u e = *(const v4u*)(EXP + i * 4); v4u o;
#pragma unroll
        for (int q = 0; q < 4; ++q) { const float zz = z[q] * (1.0f / 64.0f); const float cgv = g[q] * 0.5f * zz * (1.0f + erff(zz * 0.70710678118654752f)); o[q] = ((unsigned)__builtin_bit_cast(unsigned short, (_Float16)cgv) << 16) | e[q]; }
        *(v4u*)(CG + i * 4) = o;
    }
}
template <int MODE> __device__ __forceinline__ void p7v_accum(Frame& F, const Ptrs& P, float* dst) {
    unsigned char* ws = P.ws; const unsigned* CG = (const unsigned*)(ws + WS_CG); const unsigned char* V4 = ws + WS_UV8 + 8 * MiB; const float* x1 = P.out;
    const int lane = F.lane, ti = lane >> 3, c = lane & 7;
#define PV_LOADW(ch, W) do { const unsigned* wp_ = CG + (size_t)(tbase + 8 * ((ch) >> 3) + ti) * 128 + ((ch) & 7) * 16; _Pragma("unroll") for (int q = 0; q < 4; ++q) W[q] = *(const v4u*)(wp_ + 4 * q); } while (0)
#define PV_ISSUE(W, vl, cg) do { _Pragma("unroll") for (int it = 0; it < 16; ++it) { const unsigned w = W[it >> 2][it & 3]; cg[it] = __builtin_amdgcn_perm(w, w, 0x03020302u); \
        unsigned off; asm("v_mad_u32_u16 %0, %1, %2, %3" : "=v"(off) : "v"(w), "v"(k512), "v"(loff)); vl[it] = *(const v4u*)(V4 + off); } } while (0)
#define PV_COMPUTE(ch, vl, cg) do { \
        _Pragma("unroll") for (int it = 0; it < 16; ++it) { const f16x2v cg2 = __builtin_bit_cast(f16x2v, cg[it]); \
            _Pragma("unroll") for (int q = 0; q < 4; ++q) { \
                acc[4 * q] = cg2 * __builtin_amdgcn_cvt_scalef32_pk_f16_fp4(vl[it][q], 1.0f, 0) + acc[4 * q]; acc[4 * q + 1] = cg2 * __builtin_amdgcn_cvt_scalef32_pk_f16_fp4(vl[it][q], 1.0f, 1) + acc[4 * q + 1]; \
                acc[4 * q + 2] = cg2 * __builtin_amdgcn_cvt_scalef32_pk_f16_fp4(vl[it][q], 1.0f, 2) + acc[4 * q + 2]; acc[4 * q + 3] = cg2 * __builtin_amdgcn_cvt_scalef32_pk_f16_fp4(vl[it][q], 1.0f, 3) + acc[4 * q + 3]; } } \
        if ((((ch) & 7) == 7)) { const size_t off = (size_t)(tbase + 8 * ((ch) >> 3) + ti) * DM + hoff; \
            _Pragma("unroll") for (int q = 0; q < 8; ++q) { f32x4 v = *(const f32x4*)(x1 + off + 4 * q); \
                v += (f32x4){(float)acc[2 * q].x, (float)acc[2 * q].y, (float)acc[2 * q + 1].x, (float)acc[2 * q + 1].y} * (1.0f / 64.0f); \
                *(f32x4*)(dst + off + 4 * q) = v; } \
            _Pragma("unroll") for (int q = 0; q < 16; ++q) acc[q] = (f16x2v){(_Float16)0.f, (_Float16)0.f}; } } while (0)
    for (int vb = F.bid; vb < 256; vb += F.G) {
        const int x = vb & 7, j = vb >> 3, sl = x & 3; const int tbase = (x >> 2) * (T / 2) + 256 * j + 32 * F.wave;
        const size_t hoff = 256 * sl + 32 * c; const unsigned loff = 128 * sl + 16 * c, k512 = 512u;
        v4u WA[4], WB[4], vlA[16], vlB[16]; unsigned cgA[16], cgB[16]; f16x2v acc[16];
#pragma unroll
        for (int q = 0; q < 16; ++q) acc[q] = (f16x2v){(_Float16)0.f, (_Float16)0.f};
        PV_LOADW(0, WA); PV_LOADW(1, WB);
        PV_ISSUE(WA, vlA, cgA);
        for (int ch = 0; ch < 32; ch += 2) {
            const int c2 = ch + 2 < 31 ? ch + 2 : 31, c3 = ch + 3 < 31 ? ch + 3 : 31;
            PV_ISSUE(WB, vlB, cgB);
            PV_LOADW(c2, WA);
            PV_COMPUTE(ch, vlA, cgA);
            PV_ISSUE(WA, vlA, cgA);
            PV_LOADW(c3, WB);
            PV_COMPUTE(ch + 1, vlB, cgB);
        }
    }
#undef PV_LOADW
#undef PV_ISSUE
#undef PV_COMPUTE
}

struct MirrorOrder {
    pg8::StaticOrder S8;
    __device__ __forceinline__ bool next(int i, pg8::Unit& u) const { pg8::Unit v; if (!S8.next(i, v)) return false; u.pm = v.pn; u.pn = v.pm; return true; }
    __device__ __forceinline__ void a_ready(const pg8::Unit&) const {}
    __device__ __forceinline__ void done(const pg8::Unit&) const {}
};
struct Args { const float* in[14]; float* out; unsigned char* ws; int ph_lo, ph_hi; };
#ifdef PEER_BF16
constexpr int N_PHASES = 12;
#else
constexpr int N_PHASES = 14;
#endif
#ifndef MK_PER_PHASE
#define MK_PER_PHASE 0
#endif

__global__ void __launch_bounds__(NWAVES * 64, 2) hybrid_fwd(Args args) {
    extern __shared__ __attribute__((aligned(16))) unsigned char lds[];
    Frame F;
    F.lds = (LAS unsigned char*)lds; F.MISC = (volatile LAS unsigned*)(F.lds + MISC_OFF);
    F.tid = threadIdx.x; F.lane = F.tid & 63; F.wave = __builtin_amdgcn_readfirstlane(F.tid >> 6); F.G = gridDim.x; F.bid = blockIdx.x;
    F.ctl = (gu32*)(args.ws + WS_CTL);
    if (F.tid < 64) ((LAS unsigned*)(F.lds + MISC_OFF))[F.tid] = 0u;
    __syncthreads();
    XcdBarrier bar; bar.bar = (unsigned*)(F.ctl + CW_BAR); bar.x = 0; bar.st = nullptr;
    if (!MK_PER_PHASE) bar = xcd_barrier_post((unsigned*)(F.ctl + CW_BAR), F.MISC + 8);
    const int lo = args.ph_lo, hi = args.ph_hi;
#define LOADP() { int t_ = threadIdx.x; asm volatile("" : "+v"(t_)); F.tid = t_; F.lane = t_ & 63; F.wave = __builtin_amdgcn_readfirstlane(t_ >> 6); } Ptrs P; { const __attribute__((address_space(4))) Args* ap = (const __attribute__((address_space(4))) Args*)__builtin_amdgcn_kernarg_segment_ptr(); asm volatile("" : "+s"(ap)); \
    P.x = ap->in[0]; P.mix_g = ap->in[1]; P.w_in = ap->in[2]; P.ret_w = ap->in[3]; P.q_gain = ap->in[4]; P.k_gain = ap->in[5]; P.moba_w = ap->in[6]; P.rel_bias = ap->in[7]; \
    P.w_out = ap->in[8]; P.ffn_g = ap->in[9]; P.peer_wq = ap->in[10]; P.sub_keys = ap->in[11]; P.peer_u = ap->in[12]; P.peer_v = ap->in[13]; P.out = ap->out; P.ws = ap->ws; } \
    unsigned char* ws = P.ws; bf16* XN = (bf16*)P.out; bf16* RETG = (bf16*)P.out; bf16* ATT = (bf16*)((unsigned char*)P.out + 32 * MiB); (void)ws; (void)XN; (void)RETG; (void)ATT;
#ifdef RET_NAIVE
#define RET_FN p3a_retention
#else
#define RET_FN p3a_retention_mfma
#endif
#ifdef MOBA_NAIVE
#define MOBA_FN p3b_moba
#else
#define MOBA_FN p3b_moba_mfma<0>
#endif
#ifndef DUP_MASK
#define DUP_MASK 0
#endif
#ifndef DUPPH
#define DUPPH 0
#endif
#define REPS(k) ((((DUPPH) >> (k)) & 1) ? 2 : 1)
#ifndef PH_MASK
#define PH_MASK 0xFFFF
#endif
#define IN(k) (((PH_MASK >> (k)) & 1) && lo <= (k) && (k) < hi)
#define LOCAL_SEAM(k) do { if (MK_PER_PHASE) {} } while (0)
#define SEAM(k) do { if (IN(k) && IN((k) + 1)) xcd_barrier(bar); } while (0)
    LAS unsigned char* ring = F.lds;

    if (IN(0)) for (int rep_ = 0; rep_ < REPS(0); ++rep_) { LOADP(); p0_prologue(F, P); } SEAM(0);
    if (IN(1)) for (int rep_ = 0; rep_ < REPS(1); ++rep_) { LOADP();
        pg8::Gemm g{XN, (const bf16*)(ws + WS_WIN), T, INW, DM, DM, DM, 0}; pg8::StaticOrder S; S.init(T, INW, F.G, F.bid);
        EpiInProj E{(bf16*)(ws + WS_RQ), (bf16*)(ws + WS_RK), (bf16*)(ws + WS_RV), (bf16*)(ws + WS_RG), (bf16*)(ws + WS_MQ), (bf16*)(ws + WS_MK), (bf16*)(ws + WS_MV), (bf16*)(ws + WS_GA), (bf16*)(ws + WS_GB),
                    (const float*)(ws + WS_ROPE), P.q_gain, P.k_gain, (float*)(ws + WS_KM)};
        pg8::gemm_phase<EpiInProj, pg8::StaticOrder, true, true>(ring, g, S, E);
        { const int nunit = (T / 256) * (INW / 256), rem = nunit % F.G;
          if (rem == 0) p0b_late_weights(F, P, F.bid, F.G); else if (F.bid >= rem) p0b_late_weights(F, P, F.bid - rem, F.G - rem); }
    } SEAM(1);
#ifdef EXTRA_BARS
    for (int xb_ = 0; xb_ < EXTRA_BARS; ++xb_) xcd_barrier(bar);
#endif
    if (IN(2)) for (int rep_ = 0; rep_ < REPS(2); ++rep_) { LOADP(); p2a_kv_mfma(F, P); } SEAM(2);
    if (IN(3)) for (int rep_ = 0; rep_ < REPS(3); ++rep_) { LOADP(); p2b_scan(F, P); } SEAM(3);
    if (IN(4)) for (int rep_ = 0; rep_ < REPS(4); ++rep_) { LOADP(); RET_FN(F, P); if (DUP_MASK & 1) RET_FN(F, P); MOBA_FN(F, P); if (DUP_MASK & 2) MOBA_FN(F, P);
#ifdef MOBA_ABL
        p3b_moba_mfma<MOBA_ABL>(F, P);
#endif
    } SEAM(4);
    if (IN(5)) for (int rep_ = 0; rep_ < REPS(5); ++rep_) { LOADP();
        pg8::Gemm g0{ATT, (const bf16*)(ws + WS_WB), T, DM, 512, 512, 512, 0}, g1{RETG, (const bf16*)(ws + WS_WA), T, DM, DM, DM, DM, 0};
        TwoSegOrder S; S.B.init(T, DM, F.G, F.bid);
        EpiMerge2 E{(bf16*)(ws + WS_MRG), (const bf16*)(ws + WS_GA), (const bf16*)(ws + WS_GB)};
        pg8::gemm_phase2<EpiMerge2, TwoSegOrder, true, true>(ring, g0, g1, S, E);
    } SEAM(5);
    if (IN(6)) for (int rep_ = 0; rep_ < REPS(6); ++rep_) { LOADP();
        pg8::Gemm g{(const bf16*)(ws + WS_MRG), (const bf16*)(ws + WS_WO), T, DM, DM, DM, DM, 0}; pg8::StaticOrder S; S.init(T, DM, F.G, F.bid);
        EpiResid E{P.x, P.out, (bf16*)(ws + WS_H2), P.ffn_g, (float*)(ws + WS_SUMSQ)};
        pg8::gemm_phase<EpiResid, pg8::StaticOrder, true, true>(ring, g, S, E);
    } SEAM(6);
    if (IN(9)) for (int rep_ = 0; rep_ < REPS(9); ++rep_) { LOADP();
        pg8::Gemm g{(const bf16*)(ws + WS_WQ), (const bf16*)(ws + WS_H2), PH * 256, T, DM, DM, DM, 0}; MirrorOrder S; S.S8.init(T, 2048, F.G, F.bid);
        EpiNatBf16 E{(bf16*)(ws + WS_ST), T, (const float*)(ws + WS_SUMSQ)};
        pg8::gemm_phase<EpiNatBf16, MirrorOrder, true, true>(ring, g, S, E);
        VM_WAIT(); __syncthreads();
    } LOCAL_SEAM(9);
    if (IN(10)) for (int rep_ = 0; rep_ < REPS(10); ++rep_) { LOADP(); p6_topk(F, P); } SEAM(10);
#ifdef PEER_BF16
    if (IN(11)) for (int rep_ = 0; rep_ < REPS(11); ++rep_) { LOADP(); if (DUP_MASK & 4) p7_peer(F, P, (float*)(ws + WS_ST)); p7_peer(F, P, P.out); }
#else
    if (IN(11)) for (int rep_ = 0; rep_ < REPS(11); ++rep_) { LOADP(); p7u_dots<0>(F, P); if (DUP_MASK & 4) p7u_dots<2>(F, P); } SEAM(11);
    if (IN(12)) for (int rep_ = 0; rep_ < REPS(12); ++rep_) { LOADP(); p7z_gate(F, P); } SEAM(12);
    if (IN(13)) for (int rep_ = 0; rep_ < REPS(13); ++rep_) { LOADP(); if (DUP_MASK & 16) p7v_accum<0>(F, P, (float*)(ws + WS_PART)); p7v_accum<0>(F, P, P.out); }
#endif
#undef IN
#undef SEAM
}

extern "C" void kernel_launch(void* const* d_in, const int* in_sizes, int n_in, void* d_out, int out_size, void* d_ws, size_t ws_size, hipStream_t stream) {
    static int grid = 0;
    if (grid == 0) {
        if (n_in != 14 || out_size != T * DM || ws_size < WS_END) { fprintf(stderr, "kernel_launch: unexpected problem (n_in %d, out %d, ws %zu); nothing launched\n", n_in, out_size, ws_size); grid = -1; return; }
        int dev = 0, cus = 0, per_cu = 0;
        if (hipGetDevice(&dev) != hipSuccess || hipDeviceGetAttribute(&cus, hipDeviceAttributeMultiprocessorCount, dev) != hipSuccess) { grid = -1; return; }
        if (hipFuncSetAttribute((const void*)hybrid_fwd, hipFuncAttributeMaxDynamicSharedMemorySize, LDS_BYTES) != hipSuccess) { fprintf(stderr, "kernel_launch: hipFuncSetAttribute failed\n"); grid = -1; return; }
        if (hipOccupancyMaxActiveBlocksPerMultiprocessor(&per_cu, (const void*)hybrid_fwd, NWAVES * 64, LDS_BYTES) != hipSuccess || per_cu < 1)
            fprintf(stderr, "kernel_launch: note: occupancy query reports %d workgroups per CU\n", per_cu);
        (void)hipGetLastError();
        grid = cus;
    }
    if (grid < 0) return;
    (void)hipMemsetAsync((char*)d_ws + WS_CTL, 0, CTL_ZERO_BYTES, stream);
    Args a{};
    for (int i = 0; i < 14; ++i) a.in[i] = (const float*)d_in[i];
    a.out = (float*)d_out; a.ws = (unsigned char*)d_ws;
#if MK_PER_PHASE
    for (int p = 0; p < N_PHASES; ++p) { a.ph_lo = p; a.ph_hi = p + 1; hipLaunchKernelGGL(hybrid_fwd, dim3(grid), dim3(NWAVES * 64), LDS_BYTES, stream, a); }
#else
    a.ph_lo = 0; a.ph_hi = N_PHASES;
    hipLaunchKernelGGL(hybrid_fwd, dim3(grid), dim3(NWAVES * 64), LDS_BYTES, stream, a);
#endif
}
```

```cpp
#include <hip/hip_runtime.h>
#include <cstdio>
#include <cstdint>

#define GAS __attribute__((address_space(1)))
#define LAS __attribute__((address_space(3)))
typedef unsigned short bf16;
typedef unsigned v4u __attribute__((ext_vector_type(4)));
typedef unsigned v2u __attribute__((ext_vector_type(2)));
typedef float f32x4 __attribute__((ext_vector_type(4)));
typedef short bf16x8 __attribute__((ext_vector_type(8)));
typedef float f32x16 __attribute__((ext_vector_type(16)));
typedef GAS unsigned gu32;
#define RLX_AGENT __ATOMIC_RELAXED, __HIP_MEMORY_SCOPE_AGENT
#define LDS_WAIT() asm volatile("s_waitcnt lgkmcnt(0)" ::: "memory")
#define VM_WAIT() asm volatile("s_waitcnt vmcnt(0)" ::: "memory")

constexpr int BATCH = 4, SEQ = 4096, DM = 1024, T = BATCH * SEQ;
constexpr int RH = 8, RDK = 64, RDV = 128, RC = 128, NCH = SEQ / RC;
constexpr int MH = 8, MD = 64, MBLK = 256, NBLK = SEQ / MBLK;
constexpr int PH = 8, PNK = 128, PTOP = 16, PQD = 256;
constexpr int NEXP = PNK * PNK;
constexpr int INW = 6656;
constexpr float EPS = 1e-6f;

__device__ __forceinline__ unsigned f2bf(float f) { unsigned u = __builtin_bit_cast(unsigned, f); return (u + 0x7fffu + ((u >> 16) & 1u)) >> 16; }
typedef float f32x2_t __attribute__((ext_vector_type(2))); typedef __bf16 bf16x2_t __attribute__((ext_vector_type(2)));
__device__ __forceinline__ unsigned pk2(float lo, float hi) { const f32x2_t v = {lo, hi}; const bf16x2_t b = __builtin_convertvector(v, bf16x2_t); return __builtin_bit_cast(unsigned, b); }
__device__ __forceinline__ float bf2f(unsigned short b) { return __builtin_bit_cast(float, (unsigned)b << 16); }
__device__ __forceinline__ float bflo(unsigned w) { return __builtin_bit_cast(float, w << 16); }
__device__ __forceinline__ float bfhi(unsigned w) { return __builtin_bit_cast(float, w & 0xffff0000u); }
__device__ __forceinline__ float wave_sum(float v) {
#pragma unroll
    for (int o = 1; o < 64; o <<= 1) v += __shfl_xor(v, o);
    return v;
}
__device__ __forceinline__ float dpp_sum8(float v) {
    v += __builtin_bit_cast(float, __builtin_amdgcn_mov_dpp(__builtin_bit_cast(int, v), 0xB1, 0xF, 0xF, true));
    v += __builtin_bit_cast(float, __builtin_amdgcn_mov_dpp(__builtin_bit_cast(int, v), 0x4E, 0xF, 0xF, true));
    v += __builtin_bit_cast(float, __builtin_amdgcn_mov_dpp(__builtin_bit_cast(int, v), 0x141, 0xF, 0xF, true));
    return v;
}
__device__ __forceinline__ float ret_l2g(int h) { return log1pf(-exp2f(-5.0f - (float)h)) * 1.4426950408889634f; }

__host__ __device__ __forceinline__ int perm_row_of_col(int a) {
    const int tile = a >> 8, w = a & 255, wc = w >> 6, bj = (w >> 5) & 1, q = w & 31, fq = q >> 3, n = (q >> 2) & 1, e = q & 3;
    return tile * 256 + 128 * bj + 32 * wc + 16 * n + 4 * fq + e;
}
namespace pg8 {
#define PG8_LAS __attribute__((address_space(3)))
typedef unsigned short bf16_t;
typedef short bf16x8 __attribute__((ext_vector_type(8)));
typedef float f32x4 __attribute__((ext_vector_type(4)));
typedef unsigned u32x4 __attribute__((ext_vector_type(4)));
constexpr int BM = 256, BK = 64, HALF = 128, HTB = HALF * BK * 2  , STAGE_BYTES = 8 * HTB, NXCD = 8, WGM = 8;

__host__ __device__ __forceinline__ int lds_byte(int r, int c) { const int st = (r >> 4) * 2 + (c >> 5), rr = r & 15, cc = c & 31, ob = rr * 64 + cc * 2; return st * 1024 + (ob ^ (((ob >> 9) & 1) << 5)); }
__host__ __device__ __forceinline__ void stage_rc(int b, int& R, int& C) { const int st = b / 1024, sb = b % 1024, swz = sb ^ (((sb >> 9) & 1) << 5); R = (st >> 1) * 16 + swz / 64; C = (st & 1) * 32 + (swz % 64) / 2; }
__host__ __device__ __forceinline__ int perm32(int rho) { const int n = rho >> 4, i = rho & 15; return 8 * (i >> 2) + 4 * n + (i & 3); }

struct Unit { int pm, pn, seg; };
struct Gemm { const bf16_t* A; const bf16_t* Bt; int M, N, K, lda, ldb, bpm; };

struct StaticOrder {
    int nM, nN, nwg, G, c;
    __host__ __device__ void init(int M, int N, int G_, int c_) { nM = M / BM; nN = N / BM; nwg = nM * nN; G = G_; c = c_; }
    __host__ __device__ bool next(int i, Unit& u) const {
        const long L = (long)i * G + c; if (L >= nwg) return false;
        int wgid = (int)L; { const int q = nwg / NXCD, r = nwg % NXCD, xcd = wgid % NXCD, off = wgid / NXCD; wgid = (xcd < r ? xcd * (q + 1) : r * (q + 1) + (xcd - r) * q) + off; }
        const int nig = WGM * nN, gid = wgid / nig, fm = gid * WGM, gsz = (nM - fm) < WGM ? (nM - fm) : WGM;
        u.pm = fm + ((wgid % nig) % gsz); u.pn = (wgid % nig) / gsz; u.seg = 0; return true;
    }
    __device__ __forceinline__ void a_ready(const Unit&) const {}
    __device__ __forceinline__ void done(const Unit&) const {}
};


template <class Epi, class Sched, bool ALIGN_EPI = false, bool SP2 = false>
__device__ __forceinline__ void gemm_phase(PG8_LAS unsigned char* lds, const Gemm g, const Sched& S, const Epi& E) {
    int tid_ = threadIdx.x; asm volatile("" : "+v"(tid_));
    const int tid = tid_, wid = __builtin_amdgcn_readfirstlane(tid >> 6), lane = tid & 63, wr = wid >> 2, wc = wid & 3, fr = lane & 15, fq = lane >> 4;
    const int K = g.K, nt = K / BK;
    unsigned voffA[2], voffB[2];
#pragma unroll
    for (int i = 0; i < 2; ++i) { int R, C; stage_rc(tid * 16 + i * 8192, R, C);
        voffA[i] = (unsigned)(R * g.lda + C) * 2u; voffB[i] = (unsigned)(R * g.ldb + C) * 2u; }
    const size_t kstep = (size_t)(BK * 2);
    const size_t hstepA = (size_t)HALF * g.lda * 2, hstepB = (size_t)HALF * g.ldb * 2;
    const size_t tstepA = 2 * hstepA, tstepB = 2 * hstepB;
    const unsigned ldsw = (unsigned)wid * 1024u;
    const int aoff = lds_byte(wr * 64 + fr, fq * 8), boff = lds_byte(wc * 32 + fr, fq * 8);
#define PG8_SA(b, h) (((b) * 2 + (h)) * HTB)
#define PG8_SB(b, h) ((4 + (b) * 2 + (h)) * HTB)
#define PG8_STAGE(bufoff, gbase, voff) do { _Pragma("unroll") for (int _i = 0; _i < 2; ++_i) \
        __builtin_amdgcn_global_load_lds((const unsigned*)((const char*)(gbase) + (voff)[_i]), (PG8_LAS unsigned*)(lds + (bufoff) + ldsw + _i * 8192), 16, 0, 0); } while (0)
#define PG8_LDA(dst, b, h) do { _Pragma("unroll") for (int m = 0; m < 4; ++m) _Pragma("unroll") for (int k = 0; k < 2; ++k) dst[m][k] = *(const PG8_LAS bf16x8*)(lds + PG8_SA(b, h) + aoff + m * 2048 + k * 1024); } while (0)
#define PG8_LDB(dst, b, h) do { _Pragma("unroll") for (int n = 0; n < 2; ++n) _Pragma("unroll") for (int k = 0; k < 2; ++k) dst[n][k] = *(const PG8_LAS bf16x8*)(lds + PG8_SB(b, h) + boff + n * 2048 + k * 1024); } while (0)
#define PG8_MMA(ai, bj, At, Bt) do { __builtin_amdgcn_s_setprio(1); _Pragma("unroll") for (int m = 0; m < 4; ++m) _Pragma("unroll") for (int n = 0; n < 2; ++n) _Pragma("unroll") for (int k = 0; k < 2; ++k) \
        acc[ai][bj][m][n] = __builtin_amdgcn_mfma_f32_16x16x32_bf16(Bt[n][k], At[m][k], acc[ai][bj][m][n], 0, 0, 0); __builtin_amdgcn_s_setprio(0); } while (0)
#define PG8_WAIT_V(n) asm volatile("s_waitcnt vmcnt(" #n ")" ::: "memory")
#define PG8_WAIT_L(n) asm volatile("s_waitcnt lgkmcnt(" #n ")" ::: "memory")
#define PG8_BAR __builtin_amdgcn_s_barrier()
#define PG8_SCHED __builtin_amdgcn_sched_barrier(0)
    Unit cur, nxt; int ui = 0;
    if (!S.next(0, cur)) return;
    f32x4 acc[2][2][4][2];
#pragma unroll
    for (int a = 0; a < 2; ++a)
#pragma unroll
        for (int b = 0; b < 2; ++b)
#pragma unroll
            for (int m = 0; m < 4; ++m)
#pragma unroll
                for (int n = 0; n < 2; ++n) acc[a][b][m][n] = (f32x4){0.f, 0.f, 0.f, 0.f};
    bf16x8 At[4][2], B0[2][2], B1[2][2];
    const char* cA = (const char*)g.A + (size_t)cur.pm * tstepA; const char* cB = (const char*)g.Bt + (size_t)cur.pn * tstepB + (size_t)cur.pm * g.bpm;
    S.a_ready(cur);
    if constexpr (SP2) {
        PG8_STAGE(PG8_SB(0, 0), cB, voffB); PG8_STAGE(PG8_SB(0, 1), cB + hstepB, voffB); PG8_STAGE(PG8_SA(0, 0), cA, voffA); PG8_STAGE(PG8_SA(0, 1), cA + hstepA, voffA);
        if (wr == 1) PG8_BAR;
        PG8_WAIT_V(2); PG8_BAR;
        PG8_STAGE(PG8_SB(1, 0), cB + kstep, voffB); PG8_STAGE(PG8_SA(1, 0), cA + kstep, voffA); PG8_STAGE(PG8_SB(1, 1), cB + hstepB + kstep, voffB);
        PG8_WAIT_V(6); PG8_BAR;
    } else {
        PG8_STAGE(PG8_SB(0, 0), cB, voffB); PG8_STAGE(PG8_SA(0, 0), cA, voffA); PG8_STAGE(PG8_SB(0, 1), cB + hstepB, voffB); PG8_STAGE(PG8_SA(0, 1), cA + hstepA, voffA);
        if (wr == 1) PG8_BAR;
        PG8_WAIT_V(4); PG8_BAR;
        PG8_STAGE(PG8_SB(1, 0), cB + kstep, voffB); PG8_STAGE(PG8_SA(1, 0), cA + kstep, voffA); PG8_STAGE(PG8_SB(1, 1), cB + hstepB + kstep, voffB);
        PG8_WAIT_V(6); PG8_BAR;
    }
    for (;;) {
        const bool has_next = S.next(ui + 1, nxt);
        const char* nA = has_next ? (const char*)g.A + (size_t)nxt.pm * tstepA : cA; const char* nB = has_next ? (const char*)g.Bt + (size_t)nxt.pn * tstepB + (size_t)nxt.pm * g.bpm : cB;
        for (int t = 0; t < nt; t += 2) {
            const bool last = (t == nt - 2);
            const char* a1 = cA + (size_t)(t + 1) * kstep;
            const char* a2 = last ? nA : cA + (size_t)(t + 2) * kstep; const char* b2 = last ? nB : cB + (size_t)(t + 2) * kstep;
            const char* a3 = a2 + kstep; const char* b3 = b2 + kstep;
            if (last && has_next) S.a_ready(nxt);
            if constexpr (SP2) {
            PG8_LDB(B0, 0, 0); PG8_LDB(B1, 0, 1); PG8_SCHED; PG8_LDA(At, 0, 0); PG8_STAGE(PG8_SA(1, 1), a1 + hstepA, voffA);
            PG8_WAIT_V(8); PG8_WAIT_L(0); PG8_BAR; PG8_MMA(0, 0, At, B0); PG8_MMA(0, 1, At, B1); PG8_BAR; PG8_SCHED;
            PG8_LDA(At, 0, 1); PG8_STAGE(PG8_SB(0, 0), b2, voffB); PG8_STAGE(PG8_SB(0, 1), b2 + hstepB, voffB); PG8_STAGE(PG8_SA(0, 0), a2, voffA);
            PG8_WAIT_V(8); PG8_WAIT_L(0); PG8_BAR; PG8_MMA(1, 0, At, B0); PG8_MMA(1, 1, At, B1); PG8_BAR; PG8_SCHED;
            PG8_LDB(B0, 1, 0); PG8_LDB(B1, 1, 1); PG8_SCHED; PG8_LDA(At, 1, 0); PG8_STAGE(PG8_SA(0, 1), a2 + hstepA, voffA);
            PG8_WAIT_V(8); PG8_WAIT_L(0); PG8_BAR; PG8_MMA(0, 0, At, B0); PG8_MMA(0, 1, At, B1); PG8_BAR; PG8_SCHED;
            PG8_LDA(At, 1, 1); PG8_STAGE(PG8_SB(1, 0), b3, voffB); PG8_STAGE(PG8_SB(1, 1), b3 + hstepB, voffB); PG8_STAGE(PG8_SA(1, 0), a3, voffA);
            PG8_WAIT_V(8); PG8_WAIT_L(0); PG8_BAR; PG8_MMA(1, 0, At, B0); PG8_MMA(1, 1, At, B1); PG8_BAR; PG8_SCHED;
            } else {
            PG8_LDB(B0, 0, 0); PG8_SCHED; PG8_LDA(At, 0, 0); PG8_STAGE(PG8_SA(1, 1), a1 + hstepA, voffA);
            PG8_WAIT_L(8); PG8_BAR; PG8_WAIT_L(0); PG8_MMA(0, 0, At, B0); PG8_BAR; PG8_SCHED;
            PG8_LDB(B1, 0, 1); PG8_STAGE(PG8_SB(0, 0), b2, voffB);
            PG8_BAR; PG8_WAIT_L(0); PG8_MMA(0, 1, At, B1); PG8_BAR;
            PG8_LDA(At, 0, 1); PG8_STAGE(PG8_SA(0, 0), a2, voffA);
            PG8_BAR; PG8_WAIT_L(0); PG8_MMA(1, 0, At, B0); PG8_BAR; PG8_SCHED;
            PG8_STAGE(PG8_SB(0, 1), b2 + hstepB, voffB);
            PG8_WAIT_V(6); PG8_BAR; PG8_MMA(1, 1, At, B1); PG8_BAR;
            PG8_LDB(B0, 1, 0); PG8_SCHED; PG8_LDA(At, 1, 0); PG8_STAGE(PG8_SA(0, 1), a2 + hstepA, voffA);
            PG8_WAIT_L(8); PG8_BAR; PG8_WAIT_L(0); PG8_MMA(0, 0, At, B0); PG8_BAR; PG8_SCHED;
            PG8_LDB(B1, 1, 1); PG8_STAGE(PG8_SB(1, 0), b3, voffB);
            PG8_BAR; PG8_WAIT_L(0); PG8_MMA(0, 1, At, B1); PG8_BAR;
            PG8_LDA(At, 1, 1); PG8_STAGE(PG8_SA(1, 0), a3, voffA);
            PG8_BAR; PG8_WAIT_L(0); PG8_MMA(1, 0, At, B0); PG8_BAR; PG8_SCHED;
            PG8_STAGE(PG8_SB(1, 1), b3 + hstepB, voffB);
            PG8_WAIT_V(6); PG8_BAR; PG8_MMA(1, 1, At, B1); PG8_BAR;
            }
        }
        if constexpr (ALIGN_EPI) { if (wr == 0) PG8_BAR; }
        if constexpr (!Epi::AFTER_DRAIN) { E(acc, cur, wr, wc, fr, fq); S.done(cur); }
        if (!has_next) break;
#pragma unroll
        for (int a = 0; a < 2; ++a)
#pragma unroll
            for (int b = 0; b < 2; ++b)
#pragma unroll
                for (int m = 0; m < 4; ++m)
#pragma unroll
                    for (int n = 0; n < 2; ++n) acc[a][b][m][n] = (f32x4){0.f, 0.f, 0.f, 0.f};
        cur = nxt; cA = nA; cB = nB; ++ui;
        if constexpr (ALIGN_EPI) { if (wr == 1) PG8_BAR; }
    }
    PG8_WAIT_V(0);
    if constexpr (!ALIGN_EPI) { if (wr == 0) PG8_BAR; }
    PG8_BAR;
    if constexpr (Epi::AFTER_DRAIN) { E.fused(acc, cur, wr, wc, fr, fq, lds, wid, lane); S.done(cur); }
#undef PG8_SA
#undef PG8_SB
#undef PG8_STAGE
#undef PG8_LDA
#undef PG8_LDB
#undef PG8_MMA
#undef PG8_WAIT_V
#undef PG8_WAIT_L
#undef PG8_BAR
#undef PG8_SCHED
}
template <class Epi, class Sched, bool ALIGN_EPI = false, bool SP2 = false>
__device__ __forceinline__ void gemm_phase2(PG8_LAS unsigned char* lds, const Gemm g0, const Gemm g1, const Sched& S, const Epi& E) {
    int tid_ = threadIdx.x; asm volatile("" : "+v"(tid_));
    const int tid = tid_, wid = __builtin_amdgcn_readfirstlane(tid >> 6), lane = tid & 63, wr = wid >> 2, wc = wid & 3, fr = lane & 15, fq = lane >> 4;
    unsigned voffA0[2], voffB0[2], voffA1[2], voffB1[2];
#pragma unroll
    for (int i = 0; i < 2; ++i) { int R, C; stage_rc(tid * 16 + i * 8192, R, C);
        voffA0[i] = (unsigned)(R * g0.lda + C) * 2u; voffB0[i] = (unsigned)(R * g0.ldb + C) * 2u; voffA1[i] = (unsigned)(R * g1.lda + C) * 2u; voffB1[i] = (unsigned)(R * g1.ldb + C) * 2u; }
    const size_t kstep = (size_t)(BK * 2);
    const size_t hstepA0 = (size_t)HALF * g0.lda * 2, hstepB0 = (size_t)HALF * g0.ldb * 2, hstepA1 = (size_t)HALF * g1.lda * 2, hstepB1 = (size_t)HALF * g1.ldb * 2;
    const size_t tstepA0 = 2 * hstepA0, tstepB0 = 2 * hstepB0, tstepA1 = 2 * hstepA1, tstepB1 = 2 * hstepB1;
    const unsigned ldsw = (unsigned)wid * 1024u;
    const int aoff = lds_byte(wr * 64 + fr, fq * 8), boff = lds_byte(wc * 32 + fr, fq * 8);
#define PG8_SA(b, h) (((b) * 2 + (h)) * HTB)
#define PG8_SB(b, h) ((4 + (b) * 2 + (h)) * HTB)
#define PG8_STAGE(bufoff, gbase, voff) do { _Pragma("unroll") for (int _i = 0; _i < 2; ++_i) \
        __builtin_amdgcn_global_load_lds((const unsigned*)((const char*)(gbase) + (voff)[_i]), (PG8_LAS unsigned*)(lds + (bufoff) + ldsw + _i * 8192), 16, 0, 0); } while (0)
#define PG8_LDA(dst, b, h) do { _Pragma("unroll") for (int m = 0; m < 4; ++m) _Pragma("unroll") for (int k = 0; k < 2; ++k) dst[m][k] = *(const PG8_LAS bf16x8*)(lds + PG8_SA(b, h) + aoff + m * 2048 + k * 1024); } while (0)
#define PG8_LDB(dst, b, h) do { _Pragma("unroll") for (int n = 0; n < 2; ++n) _Pragma("unroll") for (int k = 0; k < 2; ++k) dst[n][k] = *(const PG8_LAS bf16x8*)(lds + PG8_SB(b, h) + boff + n * 2048 + k * 1024); } while (0)
#define PG8_MMA(ai, bj, At, Bt) do { __builtin_amdgcn_s_setprio(1); _Pragma("unroll") for (int m = 0; m < 4; ++m) _Pragma("unroll") for (int n = 0; n < 2; ++n) _Pragma("unroll") for (int k = 0; k < 2; ++k) \
        acc[ai][bj][m][n] = __builtin_amdgcn_mfma_f32_16x16x32_bf16(Bt[n][k], At[m][k], acc[ai][bj][m][n], 0, 0, 0); __builtin_amdgcn_s_setprio(0); } while (0)
#define PG8_WAIT_V(n) asm volatile("s_waitcnt vmcnt(" #n ")" ::: "memory")
#define PG8_WAIT_L(n) asm volatile("s_waitcnt lgkmcnt(" #n ")" ::: "memory")
#define PG8_BAR __builtin_amdgcn_s_barrier()
#define PG8_SCHED __builtin_amdgcn_sched_barrier(0)
    Unit cur, nxt; int ui = 0;
    if (!S.next(0, cur)) return;
    f32x4 acc[2][2][4][2];
#pragma unroll
    for (int a = 0; a < 2; ++a)
#pragma unroll
        for (int b = 0; b < 2; ++b)
#pragma unroll
            for (int m = 0; m < 4; ++m)
#pragma unroll
                for (int n = 0; n < 2; ++n) acc[a][b][m][n] = (f32x4){0.f, 0.f, 0.f, 0.f};
    bf16x8 At[4][2], B0[2][2], B1[2][2];
#define PG8_UA(u_) ((u_).seg ? (const char*)g1.A + (size_t)(u_).pm * tstepA1 : (const char*)g0.A + (size_t)(u_).pm * tstepA0)
#define PG8_UB(u_) ((u_).seg ? (const char*)g1.Bt + (size_t)(u_).pn * tstepB1 : (const char*)g0.Bt + (size_t)(u_).pn * tstepB0)
    const char* cA = PG8_UA(cur); const char* cB = PG8_UB(cur);
    size_t hAc = cur.seg ? hstepA1 : hstepA0, hBc = cur.seg ? hstepB1 : hstepB0; unsigned vAc[2], vBc[2];
#pragma unroll
    for (int i = 0; i < 2; ++i) { vAc[i] = cur.seg ? voffA1[i] : voffA0[i]; vBc[i] = cur.seg ? voffB1[i] : voffB0[i]; }
    int nt = (cur.seg ? g1.K : g0.K) / BK;
    S.a_ready(cur);
    if constexpr (SP2) {
        PG8_STAGE(PG8_SB(0, 0), cB, vBc); PG8_STAGE(PG8_SB(0, 1), cB + hBc, vBc); PG8_STAGE(PG8_SA(0, 0), cA, vAc); PG8_STAGE(PG8_SA(0, 1), cA + hAc, vAc);
        if (wr == 1) PG8_BAR;
        PG8_WAIT_V(2); PG8_BAR;
        PG8_STAGE(PG8_SB(1, 0), cB + kstep, vBc); PG8_STAGE(PG8_SA(1, 0), cA + kstep, vAc); PG8_STAGE(PG8_SB(1, 1), cB + hBc + kstep, vBc);
        PG8_WAIT_V(6); PG8_BAR;
    } else {
        PG8_STAGE(PG8_SB(0, 0), cB, vBc); PG8_STAGE(PG8_SA(0, 0), cA, vAc); PG8_STAGE(PG8_SB(0, 1), cB + hBc, vBc); PG8_STAGE(PG8_SA(0, 1), cA + hAc, vAc);
        if (wr == 1) PG8_BAR;
        PG8_WAIT_V(4); PG8_BAR;
        PG8_STAGE(PG8_SB(1, 0), cB + kstep, vBc); PG8_STAGE(PG8_SA(1, 0), cA + kstep, vAc); PG8_STAGE(PG8_SB(1, 1), cB + hBc + kstep, vBc);
        PG8_WAIT_V(6); PG8_BAR;
    }
    for (;;) {
        const bool has_next = S.next(ui + 1, nxt);
        const char* nA = has_next ? PG8_UA(nxt) : cA; const char* nB = has_next ? PG8_UB(nxt) : cB;
        const int sn = has_next ? nxt.seg : cur.seg; const size_t hAn = sn ? hstepA1 : hstepA0, hBn = sn ? hstepB1 : hstepB0; unsigned vAn[2], vBn[2];
#pragma unroll
        for (int i = 0; i < 2; ++i) { vAn[i] = sn ? voffA1[i] : voffA0[i]; vBn[i] = sn ? voffB1[i] : voffB0[i]; }
        for (int t = 0; t < nt; t += 2) {
            const bool last = (t == nt - 2);
            const size_t hA2 = last ? hAn : hAc, hB2 = last ? hBn : hBc; unsigned vA2[2], vB2[2];
#pragma unroll
            for (int i = 0; i < 2; ++i) { vA2[i] = last ? vAn[i] : vAc[i]; vB2[i] = last ? vBn[i] : vBc[i]; }
            const char* a1 = cA + (size_t)(t + 1) * kstep;
            const char* a2 = last ? nA : cA + (size_t)(t + 2) * kstep; const char* b2 = last ? nB : cB + (size_t)(t + 2) * kstep;
            const char* a3 = a2 + kstep; const char* b3 = b2 + kstep;
            if (last && has_next) S.a_ready(nxt);
            if constexpr (SP2) {
            PG8_LDB(B0, 0, 0); PG8_LDB(B1, 0, 1); PG8_SCHED; PG8_LDA(At, 0, 0); PG8_STAGE(PG8_SA(1, 1), a1 + hAc, vAc);
            PG8_WAIT_V(8); PG8_WAIT_L(0); PG8_BAR; PG8_MMA(0, 0, At, B0); PG8_MMA(0, 1, At, B1); PG8_BAR; PG8_SCHED;
            PG8_LDA(At, 0, 1); PG8_STAGE(PG8_SB(0, 0), b2, vB2); PG8_STAGE(PG8_SB(0, 1), b2 + hB2, vB2); PG8_STAGE(PG8_SA(0, 0), a2, vA2);
            PG8_WAIT_V(8); PG8_WAIT_L(0); PG8_BAR; PG8_MMA(1, 0, At, B0); PG8_MMA(1, 1, At, B1); PG8_BAR; PG8_SCHED;
            PG8_LDB(B0, 1, 0); PG8_LDB(B1, 1, 1); PG8_SCHED; PG8_LDA(At, 1, 0); PG8_STAGE(PG8_SA(0, 1), a2 + hA2, vA2);
            PG8_WAIT_V(8); PG8_WAIT_L(0); PG8_BAR; PG8_MMA(0, 0, At, B0); PG8_MMA(0, 1, At, B1); PG8_BAR; PG8_SCHED;
            PG8_LDA(At, 1, 1); PG8_STAGE(PG8_SB(1, 0), b3, vB2); PG8_STAGE(PG8_SB(1, 1), b3 + hB2, vB2); PG8_STAGE(PG8_SA(1, 0), a3, vA2);
            PG8_WAIT_V(8); PG8_WAIT_L(0); PG8_BAR; PG8_MMA(1, 0, At, B0); PG8_MMA(1, 1, At, B1); PG8_BAR; PG8_SCHED;
            } else {
            PG8_LDB(B0, 0, 0); PG8_SCHED; PG8_LDA(At, 0, 0); PG8_STAGE(PG8_SA(1, 1), a1 + hAc, vAc);
            PG8_WAIT_L(8); PG8_BAR; PG8_WAIT_L(0); PG8_MMA(0, 0, At, B0); PG8_BAR; PG8_SCHED;
            PG8_LDB(B1, 0, 1); PG8_STAGE(PG8_SB(0, 0), b2, vB2);
            PG8_BAR; PG8_WAIT_L(0); PG8_MMA(0, 1, At, B1); PG8_BAR;
            PG8_LDA(At, 0, 1); PG8_STAGE(PG8_SA(0, 0), a2, vA2);
            PG8_BAR; PG8_WAIT_L(0); PG8_MMA(1, 0, At, B0); PG8_BAR; PG8_SCHED;
            PG8_STAGE(PG8_SB(0, 1), b2 + hB2, vB2);
            PG8_WAIT_V(6); PG8_BAR; PG8_MMA(1, 1, At, B1); PG8_BAR;
            PG8_LDB(B0, 1, 0); PG8_SCHED; PG8_LDA(At, 1, 0); PG8_STAGE(PG8_SA(0, 1), a2 + hA2, vA2);
            PG8_WAIT_L(8); PG8_BAR; PG8_WAIT_L(0); PG8_MMA(0, 0, At, B0); PG8_BAR; PG8_SCHED;
            PG8_LDB(B1, 1, 1); PG8_STAGE(PG8_SB(1, 0), b3, vB2);
            PG8_BAR; PG8_WAIT_L(0); PG8_MMA(0, 1, At, B1); PG8_BAR;
            PG8_LDA(At, 1, 1); PG8_STAGE(PG8_SA(1, 0), a3, vA2);
            PG8_BAR; PG8_WAIT_L(0); PG8_MMA(1, 0, At, B0); PG8_BAR; PG8_SCHED;
            PG8_STAGE(PG8_SB(1, 1), b3 + hB2, vB2);
            PG8_WAIT_V(6); PG8_BAR; PG8_MMA(1, 1, At, B1); PG8_BAR;
            }
        }
        if constexpr (ALIGN_EPI) { if (wr == 0) PG8_BAR; }
        if (cur.seg == 0) E.mid(acc, cur, wr, wc, fr, fq); else { E(acc, cur, wr, wc, fr, fq); S.done(cur); }
        if (!has_next) break;
        if (cur.seg == 1) {
#pragma unroll
        for (int a = 0; a < 2; ++a)
#pragma unroll
            for (int b = 0; b < 2; ++b)
#pragma unroll
                for (int m = 0; m < 4; ++m)
#pragma unroll
                    for (int n = 0; n < 2; ++n) acc[a][b][m][n] = (f32x4){0.f, 0.f, 0.f, 0.f};
        }
        cur = nxt; cA = nA; cB = nB; ++ui; hAc = hAn; hBc = hBn; vAc[0] = vAn[0]; vAc[1] = vAn[1]; vBc[0] = vBn[0]; vBc[1] = vBn[1]; nt = (cur.seg ? g1.K : g0.K) / BK;
        if constexpr (ALIGN_EPI) { if (wr == 1) PG8_BAR; }
    }
    PG8_WAIT_V(0);
    if constexpr (!ALIGN_EPI) { if (wr == 0) PG8_BAR; }
    PG8_BAR;
#undef PG8_UA
#undef PG8_UB
#undef PG8_SA
#undef PG8_SB
#undef PG8_STAGE
#undef PG8_LDA
#undef PG8_LDB
#undef PG8_MMA
#undef PG8_WAIT_V
#undef PG8_WAIT_L
#undef PG8_BAR
#undef PG8_SCHED
}
}

#define XB_TMO      128
#define XB_XCNT(j)  (256  + 64 * (j))
#define XB_XSUB(j)  (1280 + 64 * (j))
#define XB_XGEN(j)  (2304 + 64 * (j))
#define XB_TOP      3328
#define XB_TOPGEN   3392
#define XCD_BAR_WORDS 3456
#define XB_SPIN_CAP (1u << 18)

__device__ __forceinline__ unsigned xb_ld(unsigned* p)              { return __hip_atomic_load(p, __ATOMIC_RELAXED, __HIP_MEMORY_SCOPE_AGENT); }
__device__ __forceinline__ unsigned xb_add(unsigned* p, unsigned v) { return __hip_atomic_fetch_add(p, v, __ATOMIC_RELAXED, __HIP_MEMORY_SCOPE_AGENT); }
__device__ __forceinline__ unsigned xb_xcc_id() { return (unsigned)__builtin_amdgcn_s_getreg((3 << 11) | 20) & 0xFu; }
#define XB_SPIN(cond, bar) do { unsigned _sp = 0; while (cond) { __builtin_amdgcn_s_sleep(1); \
    if ((++_sp & 255u) == 0u) { if (xb_ld(&(bar)[XB_TMO])) break; if (_sp > XB_SPIN_CAP) { atomicAdd(&(bar)[XB_TMO], 1u); break; } } } } while (0)

struct XcdBarrier {
    unsigned* bar; unsigned x;
    volatile LAS unsigned* st;
};

__device__ __forceinline__ XcdBarrier xcd_barrier_post(unsigned* bar, volatile LAS unsigned* st) {
    XcdBarrier b; b.bar = bar; b.x = xb_xcc_id(); b.st = st;
    if (threadIdx.x == 0) (void)xb_add(&bar[XB_XCNT(b.x)], 1u);
    return b;
}
__device__ __forceinline__ void xcd_barrier_complete(unsigned* bar, unsigned x, unsigned& nloc, unsigned& nx) {
    const unsigned G = gridDim.x * gridDim.y * gridDim.z;
    unsigned sum, cnt, mine, sp = 0u;
    for (;;) {
        sum = 0u; cnt = 0u; mine = 0u;
#pragma unroll
        for (unsigned j = 0; j < 16; ++j) { const unsigned c = xb_ld(&bar[XB_XCNT(j)]); sum += c; cnt += (c > 0u) ? 1u : 0u; mine = (j == x) ? c : mine; }
        if (sum == G) break;
        __builtin_amdgcn_s_sleep(1);
        if ((++sp & 255u) == 0u) { if (xb_ld(&bar[XB_TMO])) break; if (sp > XB_SPIN_CAP) { atomicAdd(&bar[XB_TMO], 1u); break; } }
    }
    nloc = mine > 0u ? mine : 1u; nx = cnt > 0u ? cnt : 1u;
}

__device__ __forceinline__ void xcd_barrier(const XcdBarrier& b) {
    asm volatile("s_waitcnt vmcnt(0)" ::: "memory");
    __syncthreads();
    if (threadIdx.x == 0) {
        unsigned* bar = b.bar;
        __builtin_amdgcn_s_waitcnt(0);
        unsigned nloc = b.st[0], nx = b.st[1];
        if (nloc == 0u) { xcd_barrier_complete(bar, b.x, nloc, nx); b.st[0] = nloc; b.st[1] = nx; }
        const unsigned old = xb_add(&bar[XB_XSUB(b.x)], 1u);
        const unsigned gen = old / nloc;
        if (old + 1u == (gen + 1u) * nloc) {
            __builtin_amdgcn_fence(__ATOMIC_RELEASE, "agent");
            asm volatile("s_waitcnt vmcnt(0)" ::: "memory");
            const unsigned og = xb_add(&bar[XB_TOP], 1u);
            const unsigned tg = og / nx;
            if (og + 1u == (tg + 1u) * nx) xb_add(&bar[XB_TOPGEN], 1u);
            else XB_SPIN(xb_ld(&bar[XB_TOPGEN]) == tg, bar);
            __builtin_amdgcn_fence(__ATOMIC_ACQUIRE, "agent");
            xb_add(&bar[XB_XGEN(b.x)], 1u);
            asm volatile("s_waitcnt vmcnt(0)" ::: "memory");
        } else {
            XB_SPIN(xb_ld(&bar[XB_XGEN(b.x)]) == gen, bar);
            __builtin_amdgcn_fence(__ATOMIC_ACQUIRE, "agent");
            asm volatile("s_waitcnt vmcnt(0)" ::: "memory");
        }
    }
    __syncthreads();
}

constexpr size_t MiB = 1u << 20;
constexpr size_t WS_CTL = 0, CTL_ZERO_BYTES = 192 * 1024;
constexpr size_t WS_SUMSQ = 128 * 1024;
constexpr int CW_BAR = 1024;
constexpr size_t WS_WIN = 1 * MiB;
constexpr size_t WS_WA = 14 * MiB;
constexpr size_t WS_WB = 16 * MiB;
constexpr size_t WS_WO = 17 * MiB;
constexpr size_t WS_WQ = 19 * MiB;
constexpr size_t WS_SKB = 23 * MiB;
constexpr size_t WS_ROPE = 24 * MiB;
constexpr size_t WS_BIAS = 25 * MiB;
constexpr size_t WS_KM = 25 * MiB + 256 * 1024;
constexpr size_t WS_PREV = 26 * MiB;
constexpr size_t WS_ACT = 42 * MiB;
constexpr size_t WS_RQ = WS_ACT, WS_RK = WS_RQ + 16 * MiB, WS_RV = WS_RK + 16 * MiB, WS_RG = WS_RV + 32 * MiB;
constexpr size_t WS_MQ = WS_RG + 32 * MiB, WS_MK = WS_MQ + 16 * MiB, WS_MV = WS_MK + 16 * MiB;
constexpr size_t WS_GA = WS_MV + 16 * MiB, WS_GB = WS_GA + 32 * MiB;
constexpr size_t WS_END = 256 * MiB;
constexpr size_t WS_YB = WS_ACT;
constexpr size_t WS_MRG = WS_ACT + 32 * MiB;
constexpr size_t WS_H2 = WS_ACT + 64 * MiB;
constexpr size_t WS_EG = WS_ACT + 96 * MiB;
constexpr size_t WS_QP = WS_ACT;
constexpr size_t WS_UV = WS_ACT;
constexpr size_t WS_UV8 = WS_ACT + 112 * MiB;
constexpr size_t WS_ST = WS_ACT + 144 * MiB;
static_assert(WS_GB + 32 * MiB <= WS_END && WS_EG + 16 * MiB <= WS_ST && WS_ST + 64 * MiB <= WS_END, "d_ws map");

constexpr int LDS_BYTES = 159 * 1024;
constexpr int MISC_OFF = LDS_BYTES - 256;
constexpr int NWAVES = 8;


using pg8::Unit;
__device__ __forceinline__ void store8_bf16(bf16* p, f32x4 a, f32x4 b) { v4u w; w.x = pk2(a[0], a[1]); w.y = pk2(a[2], a[3]); w.z = pk2(b[0], b[1]); w.w = pk2(b[2], b[3]); *(v4u*)p = w; }
__device__ __forceinline__ void load8_bf16(const bf16* p, f32x4& a, f32x4& b) { const v4u w = *(const v4u*)p; a = (f32x4){bflo(w.x), bfhi(w.x), bflo(w.y), bfhi(w.y)}; b = (f32x4){bflo(w.z), bfhi(w.z), bflo(w.w), bfhi(w.w)}; }
__device__ __forceinline__ float sigmoidf_(float x) { return __builtin_amdgcn_rcpf(1.0f + __builtin_amdgcn_exp2f(-1.4426950408889634f * x)); }
__device__ __forceinline__ f32x4 sig4(f32x4 v) { return (f32x4){sigmoidf_(v[0]), sigmoidf_(v[1]), sigmoidf_(v[2]), sigmoidf_(v[3])}; }
__device__ __forceinline__ f32x4 silu4(f32x4 v) { return v * sig4(v); }

#ifdef MOBA_NAIVE
constexpr float MOBA_QSCALE = 0.125f;
#else
constexpr float MOBA_QSCALE = 0.125f * 1.4426950408889634f;
#endif
struct EpiInProj {
    static constexpr bool AFTER_DRAIN = false;
    bf16 *RQ, *RK, *RV, *RG, *MQ, *MK, *MV, *GA, *GB; const float* rope; const float* qgain; const float* kgain; float* KMP;
    __device__ __forceinline__ void operator()(const f32x4 (&acc)[2][2][4][2], const Unit& u, int wr, int wc, int fr, int fq) const {
        const int pn = u.pn, rowb = u.pm * 256 + wr * 64 + fr, cw = 64 * wc + 8 * fq;
        if (pn < 4) {
            bf16* dst = (pn < 2 ? RQ : RK) + (pn & 1) * 256 + cw; const float sc = pn < 2 ? 1.0f : 0.125f;
#pragma unroll
            for (int ai = 0; ai < 2; ++ai)
#pragma unroll
                for (int m = 0; m < 4; ++m) {
                    const int row = rowb + ai * 128 + m * 16; const float* rp = rope + (size_t)(row & (SEQ - 1)) * 64 + 8 * fq;
                    const f32x4 c0 = *(const f32x4*)rp * sc, c1 = *(const f32x4*)(rp + 4) * sc, s0 = *(const f32x4*)(rp + 32) * sc, s1 = *(const f32x4*)(rp + 36) * sc;
                    const f32x4 x10 = acc[ai][0][m][0], x11 = acc[ai][0][m][1], x20 = acc[ai][1][m][0], x21 = acc[ai][1][m][1];
                    bf16* p = dst + (size_t)row * 512;
                    store8_bf16(p, x10 * c0 - x20 * s0, x11 * c1 - x21 * s1);
                    store8_bf16(p + 32, x10 * s0 + x20 * c0, x11 * s1 + x21 * c1);
                }
        } else if (pn < 12 || (pn >= 16)) {
            bf16* dst; int ld, mode;
            if (pn < 8) { dst = RV + (pn - 4) * 256; ld = 1024; mode = 0; }
            else if (pn < 12) { dst = RG + (pn - 8) * 256; ld = 1024; mode = 1; }
            else if (pn < 18) { dst = MV + (pn - 16) * 256; ld = 512; mode = 0; }
            else if (pn < 22) { dst = GA + (pn - 18) * 256; ld = 1024; mode = 2; }
            else { dst = GB + (pn - 22) * 256; ld = 1024; mode = 2; }
            dst += cw;
#pragma unroll
            for (int ai = 0; ai < 2; ++ai)
#pragma unroll
                for (int m = 0; m < 4; ++m) {
                    const int row = rowb + ai * 128 + m * 16; bf16* p = dst + (size_t)row * ld;
#pragma unroll
                    for (int bj = 0; bj < 2; ++bj) {
                        f32x4 a = acc[ai][bj][m][0], b = acc[ai][bj][m][1];
                        if (mode == 1) { a = silu4(a); b = silu4(b); } else if (mode == 2) { a = sig4(a); b = sig4(b); }
                        store8_bf16(p + 32 * bj, a, b);
                    }
                }
        } else {
            const bool isq = pn < 14; bf16* dst = (isq ? MQ : MK) + (pn & 1) * 256 + cw; const float* gain = (isq ? qgain : kgain) + 8 * fq; const float sc = isq ? MOBA_QSCALE : 1.0f;
            f32x4 cs00 = {0.f, 0.f, 0.f, 0.f}, cs01 = cs00, cs10 = cs00, cs11 = cs00;
            const f32x4 g00 = *(const f32x4*)gain * sc, g01 = *(const f32x4*)(gain + 4) * sc, g10 = *(const f32x4*)(gain + 32) * sc, g11 = *(const f32x4*)(gain + 36) * sc;
#pragma unroll
            for (int ai = 0; ai < 2; ++ai)
#pragma unroll
                for (int m = 0; m < 4; ++m) {
                    const int row = rowb + ai * 128 + m * 16; bf16* p = dst + (size_t)row * 512;
                    const f32x4 a0 = acc[ai][0][m][0], a1 = acc[ai][0][m][1], b0 = acc[ai][1][m][0], b1 = acc[ai][1][m][1];
                    const f32x4 q = a0 * a0 + a1 * a1 + b0 * b0 + b1 * b1; float ss = (q[0] + q[1]) + (q[2] + q[3]);
                    ss += __shfl_xor(ss, 16); ss += __shfl_xor(ss, 32);
                    const float r = rsqrtf(ss * (1.0f / 64.0f) + EPS);
                    const f32x4 y00 = a0 * r * g00, y01 = a1 * r * g01, y10 = b0 * r * g10, y11 = b1 * r * g11;
                    store8_bf16(p, y00, y01);
                    store8_bf16(p + 32, y10, y11);
                    if (!isq) { cs00 += y00; cs01 += y01; cs10 += y10; cs11 += y11; }
                }
            if (!isq) {
#pragma unroll
                for (int e = 0; e < 4; ++e) {
#pragma unroll
                    for (int o = 1; o < 16; o <<= 1) { cs00[e] += __shfl_xor(cs00[e], o); cs01[e] += __shfl_xor(cs01[e], o); cs10[e] += __shfl_xor(cs10[e], o); cs11[e] += __shfl_xor(cs11[e], o); }
                }
                if (fr == 0) { float* kp = KMP + (((size_t)u.pm * 2 + (pn & 1)) * 2 + wr) * 256 + cw;
                    *(f32x4*)kp = cs00; *(f32x4*)(kp + 4) = cs01; *(f32x4*)(kp + 32) = cs10; *(f32x4*)(kp + 36) = cs11; }
            }
        }
    }
};
struct EpiMerge2 {
    static constexpr bool AFTER_DRAIN = false;
    bf16* O; const bf16* GA; const bf16* GB;
    __device__ __forceinline__ void mid(f32x4 (&acc)[2][2][4][2], const Unit& u, int wr, int wc, int fr, int fq) const {
        const int rowb = u.pm * 256 + wr * 64 + fr, col = u.pn * 256 + 64 * wc + 8 * fq;
#pragma unroll
        for (int ai = 0; ai < 2; ++ai)
#pragma unroll
            for (int m = 0; m < 4; ++m) {
                const size_t off = (size_t)(rowb + ai * 128 + m * 16) * 1024 + col;
#pragma unroll
                for (int bj = 0; bj < 2; ++bj) { f32x4 a0, a1, b0, b1; load8_bf16(GA + off + 32 * bj, a0, a1); load8_bf16(GB + off + 32 * bj, b0, b1);
#pragma unroll
                    for (int e = 0; e < 4; ++e) { acc[ai][bj][m][0][e] *= b0[e] * __builtin_amdgcn_rcpf(fmaxf(a0[e], 1e-6f)); acc[ai][bj][m][1][e] *= b1[e] * __builtin_amdgcn_rcpf(fmaxf(a1[e], 1e-6f)); } }
            }
    }
    __device__ __forceinline__ void operator()(const f32x4 (&acc)[2][2][4][2], const Unit& u, int wr, int wc, int fr, int fq) const {
        const int rowb = u.pm * 256 + wr * 64 + fr, col = u.pn * 256 + 64 * wc + 8 * fq;
#pragma unroll
        for (int ai = 0; ai < 2; ++ai)
#pragma unroll
            for (int m = 0; m < 4; ++m) {
                const size_t off = (size_t)(rowb + ai * 128 + m * 16) * 1024 + col;
#pragma unroll
                for (int bj = 0; bj < 2; ++bj) { f32x4 a0, a1; load8_bf16(GA + off + 32 * bj, a0, a1);
#pragma unroll
                    for (int e = 0; e < 4; ++e) { a0[e] = fmaxf(a0[e], 1e-6f); a1[e] = fmaxf(a1[e], 1e-6f); }
                    store8_bf16(O + off + 32 * bj, acc[ai][bj][m][0] * a0, acc[ai][bj][m][1] * a1); }
            }
    }
};
struct TwoSegOrder {
    pg8::StaticOrder B;
    __device__ __forceinline__ bool next(int i, pg8::Unit& u) const { if (!B.next(i >> 1, u)) return false; u.seg = i & 1; return true; }
    __device__ __forceinline__ void a_ready(const pg8::Unit&) const {}
    __device__ __forceinline__ void done(const pg8::Unit&) const {}
};
struct EpiResid {
    static constexpr bool AFTER_DRAIN = false;
    const float* base; float* out; bf16* XG; const float* g2; float* SS;
    __device__ __forceinline__ void operator()(const f32x4 (&acc)[2][2][4][2], const Unit& u, int wr, int wc, int fr, int fq) const {
        const int rowb = u.pm * 256 + wr * 64 + fr, col = u.pn * 256 + 64 * wc + 8 * fq;
        const f32x4 g00 = *(const f32x4*)(g2 + col), g01 = *(const f32x4*)(g2 + col + 4), g10 = *(const f32x4*)(g2 + col + 32), g11 = *(const f32x4*)(g2 + col + 36);
#pragma unroll
        for (int ai = 0; ai < 2; ++ai)
#pragma unroll
            for (int m = 0; m < 4; ++m) {
                const int row = rowb + ai * 128 + m * 16; const size_t off = (size_t)row * 1024 + col;
                const f32x4 x00 = *(const f32x4*)(base + off) + acc[ai][0][m][0], x01 = *(const f32x4*)(base + off + 4) + acc[ai][0][m][1];
                const f32x4 x10 = *(const f32x4*)(base + off + 32) + acc[ai][1][m][0], x11 = *(const f32x4*)(base + off + 36) + acc[ai][1][m][1];
                *(f32x4*)(out + off) = x00; *(f32x4*)(out + off + 4) = x01; *(f32x4*)(out + off + 32) = x10; *(f32x4*)(out + off + 36) = x11;
                store8_bf16(XG + off, x00 * g00, x01 * g01); store8_bf16(XG + off + 32, x10 * g10, x11 * g11);
                const f32x4 q = x00 * x00 + x01 * x01 + x10 * x10 + x11 * x11; float ss = (q[0] + q[1]) + (q[2] + q[3]);
                ss += __shfl_xor(ss, 16); ss += __shfl_xor(ss, 32);
                if (fq == 0) atomicAdd(SS + row, ss);
            }
    }
};
struct EpiPlainBf16 {
    static constexpr bool AFTER_DRAIN = false;
    bf16* O; int ldc;
    __device__ __forceinline__ void operator()(const f32x4 (&acc)[2][2][4][2], const Unit& u, int wr, int wc, int fr, int fq) const {
        const int rowb = u.pm * 256 + wr * 64 + fr, col = u.pn * 256 + 64 * wc + 8 * fq;
#pragma unroll
        for (int ai = 0; ai < 2; ++ai)
#pragma unroll
            for (int m = 0; m < 4; ++m) {
                const size_t off = (size_t)(rowb + ai * 128 + m * 16) * ldc + col;
#pragma unroll
                for (int bj = 0; bj < 2; ++bj) store8_bf16(O + off + 32 * bj, acc[ai][bj][m][0], acc[ai][bj][m][1]);
            }
    }
};
struct EpiNatBf16 {
    static constexpr bool AFTER_DRAIN = false;
    bf16* O; int ldc; const float* SS;
    __device__ __forceinline__ void operator()(const f32x4 (&acc)[2][2][4][2], const Unit& u, int wr, int wc, int fr, int fq) const {
        const int rowb = u.pm * 256 + wr * 64 + fr, col = u.pn * 256 + 32 * wc + 4 * fq;
        f32x4 rs[2][2];
#pragma unroll
        for (int bj = 0; bj < 2; ++bj)
#pragma unroll
            for (int n = 0; n < 2; ++n) { const f32x4 s = *(const f32x4*)(SS + col + 128 * bj + 16 * n); rs[bj][n] = (f32x4){rsqrtf(s[0] * (1.0f / DM) + EPS), rsqrtf(s[1] * (1.0f / DM) + EPS), rsqrtf(s[2] * (1.0f / DM) + EPS), rsqrtf(s[3] * (1.0f / DM) + EPS)}; }
#pragma unroll
        for (int ai = 0; ai < 2; ++ai)
#pragma unroll
            for (int m = 0; m < 4; ++m) {
                const size_t off = (size_t)(rowb + ai * 128 + m * 16) * ldc + col;
#pragma unroll
                for (int bj = 0; bj < 2; ++bj)
#pragma unroll
                    for (int n = 0; n < 2; ++n) { const f32x4 v = acc[ai][bj][m][n] * rs[bj][n]; v2u w; w.x = pk2(v[0], v[1]); w.y = pk2(v[2], v[3]); *(v2u*)(O + off + 128 * bj + 16 * n) = w; }
            }
    }
};

struct Frame {
    LAS unsigned char* lds;
    volatile LAS unsigned* MISC;
    gu32* ctl;
    int tid, lane, wave, G, bid;
};

__device__ __forceinline__ void p0_transpose_item(const float* W, int K, int N, bf16* WT, LAS float* scr, int item, int lane) {
    const int nblk = N / 32, kb = item / nblk, nb = item % nblk, k0 = 64 * kb, n0 = 32 * nb;
#pragma unroll 8
    for (int i = 0; i < 32; ++i) { const int kk = 2 * i + (lane >> 5); scr[kk * 33 + (lane & 31)] = W[(size_t)(k0 + kk) * N + n0 + (lane & 31)]; }
    LDS_WAIT(); asm volatile("" ::: "memory");
    const int c = lane & 7;
#pragma unroll
    for (int j = 0; j < 4; ++j) { const int n = (lane >> 3) + 8 * j; const LAS float* s = scr + (8 * c) * 33 + n;
        v4u o; o.x = pk2(s[0 * 33], s[1 * 33]); o.y = pk2(s[2 * 33], s[3 * 33]); o.z = pk2(s[4 * 33], s[5 * 33]); o.w = pk2(s[6 * 33], s[7 * 33]);
        *(GAS v4u*)(WT + (size_t)perm_row_of_col(n0 + n) * K + k0 + 8 * c) = o; }
    LDS_WAIT(); asm volatile("" ::: "memory");
}
__device__ __forceinline__ void rms_row_to_bf16(const float* xrow, const float* g, bf16* orow, int lane) {
    const GAS f32x4* xr = (const GAS f32x4*)xrow + lane; const GAS f32x4* gr = (const GAS f32x4*)g + lane;
    f32x4 v[4]; float s = 0.f;
#pragma unroll
    for (int j = 0; j < 4; ++j) { v[j] = __builtin_nontemporal_load(&xr[64 * j]); s += (v[j].x * v[j].x + v[j].y * v[j].y) + (v[j].z * v[j].z + v[j].w * v[j].w); }
    const float r = rsqrtf(wave_sum(s) * (1.0f / DM) + EPS);
    GAS v2u* o8 = (GAS v2u*)orow + lane;
#pragma unroll
    for (int j = 0; j < 4; ++j) { const f32x4 gg = gr[64 * j]; v2u w; w.x = pk2(v[j].x * r * gg.x, v[j].y * r * gg.y); w.y = pk2(v[j].z * r * gg.z, v[j].w * r * gg.w); o8[64 * j] = w; }
}
__device__ __forceinline__ float t5_bias_of_dist(const float* rel_bias, int h, int dist) {
    int bkt;
    if (dist < 16) bkt = dist;
    else { const float nf = (float)dist; int lg = 16 + (int)(logf(nf / 16.0f) / 4.852030263919617f * 16.0f); bkt = lg < 31 ? lg : 31; }
    return rel_bias[bkt * MH + h];
}

struct Ptrs {
    const float *x, *mix_g, *w_in, *ret_w, *q_gain, *k_gain, *moba_w, *rel_bias, *w_out, *ffn_g, *peer_wq, *sub_keys, *peer_u, *peer_v;
    float* out; unsigned char* ws;
};

__device__ __forceinline__ void p0_prologue(Frame& F, const Ptrs& P) {
    LAS float* scr = (LAS float*)(F.lds + F.wave * 16384);
    const int gw = F.bid * NWAVES + F.wave, NGW = F.G * NWAVES;
    unsigned char* ws = P.ws;
    constexpr int I_IN = (DM / 64) * (INW / 32), I_A = (1024 / 64) * (1024 / 32), I_B = (512 / 64) * (1024 / 32), I_O = I_A, I_Q = (1024 / 64) * (2048 / 32);
    constexpr int NITEMS = I_IN + I_A + I_B + I_O; (void)I_Q;
    (void)NITEMS;
    for (int it = gw; it < I_IN; it += NGW) p0_transpose_item(P.w_in, DM, INW, (bf16*)(ws + WS_WIN), scr, it, F.lane);
    bf16* XN = (bf16*)P.out;
    for (int m = gw; m < T; m += NGW) rms_row_to_bf16(P.x + (size_t)m * DM, P.mix_g, XN + (size_t)m * DM, F.lane);
    const int gt = F.bid * 512 + F.tid, NGT = F.G * 512;
    float* rope = (float*)(ws + WS_ROPE);
    for (int i = gt; i < SEQ * 32; i += NGT) { const int pos = i >> 5, j = i & 31; const float inv = powf(10000.0f, -(float)j / 32.0f); const float ang = (float)pos * inv; float sn, cs; sincosf(ang, &sn, &cs);
        rope[pos * 64 + j] = cs; rope[pos * 64 + 32 + j] = sn; }
    float* BT = (float*)(ws + WS_BIAS);
    for (int i = gt; i < MH * SEQ; i += NGT) { const int h = i >> 12, dist = i & (SEQ - 1); BT[i] = t5_bias_of_dist(P.rel_bias, h, dist); }
}


__device__ __forceinline__ void p0b_late_weights(Frame& F, const Ptrs& P, int idx, int n) {
    LAS float* scr = (LAS float*)(F.lds + F.wave * 16384);
    const int gw = idx * NWAVES + F.wave, NGW = n * NWAVES;
    unsigned char* ws = P.ws;
    constexpr int I_A = (1024 / 64) * (1024 / 32), I_B = (512 / 64) * (1024 / 32), I_O = I_A;
    for (int it = gw; it < I_A + I_B + I_O; it += NGW) {
        int r = it;
        if (r < I_A) { p0_transpose_item(P.ret_w, 1024, 1024, (bf16*)(ws + WS_WA), scr, r, F.lane); continue; } r -= I_A;
        if (r < I_B) { p0_transpose_item(P.moba_w, 512, 1024, (bf16*)(ws + WS_WB), scr, r, F.lane); continue; } r -= I_B;
        p0_transpose_item(P.w_out, 1024, 1024, (bf16*)(ws + WS_WO), scr, r, F.lane);
    }
    { bf16* WST = (bf16*)(ws + WS_WQ);
      for (int wt = gw; wt < 16 * 4 * 32; wt += NGW) {
          const int blk = wt >> 7, nt = (wt >> 5) & 3, mt = wt & 31, r32 = F.lane & 31, hi = F.lane >> 5;
          const float* ap = P.sub_keys + ((size_t)blk * PNK + 32 * nt + r32) * 128 + 8 * hi;
          const float* bp = P.peer_wq + (size_t)(32 * mt + r32) * 2048 + blk * 128 + 8 * hi;
          f32x16 acc;
#pragma unroll
          for (int r = 0; r < 16; ++r) acc[r] = 0.f;
#pragma unroll
          for (int ds = 0; ds < 8; ++ds) {
              const f32x4 a0 = *(const f32x4*)(ap + 16 * ds), a1 = *(const f32x4*)(ap + 16 * ds + 4), b0 = *(const f32x4*)(bp + 16 * ds), b1 = *(const f32x4*)(bp + 16 * ds + 4);
              v4u aw, bw; aw.x = pk2(a0[0], a0[1]); aw.y = pk2(a0[2], a0[3]); aw.z = pk2(a1[0], a1[1]); aw.w = pk2(a1[2], a1[3]);
              bw.x = pk2(b0[0], b0[1]); bw.y = pk2(b0[2], b0[3]); bw.z = pk2(b1[0], b1[1]); bw.w = pk2(b1[2], b1[3]);
              acc = __builtin_amdgcn_mfma_f32_32x32x16_bf16(__builtin_bit_cast(bf16x8, aw), __builtin_bit_cast(bf16x8, bw), acc, 0, 0, 0);
          }
          bf16* op = WST + ((size_t)blk * 128 + 32 * nt) * DM + 32 * mt + r32;
#pragma unroll
          for (int r = 0; r < 16; ++r) op[(size_t)((r & 3) + 8 * (r >> 2) + 4 * hi) * DM] = (bf16)f2bf(acc[r]);
      } }
}
__device__ __forceinline__ void p2a_kv(Frame& F, const Ptrs& P) {
    unsigned char* ws = P.ws; const bf16* RK = (const bf16*)(ws + WS_RK); const bf16* RV = (const bf16*)(ws + WS_RV); const bf16* MK = (const bf16*)(ws + WS_MK);
    float* KVT = (float*)((unsigned char*)P.out + 32 * MiB); float* KM = (float*)(ws + WS_KM);
    LAS bf16* lK = (LAS bf16*)F.lds;
    LAS bf16* lV = (LAS bf16*)(F.lds + 16384);
    const int tid = F.tid;
    for (int task = F.bid; task < BATCH * RH * NCH; task += F.G) {
        const int b = task >> 8, h = (task >> 5) & 7, n = task & 31; const size_t row0 = (size_t)b * SEQ + n * RC; const float l2g = ret_l2g(h);
#pragma unroll
        for (int j = 0; j < 2; ++j) { const int idx = tid + 512 * j, c = idx >> 3, part = idx & 7; *(LAS v4u*)(lK + c * 64 + part * 8) = *(const v4u*)(RK + (row0 + c) * 512 + h * 64 + part * 8); }
#pragma unroll
        for (int j = 0; j < 4; ++j) { const int idx = tid + 512 * j, c = idx >> 4, part = idx & 15; *(LAS v4u*)(lV + c * 128 + part * 8) = *(const v4u*)(RV + (row0 + c) * 1024 + h * 128 + part * 8); }
        __syncthreads();
        const int dk = tid & 63, dv0 = (tid >> 6) * 16;
        float acc[16];
#pragma unroll
        for (int e = 0; e < 16; ++e) acc[e] = 0.f;
        for (int c = 0; c < RC; ++c) {
            const float kd = bf2f(lK[c * 64 + dk]) * exp2f((float)(RC - 1 - c) * l2g);
            const v4u v0 = *(LAS v4u*)(lV + c * 128 + dv0), v1 = *(LAS v4u*)(lV + c * 128 + dv0 + 8);
            acc[0] += kd * bflo(v0.x); acc[1] += kd * bfhi(v0.x); acc[2] += kd * bflo(v0.y); acc[3] += kd * bfhi(v0.y);
            acc[4] += kd * bflo(v0.z); acc[5] += kd * bfhi(v0.z); acc[6] += kd * bflo(v0.w); acc[7] += kd * bfhi(v0.w);
            acc[8] += kd * bflo(v1.x); acc[9] += kd * bfhi(v1.x); acc[10] += kd * bflo(v1.y); acc[11] += kd * bfhi(v1.y);
            acc[12] += kd * bflo(v1.z); acc[13] += kd * bfhi(v1.z); acc[14] += kd * bflo(v1.w); acc[15] += kd * bfhi(v1.w);
        }
        float* o = KVT + (size_t)task * (RDV * RDK);
#pragma unroll
        for (int e = 0; e < 16; ++e) o[(dv0 + e) * 64 + dk] = acc[e];
        __syncthreads();
    }
    const int gw = F.bid * NWAVES + F.wave, NGW = F.G * NWAVES;
    for (int wt = gw; wt < BATCH * MH * NBLK; wt += NGW) {
        const int b = wt >> 7, h = (wt >> 4) & 7, blk = wt & 15; const bf16* p = MK + ((size_t)b * SEQ + blk * MBLK) * 512 + h * 64 + F.lane;
        float s = 0.f;
        for (int j = 0; j < MBLK; ++j) s += bf2f(p[(size_t)j * 512]);
        KM[wt * 64 + F.lane] = s * (1.0f / MBLK);
    }
}
__device__ __forceinline__ void p2b_scan(Frame& F, const Ptrs& P) {
    const float* KVT = (const float*)((unsigned char*)P.out + 32 * MiB); bf16* PREV = (bf16*)(P.ws + WS_PREV);
    const int gt = F.bid * 512 + F.tid, NGT = F.G * 512;
    for (int e = gt; e < BATCH * RH * RDV * RDK; e += NGT) {
        const int bh = e >> 13, el = e & 8191, h = bh & 7; const float dC = exp2f((float)RC * ret_l2g(h));
        float S = 0.f; const size_t base = (size_t)bh * NCH * 8192 + el;
        for (int n = 0; n < NCH; ++n) { PREV[base + (size_t)n * 8192] = (bf16)f2bf(S); S = S * dC + KVT[base + (size_t)n * 8192]; }
    }
}
__device__ __forceinline__ void p3a_retention(Frame& F, const Ptrs& P) {
    unsigned char* ws = P.ws; const bf16* RQ = (const bf16*)(ws + WS_RQ); const bf16* RK = (const bf16*)(ws + WS_RK); const bf16* RV = (const bf16*)(ws + WS_RV);
    const bf16* RG = (const bf16*)(ws + WS_RG); const bf16* PREV = (const bf16*)(ws + WS_PREV); bf16* RETG = (bf16*)P.out;
    LAS bf16* lQ = (LAS bf16*)F.lds;
    LAS bf16* lK = (LAS bf16*)(F.lds + 16384);
    LAS bf16* lV = (LAS bf16*)(F.lds + 16384 + 16896);
    LAS bf16* lP = (LAS bf16*)(F.lds + 16384 + 16896 + 32768);
    LAS float* lS = (LAS float*)(F.lds + 16384 + 16896 + 32768 + 16896);
    const int tid = F.tid, lane = F.lane, wave = F.wave;
    for (int task = F.bid; task < BATCH * RH * NCH; task += F.G) {
        const int b = task >> 8, h = (task >> 5) & 7, n = task & 31; const size_t row0 = (size_t)b * SEQ + n * RC; const float l2g = ret_l2g(h);
#pragma unroll
        for (int j = 0; j < 2; ++j) { const int idx = tid + 512 * j, c = idx >> 3, part = idx & 7; *(LAS v4u*)(lQ + c * 64 + part * 8) = *(const v4u*)(RQ + (row0 + c) * 512 + h * 64 + part * 8); }
#pragma unroll
        for (int j = 0; j < 8; ++j) { const int idx = tid + 512 * j, c = idx >> 5, w = idx & 31; *(LAS unsigned*)(lK + c * 66 + w * 2) = *(const unsigned*)(RK + (row0 + c) * 512 + h * 64 + w * 2); }
#pragma unroll
        for (int j = 0; j < 4; ++j) { const int idx = tid + 512 * j, c = idx >> 4, part = idx & 15; *(LAS v4u*)(lV + c * 128 + part * 8) = *(const v4u*)(RV + (row0 + c) * 1024 + h * 128 + part * 8); }
#pragma unroll
        for (int j = 0; j < 8; ++j) { const int idx = tid + 512 * j, dv = idx >> 5, w = idx & 31; *(LAS unsigned*)(lP + dv * 66 + w * 2) = *(const unsigned*)(PREV + (size_t)task * 8192 + dv * 64 + w * 2); }
        __syncthreads();
        for (int t = 0; t < 32; ++t) {
            const int e = tid + 512 * t, i = e >> 7, j = e & 127;
            float s = 0.f;
            if (j <= i) {
                float d = 0.f;
#pragma unroll
                for (int w = 0; w < 32; ++w) { const unsigned qa = *(LAS unsigned*)(lQ + i * 64 + 2 * w), ka = *(LAS unsigned*)(lK + j * 66 + 2 * w); d += bflo(qa) * bflo(ka) + bfhi(qa) * bfhi(ka); }
                s = d * exp2f((float)(i - j) * l2g);
            }
            lS[i * 128 + j] = s;
        }
        __syncthreads();
        for (int r = 0; r < 16; ++r) {
            const int i = wave * 16 + r;
            float a0 = 0.f, a1 = 0.f;
            for (int j = 0; j <= i; ++j) { const float sv = lS[i * 128 + j]; a0 += sv * bf2f(lV[j * 128 + lane]); a1 += sv * bf2f(lV[j * 128 + lane + 64]); }
            float c0 = 0.f, c1 = 0.f;
#pragma unroll 8
            for (int w = 0; w < 32; ++w) { const unsigned qa = *(LAS unsigned*)(lQ + i * 64 + 2 * w), p0 = *(LAS unsigned*)(lP + lane * 66 + 2 * w), p1 = *(LAS unsigned*)(lP + (lane + 64) * 66 + 2 * w);
                c0 += bflo(qa) * bflo(p0) + bfhi(qa) * bfhi(p0); c1 += bflo(qa) * bflo(p1) + bfhi(qa) * bfhi(p1); }
            const float qd = exp2f((float)(i + 1) * l2g);
            const float o0 = a0 + c0 * qd, o1 = a1 + c1 * qd;
            const float mu = wave_sum(o0 + o1) * (1.0f / RDV); const float d0 = o0 - mu, d1 = o1 - mu;
            const float var = wave_sum(d0 * d0 + d1 * d1) * (1.0f / RDV); const float rs = rsqrtf(var + EPS);
            const size_t off = (row0 + i) * 1024 + h * 128 + lane;
            RETG[off] = (bf16)f2bf(d0 * rs * bf2f(RG[off])); RETG[off + 64] = (bf16)f2bf(d1 * rs * bf2f(RG[off + 64]));
        }
        __syncthreads();
    }
}
__device__ __forceinline__ void p3b_moba(Frame& F, const Ptrs& P) {
    unsigned char* ws = P.ws; const bf16* MQ = (const bf16*)(ws + WS_MQ); const bf16* MK = (const bf16*)(ws + WS_MK); const bf16* MV = (const bf16*)(ws + WS_MV);
    const float* KM = (const float*)(ws + WS_KM); const float* BT = (const float*)(ws + WS_BIAS); bf16* ATT = (bf16*)((unsigned char*)P.out + 32 * MiB);
    LAS float* lB = (LAS float*)F.lds;
    LAS bf16* lK = (LAS bf16*)(F.lds + 16384);
    LAS bf16* lV = (LAS bf16*)(F.lds + 16384 + 32768);
    LAS float* lKM = (LAS float*)(F.lds + 16384 + 65536);
    const int tid = F.tid, ql = tid >> 2, sub = tid & 3;
    for (int unit = F.bid; unit < BATCH * MH * 32; unit += F.G) {
        const int qh = 31 - (unit >> 5), bh = unit & 31, b = bh >> 3, h = bh & 7;
        const int qpos = qh * 128 + ql, qb = qh >> 1;
        for (int i = tid; i < SEQ; i += 512) lB[i] = BT[h * SEQ + i];
        float qf[64];
        { const bf16* qp = MQ + ((size_t)b * SEQ + qpos) * 512 + h * 64;
#pragma unroll
          for (int w = 0; w < 8; ++w) { const v4u x = *(const v4u*)(qp + 8 * w); qf[8 * w] = bflo(x.x); qf[8 * w + 1] = bfhi(x.x); qf[8 * w + 2] = bflo(x.y); qf[8 * w + 3] = bfhi(x.y);
              qf[8 * w + 4] = bflo(x.z); qf[8 * w + 5] = bfhi(x.z); qf[8 * w + 6] = bflo(x.w); qf[8 * w + 7] = bfhi(x.w); } }
        for (int i = tid; i < qb * 64; i += 512) lKM[i] = KM[(size_t)bh * NBLK * 64 + i];
        __syncthreads();
        unsigned mask;
        if (qb <= 3) mask = (1u << qb) - 1u;
        else {
            float g1 = -3e38f, g2 = -3e38f, g3 = -3e38f; int i1 = 0, i2 = 0, i3 = 0;
            for (int kb = 0; kb < qb; ++kb) {
                const LAS float* km = lKM + kb * 64; float g = 0.f;
#pragma unroll
                for (int d = 0; d < 64; ++d) g += qf[d] * km[d];
                if (g > g1) { g3 = g2; i3 = i2; g2 = g1; i2 = i1; g1 = g; i1 = kb; }
                else if (g > g2) { g3 = g2; i3 = i2; g2 = g; i2 = kb; }
                else if (g > g3) { g3 = g; i3 = kb; }
            }
            mask = (1u << i1) | (1u << i2) | (1u << i3);
        }
        float m = -1e30f, l = 0.f, o[64];
#pragma unroll
        for (int d = 0; d < 64; ++d) o[d] = 0.f;
        for (int kb = 0; kb <= qb; ++kb) {
            __syncthreads();
            const size_t krow0 = (size_t)b * SEQ + kb * MBLK;
#pragma unroll
            for (int j = 0; j < 4; ++j) { const int idx = tid + 512 * j, r = idx >> 3, part = idx & 7;
                *(LAS v4u*)(lK + r * 64 + part * 8) = *(const v4u*)(MK + (krow0 + r) * 512 + h * 64 + part * 8);
                *(LAS v4u*)(lV + r * 64 + part * 8) = *(const v4u*)(MV + (krow0 + r) * 512 + h * 64 + part * 8); }
            __syncthreads();
            const bool act = (kb == qb) || ((mask >> kb) & 1u);
            if (act) {
                for (int jj = 0; jj < 64; ++jj) {
                    const int j = jj * 4 + sub, kpos = kb * MBLK + j;
                    if (kpos > qpos) continue;
                    float dot = 0.f;
#pragma unroll
                    for (int w = 0; w < 8; ++w) { const v4u x = *(LAS v4u*)(lK + j * 64 + 8 * w);
                        dot += qf[8 * w] * bflo(x.x) + qf[8 * w + 1] * bfhi(x.x) + qf[8 * w + 2] * bflo(x.y) + qf[8 * w + 3] * bfhi(x.y)
                             + qf[8 * w + 4] * bflo(x.z) + qf[8 * w + 5] * bfhi(x.z) + qf[8 * w + 6] * bflo(x.w) + qf[8 * w + 7] * bfhi(x.w); }
                    const float logit = dot + lB[qpos - kpos];
                    const float mn = fmaxf(m, logit), sc = __expf(m - mn), p = __expf(logit - mn);
                    l = l * sc + p; m = mn;
#pragma unroll
                    for (int w = 0; w < 8; ++w) { const v4u x = *(LAS v4u*)(lV + j * 64 + 8 * w);
                        o[8 * w] = o[8 * w] * sc + p * bflo(x.x); o[8 * w + 1] = o[8 * w + 1] * sc + p * bfhi(x.x); o[8 * w + 2] = o[8 * w + 2] * sc + p * bflo(x.y); o[8 * w + 3] = o[8 * w + 3] * sc + p * bfhi(x.y);
                        o[8 * w + 4] = o[8 * w + 4] * sc + p * bflo(x.z); o[8 * w + 5] = o[8 * w + 5] * sc + p * bfhi(x.z); o[8 * w + 6] = o[8 * w + 6] * sc + p * bflo(x.w); o[8 * w + 7] = o[8 * w + 7] * sc + p * bfhi(x.w); }
                }
            }
        }
        float mm = fmaxf(m, __shfl_xor(m, 1)); mm = fmaxf(mm, __shfl_xor(mm, 2));
        const float f = __expf(m - mm); l *= f; l += __shfl_xor(l, 1); l += __shfl_xor(l, 2);
        const float il = 1.0f / l;
#pragma unroll
        for (int d = 0; d < 64; ++d) { float v = o[d] * f; v += __shfl_xor(v, 1); v += __shfl_xor(v, 2); o[d] = v * il; }
        bf16* op = ATT + ((size_t)b * SEQ + qpos) * 512 + h * 64;
#pragma unroll
        for (int s4 = 0; s4 < 4; ++s4) if (sub == s4) {
            v4u w0, w1; w0.x = pk2(o[16 * s4], o[16 * s4 + 1]); w0.y = pk2(o[16 * s4 + 2], o[16 * s4 + 3]); w0.z = pk2(o[16 * s4 + 4], o[16 * s4 + 5]); w0.w = pk2(o[16 * s4 + 6], o[16 * s4 + 7]);
            w1.x = pk2(o[16 * s4 + 8], o[16 * s4 + 9]); w1.y = pk2(o[16 * s4 + 10], o[16 * s4 + 11]); w1.z = pk2(o[16 * s4 + 12], o[16 * s4 + 13]); w1.w = pk2(o[16 * s4 + 14], o[16 * s4 + 15]);
            *(v4u*)(op + 16 * s4) = w0; *(v4u*)(op + 16 * s4 + 8) = w1; }
        __syncthreads();
    }
}

typedef short s16x4 __attribute__((ext_vector_type(4)));
typedef short v4i16_t __attribute__((ext_vector_type(4)));
__device__ __forceinline__ s16x4 vtr_read(const LAS unsigned char* p) { return __builtin_bit_cast(s16x4, __builtin_amdgcn_ds_read_tr16_b64_v4i16((LAS v4i16_t*)p)); }
constexpr float LOG2E = 1.4426950408889634f;
constexpr float MOBA_NEG = -1.0e30f;
constexpr float MOBA_THR = 3.0f;
constexpr int MB_LB = 0, MB_LKM = 16640, MB_WSC = 20480, MB_K0 = 24576, MB_V0 = 24576 + 65536;
static_assert(MB_V0 + 65536 <= MISC_OFF, "MoBA LDS map");

template <int ABL> __device__ __forceinline__ void p3b_moba_mfma(Frame& F, const Ptrs& P) {
    unsigned char* ws = P.ws; const bf16* MQ = (const bf16*)(ws + WS_MQ); const bf16* MK = (const bf16*)(ws + WS_MK); const bf16* MV = (const bf16*)(ws + WS_MV);
    const float* KMP = (const float*)(ws + WS_KM); const float* BT = (const float*)(ws + WS_BIAS); bf16* ATT = (bf16*)((unsigned char*)P.out + (ABL ? 48 : 32) * MiB);
    LAS float* lB = (LAS float*)(F.lds + MB_LB);
    LAS float* lKM = (LAS float*)(F.lds + MB_LKM);
    LAS float* wsc = (LAS float*)(F.lds + MB_WSC) + F.wave * 64;
    const int tid = F.tid, lane = F.lane, wave = F.wave, r32 = lane & 31, hi = lane >> 5;
    for (int vcu0 = F.bid; vcu0 < 256; vcu0 += F.G) {
    const int vcu = (F.G == 256) ? (vcu0 & 7) * 32 + (vcu0 >> 3) : vcu0;
    const int bh = vcu >> 3, sidx = vcu & 7, b = bh >> 3, h = bh & 7;
    __syncthreads();
    for (int i = tid; i < SEQ + 64; i += 512) lB[i] = (i < 64) ? 0.f : BT[h * SEQ + (i - 64)] * LOG2E;
    unsigned ksrc[4], vsrc[4];
#pragma unroll
    for (int j = 0; j < 4; ++j) { const int pc = wave * 4 + j, krow = 8 * pc + (lane >> 3); ksrc[j] = (unsigned)(krow * 512 + (((lane & 7) ^ (krow & 7)) * 8));
        const int vkey = 8 * pc + ((lane & 31) >> 2); vsrc[j] = (unsigned)(vkey * 512 + 32 * (lane >> 5) + 8 * (lane & 3)); }
#define MOBA_STAGE(kgp, vgp, kdst, vdst) do { _Pragma("unroll") for (int j = 0; j < 4; ++j) { \
        __builtin_amdgcn_global_load_lds((const unsigned*)((kgp) + ksrc[j]), (LAS unsigned*)(F.lds + (kdst) + (wave * 4 + j) * 1024), 16, 0, 0); \
        __builtin_amdgcn_global_load_lds((const unsigned*)((vgp) + vsrc[j]), (LAS unsigned*)(F.lds + (vdst) + (wave * 4 + j) * 1024), 16, 0, 0); } } while (0)
    const unsigned vbase = (unsigned)((4 * hi + ((lane & 15) >> 2)) * 64 + ((lane >> 4) & 1) * 32 + (lane & 3) * 8);
    for (int ui = 0; ui < 2; ++ui) {
        const int qb = ui == 0 ? 15 - sidx : sidx;
        const int nblk = qb + 1;
        __syncthreads();
        for (int i = tid; i < qb * 64; i += 512) { const int kb = i >> 6, dd = i & 63; const float* kp = KMP + (((size_t)(b * NBLK + kb) * 2 + (h >> 2)) * 2) * 256 + (h & 3) * 64 + dd; lKM[i] = (kp[0] + kp[256]) * (1.0f / MBLK); }
        const int qw0 = qb * MBLK + wave * 32, qpos = qw0 + r32;
        bf16x8 qf[4];
        { const bf16* qp = MQ + ((size_t)b * SEQ + qpos) * 512 + h * 64 + 8 * hi;
#pragma unroll
          for (int ds = 0; ds < 4; ++ds) qf[ds] = *(const bf16x8*)(qp + 16 * ds); }
        { const bf16* kg = MK + ((size_t)b * SEQ + (size_t)qb * MBLK) * 512 + h * 64; const bf16* vg = MV + ((size_t)b * SEQ + (size_t)qb * MBLK) * 512 + h * 64;
          MOBA_STAGE(kg, vg, MB_K0, MB_V0); }
        VM_WAIT(); __syncthreads();
        unsigned mask;
        if (qb <= 3) mask = (1u << qb) - 1u;
        else {
            float g1 = -3e38f, g2 = -3e38f, g3 = -3e38f; int i1 = 0, i2 = 0, i3 = 0;
            for (int kb = 0; kb < qb; ++kb) {
                float g = 0.f;
#pragma unroll
                for (int ds = 0; ds < 4; ++ds) { const LAS float* km = lKM + kb * 64 + 16 * ds + 8 * hi; const f32x4 k0 = *(const LAS f32x4*)km, k1 = *(const LAS f32x4*)(km + 4);
                    const v4u qx = __builtin_bit_cast(v4u, qf[ds]);
                    g += bflo(qx.x) * k0[0] + bfhi(qx.x) * k0[1] + bflo(qx.y) * k0[2] + bfhi(qx.y) * k0[3] + bflo(qx.z) * k1[0] + bfhi(qx.z) * k1[1] + bflo(qx.w) * k1[2] + bfhi(qx.w) * k1[3]; }
                g += __shfl_xor(g, 32);
                if (g > g1) { g3 = g2; i3 = i2; g2 = g1; i2 = i1; g1 = g; i1 = kb; }
                else if (g > g2) { g3 = g2; i3 = i2; g2 = g; i2 = kb; }
                else if (g > g3) { g3 = g; i3 = kb; }
            }
            mask = (1u << i1) | (1u << i2) | (1u << i3);
        }
        float m = 0.f, l = 0.f; bool first = true, pending = false;
        f32x16 o0, o1; v4u ppa[4]; unsigned pvoff = MB_V0;
#pragma unroll
        for (int r = 0; r < 16; ++r) { o0[r] = 0.f; o1[r] = 0.f; }
#pragma unroll
        for (int q = 0; q < 4; ++q) ppa[q] = (v4u){0u, 0u, 0u, 0u};
#define MOBA_PV(pa_, voff_) do { const LAS unsigned char* vp_ = F.lds + (voff_) + vbase; \
        _Pragma("unroll") for (int ks = 0; ks < 4; ++ks) { const bf16x8 pav = __builtin_bit_cast(bf16x8, pa_[ks]); \
            _Pragma("unroll") for (int db = 0; db < 2; ++db) { const s16x4 lo = vtr_read(vp_ + ((2 * ks) * 2 + db) * 512), hh = vtr_read(vp_ + ((2 * ks + 1) * 2 + db) * 512); \
                const bf16x8 vf = (bf16x8){lo[0], lo[1], lo[2], lo[3], hh[0], hh[1], hh[2], hh[3]}; \
                if (db == 0) o0 = __builtin_amdgcn_mfma_f32_32x32x16_bf16(pav, vf, o0, 0, 0, 0); else o1 = __builtin_amdgcn_mfma_f32_32x32x16_bf16(pav, vf, o1, 0, 0, 0); } } } while (0)
        for (int bi = 0; bi < nblk; ++bi) {
            const int kb = bi == 0 ? qb : bi - 1;
            const unsigned kbuf = MB_K0 + (bi & 1) * 32768, vbuf = MB_V0 + (bi & 1) * 32768;
            const bool has_next = bi + 1 < nblk;
            if (has_next) { const int kn = bi;
                if (pending) { MOBA_PV(ppa, pvoff); pending = false;
#pragma unroll
                    for (int q = 0; q < 4; ++q) ppa[q] = (v4u){0u, 0u, 0u, 0u}; }
                const bf16* kg = MK + ((size_t)b * SEQ + (size_t)kn * MBLK) * 512 + h * 64; const bf16* vg = MV + ((size_t)b * SEQ + (size_t)kn * MBLK) * 512 + h * 64;
                MOBA_STAGE(kg, vg, MB_K0 + ((bi + 1) & 1) * 32768, MB_V0 + ((bi + 1) & 1) * 32768); }
            const bool own = bi == 0;
            const bool sel = own || ((mask >> kb) & 1u);
            if (!(ABL & 16) && __any(sel)) {
                float msub = sel ? m : 1.0e30f;
                f32x16 cneg;
#pragma unroll
                for (int r = 0; r < 16; ++r) cneg[r] = -msub;
                const int npair = own ? (wave >> 1) + 1 : 4;
#define MOBA_QK(jq_, dA_, dB_) do { const int keyA_ = 64 * (jq_) + r32, keyB_ = keyA_ + 32; const LAS unsigned char* kpA_ = F.lds + kbuf + keyA_ * 128; const LAS unsigned char* kpB_ = F.lds + kbuf + keyB_ * 128; \
        _Pragma("unroll") for (int ds = 0; ds < 4; ++ds) { const bf16x8 aA_ = *(const LAS bf16x8*)(kpA_ + (((2 * ds + hi) ^ (keyA_ & 7)) * 16)), aB_ = *(const LAS bf16x8*)(kpB_ + (((2 * ds + hi) ^ (keyB_ & 7)) * 16)); \
            if (!(ABL & 8)) { dA_ = __builtin_amdgcn_mfma_f32_32x32x16_bf16(aA_, qf[ds], ds == 0 ? cneg : dA_, 0, 0, 0); dB_ = __builtin_amdgcn_mfma_f32_32x32x16_bf16(aB_, qf[ds], ds == 0 ? cneg : dB_, 0, 0, 0); } else if (ds == 0) { dA_ = cneg; dB_ = cneg; } } } while (0)
                f32x16 sA, sB, nA, nB;
                MOBA_QK(0, sA, sB);
                for (int jp = 0; jp < npair; ++jp) {
                    const int k0 = kb * MBLK + 64 * jp, dmin = qw0 - k0 - 63, dmax = qw0 + 31 - k0;
                    bool uni = false; float bu = 0.f;
                    if (dmin >= 256) { const float b0 = lB[64 + dmin], b1 = lB[64 + dmax]; uni = (b0 == b1); bu = b0; }
                    if (ABL & 1) {} else if (uni) {
#pragma unroll
                        for (int r = 0; r < 16; ++r) { sA[r] += bu; sB[r] += bu; }
                    } else {
                        const LAS float* bp = lB + (64 + qpos - k0 - 4 * hi - 27 - 32);
#pragma unroll
                        for (int r = 0; r < 16; ++r) { sA[r] += bp[32 + 27 - ((r & 3) + 8 * (r >> 2))]; sB[r] += bp[27 - ((r & 3) + 8 * (r >> 2))]; }
                    }
                    if (own && 2 * jp + 1 >= wave) {
                        const int limA = 32 * wave + r32 - 64 * jp - 4 * hi, limB = limA - 32;
#pragma unroll
                        for (int r = 0; r < 16; ++r) { const int cr = (r & 3) + 8 * (r >> 2); if (cr > limA) sA[r] = MOBA_NEG; if (cr > limB) sB[r] = MOBA_NEG; }
                    }
                    float tm = fmaxf(fmaxf(fmaxf(sA[0], sA[1]), fmaxf(sA[2], sA[3])), fmaxf(fmaxf(sB[0], sB[1]), fmaxf(sB[2], sB[3])));
#pragma unroll
                    for (int r = 4; r < 16; r += 4) tm = fmaxf(tm, fmaxf(fmaxf(fmaxf(sA[r], sA[r + 1]), fmaxf(sA[r + 2], sA[r + 3])), fmaxf(fmaxf(sB[r], sB[r + 1]), fmaxf(sB[r + 2], sB[r + 3]))));
                    if (first || __any(tm > MOBA_THR)) {
                        tm = fmaxf(tm, __shfl_xor(tm, 32));
                        const float dl = first ? tm : fmaxf(tm, 0.f);
                        first = false;
                        m += dl;
#pragma unroll
                        for (int r = 0; r < 16; ++r) { sA[r] -= dl; sB[r] -= dl; }
                        const float al = __builtin_amdgcn_exp2f(-dl);
                        l *= al;
                        if (hi == 0) wsc[r32] = al;
                        LDS_WAIT(); asm volatile("" ::: "memory");
#pragma unroll
                        for (int r = 0; r < 16; ++r) { const float a = wsc[(r & 3) + 8 * (r >> 2) + 4 * hi]; o0[r] *= a; o1[r] *= a; }
                        LDS_WAIT(); asm volatile("" ::: "memory");
                        {
#pragma unroll
                            for (int q = 0; q < 4; ++q) { ppa[q].x = pk2(bflo(ppa[q].x) * al, bfhi(ppa[q].x) * al); ppa[q].y = pk2(bflo(ppa[q].y) * al, bfhi(ppa[q].y) * al);
                                ppa[q].z = pk2(bflo(ppa[q].z) * al, bfhi(ppa[q].z) * al); ppa[q].w = pk2(bflo(ppa[q].w) * al, bfhi(ppa[q].w) * al); }
                        }
                        msub = sel ? m : 1.0e30f;
#pragma unroll
                        for (int r = 0; r < 16; ++r) cneg[r] = -msub;
                    }
                    {
                        const int jn = jp + 1 < npair ? jp + 1 : jp;
                        const int keyA_ = 64 * jn + r32, keyB_ = keyA_ + 32; const LAS unsigned char* kpA_ = F.lds + kbuf + keyA_ * 128; const LAS unsigned char* kpB_ = F.lds + kbuf + keyB_ * 128;
                        const LAS unsigned char* vp_ = F.lds + pvoff + vbase;
                        float ps = 0.f;
#pragma unroll
                        for (int i = 0; i < 4; ++i) {
                            if (!(ABL & 4)) { const bf16x8 pav = __builtin_bit_cast(bf16x8, ppa[i]);
#pragma unroll
                                for (int db = 0; db < 2; ++db) { const s16x4 lo = vtr_read(vp_ + ((2 * i) * 2 + db) * 512), hh = vtr_read(vp_ + ((2 * i + 1) * 2 + db) * 512);
                                    const bf16x8 vf = (bf16x8){lo[0], lo[1], lo[2], lo[3], hh[0], hh[1], hh[2], hh[3]};
                                    if (db == 0) o0 = __builtin_amdgcn_mfma_f32_32x32x16_bf16(pav, vf, o0, 0, 0, 0); else o1 = __builtin_amdgcn_mfma_f32_32x32x16_bf16(pav, vf, o1, 0, 0, 0); } }
                            { const bf16x8 aA_ = *(const LAS bf16x8*)(kpA_ + (((2 * i + hi) ^ (keyA_ & 7)) * 16)), aB_ = *(const LAS bf16x8*)(kpB_ + (((2 * i + hi) ^ (keyB_ & 7)) * 16));
                              if (!(ABL & 8)) { nA = __builtin_amdgcn_mfma_f32_32x32x16_bf16(aA_, qf[i], i == 0 ? cneg : nA, 0, 0, 0); nB = __builtin_amdgcn_mfma_f32_32x32x16_bf16(aB_, qf[i], i == 0 ? cneg : nB, 0, 0, 0); } else if (i == 0) { nA = cneg; nB = cneg; } }
                            float pv8[8];
#pragma unroll
                            for (int q = 0; q < 8; ++q) { const float sv = i < 2 ? sA[8 * i + q] : sB[8 * (i - 2) + q]; pv8[q] = (ABL & 2) ? sv : __builtin_amdgcn_exp2f(sv); ps += pv8[q]; }
                            ppa[i].x = pk2(pv8[0], pv8[1]); ppa[i].y = pk2(pv8[2], pv8[3]); ppa[i].z = pk2(pv8[4], pv8[5]); ppa[i].w = pk2(pv8[6], pv8[7]);
                            __builtin_amdgcn_sched_barrier(0);
                        }
                        l += ps;
                    }
                    pvoff = vbuf + (8 * jp) * 1024; pending = true;
                    sA = nA; sB = nB;
                }
#undef MOBA_QK
            }
            VM_WAIT(); __syncthreads();
        }
        if (pending) { MOBA_PV(ppa, pvoff); pending = false; }
#undef MOBA_PV
        l += __shfl_xor(l, 32);
        if (hi == 0) wsc[r32] = 1.0f / l;
        LDS_WAIT(); asm volatile("" ::: "memory");
        bf16* op = ATT + ((size_t)b * SEQ + qw0) * 512 + h * 64 + r32;
#pragma unroll
        for (int r = 0; r < 16; ++r) { const int qr = (r & 3) + 8 * (r >> 2) + 4 * hi; const float a = wsc[qr];
            op[(size_t)qr * 512] = (bf16)f2bf(o0[r] * a); op[(size_t)qr * 512 + 32] = (bf16)f2bf(o1[r] * a); }
        LDS_WAIT(); asm volatile("" ::: "memory");
    }
    }
#undef MOBA_STAGE
}


constexpr int RT_K = 0, RT_P = 16384, RT_V = 32768, RT_O = 65536, RT_OP = 132;
__device__ __forceinline__ void p3a_retention_mfma(Frame& F, const Ptrs& P) {
    unsigned char* ws = P.ws; const bf16* RQ = (const bf16*)(ws + WS_RQ); const bf16* RK = (const bf16*)(ws + WS_RK); const bf16* RV = (const bf16*)(ws + WS_RV);
    const bf16* RG = (const bf16*)(ws + WS_RG); const bf16* PREV = (const bf16*)(ws + WS_PREV); bf16* RETG = (bf16*)P.out;
    LAS float* lO = (LAS float*)(F.lds + RT_O);
    const int lane = F.lane, wave = F.wave, r32 = lane & 31, hi = lane >> 5, rt = wave >> 1, dh = wave & 1;
    const unsigned vbase = (unsigned)((4 * hi + ((lane & 15) >> 2)) * 64 + ((lane >> 4) & 1) * 32 + (lane & 3) * 8);
    unsigned ksrc[2], psrc[2], vsrc[4];
#pragma unroll
    for (int j = 0; j < 2; ++j) { const int pc = wave * 2 + j, row = 8 * pc + (lane >> 3), ch = (lane & 7) ^ (row & 7); ksrc[j] = (unsigned)(row * 512 + ch * 8); psrc[j] = (unsigned)(row * 64 + ch * 8); }
#pragma unroll
    for (int j = 0; j < 4; ++j) { const int pc = wave * 4 + j, key = 8 * (pc >> 1) + ((lane & 31) >> 2), db = 2 * (pc & 1) + (lane >> 5); vsrc[j] = (unsigned)(key * 1024 + 32 * db + 8 * (lane & 3)); }
#define RT_STAGE(task_) do { const int b_ = (task_) >> 8, h_ = ((task_) >> 5) & 7, n_ = (task_) & 31; const size_t r0_ = (size_t)b_ * SEQ + n_ * RC; \
        const bf16* kg_ = RK + r0_ * 512 + h_ * 64; const bf16* pg_ = PREV + (size_t)(task_) * 8192; const bf16* vg_ = RV + r0_ * 1024 + h_ * 128; \
        _Pragma("unroll") for (int j = 0; j < 2; ++j) { __builtin_amdgcn_global_load_lds((const unsigned*)(kg_ + ksrc[j]), (LAS unsigned*)(F.lds + RT_K + (wave * 2 + j) * 1024), 16, 0, 0); \
            __builtin_amdgcn_global_load_lds((const unsigned*)(pg_ + psrc[j]), (LAS unsigned*)(F.lds + RT_P + (wave * 2 + j) * 1024), 16, 0, 0); } \
        _Pragma("unroll") for (int j = 0; j < 4; ++j) __builtin_amdgcn_global_load_lds((const unsigned*)(vg_ + vsrc[j]), (LAS unsigned*)(F.lds + RT_V + (wave * 4 + j) * 1024), 16, 0, 0); } while (0)
    int task = F.bid;
    if (task < BATCH * RH * NCH) RT_STAGE(task);
    for (; task < BATCH * RH * NCH; task += F.G) {
        const int b = task >> 8, h = (task >> 5) & 7, n = task & 31; const size_t row0 = (size_t)b * SEQ + n * RC; const float l2g = ret_l2g(h);
        bf16x8 qf[4];
        { const bf16* qp = RQ + (row0 + 32 * rt + r32) * 512 + h * 64 + 8 * hi;
#pragma unroll
          for (int ds = 0; ds < 4; ++ds) qf[ds] = *(const bf16x8*)(qp + 16 * ds); }
        VM_WAIT(); __syncthreads();
        f32x16 o0, o1;
#pragma unroll
        for (int r = 0; r < 16; ++r) { o0[r] = 0.f; o1[r] = 0.f; }
#pragma unroll
        for (int ds = 0; ds < 4; ++ds) {
#pragma unroll
            for (int db = 0; db < 2; ++db) { const int dv = 64 * dh + 32 * db + r32; const bf16x8 bfr = *(const LAS bf16x8*)(F.lds + RT_P + dv * 128 + (((2 * ds + hi) ^ (dv & 7)) * 16));
                if (db == 0) o0 = __builtin_amdgcn_mfma_f32_32x32x16_bf16(qf[ds], bfr, o0, 0, 0, 0); else o1 = __builtin_amdgcn_mfma_f32_32x32x16_bf16(qf[ds], bfr, o1, 0, 0, 0); }
        }
#pragma unroll
        for (int r = 0; r < 16; ++r) { const float qd = __builtin_amdgcn_exp2f((float)(32 * rt + (r & 3) + 8 * (r >> 2) + 4 * hi + 1) * l2g); o0[r] *= qd; o1[r] *= qd; }
        for (int kt = 0; kt <= rt; ++kt) {
            f32x16 s;
#pragma unroll
            for (int r = 0; r < 16; ++r) s[r] = 0.f;
            { const int key = 32 * kt + r32; const LAS unsigned char* kp = F.lds + RT_K + key * 128;
#pragma unroll
              for (int ds = 0; ds < 4; ++ds) { const bf16x8 a = *(const LAS bf16x8*)(kp + (((2 * ds + hi) ^ (key & 7)) * 16)); s = __builtin_amdgcn_mfma_f32_32x32x16_bf16(a, qf[ds], s, 0, 0, 0); } }
            const int dbase = 32 * (rt - kt) + r32 - 4 * hi;
#pragma unroll
            for (int r = 0; r < 16; ++r) { const int dj = dbase - ((r & 3) + 8 * (r >> 2)); s[r] = dj >= 0 ? s[r] * __builtin_amdgcn_exp2f((float)dj * l2g) : 0.f; }
            v4u pa0, pa1;
            pa0.x = pk2(s[0], s[1]); pa0.y = pk2(s[2], s[3]); pa0.z = pk2(s[4], s[5]); pa0.w = pk2(s[6], s[7]);
            pa1.x = pk2(s[8], s[9]); pa1.y = pk2(s[10], s[11]); pa1.z = pk2(s[12], s[13]); pa1.w = pk2(s[14], s[15]);
            const LAS unsigned char* vp = F.lds + RT_V + vbase + (4 * kt) * 2048 + (2 * dh) * 512;
#pragma unroll
            for (int ks = 0; ks < 2; ++ks) {
                const bf16x8 pa = __builtin_bit_cast(bf16x8, ks == 0 ? pa0 : pa1);
#pragma unroll
                for (int db = 0; db < 2; ++db) {
                    const s16x4 lo = vtr_read(vp + (2 * ks) * 2048 + db * 512), hh = vtr_read(vp + (2 * ks + 1) * 2048 + db * 512);
                    const bf16x8 vf = (bf16x8){lo[0], lo[1], lo[2], lo[3], hh[0], hh[1], hh[2], hh[3]};
                    if (db == 0) o0 = __builtin_amdgcn_mfma_f32_32x32x16_bf16(pa, vf, o0, 0, 0, 0); else o1 = __builtin_amdgcn_mfma_f32_32x32x16_bf16(pa, vf, o1, 0, 0, 0);
                }
            }
        }
#pragma unroll
        for (int r = 0; r < 16; ++r) { const int qr = 32 * rt + (r & 3) + 8 * (r >> 2) + 4 * hi; lO[qr * RT_OP + 64 * dh + r32] = o0[r]; lO[qr * RT_OP + 64 * dh + 32 + r32] = o1[r]; }
        __syncthreads();
        if (task + F.G < BATCH * RH * NCH) RT_STAGE(task + F.G);
#pragma unroll
        for (int it = 0; it < 2; ++it) {
            const int i = wave * 16 + it * 8 + (lane >> 3), cc = lane & 7;
            f32x4 v[4];
#pragma unroll
            for (int q = 0; q < 4; ++q) v[q] = *(const LAS f32x4*)(lO + i * RT_OP + 16 * cc + 4 * q);
            const f32x4 sv = (v[0] + v[1]) + (v[2] + v[3]);
            const float mu = dpp_sum8((sv[0] + sv[1]) + (sv[2] + sv[3])) * (1.0f / RDV);
            f32x4 qv = {0.f, 0.f, 0.f, 0.f};
#pragma unroll
            for (int q = 0; q < 4; ++q) { v[q] = v[q] - mu; qv += v[q] * v[q]; }
            const float rs = rsqrtf(dpp_sum8((qv[0] + qv[1]) + (qv[2] + qv[3])) * (1.0f / RDV) + EPS);
            const size_t off = (row0 + i) * 1024 + h * 128 + 16 * cc;
            f32x4 g0, g1, g2, g3; load8_bf16(RG + off, g0, g1); load8_bf16(RG + off + 8, g2, g3);
            store8_bf16(RETG + off, v[0] * rs * g0, v[1] * rs * g1); store8_bf16(RETG + off + 8, v[2] * rs * g2, v[3] * rs * g3);
        }
    }
#undef RT_STAGE
}
constexpr int KV_K = 0, KV_V = 16384;
__device__ __forceinline__ void p2a_kv_mfma(Frame& F, const Ptrs& P) {
    unsigned char* ws = P.ws; const bf16* RK = (const bf16*)(ws + WS_RK); const bf16* RV = (const bf16*)(ws + WS_RV); float* KVT = (float*)((unsigned char*)P.out + 32 * MiB);
    const int tid = F.tid, lane = F.lane, wave = F.wave, r32 = lane & 31, hi = lane >> 5, mb = wave >> 1, nb = wave & 1;
    const unsigned vbase = (unsigned)((4 * hi + ((lane & 15) >> 2)) * 64 + ((lane >> 4) & 1) * 32 + (lane & 3) * 8);
    for (int task = F.bid; task < BATCH * RH * NCH; task += F.G) {
        const int b = task >> 8, h = (task >> 5) & 7, n = task & 31; const size_t row0 = (size_t)b * SEQ + n * RC; const float l2g = ret_l2g(h);
        __syncthreads();
#pragma unroll
        for (int j = 0; j < 2; ++j) { const int idx = tid + 512 * j, r = idx >> 3, c = idx & 7; const v4u kx = *(const v4u*)(RK + (row0 + r) * 512 + h * 64 + c * 8);
            const float dec = __builtin_amdgcn_exp2f((float)(RC - 1 - r) * l2g); v4u ko;
            ko.x = pk2(bflo(kx.x) * dec, bfhi(kx.x) * dec); ko.y = pk2(bflo(kx.y) * dec, bfhi(kx.y) * dec); ko.z = pk2(bflo(kx.z) * dec, bfhi(kx.z) * dec); ko.w = pk2(bflo(kx.w) * dec, bfhi(kx.w) * dec);
            *(LAS v4u*)(F.lds + KV_K + (((r >> 3) * 2 + (c >> 2)) * 512) + (r & 7) * 64 + (c & 3) * 16) = ko; }
#pragma unroll
        for (int j = 0; j < 4; ++j) { const int idx = tid + 512 * j, r = idx >> 4, c = idx & 15;
            *(LAS v4u*)(F.lds + KV_V + (((r >> 3) * 4 + (c >> 2)) * 512) + (r & 7) * 64 + (c & 3) * 16) = *(const v4u*)(RV + (row0 + r) * 1024 + h * 128 + c * 8); }
        __syncthreads();
        f32x16 acc;
#pragma unroll
        for (int r = 0; r < 16; ++r) acc[r] = 0.f;
#pragma unroll
        for (int ks = 0; ks < 8; ++ks) {
            const LAS unsigned char* ap = F.lds + KV_V + vbase + ((2 * ks) * 4 + mb) * 512; const LAS unsigned char* bp = F.lds + KV_K + vbase + ((2 * ks) * 2 + nb) * 512;
            const s16x4 alo = vtr_read(ap), ahi = vtr_read(ap + 4 * 512), blo = vtr_read(bp), bhi = vtr_read(bp + 2 * 512);
            const bf16x8 af = (bf16x8){alo[0], alo[1], alo[2], alo[3], ahi[0], ahi[1], ahi[2], ahi[3]}, bfv = (bf16x8){blo[0], blo[1], blo[2], blo[3], bhi[0], bhi[1], bhi[2], bhi[3]};
            acc = __builtin_amdgcn_mfma_f32_32x32x16_bf16(af, bfv, acc, 0, 0, 0);
        }
        float* o = KVT + (size_t)task * (RDV * RDK) + 32 * nb + r32;
#pragma unroll
        for (int r = 0; r < 16; ++r) o[(32 * mb + (r & 3) + 8 * (r >> 2) + 4 * hi) * 64] = acc[r];
    }
}
#define CE_D(a, i, j) do { const unsigned _hi = a[i] > a[j] ? a[i] : a[j]; const unsigned _lo = a[i] > a[j] ? a[j] : a[i]; a[i] = _hi; a[j] = _lo; } while (0)
#define CE_A(a, i, j) do { const unsigned _hi = a[i] > a[j] ? a[i] : a[j]; const unsigned _lo = a[i] > a[j] ? a[j] : a[i]; a[i] = _lo; a[j] = _hi; } while (0)
#define SORT16_DESC(a) do { CE_D(a, 0, 1); CE_A(a, 2, 3); CE_D(a, 4, 5); CE_A(a, 6, 7); CE_D(a, 8, 9); CE_A(a, 10, 11); CE_D(a, 12, 13); CE_A(a, 14, 15); CE_D(a, 0, 2); CE_D(a, 1, 3); CE_A(a, 4, 6); CE_A(a, 5, 7); CE_D(a, 8, 10); CE_D(a, 9, 11); CE_A(a, 12, 14); CE_A(a, 13, 15); CE_D(a, 0, 1); CE_D(a, 2, 3); CE_A(a, 4, 5); CE_A(a, 6, 7); CE_D(a, 8, 9); CE_D(a, 10, 11); CE_A(a, 12, 13); CE_A(a, 14, 15); CE_D(a, 0, 4); CE_D(a, 1, 5); CE_D(a, 2, 6); CE_D(a, 3, 7); CE_A(a, 8, 12); CE_A(a, 9, 13); CE_A(a, 10, 14); CE_A(a, 11, 15); CE_D(a, 0, 2); CE_D(a, 1, 3); CE_D(a, 4, 6); CE_D(a, 5, 7); CE_A(a, 8, 10); CE_A(a, 9, 11); CE_A(a, 12, 14); CE_A(a, 13, 15); CE_D(a, 0, 1); CE_D(a, 2, 3); CE_D(a, 4, 5); CE_D(a, 6, 7); CE_A(a, 8, 9); CE_A(a, 10, 11); CE_A(a, 12, 13); CE_A(a, 14, 15); CE_D(a, 0, 8); CE_D(a, 1, 9); CE_D(a, 2, 10); CE_D(a, 3, 11); CE_D(a, 4, 12); CE_D(a, 5, 13); CE_D(a, 6, 14); CE_D(a, 7, 15); CE_D(a, 0, 4); CE_D(a, 1, 5); CE_D(a, 2, 6); CE_D(a, 3, 7); CE_D(a, 8, 12); CE_D(a, 9, 13); CE_D(a, 10, 14); CE_D(a, 11, 15); CE_D(a, 0, 2); CE_D(a, 1, 3); CE_D(a, 4, 6); CE_D(a, 5, 7); CE_D(a, 8, 10); CE_D(a, 9, 11); CE_D(a, 12, 14); CE_D(a, 13, 15); CE_D(a, 0, 1); CE_D(a, 2, 3); CE_D(a, 4, 5); CE_D(a, 6, 7); CE_D(a, 8, 9); CE_D(a, 10, 11); CE_D(a, 12, 13); CE_D(a, 14, 15); } while (0)
#define MERGE16_DESC(a) do { CE_D(a, 0, 8); CE_D(a, 1, 9); CE_D(a, 2, 10); CE_D(a, 3, 11); CE_D(a, 4, 12); CE_D(a, 5, 13); CE_D(a, 6, 14); CE_D(a, 7, 15); CE_D(a, 0, 4); CE_D(a, 1, 5); CE_D(a, 2, 6); CE_D(a, 3, 7); CE_D(a, 8, 12); CE_D(a, 9, 13); CE_D(a, 10, 14); CE_D(a, 11, 15); CE_D(a, 0, 2); CE_D(a, 1, 3); CE_D(a, 4, 6); CE_D(a, 5, 7); CE_D(a, 8, 10); CE_D(a, 9, 11); CE_D(a, 12, 14); CE_D(a, 13, 15); CE_D(a, 0, 1); CE_D(a, 2, 3); CE_D(a, 4, 5); CE_D(a, 6, 7); CE_D(a, 8, 9); CE_D(a, 10, 11); CE_D(a, 12, 13); CE_D(a, 14, 15); } while (0)

#ifndef CONV_IN_TOPK
#define CONV_IN_TOPK 1
#endif
constexpr size_t CONV_N16 = (size_t)NEXP * DM / 16;
__device__ __forceinline__ void conv_load(const Ptrs& P, size_t i, f32x4 (&a)[4]) {
    const float* src = (i < CONV_N16) ? P.peer_u + i * 16 : P.peer_v + (i - CONV_N16) * 16;
#pragma unroll
    for (int q = 0; q < 4; ++q) a[q] = __builtin_nontemporal_load((const f32x4*)(src + 4 * q));
}
__device__ __forceinline__ void conv_store(const Ptrs& P, size_t i, const f32x4 (&a)[4]) {
    v2u w;
#pragma unroll
    for (int q = 0; q < 2; ++q) { unsigned pk = 0u;
        const f32x4 s0 = a[2 * q] * 64.0f, s1 = a[2 * q + 1] * 64.0f;
        pk = __builtin_amdgcn_cvt_scalef32_pk_fp4_f32(pk, s0[0], s0[1], 1.0f, 0); pk = __builtin_amdgcn_cvt_scalef32_pk_fp4_f32(pk, s0[2], s0[3], 1.0f, 1);
        pk = __builtin_amdgcn_cvt_scalef32_pk_fp4_f32(pk, s1[0], s1[1], 1.0f, 2); pk = __builtin_amdgcn_cvt_scalef32_pk_fp4_f32(pk, s1[2], s1[3], 1.0f, 3);
        w[q] = pk; }
    *(v2u*)(P.ws + WS_UV8 + i * 8) = w;
}
__device__ __forceinline__ void conv_all(Frame& F, const Ptrs& P) {
    const size_t cbase = (size_t)F.bid * 512 + F.tid, CNGT = (size_t)F.G * 512;
    for (size_t ci = cbase; ci < 2 * CONV_N16; ci += CNGT) { f32x4 cv[4]; conv_load(P, ci, cv); conv_store(P, ci, cv); }
}
__device__ __forceinline__ unsigned mono32(float f) { const unsigned u = __builtin_bit_cast(unsigned, f); return u ^ ((u >> 31) ? 0xffffffffu : 0x80000000u); }
__device__ __forceinline__ float unmono32(unsigned k) { const unsigned u = k ^ ((k >> 31) ? 0x80000000u : 0xffffffffu); return __builtin_bit_cast(float, u); }
__device__ __forceinline__ float key_val(unsigned k) { const unsigned m = k >> 16; return __builtin_bit_cast(float, (m ^ ((m & 0x8000u) ? 0x8000u : 0xffffu)) << 16); }
#define INS16(a, x) do { _Pragma("unroll") for (int _j = 0; _j < 16; ++_j) { const unsigned _t = a[_j] > x ? a[_j] : x; x = a[_j] > x ? x : a[_j]; a[_j] = _t; } } while (0)
__device__ __forceinline__ void p6_topk(Frame& F, const Ptrs& P) {
    unsigned char* ws = P.ws; const bf16* ST = (const bf16*)(ws + WS_ST); int* EXP = (int*)(ws + WS_EG); float* GT = (float*)(ws + WS_EG + 8 * MiB);
    LAS unsigned* lsc = (LAS unsigned*)F.lds;
    pg8::StaticOrder S8; S8.init(T, 2048, F.G, F.bid);
    pg8::Unit uq;
    const size_t cbase = (size_t)F.bid * 512 + F.tid, CNGT = (size_t)F.G * 512; int citem = 0;
    for (int ii = F.wave >> 2; S8.next(ii, uq); ii += 2) {
        const int hd = uq.pn, tok = uq.pm * 256 + (F.wave & 3) * 64 + F.lane;
        const bf16* sp = ST + (size_t)hd * 256 * T + tok;
        unsigned a1[16], a2[16];
#pragma unroll
        for (int j = 0; j < 16; ++j) { a1[j] = 0u; a2[j] = 0u; }
#pragma unroll 1
        for (int g = 0; g < 8; ++g) {
            f32x4 cv0[4], cv1[4]; const size_t ci0 = cbase + (size_t)citem * CNGT, ci1 = ci0 + CNGT; const bool ok0 = CONV_IN_TOPK && ci0 < 2 * CONV_N16, ok1 = CONV_IN_TOPK && ci1 < 2 * CONV_N16;
            unsigned short rr1[16], rr2[16];
#pragma unroll
            for (int q = 0; q < 16; ++q) { const int n = 16 * g + q; rr1[q] = sp[(size_t)n * T]; rr2[q] = sp[(size_t)(PNK + n) * T]; }
            asm volatile("" ::: "memory");
            if (ok0) conv_load(P, ci0, cv0);
            if (ok1) conv_load(P, ci1, cv1);
            unsigned g1[16], g2[16];
#pragma unroll
            for (int q = 0; q < 16; ++q) { const int n = 16 * g + q; const unsigned short r1 = rr1[q], r2 = rr2[q];
                g1[q] = (((unsigned)r1 ^ ((r1 & 0x8000u) ? 0xffffu : 0x8000u)) << 16) | (unsigned)(127 - n);
                g2[q] = (((unsigned)r2 ^ ((r2 & 0x8000u) ? 0xffffu : 0x8000u)) << 16) | (unsigned)(127 - n); }
            SORT16_DESC(g1); SORT16_DESC(g2);
            if (g == 0) {
#pragma unroll
                for (int q = 0; q < 16; ++q) { a1[q] = g1[q]; a2[q] = g2[q]; }
            } else {
#pragma unroll
                for (int q = 0; q < 16; ++q) { a1[q] = a1[q] > g1[15 - q] ? a1[q] : g1[15 - q]; a2[q] = a2[q] > g2[15 - q] ? a2[q] : g2[15 - q]; }
                MERGE16_DESC(a1); MERGE16_DESC(a2);
            }
            if (ok0) conv_store(P, ci0, cv0);
            if (ok1) conv_store(P, ci1, cv1);
            citem += 2;
            __builtin_amdgcn_sched_barrier(0);
        }
#pragma unroll
        for (int i = 0; i < 16; ++i) { lsc[i * 512 + F.tid] = a1[i]; lsc[(16 + i) * 512 + F.tid] = a2[i]; }
        unsigned kb[16];
#pragma unroll
        for (int j = 0; j < 16; ++j) kb[j] = 0u;
#pragma unroll
        for (int i = 0; i < 16; ++i) {
            const float s1 = key_val(a1[i]);
#pragma unroll
            for (int j = 0; j < 16; ++j) if ((i + 1) * (j + 1) <= 16) {
                unsigned xk = (mono32(s1 + key_val(a2[j])) & 0xffffff00u) | (unsigned)(i * 16 + j);
                INS16(kb, xk);
                __builtin_amdgcn_sched_barrier(0);
            }
        }
        float sv[16]; unsigned ev[16]; float smax = -3e38f;
#pragma unroll
        for (int q = 0; q < 16; ++q) { const unsigned i = (kb[q] >> 4) & 15u, j = kb[q] & 15u; const unsigned k1 = lsc[i * 512 + F.tid], k2 = lsc[(16 + j) * 512 + F.tid];
            sv[q] = key_val(k1) + key_val(k2); ev[q] = (127u - (k1 & 127u)) * 128u + (127u - (k2 & 127u)); smax = fmaxf(smax, sv[q]); }
        float gs = 0.f;
#pragma unroll
        for (int q = 0; q < 16; ++q) { sv[q] = __expf(sv[q] - smax); gs += sv[q]; }
        const float ig = 1.0f / gs;
        int* ep = EXP + (size_t)tok * 128 + hd * 16; float* gp = GT + (size_t)tok * 128 + hd * 16;
#pragma unroll
        for (int q = 0; q < 4; ++q) { *(v4u*)(ep + 4 * q) = (v4u){ev[4 * q], ev[4 * q + 1], ev[4 * q + 2], ev[4 * q + 3]};
            *(f32x4*)(gp + 4 * q) = (f32x4){sv[4 * q] * ig, sv[4 * q + 1] * ig, sv[4 * q + 2] * ig, sv[4 * q + 3] * ig}; }
    }
    if (CONV_IN_TOPK) for (;; ++citem) { const size_t ci = cbase + (size_t)citem * CNGT; if (ci >= 2 * CONV_N16) break; f32x4 cv[4]; conv_load(P, ci, cv); conv_store(P, ci, cv); }
}
__device__ __forceinline__ float dot8(const v4u w, const float* h) {
    return h[0] * bflo(w.x) + h[1] * bfhi(w.x) + h[2] * bflo(w.y) + h[3] * bfhi(w.y) + h[4] * bflo(w.z) + h[5] * bfhi(w.z) + h[6] * bflo(w.w) + h[7] * bfhi(w.w);
}
__device__ __forceinline__ void axpy8(float* acc, float c, const v4u w) {
    acc[0] += c * bflo(w.x); acc[1] += c * bfhi(w.x); acc[2] += c * bflo(w.y); acc[3] += c * bfhi(w.y); acc[4] += c * bflo(w.z); acc[5] += c * bfhi(w.z); acc[6] += c * bflo(w.w); acc[7] += c * bfhi(w.w);
}
#ifndef PB
#define PB 8
#endif
__device__ __forceinline__ void p7_peer(Frame& F, const Ptrs& P, float* dst) {
    unsigned char* ws = P.ws; const bf16* H2 = (const bf16*)(ws + WS_H2); const int* EXP = (const int*)(ws + WS_EG); const float* GT = (const float*)(ws + WS_EG + 8 * MiB);
    const bf16* U = (const bf16*)(ws + WS_UV); const bf16* V = U + (size_t)NEXP * DM; float* out = P.out;
    const int gw = F.bid * NWAVES + F.wave, NGW = F.G * NWAVES, lane = F.lane;
    for (int tok = gw; tok < T; tok += NGW) {
        float hv[16], acc[16];
        { const v4u h0 = *(const v4u*)(H2 + (size_t)tok * DM + 8 * lane), h1 = *(const v4u*)(H2 + (size_t)tok * DM + 512 + 8 * lane);
          hv[0] = bflo(h0.x); hv[1] = bfhi(h0.x); hv[2] = bflo(h0.y); hv[3] = bfhi(h0.y); hv[4] = bflo(h0.z); hv[5] = bfhi(h0.z); hv[6] = bflo(h0.w); hv[7] = bfhi(h0.w);
          hv[8] = bflo(h1.x); hv[9] = bfhi(h1.x); hv[10] = bflo(h1.y); hv[11] = bfhi(h1.y); hv[12] = bflo(h1.z); hv[13] = bfhi(h1.z); hv[14] = bflo(h1.w); hv[15] = bfhi(h1.w); }
#pragma unroll
        for (int e = 0; e < 16; ++e) acc[e] = 0.f;
        int e_lo = EXP[(size_t)tok * 128 + lane], e_hi = EXP[(size_t)tok * 128 + 64 + lane];
        float g_lo = GT[(size_t)tok * 128 + lane], g_hi = GT[(size_t)tok * 128 + 64 + lane];
#ifndef PEER_NOSORT
        {
            LAS unsigned* le = (LAS unsigned*)(F.lds + F.wave * 1024); LAS float* lg = (LAS float*)(le + 128);
            const unsigned b_lo = (unsigned)e_lo >> 9, b_hi = (unsigned)e_hi >> 9; unsigned pos_lo = 0, pos_hi = 0, base = 0;
            for (unsigned bk = 0; bk < 32; ++bk) {
                const unsigned long long mlo = __ballot(b_lo == bk), mhi = __ballot(b_hi == bk);
                const unsigned clo = (unsigned)__popcll(mlo), chi = (unsigned)__popcll(mhi);
                if (b_lo == bk) pos_lo = base + __builtin_amdgcn_mbcnt_hi((unsigned)(mlo >> 32), __builtin_amdgcn_mbcnt_lo((unsigned)mlo, 0u));
                if (b_hi == bk) pos_hi = base + clo + __builtin_amdgcn_mbcnt_hi((unsigned)(mhi >> 32), __builtin_amdgcn_mbcnt_lo((unsigned)mhi, 0u));
                base += clo + chi;
            }
            le[pos_lo] = (unsigned)e_lo; lg[pos_lo] = g_lo; le[pos_hi] = (unsigned)e_hi; lg[pos_hi] = g_hi;
            LDS_WAIT(); asm volatile("" ::: "memory");
            e_lo = (int)le[lane]; e_hi = (int)le[64 + lane]; g_lo = lg[lane]; g_hi = lg[64 + lane];
            LDS_WAIT(); asm volatile("" ::: "memory");
        }
#endif
        for (int k = 0; k < 128; k += PB) {
            int ex[PB]; float gg[PB]; v4u u0[PB], u1[PB], v0[PB], v1[PB];
#pragma unroll
            for (int q = 0; q < PB; ++q) { const int kk = k + q; ex[q] = __shfl(kk < 64 ? e_lo : e_hi, kk & 63); gg[q] = __shfl(kk < 64 ? g_lo : g_hi, kk & 63); }
#pragma unroll
            for (int q = 0; q < PB; ++q) { const bf16* up = U + (size_t)ex[q] * DM + 8 * lane; const bf16* vp = V + (size_t)ex[q] * DM + 8 * lane;
                u0[q] = *(const v4u*)up; u1[q] = *(const v4u*)(up + 512); v0[q] = *(const v4u*)vp; v1[q] = *(const v4u*)(vp + 512); }
            float d[PB];
#pragma unroll
            for (int q = 0; q < PB; ++q) d[q] = dot8(u0[q], hv) + dot8(u1[q], hv + 8);
#pragma unroll
            for (int o = 1; o < 64; o <<= 1) {
#pragma unroll
                for (int q = 0; q < PB; ++q) d[q] += __shfl_xor(d[q], o);
            }
#pragma unroll
            for (int q = 0; q < PB; ++q) { const float z = d[q]; const float a = 0.5f * z * (1.0f + erff(z * 0.70710678118654752f)); const float c = gg[q] * a; axpy8(acc, c, v0[q]); axpy8(acc + 8, c, v1[q]); }
        }
        float* op = out + (size_t)tok * DM + 8 * lane;
        f32x4 x0 = *(const f32x4*)op, x1 = *(const f32x4*)(op + 4), x2 = *(const f32x4*)(op + 512), x3 = *(const f32x4*)(op + 516);
        x0 += (f32x4){acc[0], acc[1], acc[2], acc[3]}; x1 += (f32x4){acc[4], acc[5], acc[6], acc[7]}; x2 += (f32x4){acc[8], acc[9], acc[10], acc[11]}; x3 += (f32x4){acc[12], acc[13], acc[14], acc[15]};
        float* wp = dst + (size_t)tok * DM + 8 * lane;
        *(f32x4*)wp = x0; *(f32x4*)(wp + 4) = x1; *(f32x4*)(wp + 512) = x2; *(f32x4*)(wp + 516) = x3;
    }
}

typedef float f32x2v __attribute__((ext_vector_type(2)));
typedef _Float16 f16x2v __attribute__((ext_vector_type(2)));
constexpr size_t WS_PART = WS_ST;
constexpr size_t WS_CG = WS_ACT + 32 * MiB;
__device__ __forceinline__ void fp8x16_to_f32(const v4u w, float* f) {
#pragma unroll
    for (int q = 0; q < 4; ++q) { const f32x2v lo = __builtin_amdgcn_cvt_pk_f32_fp8((int)w[q], false), hi = __builtin_amdgcn_cvt_pk_f32_fp8((int)w[q], true); f[4 * q] = lo.x; f[4 * q + 1] = lo.y; f[4 * q + 2] = hi.x; f[4 * q + 3] = hi.y; }
}
__device__ __forceinline__ float fmac_s(float acc, float a, float b) { asm("v_fmac_f32_e32 %0, %1, %2" : "+v"(acc) : "v"(a), "v"(b)); return acc; }
constexpr int TROW = DM / 2;
typedef int v8i __attribute__((ext_vector_type(8))); typedef int v2i_t __attribute__((ext_vector_type(2)));
template <int MODE> __device__ __forceinline__ void p7u_dots(Frame& F, const Ptrs& P) {
    unsigned char* ws = P.ws; const bf16* H2 = (const bf16*)(ws + WS_H2); const int* EXP = (const int*)(ws + WS_EG); const unsigned char* U4 = ws + WS_UV8; float* PART = (float*)(ws + (MODE ? WS_ACT : WS_PART)); const float* SS = (const float*)(ws + WS_SUMSQ);
    const int lane = F.lane, r = lane >> 3, c = lane & 7, i = lane & 15, kb = lane >> 4;
    LAS unsigned char* lB = F.lds; LAS float* lS = (LAS float*)(F.lds + 32768);
    LAS unsigned char* lI = F.lds + 34816 + F.wave * 2048;
    LAS unsigned char* lT = F.lds + 51200 + F.wave * 8192;
    const int wr0 = r * 128 + ((c ^ (r >> 1)) << 4), wr1 = (8 + r) * 128 + ((c ^ (4 + (r >> 1))) << 4);
    const int rd0 = i * 128 + ((kb ^ ((i >> 1) & 7)) << 4), rd1 = i * 128 + (((4 + kb) ^ ((i >> 1) & 7)) << 4);
#define PU_LOADW(tk) (*(const v2u*)(EXP + (size_t)(tbase + ((tk) < 31 ? (tk) : 31)) * 128 + 2 * lane))
#define PU_PUTW(tk, wv) do { *(LAS v2u*)(lI + ((tk) & 3) * 512 + 8 * lane) = wv; } while (0)
#define PU_ISSUE(tk, ul) do { _Pragma("unroll") for (int d_ = 0; d_ < 16; ++d_) { const unsigned ev = *(const LAS unsigned*)(lI + ((tk) & 3) * 512 + (8 * d_ + r) * 4); ul[d_] = *(const v4u*)(U4 + ((ev << 9) + loff)); } } while (0)
#define PU_V8(lo) (v8i){(int)(lo).x, (int)(lo).y, (int)(lo).z, (int)(lo).w, 0, 0, 0, 0}
#define PU_COMPUTE(tk, ul) do { const LAS unsigned char* bp_ = lB + (32 * F.wave + (tk)) * 128 + 16 * kb; const v4u bq0 = *(const LAS v4u*)bp_, bq1 = *(const LAS v4u*)(bp_ + 64); const float osc = lS[32 * F.wave + (tk)]; \
        const v8i b0 = PU_V8(bq0), b1 = PU_V8(bq1); \
        float* pp = PART + ((size_t)sl * T + (tbase + (tk))) * 128 + 4 * kb; \
        f32x4 acc[8]; \
        _Pragma("unroll") for (int g = 0; g < 8; ++g) { LAS unsigned char* tb_ = lT + (g & 3) * 2048; \
            *(LAS v4u*)(tb_ + wr0) = ul[2 * g]; *(LAS v4u*)(tb_ + wr1) = ul[2 * g + 1]; \
            const v4u a0 = *(const LAS v4u*)(tb_ + rd0), a1 = *(const LAS v4u*)(tb_ + rd1); \
            acc[g] = __builtin_amdgcn_mfma_scale_f32_16x16x128_f8f6f4(PU_V8(a0), b0, (f32x4){0.f, 0.f, 0.f, 0.f}, 4, 4, 0, 0, 0, 0); \
            acc[g] = __builtin_amdgcn_mfma_scale_f32_16x16x128_f8f6f4(PU_V8(a1), b1, acc[g], 4, 4, 0, 0, 0, 0); \
            asm volatile("" : "+v"(acc[g])); }     \
        if (i == 0) { _Pragma("unroll") for (int g = 0; g < 8; ++g) *(f32x4*)(pp + 16 * g) = acc[g] * osc; } } while (0)
    for (int vb = F.bid; vb < 256; vb += F.G) {
        const int x = vb & 7, j = vb >> 3, sl = x & 3; const int tb0 = (x >> 2) * (T / 2) + 256 * j, tbase = tb0 + 32 * F.wave; const unsigned loff = 128 * sl + 16 * c;
        v2u w0 = PU_LOADW(0), w1 = PU_LOADW(1), w2 = PU_LOADW(2), w3 = PU_LOADW(3); v4u ulA[16], ulB[16];
        __syncthreads();
        {
            const int tok = F.tid >> 1, hf = F.tid & 1; const bf16* hp = H2 + (size_t)(tb0 + tok) * DM + 256 * sl + 128 * hf;
            const float ms = SS[tb0 + tok] * (1.0f / DM) + EPS, rstd = rsqrtf(ms);
            const float sc = __builtin_bit_cast(float, (__builtin_bit_cast(unsigned, 2.0f * rstd) + 0x00400000u) & 0xFF800000u);
#pragma unroll
            for (int c4 = 0; c4 < 4; ++c4) { v4u o;
#pragma unroll
                for (int q = 0; q < 4; ++q) { const v4u a = *(const v4u*)(hp + 32 * c4 + 8 * q); unsigned pk = 0u;
                    pk = __builtin_amdgcn_cvt_scalef32_pk_fp4_f32(pk, bflo(a.x) * sc, bfhi(a.x) * sc, 1.0f, 0); pk = __builtin_amdgcn_cvt_scalef32_pk_fp4_f32(pk, bflo(a.y) * sc, bfhi(a.y) * sc, 1.0f, 1);
                    pk = __builtin_amdgcn_cvt_scalef32_pk_fp4_f32(pk, bflo(a.z) * sc, bfhi(a.z) * sc, 1.0f, 2); pk = __builtin_amdgcn_cvt_scalef32_pk_fp4_f32(pk, bflo(a.w) * sc, bfhi(a.w) * sc, 1.0f, 3); o[q] = pk; }
                *(LAS v4u*)(lB + tok * 128 + hf * 64 + c4 * 16) = o; }
            if (hf == 0) lS[tok] = rstd / sc;
        }
        PU_PUTW(0, w0); PU_ISSUE(0, ulA); w0 = PU_LOADW(4);
        __syncthreads();
        for (int tk = 0; tk < 32; tk += 4) {
            PU_PUTW(tk + 1, w1); PU_ISSUE(tk + 1, ulB); w1 = PU_LOADW(tk + 5); PU_COMPUTE(tk, ulA);
            PU_PUTW(tk + 2, w2); PU_ISSUE(tk + 2, ulA); w2 = PU_LOADW(tk + 6); PU_COMPUTE(tk + 1, ulB);
            PU_PUTW(tk + 3, w3); PU_ISSUE(tk + 3, ulB); w3 = PU_LOADW(tk + 7); PU_COMPUTE(tk + 2, ulA);
            PU_PUTW(tk + 4, w0); PU_ISSUE(tk + 4, ulA); w0 = PU_LOADW(tk + 8); PU_COMPUTE(tk + 3, ulB);
        }
    }
#undef PU_LOADW
#undef PU_PUTW
#undef PU_ISSUE
#undef PU_COMPUTE
#undef PU_V8
}
constexpr size_t WS_CGS = WS_CG + 4 * MiB;
__device__ __forceinline__ void p7z_gate(Frame& F, const Ptrs& P) {
    unsigned char* ws = P.ws; const float* PART = (const float*)(ws + WS_PART); const float* GT = (const float*)(ws + WS_EG + 8 * MiB); unsigned char* CGQ = ws + WS_CG; float* CGS = (float*)(ws + WS_CGS);
    const size_t gt = (size_t)F.bid * 512 + F.tid, NGT = (size_t)F.G * 512, n4 = (size_t)T * 128 / 4;
    for (size_t i = gt; i < n4; i += NGT) {
        f32x4 z = *(const f32x4*)(PART + i * 4);
#pragma unroll
        for (int x = 1; x < 4; ++x) z += *(const f32x4*)(PART + (size_t)x * T * 128 + i * 4);
        const f32x4 g = *(const f32x4*)(GT + i * 4); f32x4 v; float m = 1e-30f;
#pragma unroll
        for (int q = 0; q < 4; ++q) { const float zz = z[q] * (1.0f / 64.0f); v[q] = g[q] * 0.5f * zz * (1.0f + erff(zz * 0.70710678118654752f)); m = fmaxf(m, fabsf(v[q])); }
#pragma unroll
        for (int o = 1; o < 32; o <<= 1) m = fmaxf(m, __shfl_xor(m, o));
        const unsigned eb = (__builtin_bit_cast(unsigned, m) >> 23) & 0xFFu; const float sc = __builtin_bit_cast(float, (255u - eb) << 23);
        v = v * sc;
        const size_t t = i >> 5; const int ip = (int)(i & 31);
#pragma unroll
        for (int term = 0; term < 4; ++term) {
            unsigned pk = 0u; pk = __builtin_amdgcn_cvt_scalef32_pk_fp4_f32(pk, v[0], v[1], 1.0f, 0); pk = __builtin_amdgcn_cvt_scalef32_pk_fp4_f32(pk, v[2], v[3], 1.0f, 1);
            *(unsigned short*)(CGQ + t * 256 + term * 64 + 2 * ip) = (unsigned short)pk;
            const f32x2v d0 = __builtin_amdgcn_cvt_scalef32_pk_f32_fp4(pk, 1.0f, 0), d1 = __builtin_amdgcn_cvt_scalef32_pk_f32_fp4(pk, 1.0f, 1);
            v = (v - (f32x4){d0.x, d0.y, d1.x, d1.y}) * 4.0f;
        }
        if (ip == 0) CGS[t] = 1.0f / (sc * 64.0f);
    }
}
template <int MODE> __device__ __forceinline__ void p7v_accum(Frame& F, const Ptrs& P, float* dst) {
    unsigned char* ws = P.ws; const unsigned char* CGQ = ws + WS_CG; const float* CGS = (const float*)(ws + WS_CGS); const int* EXP = (const int*)(ws + WS_EG); const unsigned char* V4 = ws + WS_UV8 + 8 * MiB; const float* x1 = P.out;
    const int lane = F.lane, r = lane >> 3, c = lane & 7, i = lane & 15, kb = lane >> 4;
    LAS unsigned char* lT = F.lds + F.wave * 16384;
    LAS unsigned char* lI = F.lds + 131072 + F.wave * 2048;
    LAS float* lO = (LAS float*)(F.lds + 147456 + F.wave * 1024);
    const int wrA = r * 128 + ((c ^ r) << 4);
    const int rdb = (32 * kb + i) * 128, rdm = 2 * (i & 7) + (i >> 3);
#define PV_LOADW(tk) (*(const v2u*)(EXP + (size_t)(tbase + ((tk) < 31 ? (tk) : 31)) * 128 + 2 * lane))
#define PV_PUTW(tk, wv) do { *(LAS v2u*)(lI + ((tk) & 3) * 512 + 8 * lane) = wv; } while (0)
#define PV_ISSUE(tk, ul, av, sv, xv) do { const int t_ = tbase + ((tk) < 31 ? (tk) : 31); \
        _Pragma("unroll") for (int d_ = 0; d_ < 16; ++d_) { const unsigned ev = *(const LAS unsigned*)(lI + ((tk) & 3) * 512 + (8 * d_ + r) * 4); ul[d_] = *(const v4u*)(V4 + ((ev << 9) + loff)); } \
        av = *(const v4u*)(CGQ + (size_t)t_ * 256 + (i & 3) * 64 + kb * 16); sv = CGS[t_]; xv = *(const f32x4*)(x1 + (size_t)t_ * DM + 256 * sl + 4 * lane); } while (0)
#define PV_V8(lo) (v8i){(int)(lo).x, (int)(lo).y, (int)(lo).z, (int)(lo).w, 0, 0, 0, 0}
#define PV_COMPUTE(tk, ul, av, sv, xv) do { \
        _Pragma("unroll") for (int d_ = 0; d_ < 16; ++d_) *(LAS v4u*)(lT + d_ * 1024 + wrA) = (d_ & 1) ? (v4u){ul[d_].z, ul[d_].w, ul[d_].x, ul[d_].y} : ul[d_]; \
        const v4u am = i < 4 ? av : (v4u){0u, 0u, 0u, 0u}; const v8i a8 = PV_V8(am); \
        _Pragma("unroll") for (int n = 0; n < 16; ++n) { const LAS unsigned char* rp_ = lT + rdb + ((n ^ rdm) << 3); \
            const v2i_t lo_ = __builtin_amdgcn_ds_read_tr4_b64_v2i32((LAS v2i_t*)rp_), hi_ = __builtin_amdgcn_ds_read_tr4_b64_v2i32((LAS v2i_t*)(rp_ + 2048)); \
            const v8i b8 = {lo_.x, lo_.y, hi_.x, hi_.y, 0, 0, 0, 0}; \
            f32x4 acc = __builtin_amdgcn_mfma_scale_f32_16x16x128_f8f6f4(a8, b8, (f32x4){0.f, 0.f, 0.f, 0.f}, 4, 4, 0, 0, 0, 0); \
            asm volatile("" : "+v"(acc)); \
            const float val = (acc[0] + 0.25f * acc[1] + 0.0625f * acc[2] + 0.015625f * acc[3]) * sv; \
            if (lane < 16) lO[n * 16 + lane] = val; } \
        const f32x4 o_ = *(const LAS f32x4*)(lO + 4 * lane); \
        *(f32x4*)(dst + (size_t)(tbase + (tk)) * DM + 256 * sl + 4 * lane) = xv + o_; } while (0)
    for (int vb = F.bid; vb < 256; vb += F.G) {
        const int x = vb & 7, j = vb >> 3, sl = x & 3; const int tbase = (x >> 2) * (T / 2) + 256 * j + 32 * F.wave; const unsigned loff = 128 * sl + 16 * c;
        v2u w0 = PV_LOADW(0), w1 = PV_LOADW(1), w2 = PV_LOADW(2), w3 = PV_LOADW(3); v4u ulA[16], ulB[16], aA, aB; float sA, sB; f32x4 xA, xB;
        PV_PUTW(0, w0); PV_ISSUE(0, ulA, aA, sA, xA); w0 = PV_LOADW(4);
        for (int tk = 0; tk < 32; tk += 4) {
            PV_PUTW(tk + 1, w1); PV_ISSUE(tk + 1, ulB, aB, sB, xB); w1 = PV_LOADW(tk + 5); PV_COMPUTE(tk, ulA, aA, sA, xA);
            PV_PUTW(tk + 2, w2); PV_ISSUE(tk + 2, ulA, aA, sA, xA); w2 = PV_LOADW(tk + 6); PV_COMPUTE(tk + 1, ulB, aB, sB, xB);
            PV_PUTW(tk + 3, w3); PV_ISSUE(tk + 3, ulB, aB, sB, xB); w3 = PV_LOADW(tk + 7); PV_COMPUTE(tk + 2, ulA, aA, sA, xA);
            PV_PUTW(tk + 4, w0); PV_ISSUE(tk + 4, ulA, aA, sA, xA); w0 = PV_LOADW(tk + 8); PV_COMPUTE(tk + 3, ulB, aB, sB, xB);
        }
    }
#undef PV_LOADW
#undef PV_PUTW
#undef PV_ISSUE
#undef PV_COMPUTE
#undef PV_V8
}

struct MirrorOrder {
    pg8::StaticOrder S8;
    __device__ __forceinline__ bool next(int i, pg8::Unit& u) const { pg8::Unit v; if (!S8.next(i, v)) return false; u.pm = v.pn; u.pn = v.pm; return true; }
    __device__ __forceinline__ void a_ready(const pg8::Unit&) const {}
    __device__ __forceinline__ void done(const pg8::Unit&) const {}
};
struct Args { const float* in[14]; float* out; unsigned char* ws; int ph_lo, ph_hi; };
#ifdef PEER_BF16
constexpr int N_PHASES = 12;
#else
constexpr int N_PHASES = 14;
#endif
#ifndef MK_PER_PHASE
#define MK_PER_PHASE 0
#endif

__global__ void __launch_bounds__(NWAVES * 64, 2) hybrid_fwd(Args args) {
    extern __shared__ __attribute__((aligned(16))) unsigned char lds[];
    Frame F;
    F.lds = (LAS unsigned char*)lds; F.MISC = (volatile LAS unsigned*)(F.lds + MISC_OFF);
    F.tid = threadIdx.x; F.lane = F.tid & 63; F.wave = __builtin_amdgcn_readfirstlane(F.tid >> 6); F.G = gridDim.x; F.bid = blockIdx.x;
    F.ctl = (gu32*)(args.ws + WS_CTL);
    if (F.tid < 64) ((LAS unsigned*)(F.lds + MISC_OFF))[F.tid] = 0u;
    __syncthreads();
    XcdBarrier bar; bar.bar = (unsigned*)(F.ctl + CW_BAR); bar.x = 0; bar.st = nullptr;
    if (!MK_PER_PHASE) bar = xcd_barrier_post((unsigned*)(F.ctl + CW_BAR), F.MISC + 8);
    const int lo = args.ph_lo, hi = args.ph_hi;
#define LOADP() { int t_ = threadIdx.x; asm volatile("" : "+v"(t_)); F.tid = t_; F.lane = t_ & 63; F.wave = __builtin_amdgcn_readfirstlane(t_ >> 6); } Ptrs P; { const __attribute__((address_space(4))) Args* ap = (const __attribute__((address_space(4))) Args*)__builtin_amdgcn_kernarg_segment_ptr(); asm volatile("" : "+s"(ap)); \
    P.x = ap->in[0]; P.mix_g = ap->in[1]; P.w_in = ap->in[2]; P.ret_w = ap->in[3]; P.q_gain = ap->in[4]; P.k_gain = ap->in[5]; P.moba_w = ap->in[6]; P.rel_bias = ap->in[7]; \
    P.w_out = ap->in[8]; P.ffn_g = ap->in[9]; P.peer_wq = ap->in[10]; P.sub_keys = ap->in[11]; P.peer_u = ap->in[12]; P.peer_v = ap->in[13]; P.out = ap->out; P.ws = ap->ws; } \
    unsigned char* ws = P.ws; bf16* XN = (bf16*)P.out; bf16* RETG = (bf16*)P.out; bf16* ATT = (bf16*)((unsigned char*)P.out + 32 * MiB); (void)ws; (void)XN; (void)RETG; (void)ATT;
#ifdef RET_NAIVE
#define RET_FN p3a_retention
#else
#define RET_FN p3a_retention_mfma
#endif
#ifdef MOBA_NAIVE
#define MOBA_FN p3b_moba
#else
#define MOBA_FN p3b_moba_mfma<0>
#endif
#ifndef DUP_MASK
#define DUP_MASK 0
#endif
#ifndef DUPPH
#define DUPPH 0
#endif
#define REPS(k) ((((DUPPH) >> (k)) & 1) ? 2 : 1)
#ifndef PH_MASK
#define PH_MASK 0xFFFF
#endif
#define IN(k) (((PH_MASK >> (k)) & 1) && lo <= (k) && (k) < hi)
#define LOCAL_SEAM(k) do { if (MK_PER_PHASE) {} } while (0)
#define SEAM(k) do { if (IN(k) && IN((k) + 1)) xcd_barrier(bar); } while (0)
    LAS unsigned char* ring = F.lds;

    if (IN(0)) for (int rep_ = 0; rep_ < REPS(0); ++rep_) { LOADP(); p0_prologue(F, P); } SEAM(0);
    if (IN(1)) for (int rep_ = 0; rep_ < REPS(1); ++rep_) { LOADP();
        pg8::Gemm g{XN, (const bf16*)(ws + WS_WIN), T, INW, DM, DM, DM, 0}; pg8::StaticOrder S; S.init(T, INW, F.G, F.bid);
        EpiInProj E{(bf16*)(ws + WS_RQ), (bf16*)(ws + WS_RK), (bf16*)(ws + WS_RV), (bf16*)(ws + WS_RG), (bf16*)(ws + WS_MQ), (bf16*)(ws + WS_MK), (bf16*)(ws + WS_MV), (bf16*)(ws + WS_GA), (bf16*)(ws + WS_GB),
                    (const float*)(ws + WS_ROPE), P.q_gain, P.k_gain, (float*)(ws + WS_KM)};
        pg8::gemm_phase<EpiInProj, pg8::StaticOrder, true, true>(ring, g, S, E);
        { const int nunit = (T / 256) * (INW / 256), rem = nunit % F.G;
          if (rem == 0) p0b_late_weights(F, P, F.bid, F.G); else if (F.bid >= rem) p0b_late_weights(F, P, F.bid - rem, F.G - rem); }
    } SEAM(1);
#ifdef EXTRA_BARS
    for (int xb_ = 0; xb_ < EXTRA_BARS; ++xb_) xcd_barrier(bar);
#endif
    if (IN(2)) for (int rep_ = 0; rep_ < REPS(2); ++rep_) { LOADP(); p2a_kv_mfma(F, P); } SEAM(2);
    if (IN(3)) for (int rep_ = 0; rep_ < REPS(3); ++rep_) { LOADP(); p2b_scan(F, P); } SEAM(3);
    if (IN(4)) for (int rep_ = 0; rep_ < REPS(4); ++rep_) { LOADP(); RET_FN(F, P); if (DUP_MASK & 1) RET_FN(F, P); MOBA_FN(F, P); if (DUP_MASK & 2) MOBA_FN(F, P);
#ifdef MOBA_ABL
        p3b_moba_mfma<MOBA_ABL>(F, P);
#endif
    } SEAM(4);
    if (IN(5)) for (int rep_ = 0; rep_ < REPS(5); ++rep_) { LOADP();
        pg8::Gemm g0{ATT, (const bf16*)(ws + WS_WB), T, DM, 512, 512, 512, 0}, g1{RETG, (const bf16*)(ws + WS_WA), T, DM, DM, DM, DM, 0};
        TwoSegOrder S; S.B.init(T, DM, F.G, F.bid);
        EpiMerge2 E{(bf16*)(ws + WS_MRG), (const bf16*)(ws + WS_GA), (const bf16*)(ws + WS_GB)};
        pg8::gemm_phase2<EpiMerge2, TwoSegOrder, true, true>(ring, g0, g1, S, E);
    } SEAM(5);
    if (IN(6)) for (int rep_ = 0; rep_ < REPS(6); ++rep_) { LOADP();
        pg8::Gemm g{(const bf16*)(ws + WS_MRG), (const bf16*)(ws + WS_WO), T, DM, DM, DM, DM, 0}; pg8::StaticOrder S; S.init(T, DM, F.G, F.bid);
        EpiResid E{P.x, P.out, (bf16*)(ws + WS_H2), P.ffn_g, (float*)(ws + WS_SUMSQ)};
        pg8::gemm_phase<EpiResid, pg8::StaticOrder, true, true>(ring, g, S, E);
    } SEAM(6);
    if (IN(9)) for (int rep_ = 0; rep_ < REPS(9); ++rep_) { LOADP();
        pg8::Gemm g{(const bf16*)(ws + WS_WQ), (const bf16*)(ws + WS_H2), PH * 256, T, DM, DM, DM, 0}; MirrorOrder S; S.S8.init(T, 2048, F.G, F.bid);
        EpiNatBf16 E{(bf16*)(ws + WS_ST), T, (const float*)(ws + WS_SUMSQ)};
        pg8::gemm_phase<EpiNatBf16, MirrorOrder, true, true>(ring, g, S, E);
        VM_WAIT(); __syncthreads();
    } LOCAL_SEAM(9);
    if (IN(10)) for (int rep_ = 0; rep_ < REPS(10); ++rep_) { LOADP(); p6_topk(F, P); } SEAM(10);
#ifdef PEER_BF16
    if (IN(11)) for (int rep_ = 0; rep_ < REPS(11); ++rep_) { LOADP(); if (DUP_MASK & 4) p7_peer(F, P, (float*)(ws + WS_ST)); p7_peer(F, P, P.out); }
#else
    if (IN(11)) for (int rep_ = 0; rep_ < REPS(11); ++rep_) { LOADP(); p7u_dots<0>(F, P); if (DUP_MASK & 4) p7u_dots<2>(F, P); } SEAM(11);
    if (IN(12)) for (int rep_ = 0; rep_ < REPS(12); ++rep_) { LOADP(); p7z_gate(F, P); } SEAM(12);
    if (IN(13)) for (int rep_ = 0; rep_ < REPS(13); ++rep_) { LOADP(); if (DUP_MASK & 16) p7v_accum<0>(F, P, (float*)(ws + WS_PART)); p7v_accum<0>(F, P, P.out); }
#endif
#undef IN
#undef SEAM
}

extern "C" void kernel_launch(void* const* d_in, const int* in_sizes, int n_in, void* d_out, int out_size, void* d_ws, size_t ws_size, hipStream_t stream) {
    static int grid = 0;
    if (grid == 0) {
        if (n_in != 14 || out_size != T * DM || ws_size < WS_END) { fprintf(stderr, "kernel_launch: unexpected problem (n_in %d, out %d, ws %zu); nothing launched\n", n_in, out_size, ws_size); grid = -1; return; }
        int dev = 0, cus = 0, per_cu = 0;
        if (hipGetDevice(&dev) != hipSuccess || hipDeviceGetAttribute(&cus, hipDeviceAttributeMultiprocessorCount, dev) != hipSuccess) { grid = -1; return; }
        if (hipFuncSetAttribute((const void*)hybrid_fwd, hipFuncAttributeMaxDynamicSharedMemorySize, LDS_BYTES) != hipSuccess) { fprintf(stderr, "kernel_launch: hipFuncSetAttribute failed\n"); grid = -1; return; }
        if (hipOccupancyMaxActiveBlocksPerMultiprocessor(&per_cu, (const void*)hybrid_fwd, NWAVES * 64, LDS_BYTES) != hipSuccess || per_cu < 1)
            fprintf(stderr, "kernel_launch: note: occupancy query reports %d workgroups per CU\n", per_cu);
        (void)hipGetLastError();
        grid = cus;
    }
    if (grid < 0) return;
    (void)hipMemsetAsync((char*)d_ws + WS_CTL, 0, CTL_ZERO_BYTES, stream);
    Args a{};
    for (int i = 0; i < 14; ++i) a.in[i] = (const float*)d_in[i];
    a.out = (float*)d_out; a.ws = (unsigned char*)d_ws;
#if MK_PER_PHASE
    for (int p = 0; p < N_PHASES; ++p) { a.ph_lo = p; a.ph_hi = p + 1; hipLaunchKernelGGL(hybrid_fwd, dim3(grid), dim3(NWAVES * 64), LDS_BYTES, stream, a); }
#else
    a.ph_lo = 0; a.ph_hi = N_PHASES;
    hipLaunchKernelGGL(hybrid_fwd, dim3(grid), dim3(NWAVES * 64), LDS_BYTES, stream, a);
#endif
}
```

```cpp
#include <hip/hip_runtime.h>
#include <cstdio>
#include <cstdint>

#define GAS __attribute__((address_space(1)))
#define LAS __attribute__((address_space(3)))
typedef unsigned short bf16;
typedef unsigned v4u __attribute__((ext_vector_type(4)));
typedef unsigned v2u __attribute__((ext_vector_type(2)));
typedef float f32x4 __attribute__((ext_vector_type(4)));
typedef short bf16x8 __attribute__((ext_vector_type(8)));
typedef float f32x16 __attribute__((ext_vector_type(16)));
typedef GAS unsigned gu32;
#define RLX_AGENT __ATOMIC_RELAXED, __HIP_MEMORY_SCOPE_AGENT
#define LDS_WAIT() asm volatile("s_waitcnt lgkmcnt(0)" ::: "memory")
#define VM_WAIT() asm volatile("s_waitcnt vmcnt(0)" ::: "memory")

constexpr int BATCH = 4, SEQ = 4096, DM = 1024, T = BATCH * SEQ;
constexpr int RH = 8, RDK = 64, RDV = 128, RC = 128, NCH = SEQ / RC;
constexpr int MH = 8, MD = 64, MBLK = 256, NBLK = SEQ / MBLK;
constexpr int PH = 8, PNK = 128, PTOP = 16, PQD = 256;
constexpr int NEXP = PNK * PNK;
constexpr int INW = 6656;
constexpr float EPS = 1e-6f;

__device__ __forceinline__ unsigned f2bf(float f) { unsigned u = __builtin_bit_cast(unsigned, f); return (u + 0x7fffu + ((u >> 16) & 1u)) >> 16; }
typedef float f32x2_t __attribute__((ext_vector_type(2))); typedef __bf16 bf16x2_t __attribute__((ext_vector_type(2)));
__device__ __forceinline__ unsigned pk2(float lo, float hi) { const f32x2_t v = {lo, hi}; const bf16x2_t b = __builtin_convertvector(v, bf16x2_t); return __builtin_bit_cast(unsigned, b); }
__device__ __forceinline__ float bf2f(unsigned short b) { return __builtin_bit_cast(float, (unsigned)b << 16); }
__device__ __forceinline__ float bflo(unsigned w) { return __builtin_bit_cast(float, w << 16); }
__device__ __forceinline__ float bfhi(unsigned w) { return __builtin_bit_cast(float, w & 0xffff0000u); }
__device__ __forceinline__ float wave_sum(float v) {
#pragma unroll
    for (int o = 1; o < 64; o <<= 1) v += __shfl_xor(v, o);
    return v;
}
__device__ __forceinline__ float dpp_sum8(float v) {
    v += __builtin_bit_cast(float, __builtin_amdgcn_mov_dpp(__builtin_bit_cast(int, v), 0xB1, 0xF, 0xF, true));
    v += __builtin_bit_cast(float, __builtin_amdgcn_mov_dpp(__builtin_bit_cast(int, v), 0x4E, 0xF, 0xF, true));
    v += __builtin_bit_cast(float, __builtin_amdgcn_mov_dpp(__builtin_bit_cast(int, v), 0x141, 0xF, 0xF, true));
    return v;
}
__device__ __forceinline__ float ret_l2g(int h) { return log1pf(-exp2f(-5.0f - (float)h)) * 1.4426950408889634f; }

__host__ __device__ __forceinline__ int perm_row_of_col(int a) {
    const int tile = a >> 8, w = a & 255, wc = w >> 6, bj = (w >> 5) & 1, q = w & 31, fq = q >> 3, n = (q >> 2) & 1, e = q & 3;
    return tile * 256 + 128 * bj + 32 * wc + 16 * n + 4 * fq + e;
}
namespace pg8 {
#define PG8_LAS __attribute__((address_space(3)))
typedef unsigned short bf16_t;
typedef short bf16x8 __attribute__((ext_vector_type(8)));
typedef float f32x4 __attribute__((ext_vector_type(4)));
typedef unsigned u32x4 __attribute__((ext_vector_type(4)));
constexpr int BM = 256, BK = 64, HALF = 128, HTB = HALF * BK * 2  , STAGE_BYTES = 8 * HTB, NXCD = 8, WGM = 8;

__host__ __device__ __forceinline__ int lds_byte(int r, int c) { const int st = (r >> 4) * 2 + (c >> 5), rr = r & 15, cc = c & 31, ob = rr * 64 + cc * 2; return st * 1024 + (ob ^ (((ob >> 9) & 1) << 5)); }
__host__ __device__ __forceinline__ void stage_rc(int b, int& R, int& C) { const int st = b / 1024, sb = b % 1024, swz = sb ^ (((sb >> 9) & 1) << 5); R = (st >> 1) * 16 + swz / 64; C = (st & 1) * 32 + (swz % 64) / 2; }
__host__ __device__ __forceinline__ int perm32(int rho) { const int n = rho >> 4, i = rho & 15; return 8 * (i >> 2) + 4 * n + (i & 3); }

struct Unit { int pm, pn, seg; };
struct Gemm { const bf16_t* A; const bf16_t* Bt; int M, N, K, lda, ldb, bpm; };

struct StaticOrder {
    int nM, nN, nwg, G, c;
    __host__ __device__ void init(int M, int N, int G_, int c_) { nM = M / BM; nN = N / BM; nwg = nM * nN; G = G_; c = c_; }
    __host__ __device__ bool next(int i, Unit& u) const {
        const long L = (long)i * G + c; if (L >= nwg) return false;
        int wgid = (int)L; { const int q = nwg / NXCD, r = nwg % NXCD, xcd = wgid % NXCD, off = wgid / NXCD; wgid = (xcd < r ? xcd * (q + 1) : r * (q + 1) + (xcd - r) * q) + off; }
        const int nig = WGM * nN, gid = wgid / nig, fm = gid * WGM, gsz = (nM - fm) < WGM ? (nM - fm) : WGM;
        u.pm = fm + ((wgid % nig) % gsz); u.pn = (wgid % nig) / gsz; u.seg = 0; return true;
    }
    __device__ __forceinline__ void a_ready(const Unit&) const {}
    __device__ __forceinline__ void done(const Unit&) const {}
};


template <class Epi, class Sched, bool ALIGN_EPI = false, bool SP2 = false>
__device__ __forceinline__ void gemm_phase(PG8_LAS unsigned char* lds, const Gemm g, const Sched& S, const Epi& E) {
    int tid_ = threadIdx.x; asm volatile("" : "+v"(tid_));
    const int tid = tid_, wid = __builtin_amdgcn_readfirstlane(tid >> 6), lane = tid & 63, wr = wid >> 2, wc = wid & 3, fr = lane & 15, fq = lane >> 4;
    const int K = g.K, nt = K / BK;
    unsigned voffA[2], voffB[2];
#pragma unroll
    for (int i = 0; i < 2; ++i) { int R, C; stage_rc(tid * 16 + i * 8192, R, C);
        voffA[i] = (unsigned)(R * g.lda + C) * 2u; voffB[i] = (unsigned)(R * g.ldb + C) * 2u; }
    const size_t kstep = (size_t)(BK * 2);
    const size_t hstepA = (size_t)HALF * g.lda * 2, hstepB = (size_t)HALF * g.ldb * 2;
    const size_t tstepA = 2 * hstepA, tstepB = 2 * hstepB;
    const unsigned ldsw = (unsigned)wid * 1024u;
    const int aoff = lds_byte(wr * 64 + fr, fq * 8), boff = lds_byte(wc * 32 + fr, fq * 8);
#define PG8_SA(b, h) (((b) * 2 + (h)) * HTB)
#define PG8_SB(b, h) ((4 + (b) * 2 + (h)) * HTB)
#define PG8_STAGE(bufoff, gbase, voff) do { _Pragma("unroll") for (int _i = 0; _i < 2; ++_i) \
        __builtin_amdgcn_global_load_lds((const unsigned*)((const char*)(gbase) + (voff)[_i]), (PG8_LAS unsigned*)(lds + (bufoff) + ldsw + _i * 8192), 16, 0, 0); } while (0)
#define PG8_LDA(dst, b, h) do { _Pragma("unroll") for (int m = 0; m < 4; ++m) _Pragma("unroll") for (int k = 0; k < 2; ++k) dst[m][k] = *(const PG8_LAS bf16x8*)(lds + PG8_SA(b, h) + aoff + m * 2048 + k * 1024); } while (0)
#define PG8_LDB(dst, b, h) do { _Pragma("unroll") for (int n = 0; n < 2; ++n) _Pragma("unroll") for (int k = 0; k < 2; ++k) dst[n][k] = *(const PG8_LAS bf16x8*)(lds + PG8_SB(b, h) + boff + n * 2048 + k * 1024); } while (0)
#define PG8_MMA(ai, bj, At, Bt) do { __builtin_amdgcn_s_setprio(1); _Pragma("unroll") for (int m = 0; m < 4; ++m) _Pragma("unroll") for (int n = 0; n < 2; ++n) _Pragma("unroll") for (int k = 0; k < 2; ++k) \
        acc[ai][bj][m][n] = __builtin_amdgcn_mfma_f32_16x16x32_bf16(Bt[n][k], At[m][k], acc[ai][bj][m][n], 0, 0, 0); __builtin_amdgcn_s_setprio(0); } while (0)
#define PG8_WAIT_V(n) asm volatile("s_waitcnt vmcnt(" #n ")" ::: "memory")
#define PG8_WAIT_L(n) asm volatile("s_waitcnt lgkmcnt(" #n ")" ::: "memory")
#define PG8_BAR __builtin_amdgcn_s_barrier()
#define PG8_SCHED __builtin_amdgcn_sched_barrier(0)
    Unit cur, nxt; int ui = 0;
    if (!S.next(0, cur)) return;
    f32x4 acc[2][2][4][2];
#pragma unroll
    for (int a = 0; a < 2; ++a)
#pragma unroll
        for (int b = 0; b < 2; ++b)
#pragma unroll
            for (int m = 0; m < 4; ++m)
#pragma unroll
                for (int n = 0; n < 2; ++n) acc[a][b][m][n] = (f32x4){0.f, 0.f, 0.f, 0.f};
    bf16x8 At[4][2], B0[2][2], B1[2][2];
    const char* cA = (const char*)g.A + (size_t)cur.pm * tstepA; const char* cB = (const char*)g.Bt + (size_t)cur.pn * tstepB + (size_t)cur.pm * g.bpm;
    S.a_ready(cur);
    if constexpr (SP2) {
        PG8_STAGE(PG8_SB(0, 0), cB, voffB); PG8_STAGE(PG8_SB(0, 1), cB + hstepB, voffB); PG8_STAGE(PG8_SA(0, 0), cA, voffA); PG8_STAGE(PG8_SA(0, 1), cA + hstepA, voffA);
        if (wr == 1) PG8_BAR;
        PG8_WAIT_V(2); PG8_BAR;
        PG8_STAGE(PG8_SB(1, 0), cB + kstep, voffB); PG8_STAGE(PG8_SA(1, 0), cA + kstep, voffA); PG8_STAGE(PG8_SB(1, 1), cB + hstepB + kstep, voffB);
        PG8_WAIT_V(6); PG8_BAR;
    } else {
        PG8_STAGE(PG8_SB(0, 0), cB, voffB); PG8_STAGE(PG8_SA(0, 0), cA, voffA); PG8_STAGE(PG8_SB(0, 1), cB + hstepB, voffB); PG8_STAGE(PG8_SA(0, 1), cA + hstepA, voffA);
        if (wr == 1) PG8_BAR;
        PG8_WAIT_V(4); PG8_BAR;
        PG8_STAGE(PG8_SB(1, 0), cB + kstep, voffB); PG8_STAGE(PG8_SA(1, 0), cA + kstep, voffA); PG8_STAGE(PG8_SB(1, 1), cB + hstepB + kstep, voffB);
        PG8_WAIT_V(6); PG8_BAR;
    }
    for (;;) {
        const bool has_next = S.next(ui + 1, nxt);
        const char* nA = has_next ? (const char*)g.A + (size_t)nxt.pm * tstepA : cA; const char* nB = has_next ? (const char*)g.Bt + (size_t)nxt.pn * tstepB + (size_t)nxt.pm * g.bpm : cB;
        for (int t = 0; t < nt; t += 2) {
            const bool last = (t == nt - 2);
            const char* a1 = cA + (size_t)(t + 1) * kstep;
            const char* a2 = last ? nA : cA + (size_t)(t + 2) * kstep; const char* b2 = last ? nB : cB + (size_t)(t + 2) * kstep;
            const char* a3 = a2 + kstep; const char* b3 = b2 + kstep;
            if (last && has_next) S.a_ready(nxt);
            if constexpr (SP2) {
            PG8_LDB(B0, 0, 0); PG8_LDB(B1, 0, 1); PG8_SCHED; PG8_LDA(At, 0, 0); PG8_STAGE(PG8_SA(1, 1), a1 + hstepA, voffA);
            PG8_WAIT_V(8); PG8_WAIT_L(0); PG8_BAR; PG8_MMA(0, 0, At, B0); PG8_MMA(0, 1, At, B1); PG8_BAR; PG8_SCHED;
            PG8_LDA(At, 0, 1); PG8_STAGE(PG8_SB(0, 0), b2, voffB); PG8_STAGE(PG8_SB(0, 1), b2 + hstepB, voffB); PG8_STAGE(PG8_SA(0, 0), a2, voffA);
            PG8_WAIT_V(8); PG8_WAIT_L(0); PG8_BAR; PG8_MMA(1, 0, At, B0); PG8_MMA(1, 1, At, B1); PG8_BAR; PG8_SCHED;
            PG8_LDB(B0, 1, 0); PG8_LDB(B1, 1, 1); PG8_SCHED; PG8_LDA(At, 1, 0); PG8_STAGE(PG8_SA(0, 1), a2 + hstepA, voffA);
            PG8_WAIT_V(8); PG8_WAIT_L(0); PG8_BAR; PG8_MMA(0, 0, At, B0); PG8_MMA(0, 1, At, B1); PG8_BAR; PG8_SCHED;
            PG8_LDA(At, 1, 1); PG8_STAGE(PG8_SB(1, 0), b3, voffB); PG8_STAGE(PG8_SB(1, 1), b3 + hstepB, voffB); PG8_STAGE(PG8_SA(1, 0), a3, voffA);
            PG8_WAIT_V(8); PG8_WAIT_L(0); PG8_BAR; PG8_MMA(1, 0, At, B0); PG8_MMA(1, 1, At, B1); PG8_BAR; PG8_SCHED;
            } else {
            PG8_LDB(B0, 0, 0); PG8_SCHED; PG8_LDA(At, 0, 0); PG8_STAGE(PG8_SA(1, 1), a1 + hstepA, voffA);
            PG8_WAIT_L(8); PG8_BAR; PG8_WAIT_L(0); PG8_MMA(0, 0, At, B0); PG8_BAR; PG8_SCHED;
            PG8_LDB(B1, 0, 1); PG8_STAGE(PG8_SB(0, 0), b2, voffB);
            PG8_BAR; PG8_WAIT_L(0); PG8_MMA(0, 1, At, B1); PG8_BAR;
            PG8_LDA(At, 0, 1); PG8_STAGE(PG8_SA(0, 0), a2, voffA);
            PG8_BAR; PG8_WAIT_L(0); PG8_MMA(1, 0, At, B0); PG8_BAR; PG8_SCHED;
            PG8_STAGE(PG8_SB(0, 1), b2 + hstepB, voffB);
            PG8_WAIT_V(6); PG8_BAR; PG8_MMA(1, 1, At, B1); PG8_BAR;
            PG8_LDB(B0, 1, 0); PG8_SCHED; PG8_LDA(At, 1, 0); PG8_STAGE(PG8_SA(0, 1), a2 + hstepA, voffA);
            PG8_WAIT_L(8); PG8_BAR; PG8_WAIT_L(0); PG8_MMA(0, 0, At, B0); PG8_BAR; PG8_SCHED;
            PG8_LDB(B1, 1, 1); PG8_STAGE(PG8_SB(1, 0), b3, voffB);
            PG8_BAR; PG8_WAIT_L(0); PG8_MMA(0, 1, At, B1); PG8_BAR;
            PG8_LDA(At, 1, 1); PG8_STAGE(PG8_SA(1, 0), a3, voffA);
            PG8_BAR; PG8_WAIT_L(0); PG8_MMA(1, 0, At, B0); PG8_BAR; PG8_SCHED;
            PG8_STAGE(PG8_SB(1, 1), b3 + hstepB, voffB);
            PG8_WAIT_V(6); PG8_BAR; PG8_MMA(1, 1, At, B1); PG8_BAR;
            }
        }
        if constexpr (ALIGN_EPI) { if (wr == 0) PG8_BAR; }
        if constexpr (!Epi::AFTER_DRAIN) { E(acc, cur, wr, wc, fr, fq); S.done(cur); }
        if (!has_next) break;
#pragma unroll
        for (int a = 0; a < 2; ++a)
#pragma unroll
            for (int b = 0; b < 2; ++b)
#pragma unroll
                for (int m = 0; m < 4; ++m)
#pragma unroll
                    for (int n = 0; n < 2; ++n) acc[a][b][m][n] = (f32x4){0.f, 0.f, 0.f, 0.f};
        cur = nxt; cA = nA; cB = nB; ++ui;
        if constexpr (ALIGN_EPI) { if (wr == 1) PG8_BAR; }
    }
    PG8_WAIT_V(0);
    if constexpr (!ALIGN_EPI) { if (wr == 0) PG8_BAR; }
    PG8_BAR;
    if constexpr (Epi::AFTER_DRAIN) { E.fused(acc, cur, wr, wc, fr, fq, lds, wid, lane); S.done(cur); }
#undef PG8_SA
#undef PG8_SB
#undef PG8_STAGE
#undef PG8_LDA
#undef PG8_LDB
#undef PG8_MMA
#undef PG8_WAIT_V
#undef PG8_WAIT_L
#undef PG8_BAR
#undef PG8_SCHED
}
template <class Epi, class Sched, bool ALIGN_EPI = false, bool SP2 = false>
__device__ __forceinline__ void gemm_phase2(PG8_LAS unsigned char* lds, const Gemm g0, const Gemm g1, const Sched& S, const Epi& E) {
    int tid_ = threadIdx.x; asm volatile("" : "+v"(tid_));
    const int tid = tid_, wid = __builtin_amdgcn_readfirstlane(tid >> 6), lane = tid & 63, wr = wid >> 2, wc = wid & 3, fr = lane & 15, fq = lane >> 4;
    unsigned voffA0[2], voffB0[2], voffA1[2], voffB1[2];
#pragma unroll
    for (int i = 0; i < 2; ++i) { int R, C; stage_rc(tid * 16 + i * 8192, R, C);
        voffA0[i] = (unsigned)(R * g0.lda + C) * 2u; voffB0[i] = (unsigned)(R * g0.ldb + C) * 2u; voffA1[i] = (unsigned)(R * g1.lda + C) * 2u; voffB1[i] = (unsigned)(R * g1.ldb + C) * 2u; }
    const size_t kstep = (size_t)(BK * 2);
    const size_t hstepA0 = (size_t)HALF * g0.lda * 2, hstepB0 = (size_t)HALF * g0.ldb * 2, hstepA1 = (size_t)HALF * g1.lda * 2, hstepB1 = (size_t)HALF * g1.ldb * 2;
    const size_t tstepA0 = 2 * hstepA0, tstepB0 = 2 * hstepB0, tstepA1 = 2 * hstepA1, tstepB1 = 2 * hstepB1;
    const unsigned ldsw = (unsigned)wid * 1024u;
    const int aoff = lds_byte(wr * 64 + fr, fq * 8), boff = lds_byte(wc * 32 + fr, fq * 8);
#define PG8_SA(b, h) (((b) * 2 + (h)) * HTB)
#define PG8_SB(b, h) ((4 + (b) * 2 + (h)) * HTB)
#define PG8_STAGE(bufoff, gbase, voff) do { _Pragma("unroll") for (int _i = 0; _i < 2; ++_i) \
        __builtin_amdgcn_global_load_lds((const unsigned*)((const char*)(gbase) + (voff)[_i]), (PG8_LAS unsigned*)(lds + (bufoff) + ldsw + _i * 8192), 16, 0, 0); } while (0)
#define PG8_LDA(dst, b, h) do { _Pragma("unroll") for (int m = 0; m < 4; ++m) _Pragma("unroll") for (int k = 0; k < 2; ++k) dst[m][k] = *(const PG8_LAS bf16x8*)(lds + PG8_SA(b, h) + aoff + m * 2048 + k * 1024); } while (0)
#define PG8_LDB(dst, b, h) do { _Pragma("unroll") for (int n = 0; n < 2; ++n) _Pragma("unroll") for (int k = 0; k < 2; ++k) dst[n][k] = *(const PG8_LAS bf16x8*)(lds + PG8_SB(b, h) + boff + n * 2048 + k * 1024); } while (0)
#define PG8_MMA(ai, bj, At, Bt) do { __builtin_amdgcn_s_setprio(1); _Pragma("unroll") for (int m = 0; m < 4; ++m) _Pragma("unroll") for (int n = 0; n < 2; ++n) _Pragma("unroll") for (int k = 0; k < 2; ++k) \
        acc[ai][bj][m][n] = __builtin_amdgcn_mfma_f32_16x16x32_bf16(Bt[n][k], At[m][k], acc[ai][bj][m][n], 0, 0, 0); __builtin_amdgcn_s_setprio(0); } while (0)
#define PG8_WAIT_V(n) asm volatile("s_waitcnt vmcnt(" #n ")" ::: "memory")
#define PG8_WAIT_L(n) asm volatile("s_waitcnt lgkmcnt(" #n ")" ::: "memory")
#define PG8_BAR __builtin_amdgcn_s_barrier()
#define PG8_SCHED __builtin_amdgcn_sched_barrier(0)
    Unit cur, nxt; int ui = 0;
    if (!S.next(0, cur)) return;
    f32x4 acc[2][2][4][2];
#pragma unroll
    for (int a = 0; a < 2; ++a)
#pragma unroll
        for (int b = 0; b < 2; ++b)
#pragma unroll
            for (int m = 0; m < 4; ++m)
#pragma unroll
                for (int n = 0; n < 2; ++n) acc[a][b][m][n] = (f32x4){0.f, 0.f, 0.f, 0.f};
    bf16x8 At[4][2], B0[2][2], B1[2][2];
#define PG8_UA(u_) ((u_).seg ? (const char*)g1.A + (size_t)(u_).pm * tstepA1 : (const char*)g0.A + (size_t)(u_).pm * tstepA0)
#define PG8_UB(u_) ((u_).seg ? (const char*)g1.Bt + (size_t)(u_).pn * tstepB1 : (const char*)g0.Bt + (size_t)(u_).pn * tstepB0)
    const char* cA = PG8_UA(cur); const char* cB = PG8_UB(cur);
    size_t hAc = cur.seg ? hstepA1 : hstepA0, hBc = cur.seg ? hstepB1 : hstepB0; unsigned vAc[2], vBc[2];
#pragma unroll
    for (int i = 0; i < 2; ++i) { vAc[i] = cur.seg ? voffA1[i] : voffA0[i]; vBc[i] = cur.seg ? voffB1[i] : voffB0[i]; }
    int nt = (cur.seg ? g1.K : g0.K) / BK;
    S.a_ready(cur);
    if constexpr (SP2) {
        PG8_STAGE(PG8_SB(0, 0), cB, vBc); PG8_STAGE(PG8_SB(0, 1), cB + hBc, vBc); PG8_STAGE(PG8_SA(0, 0), cA, vAc); PG8_STAGE(PG8_SA(0, 1), cA + hAc, vAc);
        if (wr == 1) PG8_BAR;
        PG8_WAIT_V(2); PG8_BAR;
        PG8_STAGE(PG8_SB(1, 0), cB + kstep, vBc); PG8_STAGE(PG8_SA(1, 0), cA + kstep, vAc); PG8_STAGE(PG8_SB(1, 1), cB + hBc + kstep, vBc);
        PG8_WAIT_V(6); PG8_BAR;
    } else {
        PG8_STAGE(PG8_SB(0, 0), cB, vBc); PG8_STAGE(PG8_SA(0, 0), cA, vAc); PG8_STAGE(PG8_SB(0, 1), cB + hBc, vBc); PG8_STAGE(PG8_SA(0, 1), cA + hAc, vAc);
        if (wr == 1) PG8_BAR;
        PG8_WAIT_V(4); PG8_BAR;
        PG8_STAGE(PG8_SB(1, 0), cB + kstep, vBc); PG8_STAGE(PG8_SA(1, 0), cA + kstep, vAc); PG8_STAGE(PG8_SB(1, 1), cB + hBc + kstep, vBc);
        PG8_WAIT_V(6); PG8_BAR;
    }
    for (;;) {
        const bool has_next = S.next(ui + 1, nxt);
        const char* nA = has_next ? PG8_UA(nxt) : cA; const char* nB = has_next ? PG8_UB(nxt) : cB;
        const int sn = has_next ? nxt.seg : cur.seg; const size_t hAn = sn ? hstepA1 : hstepA0, hBn = sn ? hstepB1 : hstepB0; unsigned vAn[2], vBn[2];
#pragma unroll
        for (int i = 0; i < 2; ++i) { vAn[i] = sn ? voffA1[i] : voffA0[i]; vBn[i] = sn ? voffB1[i] : voffB0[i]; }
        for (int t = 0; t < nt; t += 2) {
            const bool last = (t == nt - 2);
            const size_t hA2 = last ? hAn : hAc, hB2 = last ? hBn : hBc; unsigned vA2[2], vB2[2];
#pragma unroll
            for (int i = 0; i < 2; ++i) { vA2[i] = last ? vAn[i] : vAc[i]; vB2[i] = last ? vBn[i] : vBc[i]; }
            const char* a1 = cA + (size_t)(t + 1) * kstep;
            const char* a2 = last ? nA : cA + (size_t)(t + 2) * kstep; const char* b2 = last ? nB : cB + (size_t)(t + 2) * kstep;
            const char* a3 = a2 + kstep; const char* b3 = b2 + kstep;
            if (last && has_next) S.a_ready(nxt);
            if constexpr (SP2) {
            PG8_LDB(B0, 0, 0); PG8_LDB(B1, 0, 1); PG8_SCHED; PG8_LDA(At, 0, 0); PG8_STAGE(PG8_SA(1, 1), a1 + hAc, vAc);
            PG8_WAIT_V(8); PG8_WAIT_L(0); PG8_BAR; PG8_MMA(0, 0, At, B0); PG8_MMA(0, 1, At, B1); PG8_BAR; PG8_SCHED;
            PG8_LDA(At, 0, 1); PG8_STAGE(PG8_SB(0, 0), b2, vB2); PG8_STAGE(PG8_SB(0, 1), b2 + hB2, vB2); PG8_STAGE(PG8_SA(0, 0), a2, vA2);
            PG8_WAIT_V(8); PG8_WAIT_L(0); PG8_BAR; PG8_MMA(1, 0, At, B0); PG8_MMA(1, 1, At, B1); PG8_BAR; PG8_SCHED;
            PG8_LDB(B0, 1, 0); PG8_LDB(B1, 1, 1); PG8_SCHED; PG8_LDA(At, 1, 0); PG8_STAGE(PG8_SA(0, 1), a2 + hA2, vA2);
            PG8_WAIT_V(8); PG8_WAIT_L(0); PG8_BAR; PG8_MMA(0, 0, At, B0); PG8_MMA(0, 1, At, B1); PG8_BAR; PG8_SCHED;
            PG8_LDA(At, 1, 1); PG8_STAGE(PG8_SB(1, 0), b3, vB2); PG8_STAGE(PG8_SB(1, 1), b3 + hB2, vB2); PG8_STAGE(PG8_SA(1, 0), a3, vA2);
            PG8_WAIT_V(8); PG8_WAIT_L(0); PG8_BAR; PG8_MMA(1, 0, At, B0); PG8_MMA(1, 1, At, B1); PG8_BAR; PG8_SCHED;
            } else {
            PG8_LDB(B0, 0, 0); PG8_SCHED; PG8_LDA(At, 0, 0); PG8_STAGE(PG8_SA(1, 1), a1 + hAc, vAc);
            PG8_WAIT_L(8); PG8_BAR; PG8_WAIT_L(0); PG8_MMA(0, 0, At, B0); PG8_BAR; PG8_SCHED;
            PG8_LDB(B1, 0, 1); PG8_STAGE(PG8_SB(0, 0), b2, vB2);
            PG8_BAR; PG8_WAIT_L(0); PG8_MMA(0, 1, At, B1); PG8_BAR;
            PG8_LDA(At, 0, 1); PG8_STAGE(PG8_SA(0, 0), a2, vA2);
            PG8_BAR; PG8_WAIT_L(0); PG8_MMA(1, 0, At, B0); PG8_BAR; PG8_SCHED;
            PG8_STAGE(PG8_SB(0, 1), b2 + hB2, vB2);
            PG8_WAIT_V(6); PG8_BAR; PG8_MMA(1, 1, At, B1); PG8_BAR;
            PG8_LDB(B0, 1, 0); PG8_SCHED; PG8_LDA(At, 1, 0); PG8_STAGE(PG8_SA(0, 1), a2 + hA2, vA2);
            PG8_WAIT_L(8); PG8_BAR; PG8_WAIT_L(0); PG8_MMA(0, 0, At, B0); PG8_BAR; PG8_SCHED;
            PG8_LDB(B1, 1, 1); PG8_STAGE(PG8_SB(1, 0), b3, vB2);
            PG8_BAR; PG8_WAIT_L(0); PG8_MMA(0, 1, At, B1); PG8_BAR;
            PG8_LDA(At, 1, 1); PG8_STAGE(PG8_SA(1, 0), a3, vA2);
            PG8_BAR; PG8_WAIT_L(0); PG8_MMA(1, 0, At, B0); PG8_BAR; PG8_SCHED;
            PG8_STAGE(PG8_SB(1, 1), b3 + hB2, vB2);
            PG8_WAIT_V(6); PG8_BAR; PG8_MMA(1, 1, At, B1); PG8_BAR;
            }
        }
        if constexpr (ALIGN_EPI) { if (wr == 0) PG8_BAR; }
        if (cur.seg == 0) E.mid(acc, cur, wr, wc, fr, fq); else { E(acc, cur, wr, wc, fr, fq); S.done(cur); }
        if (!has_next) break;
        if (cur.seg == 1) {
#pragma unroll
        for (int a = 0; a < 2; ++a)
#pragma unroll
            for (int b = 0; b < 2; ++b)
#pragma unroll
                for (int m = 0; m < 4; ++m)
#pragma unroll
                    for (int n = 0; n < 2; ++n) acc[a][b][m][n] = (f32x4){0.f, 0.f, 0.f, 0.f};
        }
        cur = nxt; cA = nA; cB = nB; ++ui; hAc = hAn; hBc = hBn; vAc[0] = vAn[0]; vAc[1] = vAn[1]; vBc[0] = vBn[0]; vBc[1] = vBn[1]; nt = (cur.seg ? g1.K : g0.K) / BK;
        if constexpr (ALIGN_EPI) { if (wr == 1) PG8_BAR; }
    }
    PG8_WAIT_V(0);
    if constexpr (!ALIGN_EPI) { if (wr == 0) PG8_BAR; }
    PG8_BAR;
#undef PG8_UA
#undef PG8_UB
#undef PG8_SA
#undef PG8_SB
#undef PG8_STAGE
#undef PG8_LDA
#undef PG8_LDB
#undef PG8_MMA
#undef PG8_WAIT_V
#undef PG8_WAIT_L
#undef PG8_BAR
#undef PG8_SCHED
}
}

#define XB_TMO      128
#define XB_XCNT(j)  (256  + 64 * (j))
#define XB_XSUB(j)  (1280 + 64 * (j))
#define XB_XGEN(j)  (2304 + 64 * (j))
#define XB_TOP      3328
#define XB_TOPGEN   3392
#define XCD_BAR_WORDS 3456
#define XB_SPIN_CAP (1u << 18)

__device__ __forceinline__ unsigned xb_ld(unsigned* p)              { return __hip_atomic_load(p, __ATOMIC_RELAXED, __HIP_MEMORY_SCOPE_AGENT); }
__device__ __forceinline__ unsigned xb_add(unsigned* p, unsigned v) { return __hip_atomic_fetch_add(p, v, __ATOMIC_RELAXED, __HIP_MEMORY_SCOPE_AGENT); }
__device__ __forceinline__ unsigned xb_xcc_id() { return (unsigned)__builtin_amdgcn_s_getreg((3 << 11) | 20) & 0xFu; }
#define XB_SPIN(cond, bar) do { unsigned _sp = 0; while (cond) { __builtin_amdgcn_s_sleep(1); \
    if ((++_sp & 255u) == 0u) { if (xb_ld(&(bar)[XB_TMO])) break; if (_sp > XB_SPIN_CAP) { atomicAdd(&(bar)[XB_TMO], 1u); break; } } } } while (0)

struct XcdBarrier {
    unsigned* bar; unsigned x;
    volatile LAS unsigned* st;
};

__device__ __forceinline__ XcdBarrier xcd_barrier_post(unsigned* bar, volatile LAS unsigned* st) {
    XcdBarrier b; b.bar = bar; b.x = xb_xcc_id(); b.st = st;
    if (threadIdx.x == 0) (void)xb_add(&bar[XB_XCNT(b.x)], 1u);
    return b;
}
__device__ __forceinline__ void xcd_barrier_complete(unsigned* bar, unsigned x, unsigned& nloc, unsigned& nx) {
    const unsigned G = gridDim.x * gridDim.y * gridDim.z;
    unsigned sum, cnt, mine, sp = 0u;
    for (;;) {
        sum = 0u; cnt = 0u; mine = 0u;
#pragma unroll
        for (unsigned j = 0; j < 16; ++j) { const unsigned c = xb_ld(&bar[XB_XCNT(j)]); sum += c; cnt += (c > 0u) ? 1u : 0u; mine = (j == x) ? c : mine; }
        if (sum == G) break;
        __builtin_amdgcn_s_sleep(1);
        if ((++sp & 255u) == 0u) { if (xb_ld(&bar[XB_TMO])) break; if (sp > XB_SPIN_CAP) { atomicAdd(&bar[XB_TMO], 1u); break; } }
    }
    nloc = mine > 0u ? mine : 1u; nx = cnt > 0u ? cnt : 1u;
}

__device__ __forceinline__ void xcd_barrier(const XcdBarrier& b) {
    asm volatile("s_waitcnt vmcnt(0)" ::: "memory");
    __syncthreads();
    if (threadIdx.x == 0) {
        unsigned* bar = b.bar;
        __builtin_amdgcn_s_waitcnt(0);
        unsigned nloc = b.st[0], nx = b.st[1];
        if (nloc == 0u) { xcd_barrier_complete(bar, b.x, nloc, nx); b.st[0] = nloc; b.st[1] = nx; }
        const unsigned old = xb_add(&bar[XB_XSUB(b.x)], 1u);
        const unsigned gen = old / nloc;
        if (old + 1u == (gen + 1u) * nloc) {
            __builtin_amdgcn_fence(__ATOMIC_RELEASE, "agent");
            asm volatile("s_waitcnt vmcnt(0)" ::: "memory");
            const unsigned og = xb_add(&bar[XB_TOP], 1u);
            const unsigned tg = og / nx;
            if (og + 1u == (tg + 1u) * nx) xb_add(&bar[XB_TOPGEN], 1u);
            else XB_SPIN(xb_ld(&bar[XB_TOPGEN]) == tg, bar);
            __builtin_amdgcn_fence(__ATOMIC_ACQUIRE, "agent");
            xb_add(&bar[XB_XGEN(b.x)], 1u);
            asm volatile("s_waitcnt vmcnt(0)" ::: "memory");
        } else {
            XB_SPIN(xb_ld(&bar[XB_XGEN(b.x)]) == gen, bar);
            __builtin_amdgcn_fence(__ATOMIC_ACQUIRE, "agent");
            asm volatile("s_waitcnt vmcnt(0)" ::: "memory");
        }
    }
    __syncthreads();
}

constexpr size_t MiB = 1u << 20;
constexpr size_t WS_CTL = 0, CTL_ZERO_BYTES = 192 * 1024;
constexpr size_t WS_SUMSQ = 128 * 1024;
constexpr int CW_BAR = 1024;
constexpr size_t WS_WIN = 1 * MiB;
constexpr size_t WS_WA = 14 * MiB;
constexpr size_t WS_WB = 16 * MiB;
constexpr size_t WS_WO = 17 * MiB;
constexpr size_t WS_WQ = 19 * MiB;
constexpr size_t WS_SKB = 23 * MiB;
constexpr size_t WS_ROPE = 24 * MiB;
constexpr size_t WS_BIAS = 25 * MiB;
constexpr size_t WS_KM = 25 * MiB + 256 * 1024;
constexpr size_t WS_PREV = 26 * MiB;
constexpr size_t WS_ACT = 42 * MiB;
constexpr size_t WS_RQ = WS_ACT, WS_RK = WS_RQ + 16 * MiB, WS_RV = WS_RK + 16 * MiB, WS_RG = WS_RV + 32 * MiB;
constexpr size_t WS_MQ = WS_RG + 32 * MiB, WS_MK = WS_MQ + 16 * MiB, WS_MV = WS_MK + 16 * MiB;
constexpr size_t WS_GA = WS_MV + 16 * MiB, WS_GB = WS_GA + 32 * MiB;
constexpr size_t WS_END = 256 * MiB;
constexpr size_t WS_YB = WS_ACT;
constexpr size_t WS_MRG = WS_ACT + 32 * MiB;
constexpr size_t WS_H2 = WS_ACT + 64 * MiB;
constexpr size_t WS_EG = WS_ACT + 96 * MiB;
constexpr size_t WS_QP = WS_ACT;
constexpr size_t WS_UV = WS_ACT;
constexpr size_t WS_UV8 = WS_ACT + 112 * MiB;
constexpr size_t WS_ST = WS_ACT + 144 * MiB;
static_assert(WS_GB + 32 * MiB <= WS_END && WS_EG + 16 * MiB <= WS_ST && WS_ST + 64 * MiB <= WS_END, "d_ws map");

constexpr int LDS_BYTES = 159 * 1024;
constexpr int MISC_OFF = LDS_BYTES - 256;
constexpr int NWAVES = 8;


using pg8::Unit;
__device__ __forceinline__ void store8_bf16(bf16* p, f32x4 a, f32x4 b) { v4u w; w.x = pk2(a[0], a[1]); w.y = pk2(a[2], a[3]); w.z = pk2(b[0], b[1]); w.w = pk2(b[2], b[3]); *(v4u*)p = w; }
__device__ __forceinline__ void load8_bf16(const bf16* p, f32x4& a, f32x4& b) { const v4u w = *(const v4u*)p; a = (f32x4){bflo(w.x), bfhi(w.x), bflo(w.y), bfhi(w.y)}; b = (f32x4){bflo(w.z), bfhi(w.z), bflo(w.w), bfhi(w.w)}; }
__device__ __forceinline__ float sigmoidf_(float x) { return __builtin_amdgcn_rcpf(1.0f + __builtin_amdgcn_exp2f(-1.4426950408889634f * x)); }
__device__ __forceinline__ f32x4 sig4(f32x4 v) { return (f32x4){sigmoidf_(v[0]), sigmoidf_(v[1]), sigmoidf_(v[2]), sigmoidf_(v[3])}; }
__device__ __forceinline__ f32x4 silu4(f32x4 v) { return v * sig4(v); }

#ifdef MOBA_NAIVE
constexpr float MOBA_QSCALE = 0.125f;
#else
constexpr float MOBA_QSCALE = 0.125f * 1.4426950408889634f;
#endif
struct EpiInProj {
    static constexpr bool AFTER_DRAIN = false;
    bf16 *RQ, *RK, *RV, *RG, *MQ, *MK, *MV, *GA, *GB; const float* rope; const float* qgain; const float* kgain; float* KMP;
    __device__ __forceinline__ void operator()(const f32x4 (&acc)[2][2][4][2], const Unit& u, int wr, int wc, int fr, int fq) const {
        const int pn = u.pn, rowb = u.pm * 256 + wr * 64 + fr, cw = 64 * wc + 8 * fq;
        if (pn < 4) {
            bf16* dst = (pn < 2 ? RQ : RK) + (pn & 1) * 256 + cw; const float sc = pn < 2 ? 1.0f : 0.125f;
#pragma unroll
            for (int ai = 0; ai < 2; ++ai)
#pragma unroll
                for (int m = 0; m < 4; ++m) {
                    const int row = rowb + ai * 128 + m * 16; const float* rp = rope + (size_t)(row & (SEQ - 1)) * 64 + 8 * fq;
                    const f32x4 c0 = *(const f32x4*)rp * sc, c1 = *(const f32x4*)(rp + 4) * sc, s0 = *(const f32x4*)(rp + 32) * sc, s1 = *(const f32x4*)(rp + 36) * sc;
                    const f32x4 x10 = acc[ai][0][m][0], x11 = acc[ai][0][m][1], x20 = acc[ai][1][m][0], x21 = acc[ai][1][m][1];
                    bf16* p = dst + (size_t)row * 512;
                    store8_bf16(p, x10 * c0 - x20 * s0, x11 * c1 - x21 * s1);
                    store8_bf16(p + 32, x10 * s0 + x20 * c0, x11 * s1 + x21 * c1);
                }
        } else if (pn < 12 || (pn >= 16)) {
            bf16* dst; int ld, mode;
            if (pn < 8) { dst = RV + (pn - 4) * 256; ld = 1024; mode = 0; }
            else if (pn < 12) { dst = RG + (pn - 8) * 256; ld = 1024; mode = 1; }
            else if (pn < 18) { dst = MV + (pn - 16) * 256; ld = 512; mode = 0; }
            else if (pn < 22) { dst = GA + (pn - 18) * 256; ld = 1024; mode = 2; }
            else { dst = GB + (pn - 22) * 256; ld = 1024; mode = 2; }
            dst += cw;
#pragma unroll
            for (int ai = 0; ai < 2; ++ai)
#pragma unroll
                for (int m = 0; m < 4; ++m) {
                    const int row = rowb + ai * 128 + m * 16; bf16* p = dst + (size_t)row * ld;
#pragma unroll
                    for (int bj = 0; bj < 2; ++bj) {
                        f32x4 a = acc[ai][bj][m][0], b = acc[ai][bj][m][1];
                        if (mode == 1) { a = silu4(a); b = silu4(b); } else if (mode == 2) { a = sig4(a); b = sig4(b); }
                        store8_bf16(p + 32 * bj, a, b);
                    }
                }
        } else {
            const bool isq = pn < 14; bf16* dst = (isq ? MQ : MK) + (pn & 1) * 256 + cw; const float* gain = (isq ? qgain : kgain) + 8 * fq; const float sc = isq ? MOBA_QSCALE : 1.0f;
            f32x4 cs00 = {0.f, 0.f, 0.f, 0.f}, cs01 = cs00, cs10 = cs00, cs11 = cs00;
            const f32x4 g00 = *(const f32x4*)gain * sc, g01 = *(const f32x4*)(gain + 4) * sc, g10 = *(const f32x4*)(gain + 32) * sc, g11 = *(const f32x4*)(gain + 36) * sc;
#pragma unroll
            for (int ai = 0; ai < 2; ++ai)
#pragma unroll
                for (int m = 0; m < 4; ++m) {
                    const int row = rowb + ai * 128 + m * 16; bf16* p = dst + (size_t)row * 512;
                    const f32x4 a0 = acc[ai][0][m][0], a1 = acc[ai][0][m][1], b0 = acc[ai][1][m][0], b1 = acc[ai][1][m][1];
                    const f32x4 q = a0 * a0 + a1 * a1 + b0 * b0 + b1 * b1; float ss = (q[0] + q[1]) + (q[2] + q[3]);
                    ss += __shfl_xor(ss, 16); ss += __shfl_xor(ss, 32);
                    const float r = rsqrtf(ss * (1.0f / 64.0f) + EPS);
                    const f32x4 y00 = a0 * r * g00, y01 = a1 * r * g01, y10 = b0 * r * g10, y11 = b1 * r * g11;
                    store8_bf16(p, y00, y01);
                    store8_bf16(p + 32, y10, y11);
                    if (!isq) { cs00 += y00; cs01 += y01; cs10 += y10; cs11 += y11; }
                }
            if (!isq) {
#pragma unroll
                for (int e = 0; e < 4; ++e) {
#pragma unroll
                    for (int o = 1; o < 16; o <<= 1) { cs00[e] += __shfl_xor(cs00[e], o); cs01[e] += __shfl_xor(cs01[e], o); cs10[e] += __shfl_xor(cs10[e], o); cs11[e] += __shfl_xor(cs11[e], o); }
                }
                if (fr == 0) { float* kp = KMP + (((size_t)u.pm * 2 + (pn & 1)) * 2 + wr) * 256 + cw;
                    *(f32x4*)kp = cs00; *(f32x4*)(kp + 4) = cs01; *(f32x4*)(kp + 32) = cs10; *(f32x4*)(kp + 36) = cs11; }
            }
        }
    }
};
struct EpiMerge2 {
    static constexpr bool AFTER_DRAIN = false;
    bf16* O; const bf16* GA; const bf16* GB;
    __device__ __forceinline__ void mid(f32x4 (&acc)[2][2][4][2], const Unit& u, int wr, int wc, int fr, int fq) const {
        const int rowb = u.pm * 256 + wr * 64 + fr, col = u.pn * 256 + 64 * wc + 8 * fq;
#pragma unroll
        for (int ai = 0; ai < 2; ++ai)
#pragma unroll
            for (int m = 0; m < 4; ++m) {
                const size_t off = (size_t)(rowb + ai * 128 + m * 16) * 1024 + col;
#pragma unroll
                for (int bj = 0; bj < 2; ++bj) { f32x4 a0, a1, b0, b1; load8_bf16(GA + off + 32 * bj, a0, a1); load8_bf16(GB + off + 32 * bj, b0, b1);
#pragma unroll
                    for (int e = 0; e < 4; ++e) { acc[ai][bj][m][0][e] *= b0[e] * __builtin_amdgcn_rcpf(fmaxf(a0[e], 1e-6f)); acc[ai][bj][m][1][e] *= b1[e] * __builtin_amdgcn_rcpf(fmaxf(a1[e], 1e-6f)); } }
            }
    }
    __device__ __forceinline__ void operator()(const f32x4 (&acc)[2][2][4][2], const Unit& u, int wr, int wc, int fr, int fq) const {
        const int rowb = u.pm * 256 + wr * 64 + fr, col = u.pn * 256 + 64 * wc + 8 * fq;
#pragma unroll
        for (int ai = 0; ai < 2; ++ai)
#pragma unroll
            for (int m = 0; m < 4; ++m) {
                const size_t off = (size_t)(rowb + ai * 128 + m * 16) * 1024 + col;
#pragma unroll
                for (int bj = 0; bj < 2; ++bj) { f32x4 a0, a1; load8_bf16(GA + off + 32 * bj, a0, a1);
#pragma unroll
                    for (int e = 0; e < 4; ++e) { a0[e] = fmaxf(a0[e], 1e-6f); a1[e] = fmaxf(a1[e], 1e-6f); }
                    store8_bf16(O + off + 32 * bj, acc[ai][bj][m][0] * a0, acc[ai][bj][m][1] * a1); }
            }
    }
};
struct TwoSegOrder {
    pg8::StaticOrder B;
    __device__ __forceinline__ bool next(int i, pg8::Unit& u) const { if (!B.next(i >> 1, u)) return false; u.seg = i & 1; return true; }
    __device__ __forceinline__ void a_ready(const pg8::Unit&) const {}
    __device__ __forceinline__ void done(const pg8::Unit&) const {}
};
struct EpiResid {
    static constexpr bool AFTER_DRAIN = false;
    const float* base; float* out; bf16* XG; const float* g2; float* SS;
    __device__ __forceinline__ void operator()(const f32x4 (&acc)[2][2][4][2], const Unit& u, int wr, int wc, int fr, int fq) const {
        const int rowb = u.pm * 256 + wr * 64 + fr, col = u.pn * 256 + 64 * wc + 8 * fq;
        const f32x4 g00 = *(const f32x4*)(g2 + col), g01 = *(const f32x4*)(g2 + col + 4), g10 = *(const f32x4*)(g2 + col + 32), g11 = *(const f32x4*)(g2 + col + 36);
#pragma unroll
        for (int ai = 0; ai < 2; ++ai)
#pragma unroll
            for (int m = 0; m < 4; ++m) {
                const int row = rowb + ai * 128 + m * 16; const size_t off = (size_t)row * 1024 + col;
                const f32x4 x00 = *(const f32x4*)(base + off) + acc[ai][0][m][0], x01 = *(const f32x4*)(base + off + 4) + acc[ai][0][m][1];
                const f32x4 x10 = *(const f32x4*)(base + off + 32) + acc[ai][1][m][0], x11 = *(const f32x4*)(base + off + 36) + acc[ai][1][m][1];
                *(f32x4*)(out + off) = x00; *(f32x4*)(out + off + 4) = x01; *(f32x4*)(out + off + 32) = x10; *(f32x4*)(out + off + 36) = x11;
                store8_bf16(XG + off, x00 * g00, x01 * g01); store8_bf16(XG + off + 32, x10 * g10, x11 * g11);
                const f32x4 q = x00 * x00 + x01 * x01 + x10 * x10 + x11 * x11; float ss = (q[0] + q[1]) + (q[2] + q[3]);
                ss += __shfl_xor(ss, 16); ss += __shfl_xor(ss, 32);
                if (fq == 0) atomicAdd(SS + row, ss);
            }
    }
};
struct EpiPlainBf16 {
    static constexpr bool AFTER_DRAIN = false;
    bf16* O; int ldc;
    __device__ __forceinline__ void operator()(const f32x4 (&acc)[2][2][4][2], const Unit& u, int wr, int wc, int fr, int fq) const {
        const int rowb = u.pm * 256 + wr * 64 + fr, col = u.pn * 256 + 64 * wc + 8 * fq;
#pragma unroll
        for (int ai = 0; ai < 2; ++ai)
#pragma unroll
            for (int m = 0; m < 4; ++m) {
                const size_t off = (size_t)(rowb + ai * 128 + m * 16) * ldc + col;
#pragma unroll
                for (int bj = 0; bj < 2; ++bj) store8_bf16(O + off + 32 * bj, acc[ai][bj][m][0], acc[ai][bj][m][1]);
            }
    }
};
struct EpiNatBf16 {
    static constexpr bool AFTER_DRAIN = false;
    bf16* O; int ldc; const float* SS;
    __device__ __forceinline__ void operator()(const f32x4 (&acc)[2][2][4][2], const Unit& u, int wr, int wc, int fr, int fq) const {
        const int rowb = u.pm * 256 + wr * 64 + fr, col = u.pn * 256 + 32 * wc + 4 * fq;
        f32x4 rs[2][2];
#pragma unroll
        for (int bj = 0; bj < 2; ++bj)
#pragma unroll
            for (int n = 0; n < 2; ++n) { const f32x4 s = *(const f32x4*)(SS + col + 128 * bj + 16 * n); rs[bj][n] = (f32x4){rsqrtf(s[0] * (1.0f / DM) + EPS), rsqrtf(s[1] * (1.0f / DM) + EPS), rsqrtf(s[2] * (1.0f / DM) + EPS), rsqrtf(s[3] * (1.0f / DM) + EPS)}; }
#pragma unroll
        for (int ai = 0; ai < 2; ++ai)
#pragma unroll
            for (int m = 0; m < 4; ++m) {
                const size_t off = (size_t)(rowb + ai * 128 + m * 16) * ldc + col;
#pragma unroll
                for (int bj = 0; bj < 2; ++bj)
#pragma unroll
                    for (int n = 0; n < 2; ++n) { const f32x4 v = acc[ai][bj][m][n] * rs[bj][n]; v2u w; w.x = pk2(v[0], v[1]); w.y = pk2(v[2], v[3]); *(v2u*)(O + off + 128 * bj + 16 * n) = w; }
            }
    }
};

struct Frame {
    LAS unsigned char* lds;
    volatile LAS unsigned* MISC;
    gu32* ctl;
    int tid, lane, wave, G, bid;
};

__device__ __forceinline__ void p0_transpose_item(const float* W, int K, int N, bf16* WT, LAS float* scr, int item, int lane) {
    const int nblk = N / 32, kb = item / nblk, nb = item % nblk, k0 = 64 * kb, n0 = 32 * nb;
#pragma unroll 8
    for (int i = 0; i < 32; ++i) { const int kk = 2 * i + (lane >> 5); scr[kk * 33 + (lane & 31)] = W[(size_t)(k0 + kk) * N + n0 + (lane & 31)]; }
    LDS_WAIT(); asm volatile("" ::: "memory");
    const int c = lane & 7;
#pragma unroll
    for (int j = 0; j < 4; ++j) { const int n = (lane >> 3) + 8 * j; const LAS float* s = scr + (8 * c) * 33 + n;
        v4u o; o.x = pk2(s[0 * 33], s[1 * 33]); o.y = pk2(s[2 * 33], s[3 * 33]); o.z = pk2(s[4 * 33], s[5 * 33]); o.w = pk2(s[6 * 33], s[7 * 33]);
        *(GAS v4u*)(WT + (size_t)perm_row_of_col(n0 + n) * K + k0 + 8 * c) = o; }
    LDS_WAIT(); asm volatile("" ::: "memory");
}
__device__ __forceinline__ void rms_row_to_bf16(const float* xrow, const float* g, bf16* orow, int lane) {
    const GAS f32x4* xr = (const GAS f32x4*)xrow + lane; const GAS f32x4* gr = (const GAS f32x4*)g + lane;
    f32x4 v[4]; float s = 0.f;
#pragma unroll
    for (int j = 0; j < 4; ++j) { v[j] = __builtin_nontemporal_load(&xr[64 * j]); s += (v[j].x * v[j].x + v[j].y * v[j].y) + (v[j].z * v[j].z + v[j].w * v[j].w); }
    const float r = rsqrtf(wave_sum(s) * (1.0f / DM) + EPS);
    GAS v2u* o8 = (GAS v2u*)orow + lane;
#pragma unroll
    for (int j = 0; j < 4; ++j) { const f32x4 gg = gr[64 * j]; v2u w; w.x = pk2(v[j].x * r * gg.x, v[j].y * r * gg.y); w.y = pk2(v[j].z * r * gg.z, v[j].w * r * gg.w); o8[64 * j] = w; }
}
__device__ __forceinline__ float t5_bias_of_dist(const float* rel_bias, int h, int dist) {
    int bkt;
    if (dist < 16) bkt = dist;
    else { const float nf = (float)dist; int lg = 16 + (int)(logf(nf / 16.0f) / 4.852030263919617f * 16.0f); bkt = lg < 31 ? lg : 31; }
    return rel_bias[bkt * MH + h];
}

struct Ptrs {
    const float *x, *mix_g, *w_in, *ret_w, *q_gain, *k_gain, *moba_w, *rel_bias, *w_out, *ffn_g, *peer_wq, *sub_keys, *peer_u, *peer_v;
    float* out; unsigned char* ws;
};

__device__ __forceinline__ void p0_prologue(Frame& F, const Ptrs& P) {
    LAS float* scr = (LAS float*)(F.lds + F.wave * 16384);
    const int gw = F.bid * NWAVES + F.wave, NGW = F.G * NWAVES;
    unsigned char* ws = P.ws;
    constexpr int I_IN = (DM / 64) * (INW / 32), I_A = (1024 / 64) * (1024 / 32), I_B = (512 / 64) * (1024 / 32), I_O = I_A, I_Q = (1024 / 64) * (2048 / 32);
    constexpr int NITEMS = I_IN + I_A + I_B + I_O; (void)I_Q;
    (void)NITEMS;
    for (int it = gw; it < I_IN; it += NGW) p0_transpose_item(P.w_in, DM, INW, (bf16*)(ws + WS_WIN), scr, it, F.lane);
    bf16* XN = (bf16*)P.out;
    for (int m = gw; m < T; m += NGW) rms_row_to_bf16(P.x + (size_t)m * DM, P.mix_g, XN + (size_t)m * DM, F.lane);
    const int gt = F.bid * 512 + F.tid, NGT = F.G * 512;
    float* rope = (float*)(ws + WS_ROPE);
    for (int i = gt; i < SEQ * 32; i += NGT) { const int pos = i >> 5, j = i & 31; const float inv = powf(10000.0f, -(float)j / 32.0f); const float ang = (float)pos * inv; float sn, cs; sincosf(ang, &sn, &cs);
        rope[pos * 64 + j] = cs; rope[pos * 64 + 32 + j] = sn; }
    float* BT = (float*)(ws + WS_BIAS);
    for (int i = gt; i < MH * SEQ; i += NGT) { const int h = i >> 12, dist = i & (SEQ - 1); BT[i] = t5_bias_of_dist(P.rel_bias, h, dist); }
}


__device__ __forceinline__ void p0b_late_weights(Frame& F, const Ptrs& P, int idx, int n) {
    LAS float* scr = (LAS float*)(F.lds + F.wave * 16384);
    const int gw = idx * NWAVES + F.wave, NGW = n * NWAVES;
    unsigned char* ws = P.ws;
    constexpr int I_A = (1024 / 64) * (1024 / 32), I_B = (512 / 64) * (1024 / 32), I_O = I_A;
    for (int it = gw; it < I_A + I_B + I_O; it += NGW) {
        int r = it;
        if (r < I_A) { p0_transpose_item(P.ret_w, 1024, 1024, (bf16*)(ws + WS_WA), scr, r, F.lane); continue; } r -= I_A;
        if (r < I_B) { p0_transpose_item(P.moba_w, 512, 1024, (bf16*)(ws + WS_WB), scr, r, F.lane); continue; } r -= I_B;
        p0_transpose_item(P.w_out, 1024, 1024, (bf16*)(ws + WS_WO), scr, r, F.lane);
    }
    { bf16* WST = (bf16*)(ws + WS_WQ);
      for (int wt = gw; wt < 16 * 4 * 32; wt += NGW) {
          const int blk = wt >> 7, nt = (wt >> 5) & 3, mt = wt & 31, r32 = F.lane & 31, hi = F.lane >> 5;
          const float* ap = P.sub_keys + ((size_t)blk * PNK + 32 * nt + r32) * 128 + 8 * hi;
          const float* bp = P.peer_wq + (size_t)(32 * mt + r32) * 2048 + blk * 128 + 8 * hi;
          f32x16 acc;
#pragma unroll
          for (int r = 0; r < 16; ++r) acc[r] = 0.f;
#pragma unroll
          for (int ds = 0; ds < 8; ++ds) {
              const f32x4 a0 = *(const f32x4*)(ap + 16 * ds), a1 = *(const f32x4*)(ap + 16 * ds + 4), b0 = *(const f32x4*)(bp + 16 * ds), b1 = *(const f32x4*)(bp + 16 * ds + 4);
              v4u aw, bw; aw.x = pk2(a0[0], a0[1]); aw.y = pk2(a0[2], a0[3]); aw.z = pk2(a1[0], a1[1]); aw.w = pk2(a1[2], a1[3]);
              bw.x = pk2(b0[0], b0[1]); bw.y = pk2(b0[2], b0[3]); bw.z = pk2(b1[0], b1[1]); bw.w = pk2(b1[2], b1[3]);
              acc = __builtin_amdgcn_mfma_f32_32x32x16_bf16(__builtin_bit_cast(bf16x8, aw), __builtin_bit_cast(bf16x8, bw), acc, 0, 0, 0);
          }
          bf16* op = WST + ((size_t)blk * 128 + 32 * nt) * DM + 32 * mt + r32;
#pragma unroll
          for (int r = 0; r < 16; ++r) op[(size_t)((r & 3) + 8 * (r >> 2) + 4 * hi) * DM] = (bf16)f2bf(acc[r]);
      } }
}
__device__ __forceinline__ void p2a_kv(Frame& F, const Ptrs& P) {
    unsigned char* ws = P.ws; const bf16* RK = (const bf16*)(ws + WS_RK); const bf16* RV = (const bf16*)(ws + WS_RV); const bf16* MK = (const bf16*)(ws + WS_MK);
    float* KVT = (float*)((unsigned char*)P.out + 32 * MiB); float* KM = (float*)(ws + WS_KM);
    LAS bf16* lK = (LAS bf16*)F.lds;
    LAS bf16* lV = (LAS bf16*)(F.lds + 16384);
    const int tid = F.tid;
    for (int task = F.bid; task < BATCH * RH * NCH; task += F.G) {
        const int b = task >> 8, h = (task >> 5) & 7, n = task & 31; const size_t row0 = (size_t)b * SEQ + n * RC; const float l2g = ret_l2g(h);
#pragma unroll
        for (int j = 0; j < 2; ++j) { const int idx = tid + 512 * j, c = idx >> 3, part = idx & 7; *(LAS v4u*)(lK + c * 64 + part * 8) = *(const v4u*)(RK + (row0 + c) * 512 + h * 64 + part * 8); }
#pragma unroll
        for (int j = 0; j < 4; ++j) { const int idx = tid + 512 * j, c = idx >> 4, part = idx & 15; *(LAS v4u*)(lV + c * 128 + part * 8) = *(const v4u*)(RV + (row0 + c) * 1024 + h * 128 + part * 8); }
        __syncthreads();
        const int dk = tid & 63, dv0 = (tid >> 6) * 16;
        float acc[16];
#pragma unroll
        for (int e = 0; e < 16; ++e) acc[e] = 0.f;
        for (int c = 0; c < RC; ++c) {
            const float kd = bf2f(lK[c * 64 + dk]) * exp2f((float)(RC - 1 - c) * l2g);
            const v4u v0 = *(LAS v4u*)(lV + c * 128 + dv0), v1 = *(LAS v4u*)(lV + c * 128 + dv0 + 8);
            acc[0] += kd * bflo(v0.x); acc[1] += kd * bfhi(v0.x); acc[2] += kd * bflo(v0.y); acc[3] += kd * bfhi(v0.y);
            acc[4] += kd * bflo(v0.z); acc[5] += kd * bfhi(v0.z); acc[6] += kd * bflo(v0.w); acc[7] += kd * bfhi(v0.w);
            acc[8] += kd * bflo(v1.x); acc[9] += kd * bfhi(v1.x); acc[10] += kd * bflo(v1.y); acc[11] += kd * bfhi(v1.y);
            acc[12] += kd * bflo(v1.z); acc[13] += kd * bfhi(v1.z); acc[14] += kd * bflo(v1.w); acc[15] += kd * bfhi(v1.w);
        }
        float* o = KVT + (size_t)task * (RDV * RDK);
#pragma unroll
        for (int e = 0; e < 16; ++e) o[(dv0 + e) * 64 + dk] = acc[e];
        __syncthreads();
    }
    const int gw = F.bid * NWAVES + F.wave, NGW = F.G * NWAVES;
    for (int wt = gw; wt < BATCH * MH * NBLK; wt += NGW) {
        const int b = wt >> 7, h = (wt >> 4) & 7, blk = wt & 15; const bf16* p = MK + ((size_t)b * SEQ + blk * MBLK) * 512 + h * 64 + F.lane;
        float s = 0.f;
        for (int j = 0; j < MBLK; ++j) s += bf2f(p[(size_t)j * 512]);
        KM[wt * 64 + F.lane] = s * (1.0f / MBLK);
    }
}
__device__ __forceinline__ void p2b_scan(Frame& F, const Ptrs& P) {
    const float* KVT = (const float*)((unsigned char*)P.out + 32 * MiB); bf16* PREV = (bf16*)(P.ws + WS_PREV);
    const int gt = F.bid * 512 + F.tid, NGT = F.G * 512;
    for (int e = gt; e < BATCH * RH * RDV * RDK; e += NGT) {
        const int bh = e >> 13, el = e & 8191, h = bh & 7; const float dC = exp2f((float)RC * ret_l2g(h));
        float S = 0.f; const size_t base = (size_t)bh * NCH * 8192 + el;
        for (int n = 0; n < NCH; ++n) { PREV[base + (size_t)n * 8192] = (bf16)f2bf(S); S = S * dC + KVT[base + (size_t)n * 8192]; }
    }
}
__device__ __forceinline__ void p3a_retention(Frame& F, const Ptrs& P) {
    unsigned char* ws = P.ws; const bf16* RQ = (const bf16*)(ws + WS_RQ); const bf16* RK = (const bf16*)(ws + WS_RK); const bf16* RV = (const bf16*)(ws + WS_RV);
    const bf16* RG = (const bf16*)(ws + WS_RG); const bf16* PREV = (const bf16*)(ws + WS_PREV); bf16* RETG = (bf16*)P.out;
    LAS bf16* lQ = (LAS bf16*)F.lds;
    LAS bf16* lK = (LAS bf16*)(F.lds + 16384);
    LAS bf16* lV = (LAS bf16*)(F.lds + 16384 + 16896);
    LAS bf16* lP = (LAS bf16*)(F.lds + 16384 + 16896 + 32768);
    LAS float* lS = (LAS float*)(F.lds + 16384 + 16896 + 32768 + 16896);
    const int tid = F.tid, lane = F.lane, wave = F.wave;
    for (int task = F.bid; task < BATCH * RH * NCH; task += F.G) {
        const int b = task >> 8, h = (task >> 5) & 7, n = task & 31; const size_t row0 = (size_t)b * SEQ + n * RC; const float l2g = ret_l2g(h);
#pragma unroll
        for (int j = 0; j < 2; ++j) { const int idx = tid + 512 * j, c = idx >> 3, part = idx & 7; *(LAS v4u*)(lQ + c * 64 + part * 8) = *(const v4u*)(RQ + (row0 + c) * 512 + h * 64 + part * 8); }
#pragma unroll
        for (int j = 0; j < 8; ++j) { const int idx = tid + 512 * j, c = idx >> 5, w = idx & 31; *(LAS unsigned*)(lK + c * 66 + w * 2) = *(const unsigned*)(RK + (row0 + c) * 512 + h * 64 + w * 2); }
#pragma unroll
        for (int j = 0; j < 4; ++j) { const int idx = tid + 512 * j, c = idx >> 4, part = idx & 15; *(LAS v4u*)(lV + c * 128 + part * 8) = *(const v4u*)(RV + (row0 + c) * 1024 + h * 128 + part * 8); }
#pragma unroll
        for (int j = 0; j < 8; ++j) { const int idx = tid + 512 * j, dv = idx >> 5, w = idx & 31; *(LAS unsigned*)(lP + dv * 66 + w * 2) = *(const unsigned*)(PREV + (size_t)task * 8192 + dv * 64 + w * 2); }
        __syncthreads();
        for (int t = 0; t < 32; ++t) {
            const int e = tid + 512 * t, i = e >> 7, j = e & 127;
            float s = 0.f;
            if (j <= i) {
                float d = 0.f;
#pragma unroll
                for (int w = 0; w < 32; ++w) { const unsigned qa = *(LAS unsigned*)(lQ + i * 64 + 2 * w), ka = *(LAS unsigned*)(lK + j * 66 + 2 * w); d += bflo(qa) * bflo(ka) + bfhi(qa) * bfhi(ka); }
                s = d * exp2f((float)(i - j) * l2g);
            }
            lS[i * 128 + j] = s;
        }
        __syncthreads();
        for (int r = 0; r < 16; ++r) {
            const int i = wave * 16 + r;
            float a0 = 0.f, a1 = 0.f;
            for (int j = 0; j <= i; ++j) { const float sv = lS[i * 128 + j]; a0 += sv * bf2f(lV[j * 128 + lane]); a1 += sv * bf2f(lV[j * 128 + lane + 64]); }
            float c0 = 0.f, c1 = 0.f;
#pragma unroll 8
            for (int w = 0; w < 32; ++w) { const unsigned qa = *(LAS unsigned*)(lQ + i * 64 + 2 * w), p0 = *(LAS unsigned*)(lP + lane * 66 + 2 * w), p1 = *(LAS unsigned*)(lP + (lane + 64) * 66 + 2 * w);
                c0 += bflo(qa) * bflo(p0) + bfhi(qa) * bfhi(p0); c1 += bflo(qa) * bflo(p1) + bfhi(qa) * bfhi(p1); }
            const float qd = exp2f((float)(i + 1) * l2g);
            const float o0 = a0 + c0 * qd, o1 = a1 + c1 * qd;
            const float mu = wave_sum(o0 + o1) * (1.0f / RDV); const float d0 = o0 - mu, d1 = o1 - mu;
            const float var = wave_sum(d0 * d0 + d1 * d1) * (1.0f / RDV); const float rs = rsqrtf(var + EPS);
            const size_t off = (row0 + i) * 1024 + h * 128 + lane;
            RETG[off] = (bf16)f2bf(d0 * rs * bf2f(RG[off])); RETG[off + 64] = (bf16)f2bf(d1 * rs * bf2f(RG[off + 64]));
        }
        __syncthreads();
    }
}
__device__ __forceinline__ void p3b_moba(Frame& F, const Ptrs& P) {
    unsigned char* ws = P.ws; const bf16* MQ = (const bf16*)(ws + WS_MQ); const bf16* MK = (const bf16*)(ws + WS_MK); const bf16* MV = (const bf16*)(ws + WS_MV);
    const float* KM = (const float*)(ws + WS_KM); const float* BT = (const float*)(ws + WS_BIAS); bf16* ATT = (bf16*)((unsigned char*)P.out + 32 * MiB);
    LAS float* lB = (LAS float*)F.lds;
    LAS bf16* lK = (LAS bf16*)(F.lds + 16384);
    LAS bf16* lV = (LAS bf16*)(F.lds + 16384 + 32768);
    LAS float* lKM = (LAS float*)(F.lds + 16384 + 65536);
    const int tid = F.tid, ql = tid >> 2, sub = tid & 3;
    for (int unit = F.bid; unit < BATCH * MH * 32; unit += F.G) {
        const int qh = 31 - (unit >> 5), bh = unit & 31, b = bh >> 3, h = bh & 7;
        const int qpos = qh * 128 + ql, qb = qh >> 1;
        for (int i = tid; i < SEQ; i += 512) lB[i] = BT[h * SEQ + i];
        float qf[64];
        { const bf16* qp = MQ + ((size_t)b * SEQ + qpos) * 512 + h * 64;
#pragma unroll
          for (int w = 0; w < 8; ++w) { const v4u x = *(const v4u*)(qp + 8 * w); qf[8 * w] = bflo(x.x); qf[8 * w + 1] = bfhi(x.x); qf[8 * w + 2] = bflo(x.y); qf[8 * w + 3] = bfhi(x.y);
              qf[8 * w + 4] = bflo(x.z); qf[8 * w + 5] = bfhi(x.z); qf[8 * w + 6] = bflo(x.w); qf[8 * w + 7] = bfhi(x.w); } }
        for (int i = tid; i < qb * 64; i += 512) lKM[i] = KM[(size_t)bh * NBLK * 64 + i];
        __syncthreads();
        unsigned mask;
        if (qb <= 3) mask = (1u << qb) - 1u;
        else {
            float g1 = -3e38f, g2 = -3e38f, g3 = -3e38f; int i1 = 0, i2 = 0, i3 = 0;
            for (int kb = 0; kb < qb; ++kb) {
                const LAS float* km = lKM + kb * 64; float g = 0.f;
#pragma unroll
                for (int d = 0; d < 64; ++d) g += qf[d] * km[d];
                if (g > g1) { g3 = g2; i3 = i2; g2 = g1; i2 = i1; g1 = g; i1 = kb; }
                else if (g > g2) { g3 = g2; i3 = i2; g2 = g; i2 = kb; }
                else if (g > g3) { g3 = g; i3 = kb; }
            }
            mask = (1u << i1) | (1u << i2) | (1u << i3);
        }
        float m = -1e30f, l = 0.f, o[64];
#pragma unroll
        for (int d = 0; d < 64; ++d) o[d] = 0.f;
        for (int kb = 0; kb <= qb; ++kb) {
            __syncthreads();
            const size_t krow0 = (size_t)b * SEQ + kb * MBLK;
#pragma unroll
            for (int j = 0; j < 4; ++j) { const int idx = tid + 512 * j, r = idx >> 3, part = idx & 7;
                *(LAS v4u*)(lK + r * 64 + part * 8) = *(const v4u*)(MK + (krow0 + r) * 512 + h * 64 + part * 8);
                *(LAS v4u*)(lV + r * 64 + part * 8) = *(const v4u*)(MV + (krow0 + r) * 512 + h * 64 + part * 8); }
            __syncthreads();
            const bool act = (kb == qb) || ((mask >> kb) & 1u);
            if (act) {
                for (int jj = 0; jj < 64; ++jj) {
                    const int j = jj * 4 + sub, kpos = kb * MBLK + j;
                    if (kpos > qpos) continue;
                    float dot = 0.f;
#pragma unroll
                    for (int w = 0; w < 8; ++w) { const v4u x = *(LAS v4u*)(lK + j * 64 + 8 * w);
                        dot += qf[8 * w] * bflo(x.x) + qf[8 * w + 1] * bfhi(x.x) + qf[8 * w + 2] * bflo(x.y) + qf[8 * w + 3] * bfhi(x.y)
                             + qf[8 * w + 4] * bflo(x.z) + qf[8 * w + 5] * bfhi(x.z) + qf[8 * w + 6] * bflo(x.w) + qf[8 * w + 7] * bfhi(x.w); }
                    const float logit = dot + lB[qpos - kpos];
                    const float mn = fmaxf(m, logit), sc = __expf(m - mn), p = __expf(logit - mn);
                    l = l * sc + p; m = mn;
#pragma unroll
                    for (int w = 0; w < 8; ++w) { const v4u x = *(LAS v4u*)(lV + j * 64 + 8 * w);
                        o[8 * w] = o[8 * w] * sc + p * bflo(x.x); o[8 * w + 1] = o[8 * w + 1] * sc + p * bfhi(x.x); o[8 * w + 2] = o[8 * w + 2] * sc + p * bflo(x.y); o[8 * w + 3] = o[8 * w + 3] * sc + p * bfhi(x.y);
                        o[8 * w + 4] = o[8 * w + 4] * sc + p * bflo(x.z); o[8 * w + 5] = o[8 * w + 5] * sc + p * bfhi(x.z); o[8 * w + 6] = o[8 * w + 6] * sc + p * bflo(x.w); o[8 * w + 7] = o[8 * w + 7] * sc + p * bfhi(x.w); }
                }
            }
        }
        float mm = fmaxf(m, __shfl_xor(m, 1)); mm = fmaxf(mm, __shfl_xor(mm, 2));
        const float f = __expf(m - mm); l *= f; l += __shfl_xor(l, 1); l += __shfl_xor(l, 2);
        const float il = 1.0f / l;
#pragma unroll
        for (int d = 0; d < 64; ++d) { float v = o[d] * f; v += __shfl_xor(v, 1); v += __shfl_xor(v, 2); o[d] = v * il; }
        bf16* op = ATT + ((size_t)b * SEQ + qpos) * 512 + h * 64;
#pragma unroll
        for (int s4 = 0; s4 < 4; ++s4) if (sub == s4) {
            v4u w0, w1; w0.x = pk2(o[16 * s4], o[16 * s4 + 1]); w0.y = pk2(o[16 * s4 + 2], o[16 * s4 + 3]); w0.z = pk2(o[16 * s4 + 4], o[16 * s4 + 5]); w0.w = pk2(o[16 * s4 + 6], o[16 * s4 + 7]);
            w1.x = pk2(o[16 * s4 + 8], o[16 * s4 + 9]); w1.y = pk2(o[16 * s4 + 10], o[16 * s4 + 11]); w1.z = pk2(o[16 * s4 + 12], o[16 * s4 + 13]); w1.w = pk2(o[16 * s4 + 14], o[16 * s4 + 15]);
            *(v4u*)(op + 16 * s4) = w0; *(v4u*)(op + 16 * s4 + 8) = w1; }
        __syncthreads();
    }
}

typedef short s16x4 __attribute__((ext_vector_type(4)));
typedef short v4i16_t __attribute__((ext_vector_type(4)));
__device__ __forceinline__ s16x4 vtr_read(const LAS unsigned char* p) { return __builtin_bit_cast(s16x4, __builtin_amdgcn_ds_read_tr16_b64_v4i16((LAS v4i16_t*)p)); }
constexpr float LOG2E = 1.4426950408889634f;
constexpr float MOBA_NEG = -1.0e30f;

constexpr int MB_LB = 0, MB_LKM = 16640, MB_WSC = 20480, MB_K0 = 24576, MB_V0 = 24576 + 65536;
static_assert(MB_V0 + 65536 <= MISC_OFF, "MoBA LDS map");

template <int ABL> __device__ __forceinline__ void p3b_moba_mfma(Frame& F, const Ptrs& P) {
    unsigned char* ws = P.ws; const bf16* MQ = (const bf16*)(ws + WS_MQ); const bf16* MK = (const bf16*)(ws + WS_MK); const bf16* MV = (const bf16*)(ws + WS_MV);
    const float* KMP = (const float*)(ws + WS_KM); const float* BT = (const float*)(ws + WS_BIAS); bf16* ATT = (bf16*)((unsigned char*)P.out + (ABL ? 48 : 32) * MiB);
    LAS float* lB = (LAS float*)(F.lds + MB_LB);
    LAS float* lKM = (LAS float*)(F.lds + MB_LKM);
    LAS float* wsc = (LAS float*)(F.lds + MB_WSC) + F.wave * 64;
    const int tid = F.tid, lane = F.lane, wave = F.wave, r32 = lane & 31, hi = lane >> 5;
    for (int vcu0 = F.bid; vcu0 < 256; vcu0 += F.G) {
    const int vcu = (F.G == 256) ? (vcu0 & 7) * 32 + (vcu0 >> 3) : vcu0;
    const int bh = vcu >> 3, sidx = vcu & 7, b = bh >> 3, h = bh & 7;
    __syncthreads();
    for (int i = tid; i < SEQ + 64; i += 512) lB[i] = (i < 64) ? 0.f : BT[h * SEQ + (i - 64)] * LOG2E;
    float mbound;
    { float gq = fabsf(P.q_gain[lane]), gk = fabsf(P.k_gain[lane]), bb = lane < 32 ? P.rel_bias[lane * MH + h] : 0.f;
#pragma unroll
      for (int o = 1; o < 64; o <<= 1) { gq = fmaxf(gq, __shfl_xor(gq, o)); gk = fmaxf(gk, __shfl_xor(gk, o)); bb = fmaxf(bb, __shfl_xor(bb, o)); }
      mbound = (8.0f * gq * gk * 1.02f + bb) * LOG2E + 0.5f; }
    unsigned ksrc[4], vsrc[4];
#pragma unroll
    for (int j = 0; j < 4; ++j) { const int pc = wave * 4 + j, krow = 8 * pc + (lane >> 3); ksrc[j] = (unsigned)(krow * 512 + (((lane & 7) ^ (krow & 7)) * 8));
        const int vkey = 8 * pc + ((lane & 31) >> 2); vsrc[j] = (unsigned)(vkey * 512 + 32 * (lane >> 5) + 8 * (lane & 3)); }
#define MOBA_STAGE(kgp, vgp, kdst, vdst) do { _Pragma("unroll") for (int j = 0; j < 4; ++j) { \
        __builtin_amdgcn_global_load_lds((const unsigned*)((kgp) + ksrc[j]), (LAS unsigned*)(F.lds + (kdst) + (wave * 4 + j) * 1024), 16, 0, 0); \
        __builtin_amdgcn_global_load_lds((const unsigned*)((vgp) + vsrc[j]), (LAS unsigned*)(F.lds + (vdst) + (wave * 4 + j) * 1024), 16, 0, 0); } } while (0)
    const unsigned vbase = (unsigned)((4 * hi + ((lane & 15) >> 2)) * 64 + ((lane >> 4) & 1) * 32 + (lane & 3) * 8);
    for (int ui = 0; ui < 2; ++ui) {
        const int qb = ui == 0 ? 15 - sidx : sidx;
        const int nblk = qb + 1;
        __syncthreads();
        for (int i = tid; i < qb * 64; i += 512) { const int kb = i >> 6, dd = i & 63; const float* kp = KMP + (((size_t)(b * NBLK + kb) * 2 + (h >> 2)) * 2) * 256 + (h & 3) * 64 + dd; lKM[i] = (kp[0] + kp[256]) * (1.0f / MBLK); }
        const int qw0 = qb * MBLK + wave * 32, qpos = qw0 + r32;
        bf16x8 qf[4];
        { const bf16* qp = MQ + ((size_t)b * SEQ + qpos) * 512 + h * 64 + 8 * hi;
#pragma unroll
          for (int ds = 0; ds < 4; ++ds) qf[ds] = *(const bf16x8*)(qp + 16 * ds); }
        { const bf16* kg = MK + ((size_t)b * SEQ + (size_t)qb * MBLK) * 512 + h * 64; const bf16* vg = MV + ((size_t)b * SEQ + (size_t)qb * MBLK) * 512 + h * 64;
          MOBA_STAGE(kg, vg, MB_K0, MB_V0); }
        VM_WAIT(); __syncthreads();
        unsigned mask;
        if (qb <= 3) mask = (1u << qb) - 1u;
        else {
            float g1 = -3e38f, g2 = -3e38f, g3 = -3e38f; int i1 = 0, i2 = 0, i3 = 0;
            for (int kb = 0; kb < qb; ++kb) {
                float g = 0.f;
#pragma unroll
                for (int ds = 0; ds < 4; ++ds) { const LAS float* km = lKM + kb * 64 + 16 * ds + 8 * hi; const f32x4 k0 = *(const LAS f32x4*)km, k1 = *(const LAS f32x4*)(km + 4);
                    const v4u qx = __builtin_bit_cast(v4u, qf[ds]);
                    g += bflo(qx.x) * k0[0] + bfhi(qx.x) * k0[1] + bflo(qx.y) * k0[2] + bfhi(qx.y) * k0[3] + bflo(qx.z) * k1[0] + bfhi(qx.z) * k1[1] + bflo(qx.w) * k1[2] + bfhi(qx.w) * k1[3]; }
                g += __shfl_xor(g, 32);
                if (g > g1) { g3 = g2; i3 = i2; g2 = g1; i2 = i1; g1 = g; i1 = kb; }
                else if (g > g2) { g3 = g2; i3 = i2; g2 = g; i2 = kb; }
                else if (g > g3) { g3 = g; i3 = kb; }
            }
            mask = (1u << i1) | (1u << i2) | (1u << i3);
        }
        const float m = mbound; float l = 0.f; bool pending = false;
        f32x16 o0, o1; v4u ppa[4]; unsigned pvoff = MB_V0;
#pragma unroll
        for (int r = 0; r < 16; ++r) { o0[r] = 0.f; o1[r] = 0.f; }
#pragma unroll
        for (int q = 0; q < 4; ++q) ppa[q] = (v4u){0u, 0u, 0u, 0u};
#define MOBA_PV(pa_, voff_) do { const LAS unsigned char* vp_ = F.lds + (voff_) + vbase; \
        _Pragma("unroll") for (int ks = 0; ks < 4; ++ks) { const bf16x8 pav = __builtin_bit_cast(bf16x8, pa_[ks]); \
            _Pragma("unroll") for (int db = 0; db < 2; ++db) { const s16x4 lo = vtr_read(vp_ + ((2 * ks) * 2 + db) * 512), hh = vtr_read(vp_ + ((2 * ks + 1) * 2 + db) * 512); \
                const bf16x8 vf = (bf16x8){lo[0], lo[1], lo[2], lo[3], hh[0], hh[1], hh[2], hh[3]}; \
                if (db == 0) o0 = __builtin_amdgcn_mfma_f32_32x32x16_bf16(pav, vf, o0, 0, 0, 0); else o1 = __builtin_amdgcn_mfma_f32_32x32x16_bf16(pav, vf, o1, 0, 0, 0); } } } while (0)
        for (int bi = 0; bi < nblk; ++bi) {
            const int kb = bi == 0 ? qb : bi - 1;
            const unsigned kbuf = MB_K0 + (bi & 1) * 32768, vbuf = MB_V0 + (bi & 1) * 32768;
            const bool has_next = bi + 1 < nblk;
            if (has_next) { const int kn = bi;
                if (pending) { MOBA_PV(ppa, pvoff); pending = false;
#pragma unroll
                    for (int q = 0; q < 4; ++q) ppa[q] = (v4u){0u, 0u, 0u, 0u}; }
                const bf16* kg = MK + ((size_t)b * SEQ + (size_t)kn * MBLK) * 512 + h * 64; const bf16* vg = MV + ((size_t)b * SEQ + (size_t)kn * MBLK) * 512 + h * 64;
                MOBA_STAGE(kg, vg, MB_K0 + ((bi + 1) & 1) * 32768, MB_V0 + ((bi + 1) & 1) * 32768); }
            const bool own = bi == 0;
            const bool sel = own || ((mask >> kb) & 1u);
            if (!(ABL & 16) && __any(sel)) {
                float msub = sel ? m : 1.0e30f;
                f32x16 cneg;
#pragma unroll
                for (int r = 0; r < 16; ++r) cneg[r] = -msub;
                const int npair = own ? (wave >> 1) + 1 : 4;
#define MOBA_QK(jq_, dA_, dB_) do { const int keyA_ = 64 * (jq_) + r32, keyB_ = keyA_ + 32; const LAS unsigned char* kpA_ = F.lds + kbuf + keyA_ * 128; const LAS unsigned char* kpB_ = F.lds + kbuf + keyB_ * 128; \
        _Pragma("unroll") for (int ds = 0; ds < 4; ++ds) { const bf16x8 aA_ = *(const LAS bf16x8*)(kpA_ + (((2 * ds + hi) ^ (keyA_ & 7)) * 16)), aB_ = *(const LAS bf16x8*)(kpB_ + (((2 * ds + hi) ^ (keyB_ & 7)) * 16)); \
            if (!(ABL & 8)) { dA_ = __builtin_amdgcn_mfma_f32_32x32x16_bf16(aA_, qf[ds], ds == 0 ? cneg : dA_, 0, 0, 0); dB_ = __builtin_amdgcn_mfma_f32_32x32x16_bf16(aB_, qf[ds], ds == 0 ? cneg : dB_, 0, 0, 0); } else if (ds == 0) { dA_ = cneg; dB_ = cneg; } } } while (0)
                f32x16 sA, sB, nA, nB;
                MOBA_QK(0, sA, sB);
                for (int jp = 0; jp < npair; ++jp) {
                    const int k0 = kb * MBLK + 64 * jp, dmin = qw0 - k0 - 63, dmax = qw0 + 31 - k0;
                    bool uni = false; float bu = 0.f;
                    if (dmin >= 256) { const float b0 = lB[64 + dmin], b1 = lB[64 + dmax]; uni = (b0 == b1); bu = b0; }
                    if (ABL & 1) {} else if (uni) {
#pragma unroll
                        for (int r = 0; r < 16; ++r) { sA[r] += bu; sB[r] += bu; }
                    } else {
                        const LAS float* bp = lB + (64 + qpos - k0 - 4 * hi - 27 - 32);
#pragma unroll
                        for (int r = 0; r < 16; ++r) { sA[r] += bp[32 + 27 - ((r & 3) + 8 * (r >> 2))]; sB[r] += bp[27 - ((r & 3) + 8 * (r >> 2))]; }
                    }
                    if (own && 2 * jp + 1 >= wave) {
                        const int limA = 32 * wave + r32 - 64 * jp - 4 * hi, limB = limA - 32;
#pragma unroll
                        for (int r = 0; r < 16; ++r) { const int cr = (r & 3) + 8 * (r >> 2); if (cr > limA) sA[r] = MOBA_NEG; if (cr > limB) sB[r] = MOBA_NEG; }
                    }
                    {
                        const int jn = jp + 1 < npair ? jp + 1 : jp;
                        const int keyA_ = 64 * jn + r32, keyB_ = keyA_ + 32; const LAS unsigned char* kpA_ = F.lds + kbuf + keyA_ * 128; const LAS unsigned char* kpB_ = F.lds + kbuf + keyB_ * 128;
                        const LAS unsigned char* vp_ = F.lds + pvoff + vbase;
                        float ps = 0.f;
#pragma unroll
                        for (int i = 0; i < 4; ++i) {
                            if (!(ABL & 4)) { const bf16x8 pav = __builtin_bit_cast(bf16x8, ppa[i]);
#pragma unroll
                                for (int db = 0; db < 2; ++db) { const s16x4 lo = vtr_read(vp_ + ((2 * i) * 2 + db) * 512), hh = vtr_read(vp_ + ((2 * i + 1) * 2 + db) * 512);
                                    const bf16x8 vf = (bf16x8){lo[0], lo[1], lo[2], lo[3], hh[0], hh[1], hh[2], hh[3]};
                                    if (db == 0) o0 = __builtin_amdgcn_mfma_f32_32x32x16_bf16(pav, vf, o0, 0, 0, 0); else o1 = __builtin_amdgcn_mfma_f32_32x32x16_bf16(pav, vf, o1, 0, 0, 0); } }
                            { const bf16x8 aA_ = *(const LAS bf16x8*)(kpA_ + (((2 * i + hi) ^ (keyA_ & 7)) * 16)), aB_ = *(const LAS bf16x8*)(kpB_ + (((2 * i + hi) ^ (keyB_ & 7)) * 16));
                              if (!(ABL & 8)) { nA = __builtin_amdgcn_mfma_f32_32x32x16_bf16(aA_, qf[i], i == 0 ? cneg : nA, 0, 0, 0); nB = __builtin_amdgcn_mfma_f32_32x32x16_bf16(aB_, qf[i], i == 0 ? cneg : nB, 0, 0, 0); } else if (i == 0) { nA = cneg; nB = cneg; } }
                            float pv8[8];
#pragma unroll
                            for (int q = 0; q < 8; ++q) { const float sv = i < 2 ? sA[8 * i + q] : sB[8 * (i - 2) + q]; pv8[q] = (ABL & 2) ? sv : __builtin_amdgcn_exp2f(sv); ps += pv8[q]; }
                            ppa[i].x = pk2(pv8[0], pv8[1]); ppa[i].y = pk2(pv8[2], pv8[3]); ppa[i].z = pk2(pv8[4], pv8[5]); ppa[i].w = pk2(pv8[6], pv8[7]);
                            __builtin_amdgcn_sched_barrier(0);
                        }
                        l += ps;
                    }
                    pvoff = vbuf + (8 * jp) * 1024; pending = true;
                    sA = nA; sB = nB;
                }
#undef MOBA_QK
            }
            VM_WAIT(); __syncthreads();
        }
        if (pending) { MOBA_PV(ppa, pvoff); pending = false; }
#undef MOBA_PV
        l += __shfl_xor(l, 32);
        if (hi == 0) wsc[r32] = 1.0f / l;
        LDS_WAIT(); asm volatile("" ::: "memory");
        bf16* op = ATT + ((size_t)b * SEQ + qw0) * 512 + h * 64 + r32;
#pragma unroll
        for (int r = 0; r < 16; ++r) { const int qr = (r & 3) + 8 * (r >> 2) + 4 * hi; const float a = wsc[qr];
            op[(size_t)qr * 512] = (bf16)f2bf(o0[r] * a); op[(size_t)qr * 512 + 32] = (bf16)f2bf(o1[r] * a); }
        LDS_WAIT(); asm volatile("" ::: "memory");
    }
    }
#undef MOBA_STAGE
}


constexpr int RT_K = 0, RT_P = 16384, RT_V = 32768, RT_O = 65536, RT_OP = 132;
__device__ __forceinline__ void p3a_retention_mfma(Frame& F, const Ptrs& P) {
    unsigned char* ws = P.ws; const bf16* RQ = (const bf16*)(ws + WS_RQ); const bf16* RK = (const bf16*)(ws + WS_RK); const bf16* RV = (const bf16*)(ws + WS_RV);
    const bf16* RG = (const bf16*)(ws + WS_RG); const bf16* PREV = (const bf16*)(ws + WS_PREV); bf16* RETG = (bf16*)P.out;
    LAS float* lO = (LAS float*)(F.lds + RT_O);
    const int lane = F.lane, wave = F.wave, r32 = lane & 31, hi = lane >> 5, rt = wave >> 1, dh = wave & 1;
    const unsigned vbase = (unsigned)((4 * hi + ((lane & 15) >> 2)) * 64 + ((lane >> 4) & 1) * 32 + (lane & 3) * 8);
    unsigned ksrc[2], psrc[2], vsrc[4];
#pragma unroll
    for (int j = 0; j < 2; ++j) { const int pc = wave * 2 + j, row = 8 * pc + (lane >> 3), ch = (lane & 7) ^ (row & 7); ksrc[j] = (unsigned)(row * 512 + ch * 8); psrc[j] = (unsigned)(row * 64 + ch * 8); }
#pragma unroll
    for (int j = 0; j < 4; ++j) { const int pc = wave * 4 + j, key = 8 * (pc >> 1) + ((lane & 31) >> 2), db = 2 * (pc & 1) + (lane >> 5); vsrc[j] = (unsigned)(key * 1024 + 32 * db + 8 * (lane & 3)); }
#define RT_STAGE(task_) do { const int b_ = (task_) >> 8, h_ = ((task_) >> 5) & 7, n_ = (task_) & 31; const size_t r0_ = (size_t)b_ * SEQ + n_ * RC; \
        const bf16* kg_ = RK + r0_ * 512 + h_ * 64; const bf16* pg_ = PREV + (size_t)(task_) * 8192; const bf16* vg_ = RV + r0_ * 1024 + h_ * 128; \
        _Pragma("unroll") for (int j = 0; j < 2; ++j) { __builtin_amdgcn_global_load_lds((const unsigned*)(kg_ + ksrc[j]), (LAS unsigned*)(F.lds + RT_K + (wave * 2 + j) * 1024), 16, 0, 0); \
            __builtin_amdgcn_global_load_lds((const unsigned*)(pg_ + psrc[j]), (LAS unsigned*)(F.lds + RT_P + (wave * 2 + j) * 1024), 16, 0, 0); } \
        _Pragma("unroll") for (int j = 0; j < 4; ++j) __builtin_amdgcn_global_load_lds((const unsigned*)(vg_ + vsrc[j]), (LAS unsigned*)(F.lds + RT_V + (wave * 4 + j) * 1024), 16, 0, 0); } while (0)
    int task = F.bid;
    if (task < BATCH * RH * NCH) RT_STAGE(task);
    for (; task < BATCH * RH * NCH; task += F.G) {
        const int b = task >> 8, h = (task >> 5) & 7, n = task & 31; const size_t row0 = (size_t)b * SEQ + n * RC; const float l2g = ret_l2g(h);
        bf16x8 qf[4];
        { const bf16* qp = RQ + (row0 + 32 * rt + r32) * 512 + h * 64 + 8 * hi;
#pragma unroll
          for (int ds = 0; ds < 4; ++ds) qf[ds] = *(const bf16x8*)(qp + 16 * ds); }
        VM_WAIT(); __syncthreads();
        f32x16 o0, o1;
#pragma unroll
        for (int r = 0; r < 16; ++r) { o0[r] = 0.f; o1[r] = 0.f; }
#pragma unroll
        for (int ds = 0; ds < 4; ++ds) {
#pragma unroll
            for (int db = 0; db < 2; ++db) { const int dv = 64 * dh + 32 * db + r32; const bf16x8 bfr = *(const LAS bf16x8*)(F.lds + RT_P + dv * 128 + (((2 * ds + hi) ^ (dv & 7)) * 16));
                if (db == 0) o0 = __builtin_amdgcn_mfma_f32_32x32x16_bf16(qf[ds], bfr, o0, 0, 0, 0); else o1 = __builtin_amdgcn_mfma_f32_32x32x16_bf16(qf[ds], bfr, o1, 0, 0, 0); }
        }
#pragma unroll
        for (int r = 0; r < 16; ++r) { const float qd = __builtin_amdgcn_exp2f((float)(32 * rt + (r & 3) + 8 * (r >> 2) + 4 * hi + 1) * l2g); o0[r] *= qd; o1[r] *= qd; }
        for (int kt = 0; kt <= rt; ++kt) {
            f32x16 s;
#pragma unroll
            for (int r = 0; r < 16; ++r) s[r] = 0.f;
            { const int key = 32 * kt + r32; const LAS unsigned char* kp = F.lds + RT_K + key * 128;
#pragma unroll
              for (int ds = 0; ds < 4; ++ds) { const bf16x8 a = *(const LAS bf16x8*)(kp + (((2 * ds + hi) ^ (key & 7)) * 16)); s = __builtin_amdgcn_mfma_f32_32x32x16_bf16(a, qf[ds], s, 0, 0, 0); } }
            const int dbase = 32 * (rt - kt) + r32 - 4 * hi;
#pragma unroll
            for (int r = 0; r < 16; ++r) { const int dj = dbase - ((r & 3) + 8 * (r >> 2)); s[r] = dj >= 0 ? s[r] * __builtin_amdgcn_exp2f((float)dj * l2g) : 0.f; }
            v4u pa0, pa1;
            pa0.x = pk2(s[0], s[1]); pa0.y = pk2(s[2], s[3]); pa0.z = pk2(s[4], s[5]); pa0.w = pk2(s[6], s[7]);
            pa1.x = pk2(s[8], s[9]); pa1.y = pk2(s[10], s[11]); pa1.z = pk2(s[12], s[13]); pa1.w = pk2(s[14], s[15]);
            const LAS unsigned char* vp = F.lds + RT_V + vbase + (4 * kt) * 2048 + (2 * dh) * 512;
#pragma unroll
            for (int ks = 0; ks < 2; ++ks) {
                const bf16x8 pa = __builtin_bit_cast(bf16x8, ks == 0 ? pa0 : pa1);
#pragma unroll
                for (int db = 0; db < 2; ++db) {
                    const s16x4 lo = vtr_read(vp + (2 * ks) * 2048 + db * 512), hh = vtr_read(vp + (2 * ks + 1) * 2048 + db * 512);
                    const bf16x8 vf = (bf16x8){lo[0], lo[1], lo[2], lo[3], hh[0], hh[1], hh[2], hh[3]};
                    if (db == 0) o0 = __builtin_amdgcn_mfma_f32_32x32x16_bf16(pa, vf, o0, 0, 0, 0); else o1 = __builtin_amdgcn_mfma_f32_32x32x16_bf16(pa, vf, o1, 0, 0, 0);
                }
            }
        }
#pragma unroll
        for (int r = 0; r < 16; ++r) { const int qr = 32 * rt + (r & 3) + 8 * (r >> 2) + 4 * hi; lO[qr * RT_OP + 64 * dh + r32] = o0[r]; lO[qr * RT_OP + 64 * dh + 32 + r32] = o1[r]; }
        __syncthreads();
        if (task + F.G < BATCH * RH * NCH) RT_STAGE(task + F.G);
#pragma unroll
        for (int it = 0; it < 2; ++it) {
            const int i = wave * 16 + it * 8 + (lane >> 3), cc = lane & 7;
            f32x4 v[4];
#pragma unroll
            for (int q = 0; q < 4; ++q) v[q] = *(const LAS f32x4*)(lO + i * RT_OP + 16 * cc + 4 * q);
            const f32x4 sv = (v[0] + v[1]) + (v[2] + v[3]);
            const float mu = dpp_sum8((sv[0] + sv[1]) + (sv[2] + sv[3])) * (1.0f / RDV);
            f32x4 qv = {0.f, 0.f, 0.f, 0.f};
#pragma unroll
            for (int q = 0; q < 4; ++q) { v[q] = v[q] - mu; qv += v[q] * v[q]; }
            const float rs = rsqrtf(dpp_sum8((qv[0] + qv[1]) + (qv[2] + qv[3])) * (1.0f / RDV) + EPS);
            const size_t off = (row0 + i) * 1024 + h * 128 + 16 * cc;
            f32x4 g0, g1, g2, g3; load8_bf16(RG + off, g0, g1); load8_bf16(RG + off + 8, g2, g3);
            store8_bf16(RETG + off, v[0] * rs * g0, v[1] * rs * g1); store8_bf16(RETG + off + 8, v[2] * rs * g2, v[3] * rs * g3);
        }
    }
#undef RT_STAGE
}
constexpr int KV_K = 0, KV_V = 16384;
__device__ __forceinline__ void p2a_kv_mfma(Frame& F, const Ptrs& P) {
    unsigned char* ws = P.ws; const bf16* RK = (const bf16*)(ws + WS_RK); const bf16* RV = (const bf16*)(ws + WS_RV); float* KVT = (float*)((unsigned char*)P.out + 32 * MiB);
    const int tid = F.tid, lane = F.lane, wave = F.wave, r32 = lane & 31, hi = lane >> 5, mb = wave >> 1, nb = wave & 1;
    const unsigned vbase = (unsigned)((4 * hi + ((lane & 15) >> 2)) * 64 + ((lane >> 4) & 1) * 32 + (lane & 3) * 8);
    for (int task = F.bid; task < BATCH * RH * NCH; task += F.G) {
        const int b = task >> 8, h = (task >> 5) & 7, n = task & 31; const size_t row0 = (size_t)b * SEQ + n * RC; const float l2g = ret_l2g(h);
        __syncthreads();
#pragma unroll
        for (int j = 0; j < 2; ++j) { const int idx = tid + 512 * j, r = idx >> 3, c = idx & 7; const v4u kx = *(const v4u*)(RK + (row0 + r) * 512 + h * 64 + c * 8);
            const float dec = __builtin_amdgcn_exp2f((float)(RC - 1 - r) * l2g); v4u ko;
            ko.x = pk2(bflo(kx.x) * dec, bfhi(kx.x) * dec); ko.y = pk2(bflo(kx.y) * dec, bfhi(kx.y) * dec); ko.z = pk2(bflo(kx.z) * dec, bfhi(kx.z) * dec); ko.w = pk2(bflo(kx.w) * dec, bfhi(kx.w) * dec);
            *(LAS v4u*)(F.lds + KV_K + (((r >> 3) * 2 + (c >> 2)) * 512) + (r & 7) * 64 + (c & 3) * 16) = ko; }
#pragma unroll
        for (int j = 0; j < 4; ++j) { const int idx = tid + 512 * j, r = idx >> 4, c = idx & 15;
            *(LAS v4u*)(F.lds + KV_V + (((r >> 3) * 4 + (c >> 2)) * 512) + (r & 7) * 64 + (c & 3) * 16) = *(const v4u*)(RV + (row0 + r) * 1024 + h * 128 + c * 8); }
        __syncthreads();
        f32x16 acc;
#pragma unroll
        for (int r = 0; r < 16; ++r) acc[r] = 0.f;
#pragma unroll
        for (int ks = 0; ks < 8; ++ks) {
            const LAS unsigned char* ap = F.lds + KV_V + vbase + ((2 * ks) * 4 + mb) * 512; const LAS unsigned char* bp = F.lds + KV_K + vbase + ((2 * ks) * 2 + nb) * 512;
            const s16x4 alo = vtr_read(ap), ahi = vtr_read(ap + 4 * 512), blo = vtr_read(bp), bhi = vtr_read(bp + 2 * 512);
            const bf16x8 af = (bf16x8){alo[0], alo[1], alo[2], alo[3], ahi[0], ahi[1], ahi[2], ahi[3]}, bfv = (bf16x8){blo[0], blo[1], blo[2], blo[3], bhi[0], bhi[1], bhi[2], bhi[3]};
            acc = __builtin_amdgcn_mfma_f32_32x32x16_bf16(af, bfv, acc, 0, 0, 0);
        }
        float* o = KVT + (size_t)task * (RDV * RDK) + 32 * nb + r32;
#pragma unroll
        for (int r = 0; r < 16; ++r) o[(32 * mb + (r & 3) + 8 * (r >> 2) + 4 * hi) * 64] = acc[r];
    }
}
#define CE_D(a, i, j) do { const unsigned _hi = a[i] > a[j] ? a[i] : a[j]; const unsigned _lo = a[i] > a[j] ? a[j] : a[i]; a[i] = _hi; a[j] = _lo; } while (0)
#define CE_A(a, i, j) do { const unsigned _hi = a[i] > a[j] ? a[i] : a[j]; const unsigned _lo = a[i] > a[j] ? a[j] : a[i]; a[i] = _lo; a[j] = _hi; } while (0)
#define SORT16_DESC(a) do { CE_D(a, 0, 1); CE_A(a, 2, 3); CE_D(a, 4, 5); CE_A(a, 6, 7); CE_D(a, 8, 9); CE_A(a, 10, 11); CE_D(a, 12, 13); CE_A(a, 14, 15); CE_D(a, 0, 2); CE_D(a, 1, 3); CE_A(a, 4, 6); CE_A(a, 5, 7); CE_D(a, 8, 10); CE_D(a, 9, 11); CE_A(a, 12, 14); CE_A(a, 13, 15); CE_D(a, 0, 1); CE_D(a, 2, 3); CE_A(a, 4, 5); CE_A(a, 6, 7); CE_D(a, 8, 9); CE_D(a, 10, 11); CE_A(a, 12, 13); CE_A(a, 14, 15); CE_D(a, 0, 4); CE_D(a, 1, 5); CE_D(a, 2, 6); CE_D(a, 3, 7); CE_A(a, 8, 12); CE_A(a, 9, 13); CE_A(a, 10, 14); CE_A(a, 11, 15); CE_D(a, 0, 2); CE_D(a, 1, 3); CE_D(a, 4, 6); CE_D(a, 5, 7); CE_A(a, 8, 10); CE_A(a, 9, 11); CE_A(a, 12, 14); CE_A(a, 13, 15); CE_D(a, 0, 1); CE_D(a, 2, 3); CE_D(a, 4, 5); CE_D(a, 6, 7); CE_A(a, 8, 9); CE_A(a, 10, 11); CE_A(a, 12, 13); CE_A(a, 14, 15); CE_D(a, 0, 8); CE_D(a, 1, 9); CE_D(a, 2, 10); CE_D(a, 3, 11); CE_D(a, 4, 12); CE_D(a, 5, 13); CE_D(a, 6, 14); CE_D(a, 7, 15); CE_D(a, 0, 4); CE_D(a, 1, 5); CE_D(a, 2, 6); CE_D(a, 3, 7); CE_D(a, 8, 12); CE_D(a, 9, 13); CE_D(a, 10, 14); CE_D(a, 11, 15); CE_D(a, 0, 2); CE_D(a, 1, 3); CE_D(a, 4, 6); CE_D(a, 5, 7); CE_D(a, 8, 10); CE_D(a, 9, 11); CE_D(a, 12, 14); CE_D(a, 13, 15); CE_D(a, 0, 1); CE_D(a, 2, 3); CE_D(a, 4, 5); CE_D(a, 6, 7); CE_D(a, 8, 9); CE_D(a, 10, 11); CE_D(a, 12, 13); CE_D(a, 14, 15); } while (0)
#define MERGE16_DESC(a) do { CE_D(a, 0, 8); CE_D(a, 1, 9); CE_D(a, 2, 10); CE_D(a, 3, 11); CE_D(a, 4, 12); CE_D(a, 5, 13); CE_D(a, 6, 14); CE_D(a, 7, 15); CE_D(a, 0, 4); CE_D(a, 1, 5); CE_D(a, 2, 6); CE_D(a, 3, 7); CE_D(a, 8, 12); CE_D(a, 9, 13); CE_D(a, 10, 14); CE_D(a, 11, 15); CE_D(a, 0, 2); CE_D(a, 1, 3); CE_D(a, 4, 6); CE_D(a, 5, 7); CE_D(a, 8, 10); CE_D(a, 9, 11); CE_D(a, 12, 14); CE_D(a, 13, 15); CE_D(a, 0, 1); CE_D(a, 2, 3); CE_D(a, 4, 5); CE_D(a, 6, 7); CE_D(a, 8, 9); CE_D(a, 10, 11); CE_D(a, 12, 13); CE_D(a, 14, 15); } while (0)

#ifndef CONV_IN_TOPK
#define CONV_IN_TOPK 1
#endif
constexpr size_t CONV_N16 = (size_t)NEXP * DM / 16;
__device__ __forceinline__ void conv_load(const Ptrs& P, size_t i, f32x4 (&a)[4]) {
    const float* src = (i < CONV_N16) ? P.peer_u + i * 16 : P.peer_v + (i - CONV_N16) * 16;
#pragma unroll
    for (int q = 0; q < 4; ++q) a[q] = __builtin_nontemporal_load((const f32x4*)(src + 4 * q));
}
__device__ __forceinline__ void conv_store(const Ptrs& P, size_t i, const f32x4 (&a)[4]) {
    v2u w;
#pragma unroll
    for (int q = 0; q < 2; ++q) { unsigned pk = 0u;
        const f32x4 s0 = a[2 * q] * 64.0f, s1 = a[2 * q + 1] * 64.0f;
        pk = __builtin_amdgcn_cvt_scalef32_pk_fp4_f32(pk, s0[0], s0[1], 1.0f, 0); pk = __builtin_amdgcn_cvt_scalef32_pk_fp4_f32(pk, s0[2], s0[3], 1.0f, 1);
        pk = __builtin_amdgcn_cvt_scalef32_pk_fp4_f32(pk, s1[0], s1[1], 1.0f, 2); pk = __builtin_amdgcn_cvt_scalef32_pk_fp4_f32(pk, s1[2], s1[3], 1.0f, 3);
        w[q] = pk; }
    *(v2u*)(P.ws + WS_UV8 + i * 8) = w;
}
__device__ __forceinline__ void conv_all(Frame& F, const Ptrs& P) {
    const size_t cbase = (size_t)F.bid * 512 + F.tid, CNGT = (size_t)F.G * 512;
    for (size_t ci = cbase; ci < 2 * CONV_N16; ci += CNGT) { f32x4 cv[4]; conv_load(P, ci, cv); conv_store(P, ci, cv); }
}
__device__ __forceinline__ unsigned mono32(float f) { const unsigned u = __builtin_bit_cast(unsigned, f); return u ^ ((u >> 31) ? 0xffffffffu : 0x80000000u); }
__device__ __forceinline__ float unmono32(unsigned k) { const unsigned u = k ^ ((k >> 31) ? 0x80000000u : 0xffffffffu); return __builtin_bit_cast(float, u); }
__device__ __forceinline__ float key_val(unsigned k) { const unsigned m = k >> 16; return __builtin_bit_cast(float, (m ^ ((m & 0x8000u) ? 0x8000u : 0xffffu)) << 16); }
#define INS16(a, x) do { _Pragma("unroll") for (int _j = 0; _j < 16; ++_j) { const unsigned _t = a[_j] > x ? a[_j] : x; x = a[_j] > x ? x : a[_j]; a[_j] = _t; } } while (0)
__device__ __forceinline__ void p6_topk(Frame& F, const Ptrs& P) {
    unsigned char* ws = P.ws; const bf16* ST = (const bf16*)(ws + WS_ST); int* EXP = (int*)(ws + WS_EG); float* GT = (float*)(ws + WS_EG + 8 * MiB);
    LAS unsigned* lsc = (LAS unsigned*)F.lds;
    pg8::StaticOrder S8; S8.init(T, 2048, F.G, F.bid);
    pg8::Unit uq;
    const size_t cbase = (size_t)F.bid * 512 + F.tid, CNGT = (size_t)F.G * 512; int citem = 0;
    for (int ii = F.wave >> 2; S8.next(ii, uq); ii += 2) {
        const int hd = uq.pn, tok = uq.pm * 256 + (F.wave & 3) * 64 + F.lane;
        const bf16* sp = ST + (size_t)hd * 256 * T + tok;
        unsigned a1[16], a2[16];
#pragma unroll
        for (int j = 0; j < 16; ++j) { a1[j] = 0u; a2[j] = 0u; }
#pragma unroll 1
        for (int g = 0; g < 8; ++g) {
            f32x4 cv0[4], cv1[4]; const size_t ci0 = cbase + (size_t)citem * CNGT, ci1 = ci0 + CNGT; const bool ok0 = CONV_IN_TOPK && ci0 < 2 * CONV_N16, ok1 = CONV_IN_TOPK && ci1 < 2 * CONV_N16;
            unsigned short rr1[16], rr2[16];
#pragma unroll
            for (int q = 0; q < 16; ++q) { const int n = 16 * g + q; rr1[q] = sp[(size_t)n * T]; rr2[q] = sp[(size_t)(PNK + n) * T]; }
            asm volatile("" ::: "memory");
            if (ok0) conv_load(P, ci0, cv0);
            if (ok1) conv_load(P, ci1, cv1);
            unsigned g1[16], g2[16];
#pragma unroll
            for (int q = 0; q < 16; ++q) { const int n = 16 * g + q; const unsigned short r1 = rr1[q], r2 = rr2[q];
                g1[q] = (((unsigned)r1 ^ ((r1 & 0x8000u) ? 0xffffu : 0x8000u)) << 16) | (unsigned)(127 - n);
                g2[q] = (((unsigned)r2 ^ ((r2 & 0x8000u) ? 0xffffu : 0x8000u)) << 16) | (unsigned)(127 - n); }
            SORT16_DESC(g1); SORT16_DESC(g2);
            if (g == 0) {
#pragma unroll
                for (int q = 0; q < 16; ++q) { a1[q] = g1[q]; a2[q] = g2[q]; }
            } else {
#pragma unroll
                for (int q = 0; q < 16; ++q) { a1[q] = a1[q] > g1[15 - q] ? a1[q] : g1[15 - q]; a2[q] = a2[q] > g2[15 - q] ? a2[q] : g2[15 - q]; }
                MERGE16_DESC(a1); MERGE16_DESC(a2);
            }
            if (ok0) conv_store(P, ci0, cv0);
            if (ok1) conv_store(P, ci1, cv1);
            citem += 2;
            __builtin_amdgcn_sched_barrier(0);
        }
#pragma unroll
        for (int i = 0; i < 16; ++i) { lsc[i * 512 + F.tid] = a1[i]; lsc[(16 + i) * 512 + F.tid] = a2[i]; }
        unsigned kb[16];
#pragma unroll
        for (int j = 0; j < 16; ++j) kb[j] = 0u;
#pragma unroll
        for (int i = 0; i < 16; ++i) {
            const float s1 = key_val(a1[i]);
#pragma unroll
            for (int j = 0; j < 16; ++j) if ((i + 1) * (j + 1) <= 16) {
                unsigned xk = (mono32(s1 + key_val(a2[j])) & 0xffffff00u) | (unsigned)(i * 16 + j);
                INS16(kb, xk);
                __builtin_amdgcn_sched_barrier(0);
            }
        }
        float sv[16]; unsigned ev[16]; float smax = -3e38f;
#pragma unroll
        for (int q = 0; q < 16; ++q) { const unsigned i = (kb[q] >> 4) & 15u, j = kb[q] & 15u; const unsigned k1 = lsc[i * 512 + F.tid], k2 = lsc[(16 + j) * 512 + F.tid];
            sv[q] = key_val(k1) + key_val(k2); ev[q] = (127u - (k1 & 127u)) * 128u + (127u - (k2 & 127u)); smax = fmaxf(smax, sv[q]); }
        float gs = 0.f;
#pragma unroll
        for (int q = 0; q < 16; ++q) { sv[q] = __expf(sv[q] - smax); gs += sv[q]; }
        const float ig = 1.0f / gs;
        int* ep = EXP + (size_t)tok * 128 + hd * 16; float* gp = GT + (size_t)tok * 128 + hd * 16;
#pragma unroll
        for (int q = 0; q < 4; ++q) { *(v4u*)(ep + 4 * q) = (v4u){ev[4 * q], ev[4 * q + 1], ev[4 * q + 2], ev[4 * q + 3]};
            *(f32x4*)(gp + 4 * q) = (f32x4){sv[4 * q] * ig, sv[4 * q + 1] * ig, sv[4 * q + 2] * ig, sv[4 * q + 3] * ig}; }
    }
    if (CONV_IN_TOPK) for (;; ++citem) { const size_t ci = cbase + (size_t)citem * CNGT; if (ci >= 2 * CONV_N16) break; f32x4 cv[4]; conv_load(P, ci, cv); conv_store(P, ci, cv); }
}
__device__ __forceinline__ float dot8(const v4u w, const float* h) {
    return h[0] * bflo(w.x) + h[1] * bfhi(w.x) + h[2] * bflo(w.y) + h[3] * bfhi(w.y) + h[4] * bflo(w.z) + h[5] * bfhi(w.z) + h[6] * bflo(w.w) + h[7] * bfhi(w.w);
}
__device__ __forceinline__ void axpy8(float* acc, float c, const v4u w) {
    acc[0] += c * bflo(w.x); acc[1] += c * bfhi(w.x); acc[2] += c * bflo(w.y); acc[3] += c * bfhi(w.y); acc[4] += c * bflo(w.z); acc[5] += c * bfhi(w.z); acc[6] += c * bflo(w.w); acc[7] += c * bfhi(w.w);
}
#ifndef PB
#define PB 8
#endif
__device__ __forceinline__ void p7_peer(Frame& F, const Ptrs& P, float* dst) {
    unsigned char* ws = P.ws; const bf16* H2 = (const bf16*)(ws + WS_H2); const int* EXP = (const int*)(ws + WS_EG); const float* GT = (const float*)(ws + WS_EG + 8 * MiB);
    const bf16* U = (const bf16*)(ws + WS_UV); const bf16* V = U + (size_t)NEXP * DM; float* out = P.out;
    const int gw = F.bid * NWAVES + F.wave, NGW = F.G * NWAVES, lane = F.lane;
    for (int tok = gw; tok < T; tok += NGW) {
        float hv[16], acc[16];
        { const v4u h0 = *(const v4u*)(H2 + (size_t)tok * DM + 8 * lane), h1 = *(const v4u*)(H2 + (size_t)tok * DM + 512 + 8 * lane);
          hv[0] = bflo(h0.x); hv[1] = bfhi(h0.x); hv[2] = bflo(h0.y); hv[3] = bfhi(h0.y); hv[4] = bflo(h0.z); hv[5] = bfhi(h0.z); hv[6] = bflo(h0.w); hv[7] = bfhi(h0.w);
          hv[8] = bflo(h1.x); hv[9] = bfhi(h1.x); hv[10] = bflo(h1.y); hv[11] = bfhi(h1.y); hv[12] = bflo(h1.z); hv[13] = bfhi(h1.z); hv[14] = bflo(h1.w); hv[15] = bfhi(h1.w); }
#pragma unroll
        for (int e = 0; e < 16; ++e) acc[e] = 0.f;
        int e_lo = EXP[(size_t)tok * 128 + lane], e_hi = EXP[(size_t)tok * 128 + 64 + lane];
        float g_lo = GT[(size_t)tok * 128 + lane], g_hi = GT[(size_t)tok * 128 + 64 + lane];
#ifndef PEER_NOSORT
        {
            LAS unsigned* le = (LAS unsigned*)(F.lds + F.wave * 1024); LAS float* lg = (LAS float*)(le + 128);
            const unsigned b_lo = (unsigned)e_lo >> 9, b_hi = (unsigned)e_hi >> 9; unsigned pos_lo = 0, pos_hi = 0, base = 0;
            for (unsigned bk = 0; bk < 32; ++bk) {
                const unsigned long long mlo = __ballot(b_lo == bk), mhi = __ballot(b_hi == bk);
                const unsigned clo = (unsigned)__popcll(mlo), chi = (unsigned)__popcll(mhi);
                if (b_lo == bk) pos_lo = base + __builtin_amdgcn_mbcnt_hi((unsigned)(mlo >> 32), __builtin_amdgcn_mbcnt_lo((unsigned)mlo, 0u));
                if (b_hi == bk) pos_hi = base + clo + __builtin_amdgcn_mbcnt_hi((unsigned)(mhi >> 32), __builtin_amdgcn_mbcnt_lo((unsigned)mhi, 0u));
                base += clo + chi;
            }
            le[pos_lo] = (unsigned)e_lo; lg[pos_lo] = g_lo; le[pos_hi] = (unsigned)e_hi; lg[pos_hi] = g_hi;
            LDS_WAIT(); asm volatile("" ::: "memory");
            e_lo = (int)le[lane]; e_hi = (int)le[64 + lane]; g_lo = lg[lane]; g_hi = lg[64 + lane];
            LDS_WAIT(); asm volatile("" ::: "memory");
        }
#endif
        for (int k = 0; k < 128; k += PB) {
            int ex[PB]; float gg[PB]; v4u u0[PB], u1[PB], v0[PB], v1[PB];
#pragma unroll
            for (int q = 0; q < PB; ++q) { const int kk = k + q; ex[q] = __shfl(kk < 64 ? e_lo : e_hi, kk & 63); gg[q] = __shfl(kk < 64 ? g_lo : g_hi, kk & 63); }
#pragma unroll
            for (int q = 0; q < PB; ++q) { const bf16* up = U + (size_t)ex[q] * DM + 8 * lane; const bf16* vp = V + (size_t)ex[q] * DM + 8 * lane;
                u0[q] = *(const v4u*)up; u1[q] = *(const v4u*)(up + 512); v0[q] = *(const v4u*)vp; v1[q] = *(const v4u*)(vp + 512); }
            float d[PB];
#pragma unroll
            for (int q = 0; q < PB; ++q) d[q] = dot8(u0[q], hv) + dot8(u1[q], hv + 8);
#pragma unroll
            for (int o = 1; o < 64; o <<= 1) {
#pragma unroll
                for (int q = 0; q < PB; ++q) d[q] += __shfl_xor(d[q], o);
            }
#pragma unroll
            for (int q = 0; q < PB; ++q) { const float z = d[q]; const float a = 0.5f * z * (1.0f + erff(z * 0.70710678118654752f)); const float c = gg[q] * a; axpy8(acc, c, v0[q]); axpy8(acc + 8, c, v1[q]); }
        }
        float* op = out + (size_t)tok * DM + 8 * lane;
        f32x4 x0 = *(const f32x4*)op, x1 = *(const f32x4*)(op + 4), x2 = *(const f32x4*)(op + 512), x3 = *(const f32x4*)(op + 516);
        x0 += (f32x4){acc[0], acc[1], acc[2], acc[3]}; x1 += (f32x4){acc[4], acc[5], acc[6], acc[7]}; x2 += (f32x4){acc[8], acc[9], acc[10], acc[11]}; x3 += (f32x4){acc[12], acc[13], acc[14], acc[15]};
        float* wp = dst + (size_t)tok * DM + 8 * lane;
        *(f32x4*)wp = x0; *(f32x4*)(wp + 4) = x1; *(f32x4*)(wp + 512) = x2; *(f32x4*)(wp + 516) = x3;
    }
}

typedef float f32x2v __attribute__((ext_vector_type(2)));
typedef _Float16 f16x2v __attribute__((ext_vector_type(2)));
constexpr size_t WS_PART = WS_ST;
constexpr size_t WS_CG = WS_ACT + 32 * MiB;
__device__ __forceinline__ void fp8x16_to_f32(const v4u w, float* f) {
#pragma unroll
    for (int q = 0; q < 4; ++q) { const f32x2v lo = __builtin_amdgcn_cvt_pk_f32_fp8((int)w[q], false), hi = __builtin_amdgcn_cvt_pk_f32_fp8((int)w[q], true); f[4 * q] = lo.x; f[4 * q + 1] = lo.y; f[4 * q + 2] = hi.x; f[4 * q + 3] = hi.y; }
}
__device__ __forceinline__ float fmac_s(float acc, float a, float b) { asm("v_fmac_f32_e32 %0, %1, %2" : "+v"(acc) : "v"(a), "v"(b)); return acc; }
constexpr int TROW = DM / 2;
typedef int v8i __attribute__((ext_vector_type(8))); typedef int v2i_t __attribute__((ext_vector_type(2)));
template <int MODE> __device__ __forceinline__ void p7u_dots(Frame& F, const Ptrs& P) {
    unsigned char* ws = P.ws; const bf16* H2 = (const bf16*)(ws + WS_H2); const int* EXP = (const int*)(ws + WS_EG); const unsigned char* U4 = ws + WS_UV8; float* PART = (float*)(ws + (MODE ? WS_ACT : WS_PART)); const float* SS = (const float*)(ws + WS_SUMSQ);
    const int lane = F.lane, r = lane >> 3, c = lane & 7, i = lane & 15, kb = lane >> 4;
    LAS unsigned char* lB = F.lds; LAS float* lS = (LAS float*)(F.lds + 32768);
    LAS unsigned char* lI = F.lds + 34816 + F.wave * 2048;
    LAS unsigned char* lT = F.lds + 51200 + F.wave * 8192;
    const int wr0 = r * 128 + ((c ^ (r >> 1)) << 4), wr1 = (8 + r) * 128 + ((c ^ (4 + (r >> 1))) << 4);
    const int rd0 = i * 128 + ((kb ^ ((i >> 1) & 7)) << 4), rd1 = i * 128 + (((4 + kb) ^ ((i >> 1) & 7)) << 4);
#define PU_LOADW(tk) (*(const v2u*)(EXP + (size_t)(tbase + ((tk) < 31 ? (tk) : 31)) * 128 + 2 * lane))
#define PU_PUTW(tk, wv) do { *(LAS v2u*)(lI + ((tk) & 3) * 512 + 8 * lane) = wv; } while (0)
#define PU_ISSUE(tk, ul) do { _Pragma("unroll") for (int d_ = 0; d_ < 16; ++d_) { const unsigned ev = *(const LAS unsigned*)(lI + ((tk) & 3) * 512 + (8 * d_ + r) * 4); ul[d_] = *(const v4u*)(U4 + ((ev << 9) + loff)); } } while (0)
#define PU_V8(lo) (v8i){(int)(lo).x, (int)(lo).y, (int)(lo).z, (int)(lo).w, 0, 0, 0, 0}
#define PU_COMPUTE(tk, ul) do { const LAS unsigned char* bp_ = lB + (32 * F.wave + (tk)) * 128 + 16 * kb; const v4u bq0 = *(const LAS v4u*)bp_, bq1 = *(const LAS v4u*)(bp_ + 64); const float osc = lS[32 * F.wave + (tk)]; \
        const v8i b0 = PU_V8(bq0), b1 = PU_V8(bq1); \
        float* pp = PART + ((size_t)sl * T + (tbase + (tk))) * 128 + 4 * kb; \
        f32x4 acc[8]; \
        _Pragma("unroll") for (int g = 0; g < 8; ++g) { LAS unsigned char* tb_ = lT + (g & 3) * 2048; \
            *(LAS v4u*)(tb_ + wr0) = ul[2 * g]; *(LAS v4u*)(tb_ + wr1) = ul[2 * g + 1]; \
            const v4u a0 = *(const LAS v4u*)(tb_ + rd0), a1 = *(const LAS v4u*)(tb_ + rd1); \
            acc[g] = __builtin_amdgcn_mfma_scale_f32_16x16x128_f8f6f4(PU_V8(a0), b0, (f32x4){0.f, 0.f, 0.f, 0.f}, 4, 4, 0, 0, 0, 0); \
            acc[g] = __builtin_amdgcn_mfma_scale_f32_16x16x128_f8f6f4(PU_V8(a1), b1, acc[g], 4, 4, 0, 0, 0, 0); \
            asm volatile("" : "+v"(acc[g])); }     \
        if (i == 0) { _Pragma("unroll") for (int g = 0; g < 8; ++g) *(f32x4*)(pp + 16 * g) = acc[g] * osc; } } while (0)
    for (int vb = F.bid; vb < 256; vb += F.G) {
        const int x = vb & 7, j = vb >> 3, sl = x & 3; const int tb0 = (x >> 2) * (T / 2) + 256 * j, tbase = tb0 + 32 * F.wave; const unsigned loff = 128 * sl + 16 * c;
        v2u w0 = PU_LOADW(0), w1 = PU_LOADW(1), w2 = PU_LOADW(2), w3 = PU_LOADW(3); v4u ulA[16], ulB[16];
        __syncthreads();
        {
            const int tok = F.tid >> 1, hf = F.tid & 1; const bf16* hp = H2 + (size_t)(tb0 + tok) * DM + 256 * sl + 128 * hf;
            const float ms = SS[tb0 + tok] * (1.0f / DM) + EPS, rstd = rsqrtf(ms);
            const float sc = __builtin_bit_cast(float, (__builtin_bit_cast(unsigned, 2.0f * rstd) + 0x00400000u) & 0xFF800000u);
#pragma unroll
            for (int c4 = 0; c4 < 4; ++c4) { v4u o;
#pragma unroll
                for (int q = 0; q < 4; ++q) { const v4u a = *(const v4u*)(hp + 32 * c4 + 8 * q); unsigned pk = 0u;
                    pk = __builtin_amdgcn_cvt_scalef32_pk_fp4_f32(pk, bflo(a.x) * sc, bfhi(a.x) * sc, 1.0f, 0); pk = __builtin_amdgcn_cvt_scalef32_pk_fp4_f32(pk, bflo(a.y) * sc, bfhi(a.y) * sc, 1.0f, 1);
                    pk = __builtin_amdgcn_cvt_scalef32_pk_fp4_f32(pk, bflo(a.z) * sc, bfhi(a.z) * sc, 1.0f, 2); pk = __builtin_amdgcn_cvt_scalef32_pk_fp4_f32(pk, bflo(a.w) * sc, bfhi(a.w) * sc, 1.0f, 3); o[q] = pk; }
                *(LAS v4u*)(lB + tok * 128 + hf * 64 + c4 * 16) = o; }
            if (hf == 0) lS[tok] = rstd / sc;
        }
        PU_PUTW(0, w0); PU_ISSUE(0, ulA); w0 = PU_LOADW(4);
        __syncthreads();
        for (int tk = 0; tk < 32; tk += 4) {
            PU_PUTW(tk + 1, w1); PU_ISSUE(tk + 1, ulB); w1 = PU_LOADW(tk + 5); PU_COMPUTE(tk, ulA);
            PU_PUTW(tk + 2, w2); PU_ISSUE(tk + 2, ulA); w2 = PU_LOADW(tk + 6); PU_COMPUTE(tk + 1, ulB);
            PU_PUTW(tk + 3, w3); PU_ISSUE(tk + 3, ulB); w3 = PU_LOADW(tk + 7); PU_COMPUTE(tk + 2, ulA);
            PU_PUTW(tk + 4, w0); PU_ISSUE(tk + 4, ulA); w0 = PU_LOADW(tk + 8); PU_COMPUTE(tk + 3, ulB);
        }
    }
#undef PU_LOADW
#undef PU_PUTW
#undef PU_ISSUE
#undef PU_COMPUTE
#undef PU_V8
}
constexpr size_t WS_CGS = WS_CG + 4 * MiB;
__device__ __forceinline__ void p7z_gate(Frame& F, const Ptrs& P) {
    unsigned char* ws = P.ws; const float* PART = (const float*)(ws + WS_PART); const float* GT = (const float*)(ws + WS_EG + 8 * MiB); unsigned char* CGQ = ws + WS_CG; float* CGS = (float*)(ws + WS_CGS);
    const size_t gt = (size_t)F.bid * 512 + F.tid, NGT = (size_t)F.G * 512, n4 = (size_t)T * 128 / 4;
    for (size_t i = gt; i < n4; i += NGT) {
        f32x4 z = *(const f32x4*)(PART + i * 4);
#pragma unroll
        for (int x = 1; x < 4; ++x) z += *(const f32x4*)(PART + (size_t)x * T * 128 + i * 4);
        const f32x4 g = *(const f32x4*)(GT + i * 4); f32x4 v; float m = 1e-30f;
#pragma unroll
        for (int q = 0; q < 4; ++q) { const float zz = z[q] * (1.0f / 64.0f); v[q] = g[q] * 0.5f * zz * (1.0f + erff(zz * 0.70710678118654752f)); m = fmaxf(m, fabsf(v[q])); }
#pragma unroll
        for (int o = 1; o < 32; o <<= 1) m = fmaxf(m, __shfl_xor(m, o));
        const unsigned eb = (__builtin_bit_cast(unsigned, m) >> 23) & 0xFFu; const float sc = __builtin_bit_cast(float, (255u - eb) << 23);
        v = v * sc;
        const size_t t = i >> 5; const int ip = (int)(i & 31);
#pragma unroll
        for (int term = 0; term < 4; ++term) {
            unsigned pk = 0u; pk = __builtin_amdgcn_cvt_scalef32_pk_fp4_f32(pk, v[0], v[1], 1.0f, 0); pk = __builtin_amdgcn_cvt_scalef32_pk_fp4_f32(pk, v[2], v[3], 1.0f, 1);
            *(unsigned short*)(CGQ + t * 256 + term * 64 + 2 * ip) = (unsigned short)pk;
            const f32x2v d0 = __builtin_amdgcn_cvt_scalef32_pk_f32_fp4(pk, 1.0f, 0), d1 = __builtin_amdgcn_cvt_scalef32_pk_f32_fp4(pk, 1.0f, 1);
            v = (v - (f32x4){d0.x, d0.y, d1.x, d1.y}) * 4.0f;
        }
        if (ip == 0) CGS[t] = 1.0f / (sc * 64.0f);
    }
}
template <int MODE> __device__ __forceinline__ void p7v_accum(Frame& F, const Ptrs& P, float* dst) {
    unsigned char* ws = P.ws; const unsigned char* CGQ = ws + WS_CG; const float* CGS = (const float*)(ws + WS_CGS); const int* EXP = (const int*)(ws + WS_EG); const unsigned char* V4 = ws + WS_UV8 + 8 * MiB; const float* x1 = P.out;
    const int lane = F.lane, r = lane >> 3, c = lane & 7, i = lane & 15, kb = lane >> 4;
    LAS unsigned char* lT = F.lds + F.wave * 16384;
    LAS unsigned char* lI = F.lds + 131072 + F.wave * 2048;
    LAS float* lO = (LAS float*)(F.lds + 147456 + F.wave * 1024);
    const int wrA = r * 128 + ((c ^ r) << 4);
    const int rdb = (32 * kb + i) * 128, rdm = 2 * (i & 7) + (i >> 3);
#define PV_LOADW(tk) (*(const v2u*)(EXP + (size_t)(tbase + ((tk) < 31 ? (tk) : 31)) * 128 + 2 * lane))
#define PV_PUTW(tk, wv) do { *(LAS v2u*)(lI + ((tk) & 3) * 512 + 8 * lane) = wv; } while (0)
#define PV_ISSUE(tk, ul, av, sv, xv) do { const int t_ = tbase + ((tk) < 31 ? (tk) : 31); \
        _Pragma("unroll") for (int d_ = 0; d_ < 16; ++d_) { const unsigned ev = *(const LAS unsigned*)(lI + ((tk) & 3) * 512 + (8 * d_ + r) * 4); ul[d_] = *(const v4u*)(V4 + ((ev << 9) + loff)); } \
        av = *(const v4u*)(CGQ + (size_t)t_ * 256 + (i & 3) * 64 + kb * 16); sv = CGS[t_]; xv = *(const f32x4*)(x1 + (size_t)t_ * DM + 256 * sl + 4 * lane); } while (0)
#define PV_V8(lo) (v8i){(int)(lo).x, (int)(lo).y, (int)(lo).z, (int)(lo).w, 0, 0, 0, 0}
#define PV_COMPUTE(tk, ul, av, sv, xv) do { \
        _Pragma("unroll") for (int d_ = 0; d_ < 16; ++d_) *(LAS v4u*)(lT + d_ * 1024 + wrA) = (d_ & 1) ? (v4u){ul[d_].z, ul[d_].w, ul[d_].x, ul[d_].y} : ul[d_]; \
        const v4u am = i < 4 ? av : (v4u){0u, 0u, 0u, 0u}; const v8i a8 = PV_V8(am); \
        _Pragma("unroll") for (int n = 0; n < 16; ++n) { const LAS unsigned char* rp_ = lT + rdb + ((n ^ rdm) << 3); \
            const v2i_t lo_ = __builtin_amdgcn_ds_read_tr4_b64_v2i32((LAS v2i_t*)rp_), hi_ = __builtin_amdgcn_ds_read_tr4_b64_v2i32((LAS v2i_t*)(rp_ + 2048)); \
            const v8i b8 = {lo_.x, lo_.y, hi_.x, hi_.y, 0, 0, 0, 0}; \
            f32x4 acc = __builtin_amdgcn_mfma_scale_f32_16x16x128_f8f6f4(a8, b8, (f32x4){0.f, 0.f, 0.f, 0.f}, 4, 4, 0, 0, 0, 0); \
            asm volatile("" : "+v"(acc)); \
            const float val = (acc[0] + 0.25f * acc[1] + 0.0625f * acc[2] + 0.015625f * acc[3]) * sv; \
            if (lane < 16) lO[n * 16 + lane] = val; } \
        const f32x4 o_ = *(const LAS f32x4*)(lO + 4 * lane); \
        *(f32x4*)(dst + (size_t)(tbase + (tk)) * DM + 256 * sl + 4 * lane) = xv + o_; } while (0)
    for (int vb = F.bid; vb < 256; vb += F.G) {
        const int x = vb & 7, j = vb >> 3, sl = x & 3; const int tbase = (x >> 2) * (T / 2) + 256 * j + 32 * F.wave; const unsigned loff = 128 * sl + 16 * c;
        v2u w0 = PV_LOADW(0), w1 = PV_LOADW(1), w2 = PV_LOADW(2), w3 = PV_LOADW(3); v4u ulA[16], ulB[16], aA, aB; float sA, sB; f32x4 xA, xB;
        PV_PUTW(0, w0); PV_ISSUE(0, ulA, aA, sA, xA); w0 = PV_LOADW(4);
        for (int tk = 0; tk < 32; tk += 4) {
            PV_PUTW(tk + 1, w1); PV_ISSUE(tk + 1, ulB, aB, sB, xB); w1 = PV_LOADW(tk + 5); PV_COMPUTE(tk, ulA, aA, sA, xA);
            PV_PUTW(tk + 2, w2); PV_ISSUE(tk + 2, ulA, aA, sA, xA); w2 = PV_LOADW(tk + 6); PV_COMPUTE(tk + 1, ulB, aB, sB, xB);
            PV_PUTW(tk + 3, w3); PV_ISSUE(tk + 3, ulB, aB, sB, xB); w3 = PV_LOADW(tk + 7); PV_COMPUTE(tk + 2, ulA, aA, sA, xA);
            PV_PUTW(tk + 4, w0); PV_ISSUE(tk + 4, ulA, aA, sA, xA); w0 = PV_LOADW(tk + 8); PV_COMPUTE(tk + 3, ulB, aB, sB, xB);
        }
    }
#undef PV_LOADW
#undef PV_PUTW
#undef PV_ISSUE
#undef PV_COMPUTE
#undef PV_V8
}

struct MirrorOrder {
    pg8::StaticOrder S8;
    __device__ __forceinline__ bool next(int i, pg8::Unit& u) const { pg8::Unit v; if (!S8.next(i, v)) return false; u.pm = v.pn; u.pn = v.pm; return true; }
    __device__ __forceinline__ void a_ready(const pg8::Unit&) const {}
    __device__ __forceinline__ void done(const pg8::Unit&) const {}
};
struct Args { const float* in[14]; float* out; unsigned char* ws; int ph_lo, ph_hi; };
#ifdef PEER_BF16
constexpr int N_PHASES = 12;
#else
constexpr int N_PHASES = 14;
#endif
#ifndef MK_PER_PHASE
#define MK_PER_PHASE 0
#endif

__global__ void __launch_bounds__(NWAVES * 64, 2) hybrid_fwd(Args args) {
    extern __shared__ __attribute__((aligned(16))) unsigned char lds[];
    Frame F;
    F.lds = (LAS unsigned char*)lds; F.MISC = (volatile LAS unsigned*)(F.lds + MISC_OFF);
    F.tid = threadIdx.x; F.lane = F.tid & 63; F.wave = __builtin_amdgcn_readfirstlane(F.tid >> 6); F.G = gridDim.x; F.bid = blockIdx.x;
    F.ctl = (gu32*)(args.ws + WS_CTL);
    if (F.tid < 64) ((LAS unsigned*)(F.lds + MISC_OFF))[F.tid] = 0u;
    __syncthreads();
    XcdBarrier bar; bar.bar = (unsigned*)(F.ctl + CW_BAR); bar.x = 0; bar.st = nullptr;
    if (!MK_PER_PHASE) bar = xcd_barrier_post((unsigned*)(F.ctl + CW_BAR), F.MISC + 8);
    const int lo = args.ph_lo, hi = args.ph_hi;
#define LOADP() { int t_ = threadIdx.x; asm volatile("" : "+v"(t_)); F.tid = t_; F.lane = t_ & 63; F.wave = __builtin_amdgcn_readfirstlane(t_ >> 6); } Ptrs P; { const __attribute__((address_space(4))) Args* ap = (const __attribute__((address_space(4))) Args*)__builtin_amdgcn_kernarg_segment_ptr(); asm volatile("" : "+s"(ap)); \
    P.x = ap->in[0]; P.mix_g = ap->in[1]; P.w_in = ap->in[2]; P.ret_w = ap->in[3]; P.q_gain = ap->in[4]; P.k_gain = ap->in[5]; P.moba_w = ap->in[6]; P.rel_bias = ap->in[7]; \
    P.w_out = ap->in[8]; P.ffn_g = ap->in[9]; P.peer_wq = ap->in[10]; P.sub_keys = ap->in[11]; P.peer_u = ap->in[12]; P.peer_v = ap->in[13]; P.out = ap->out; P.ws = ap->ws; } \
    unsigned char* ws = P.ws; bf16* XN = (bf16*)P.out; bf16* RETG = (bf16*)P.out; bf16* ATT = (bf16*)((unsigned char*)P.out + 32 * MiB); (void)ws; (void)XN; (void)RETG; (void)ATT;
#ifdef RET_NAIVE
#define RET_FN p3a_retention
#else
#define RET_FN p3a_retention_mfma
#endif
#ifdef MOBA_NAIVE
#define MOBA_FN p3b_moba
#else
#define MOBA_FN p3b_moba_mfma<0>
#endif
#ifndef DUP_MASK
#define DUP_MASK 0
#endif
#ifndef DUPPH
#define DUPPH 0
#endif
#define REPS(k) ((((DUPPH) >> (k)) & 1) ? 2 : 1)
#ifndef PH_MASK
#define PH_MASK 0xFFFF
#endif
#define IN(k) (((PH_MASK >> (k)) & 1) && lo <= (k) && (k) < hi)
#define LOCAL_SEAM(k) do { if (MK_PER_PHASE) {} } while (0)
#define SEAM(k) do { if (IN(k) && IN((k) + 1)) xcd_barrier(bar); } while (0)
    LAS unsigned char* ring = F.lds;

    if (IN(0)) for (int rep_ = 0; rep_ < REPS(0); ++rep_) { LOADP(); p0_prologue(F, P); } SEAM(0);
    if (IN(1)) for (int rep_ = 0; rep_ < REPS(1); ++rep_) { LOADP();
        pg8::Gemm g{XN, (const bf16*)(ws + WS_WIN), T, INW, DM, DM, DM, 0}; pg8::StaticOrder S; S.init(T, INW, F.G, F.bid);
        EpiInProj E{(bf16*)(ws + WS_RQ), (bf16*)(ws + WS_RK), (bf16*)(ws + WS_RV), (bf16*)(ws + WS_RG), (bf16*)(ws + WS_MQ), (bf16*)(ws + WS_MK), (bf16*)(ws + WS_MV), (bf16*)(ws + WS_GA), (bf16*)(ws + WS_GB),
                    (const float*)(ws + WS_ROPE), P.q_gain, P.k_gain, (float*)(ws + WS_KM)};
        pg8::gemm_phase<EpiInProj, pg8::StaticOrder, true, true>(ring, g, S, E);
        { const int nunit = (T / 256) * (INW / 256), rem = nunit % F.G;
          if (rem == 0) p0b_late_weights(F, P, F.bid, F.G); else if (F.bid >= rem) p0b_late_weights(F, P, F.bid - rem, F.G - rem); }
    } SEAM(1);
#ifdef EXTRA_BARS
    for (int xb_ = 0; xb_ < EXTRA_BARS; ++xb_) xcd_barrier(bar);
#endif
    if (IN(2)) for (int rep_ = 0; rep_ < REPS(2); ++rep_) { LOADP(); p2a_kv_mfma(F, P); } SEAM(2);
    if (IN(3)) for (int rep_ = 0; rep_ < REPS(3); ++rep_) { LOADP(); p2b_scan(F, P); } SEAM(3);
    if (IN(4)) for (int rep_ = 0; rep_ < REPS(4); ++rep_) { LOADP(); RET_FN(F, P); if (DUP_MASK & 1) RET_FN(F, P); MOBA_FN(F, P); if (DUP_MASK & 2) MOBA_FN(F, P);
#ifdef MOBA_ABL
        p3b_moba_mfma<MOBA_ABL>(F, P);
#endif
    } SEAM(4);
    if (IN(5)) for (int rep_ = 0; rep_ < REPS(5); ++rep_) { LOADP();
        pg8::Gemm g0{ATT, (const bf16*)(ws + WS_WB), T, DM, 512, 512, 512, 0}, g1{RETG, (const bf16*)(ws + WS_WA), T, DM, DM, DM, DM, 0};
        TwoSegOrder S; S.B.init(T, DM, F.G, F.bid);
        EpiMerge2 E{(bf16*)(ws + WS_MRG), (const bf16*)(ws + WS_GA), (const bf16*)(ws + WS_GB)};
        pg8::gemm_phase2<EpiMerge2, TwoSegOrder, true, true>(ring, g0, g1, S, E);
    } SEAM(5);
    if (IN(6)) for (int rep_ = 0; rep_ < REPS(6); ++rep_) { LOADP();
        pg8::Gemm g{(const bf16*)(ws + WS_MRG), (const bf16*)(ws + WS_WO), T, DM, DM, DM, DM, 0}; pg8::StaticOrder S; S.init(T, DM, F.G, F.bid);
        EpiResid E{P.x, P.out, (bf16*)(ws + WS_H2), P.ffn_g, (float*)(ws + WS_SUMSQ)};
        pg8::gemm_phase<EpiResid, pg8::StaticOrder, true, true>(ring, g, S, E);
    } SEAM(6);
    if (IN(9)) for (int rep_ = 0; rep_ < REPS(9); ++rep_) { LOADP();
        pg8::Gemm g{(const bf16*)(ws + WS_WQ), (const bf16*)(ws + WS_H2), PH * 256, T, DM, DM, DM, 0}; MirrorOrder S; S.S8.init(T, 2048, F.G, F.bid);
        EpiNatBf16 E{(bf16*)(ws + WS_ST), T, (const float*)(ws + WS_SUMSQ)};
        pg8::gemm_phase<EpiNatBf16, MirrorOrder, true, true>(ring, g, S, E);
        VM_WAIT(); __syncthreads();
    } LOCAL_SEAM(9);
    if (IN(10)) for (int rep_ = 0; rep_ < REPS(10); ++rep_) { LOADP(); p6_topk(F, P); } SEAM(10);
#ifdef PEER_BF16
    if (IN(11)) for (int rep_ = 0; rep_ < REPS(11); ++rep_) { LOADP(); if (DUP_MASK & 4) p7_peer(F, P, (float*)(ws + WS_ST)); p7_peer(F, P, P.out); }
#else
    if (IN(11)) for (int rep_ = 0; rep_ < REPS(11); ++rep_) { LOADP(); p7u_dots<0>(F, P); if (DUP_MASK & 4) p7u_dots<2>(F, P); } SEAM(11);
    if (IN(12)) for (int rep_ = 0; rep_ < REPS(12); ++rep_) { LOADP(); p7z_gate(F, P); } SEAM(12);
    if (IN(13)) for (int rep_ = 0; rep_ < REPS(13); ++rep_) { LOADP(); if (DUP_MASK & 16) p7v_accum<0>(F, P, (float*)(ws + WS_PART)); p7v_accum<0>(F, P, P.out); }
#endif
#undef IN
#undef SEAM
}

extern "C" void kernel_launch(void* const* d_in, const int* in_sizes, int n_in, void* d_out, int out_size, void* d_ws, size_t ws_size, hipStream_t stream) {
    static int grid = 0;
    if (grid == 0) {
        if (n_in != 14 || out_size != T * DM || ws_size < WS_END) { fprintf(stderr, "kernel_launch: unexpected problem (n_in %d, out %d, ws %zu); nothing launched\n", n_in, out_size, ws_size); grid = -1; return; }
        int dev = 0, cus = 0, per_cu = 0;
        if (hipGetDevice(&dev) != hipSuccess || hipDeviceGetAttribute(&cus, hipDeviceAttributeMultiprocessorCount, dev) != hipSuccess) { grid = -1; return; }
        if (hipFuncSetAttribute((const void*)hybrid_fwd, hipFuncAttributeMaxDynamicSharedMemorySize, LDS_BYTES) != hipSuccess) { fprintf(stderr, "kernel_launch: hipFuncSetAttribute failed\n"); grid = -1; return; }
        if (hipOccupancyMaxActiveBlocksPerMultiprocessor(&per_cu, (const void*)hybrid_fwd, NWAVES * 64, LDS_BYTES) != hipSuccess || per_cu < 1)
            fprintf(stderr, "kernel_launch: note: occupancy query reports %d workgroups per CU\n", per_cu);
        (void)hipGetLastError();
        grid = cus;
    }
    if (grid < 0) return;
    (void)hipMemsetAsync((char*)d_ws + WS_CTL, 0, CTL_ZERO_BYTES, stream);
    Args a{};
    for (int i = 0; i < 14; ++i) a.in[i] = (const float*)d_in[i];
    a.out = (float*)d_out; a.ws = (unsigned char*)d_ws;
#if MK_PER_PHASE
    for (int p = 0; p < N_PHASES; ++p) { a.ph_lo = p; a.ph_hi = p + 1; hipLaunchKernelGGL(hybrid_fwd, dim3(grid), dim3(NWAVES * 64), LDS_BYTES, stream, a); }
#else
    a.ph_lo = 0; a.ph_hi = N_PHASES;
    hipLaunchKernelGGL(hybrid_fwd, dim3(grid), dim3(NWAVES * 64), LDS_BYTES, stream, a);
#endif
}
```

```cpp
#include <hip/hip_runtime.h>
#include <cstdio>
#include <cstdint>

#define GAS __attribute__((address_space(1)))
#define LAS __attribute__((address_space(3)))
typedef unsigned short bf16;
typedef unsigned v4u __attribute__((ext_vector_type(4)));
typedef unsigned v2u __attribute__((ext_vector_type(2)));
typedef float f32x4 __attribute__((ext_vector_type(4)));
typedef short bf16x8 __attribute__((ext_vector_type(8)));
typedef float f32x16 __attribute__((ext_vector_type(16)));
typedef GAS unsigned gu32;
#define RLX_AGENT __ATOMIC_RELAXED, __HIP_MEMORY_SCOPE_AGENT
#define LDS_WAIT() asm volatile("s_waitcnt lgkmcnt(0)" ::: "memory")
#define VM_WAIT() asm volatile("s_waitcnt vmcnt(0)" ::: "memory")

constexpr int BATCH = 4, SEQ = 4096, DM = 1024, T = BATCH * SEQ;
constexpr int RH = 8, RDK = 64, RDV = 128, RC = 128, NCH = SEQ / RC;
constexpr int MH = 8, MD = 64, MBLK = 256, NBLK = SEQ / MBLK;
constexpr int PH = 8, PNK = 128, PTOP = 16, PQD = 256;
constexpr int NEXP = PNK * PNK;
constexpr int INW = 6656;
constexpr float EPS = 1e-6f;

__device__ __forceinline__ unsigned f2bf(float f) { unsigned u = __builtin_bit_cast(unsigned, f); return (u + 0x7fffu + ((u >> 16) & 1u)) >> 16; }
typedef float f32x2_t __attribute__((ext_vector_type(2))); typedef __bf16 bf16x2_t __attribute__((ext_vector_type(2)));
__device__ __forceinline__ unsigned pk2(float lo, float hi) { const f32x2_t v = {lo, hi}; const bf16x2_t b = __builtin_convertvector(v, bf16x2_t); return __builtin_bit_cast(unsigned, b); }
__device__ __forceinline__ float bf2f(unsigned short b) { return __builtin_bit_cast(float, (unsigned)b << 16); }
__device__ __forceinline__ float bflo(unsigned w) { return __builtin_bit_cast(float, w << 16); }
__device__ __forceinline__ float bfhi(unsigned w) { return __builtin_bit_cast(float, w & 0xffff0000u); }
__device__ __forceinline__ float wave_sum(float v) {
#pragma unroll
    for (int o = 1; o < 64; o <<= 1) v += __shfl_xor(v, o);
    return v;
}
__device__ __forceinline__ float dpp_sum8(float v) {
    v += __builtin_bit_cast(float, __builtin_amdgcn_mov_dpp(__builtin_bit_cast(int, v), 0xB1, 0xF, 0xF, true));
    v += __builtin_bit_cast(float, __builtin_amdgcn_mov_dpp(__builtin_bit_cast(int, v), 0x4E, 0xF, 0xF, true));
    v += __builtin_bit_cast(float, __builtin_amdgcn_mov_dpp(__builtin_bit_cast(int, v), 0x141, 0xF, 0xF, true));
    return v;
}
__device__ __forceinline__ float ret_l2g(int h) { return log1pf(-exp2f(-5.0f - (float)h)) * 1.4426950408889634f; }

__host__ __device__ __forceinline__ int perm_row_of_col(int a) {
    const int tile = a >> 8, w = a & 255, wc = w >> 6, bj = (w >> 5) & 1, q = w & 31, fq = q >> 3, n = (q >> 2) & 1, e = q & 3;
    return tile * 256 + 128 * bj + 32 * wc + 16 * n + 4 * fq + e;
}
namespace pg8 {
#define PG8_LAS __attribute__((address_space(3)))
typedef unsigned short bf16_t;
typedef short bf16x8 __attribute__((ext_vector_type(8)));
typedef float f32x4 __attribute__((ext_vector_type(4)));
typedef unsigned u32x4 __attribute__((ext_vector_type(4)));
constexpr int BM = 256, BK = 64, HALF = 128, HTB = HALF * BK * 2  , STAGE_BYTES = 8 * HTB, NXCD = 8, WGM = 8;

__host__ __device__ __forceinline__ int lds_byte(int r, int c) { const int st = (r >> 4) * 2 + (c >> 5), rr = r & 15, cc = c & 31, ob = rr * 64 + cc * 2; return st * 1024 + (ob ^ (((ob >> 9) & 1) << 5)); }
__host__ __device__ __forceinline__ void stage_rc(int b, int& R, int& C) { const int st = b / 1024, sb = b % 1024, swz = sb ^ (((sb >> 9) & 1) << 5); R = (st >> 1) * 16 + swz / 64; C = (st & 1) * 32 + (swz % 64) / 2; }
__host__ __device__ __forceinline__ int perm32(int rho) { const int n = rho >> 4, i = rho & 15; return 8 * (i >> 2) + 4 * n + (i & 3); }

struct Unit { int pm, pn, seg; };
struct Gemm { const bf16_t* A; const bf16_t* Bt; int M, N, K, lda, ldb, bpm; };

struct StaticOrder {
    int nM, nN, nwg, G, c;
    __host__ __device__ void init(int M, int N, int G_, int c_) { nM = M / BM; nN = N / BM; nwg = nM * nN; G = G_; c = c_; }
    __host__ __device__ bool next(int i, Unit& u) const {
        const long L = (long)i * G + c; if (L >= nwg) return false;
        int wgid = (int)L; { const int q = nwg / NXCD, r = nwg % NXCD, xcd = wgid % NXCD, off = wgid / NXCD; wgid = (xcd < r ? xcd * (q + 1) : r * (q + 1) + (xcd - r) * q) + off; }
        const int nig = WGM * nN, gid = wgid / nig, fm = gid * WGM, gsz = (nM - fm) < WGM ? (nM - fm) : WGM;
        u.pm = fm + ((wgid % nig) % gsz); u.pn = (wgid % nig) / gsz; u.seg = 0; return true;
    }
    __device__ __forceinline__ void a_ready(const Unit&) const {}
    __device__ __forceinline__ void done(const Unit&) const {}
};


template <class Epi, class Sched, bool ALIGN_EPI = false, bool SP2 = false>
__device__ __forceinline__ void gemm_phase(PG8_LAS unsigned char* lds, const Gemm g, const Sched& S, const Epi& E) {
    int tid_ = threadIdx.x; asm volatile("" : "+v"(tid_));
    const int tid = tid_, wid = __builtin_amdgcn_readfirstlane(tid >> 6), lane = tid & 63, wr = wid >> 2, wc = wid & 3, fr = lane & 15, fq = lane >> 4;
    const int K = g.K, nt = K / BK;
    unsigned voffA[2], voffB[2];
#pragma unroll
    for (int i = 0; i < 2; ++i) { int R, C; stage_rc(tid * 16 + i * 8192, R, C);
        voffA[i] = (unsigned)(R * g.lda + C) * 2u; voffB[i] = (unsigned)(R * g.ldb + C) * 2u; }
    const size_t kstep = (size_t)(BK * 2);
    const size_t hstepA = (size_t)HALF * g.lda * 2, hstepB = (size_t)HALF * g.ldb * 2;
    const size_t tstepA = 2 * hstepA, tstepB = 2 * hstepB;
    const unsigned ldsw = (unsigned)wid * 1024u;
    const int aoff = lds_byte(wr * 64 + fr, fq * 8), boff = lds_byte(wc * 32 + fr, fq * 8);
#define PG8_SA(b, h) (((b) * 2 + (h)) * HTB)
#define PG8_SB(b, h) ((4 + (b) * 2 + (h)) * HTB)
#define PG8_STAGE(bufoff, gbase, voff) do { _Pragma("unroll") for (int _i = 0; _i < 2; ++_i) \
        __builtin_amdgcn_global_load_lds((const unsigned*)((const char*)(gbase) + (voff)[_i]), (PG8_LAS unsigned*)(lds + (bufoff) + ldsw + _i * 8192), 16, 0, 0); } while (0)
#define PG8_LDA(dst, b, h) do { _Pragma("unroll") for (int m = 0; m < 4; ++m) _Pragma("unroll") for (int k = 0; k < 2; ++k) dst[m][k] = *(const PG8_LAS bf16x8*)(lds + PG8_SA(b, h) + aoff + m * 2048 + k * 1024); } while (0)
#define PG8_LDB(dst, b, h) do { _Pragma("unroll") for (int n = 0; n < 2; ++n) _Pragma("unroll") for (int k = 0; k < 2; ++k) dst[n][k] = *(const PG8_LAS bf16x8*)(lds + PG8_SB(b, h) + boff + n * 2048 + k * 1024); } while (0)
#define PG8_MMA(ai, bj, At, Bt) do { __builtin_amdgcn_s_setprio(1); _Pragma("unroll") for (int m = 0; m < 4; ++m) _Pragma("unroll") for (int n = 0; n < 2; ++n) _Pragma("unroll") for (int k = 0; k < 2; ++k) \
        acc[ai][bj][m][n] = __builtin_amdgcn_mfma_f32_16x16x32_bf16(Bt[n][k], At[m][k], acc[ai][bj][m][n], 0, 0, 0); __builtin_amdgcn_s_setprio(0); } while (0)
#define PG8_WAIT_V(n) asm volatile("s_waitcnt vmcnt(" #n ")" ::: "memory")
#define PG8_WAIT_L(n) asm volatile("s_waitcnt lgkmcnt(" #n ")" ::: "memory")
#define PG8_BAR __builtin_amdgcn_s_barrier()
#define PG8_SCHED __builtin_amdgcn_sched_barrier(0)
    Unit cur, nxt; int ui = 0;
    if (!S.next(0, cur)) return;
    f32x4 acc[2][2][4][2];
#pragma unroll
    for (int a = 0; a < 2; ++a)
#pragma unroll
        for (int b = 0; b < 2; ++b)
#pragma unroll
            for (int m = 0; m < 4; ++m)
#pragma unroll
                for (int n = 0; n < 2; ++n) acc[a][b][m][n] = (f32x4){0.f, 0.f, 0.f, 0.f};
    bf16x8 At[4][2], B0[2][2], B1[2][2];
    const char* cA = (const char*)g.A + (size_t)cur.pm * tstepA; const char* cB = (const char*)g.Bt + (size_t)cur.pn * tstepB + (size_t)cur.pm * g.bpm;
    S.a_ready(cur);
    if constexpr (SP2) {
        PG8_STAGE(PG8_SB(0, 0), cB, voffB); PG8_STAGE(PG8_SB(0, 1), cB + hstepB, voffB); PG8_STAGE(PG8_SA(0, 0), cA, voffA); PG8_STAGE(PG8_SA(0, 1), cA + hstepA, voffA);
        if (wr == 1) PG8_BAR;
        PG8_WAIT_V(2); PG8_BAR;
        PG8_STAGE(PG8_SB(1, 0), cB + kstep, voffB); PG8_STAGE(PG8_SA(1, 0), cA + kstep, voffA); PG8_STAGE(PG8_SB(1, 1), cB + hstepB + kstep, voffB);
        PG8_WAIT_V(6); PG8_BAR;
    } else {
        PG8_STAGE(PG8_SB(0, 0), cB, voffB); PG8_STAGE(PG8_SA(0, 0), cA, voffA); PG8_STAGE(PG8_SB(0, 1), cB + hstepB, voffB); PG8_STAGE(PG8_SA(0, 1), cA + hstepA, voffA);
        if (wr == 1) PG8_BAR;
        PG8_WAIT_V(4); PG8_BAR;
        PG8_STAGE(PG8_SB(1, 0), cB + kstep, voffB); PG8_STAGE(PG8_SA(1, 0), cA + kstep, voffA); PG8_STAGE(PG8_SB(1, 1), cB + hstepB + kstep, voffB);
        PG8_WAIT_V(6); PG8_BAR;
    }
    for (;;) {
        const bool has_next = S.next(ui + 1, nxt);
        const char* nA = has_next ? (const char*)g.A + (size_t)nxt.pm * tstepA : cA; const char* nB = has_next ? (const char*)g.Bt + (size_t)nxt.pn * tstepB + (size_t)nxt.pm * g.bpm : cB;
        for (int t = 0; t < nt; t += 2) {
            const bool last = (t == nt - 2);
            const char* a1 = cA + (size_t)(t + 1) * kstep;
            const char* a2 = last ? nA : cA + (size_t)(t + 2) * kstep; const char* b2 = last ? nB : cB + (size_t)(t + 2) * kstep;
            const char* a3 = a2 + kstep; const char* b3 = b2 + kstep;
            if (last && has_next) S.a_ready(nxt);
            if constexpr (SP2) {
            PG8_LDB(B0, 0, 0); PG8_LDB(B1, 0, 1); PG8_SCHED; PG8_LDA(At, 0, 0); PG8_STAGE(PG8_SA(1, 1), a1 + hstepA, voffA);
            PG8_WAIT_V(8); PG8_WAIT_L(0); PG8_BAR; PG8_MMA(0, 0, At, B0); PG8_MMA(0, 1, At, B1); PG8_BAR; PG8_SCHED;
            PG8_LDA(At, 0, 1); PG8_STAGE(PG8_SB(0, 0), b2, voffB); PG8_STAGE(PG8_SB(0, 1), b2 + hstepB, voffB); PG8_STAGE(PG8_SA(0, 0), a2, voffA);
            PG8_WAIT_V(8); PG8_WAIT_L(0); PG8_BAR; PG8_MMA(1, 0, At, B0); PG8_MMA(1, 1, At, B1); PG8_BAR; PG8_SCHED;
            PG8_LDB(B0, 1, 0); PG8_LDB(B1, 1, 1); PG8_SCHED; PG8_LDA(At, 1, 0); PG8_STAGE(PG8_SA(0, 1), a2 + hstepA, voffA);
            PG8_WAIT_V(8); PG8_WAIT_L(0); PG8_BAR; PG8_MMA(0, 0, At, B0); PG8_MMA(0, 1, At, B1); PG8_BAR; PG8_SCHED;
            PG8_LDA(At, 1, 1); PG8_STAGE(PG8_SB(1, 0), b3, voffB); PG8_STAGE(PG8_SB(1, 1), b3 + hstepB, voffB); PG8_STAGE(PG8_SA(1, 0), a3, voffA);
            PG8_WAIT_V(8); PG8_WAIT_L(0); PG8_BAR; PG8_MMA(1, 0, At, B0); PG8_MMA(1, 1, At, B1); PG8_BAR; PG8_SCHED;
            } else {
            PG8_LDB(B0, 0, 0); PG8_SCHED; PG8_LDA(At, 0, 0); PG8_STAGE(PG8_SA(1, 1), a1 + hstepA, voffA);
            PG8_WAIT_L(8); PG8_BAR; PG8_WAIT_L(0); PG8_MMA(0, 0, At, B0); PG8_BAR; PG8_SCHED;
            PG8_LDB(B1, 0, 1); PG8_STAGE(PG8_SB(0, 0), b2, voffB);
            PG8_BAR; PG8_WAIT_L(0); PG8_MMA(0, 1, At, B1); PG8_BAR;
            PG8_LDA(At, 0, 1); PG8_STAGE(PG8_SA(0, 0), a2, voffA);
            PG8_BAR; PG8_WAIT_L(0); PG8_MMA(1, 0, At, B0); PG8_BAR; PG8_SCHED;
            PG8_STAGE(PG8_SB(0, 1), b2 + hstepB, voffB);
            PG8_WAIT_V(6); PG8_BAR; PG8_MMA(1, 1, At, B1); PG8_BAR;
            PG8_LDB(B0, 1, 0); PG8_SCHED; PG8_LDA(At, 1, 0); PG8_STAGE(PG8_SA(0, 1), a2 + hstepA, voffA);
            PG8_WAIT_L(8); PG8_BAR; PG8_WAIT_L(0); PG8_MMA(0, 0, At, B0); PG8_BAR; PG8_SCHED;
            PG8_LDB(B1, 1, 1); PG8_STAGE(PG8_SB(1, 0), b3, voffB);
            PG8_BAR; PG8_WAIT_L(0); PG8_MMA(0, 1, At, B1); PG8_BAR;
            PG8_LDA(At, 1, 1); PG8_STAGE(PG8_SA(1, 0), a3, voffA);
            PG8_BAR; PG8_WAIT_L(0); PG8_MMA(1, 0, At, B0); PG8_BAR; PG8_SCHED;
            PG8_STAGE(PG8_SB(1, 1), b3 + hstepB, voffB);
            PG8_WAIT_V(6); PG8_BAR; PG8_MMA(1, 1, At, B1); PG8_BAR;
            }
        }
        if constexpr (ALIGN_EPI) { if (wr == 0) PG8_BAR; }
        if constexpr (!Epi::AFTER_DRAIN) { E(acc, cur, wr, wc, fr, fq); S.done(cur); }
        if (!has_next) break;
#pragma unroll
        for (int a = 0; a < 2; ++a)
#pragma unroll
            for (int b = 0; b < 2; ++b)
#pragma unroll
                for (int m = 0; m < 4; ++m)
#pragma unroll
                    for (int n = 0; n < 2; ++n) acc[a][b][m][n] = (f32x4){0.f, 0.f, 0.f, 0.f};
        cur = nxt; cA = nA; cB = nB; ++ui;
        if constexpr (ALIGN_EPI) { if (wr == 1) PG8_BAR; }
    }
    PG8_WAIT_V(0);
    if constexpr (!ALIGN_EPI) { if (wr == 0) PG8_BAR; }
    PG8_BAR;
    if constexpr (Epi::AFTER_DRAIN) { E.fused(acc, cur, wr, wc, fr, fq, lds, wid, lane); S.done(cur); }
#undef PG8_SA
#undef PG8_SB
#undef PG8_STAGE
#undef PG8_LDA
#undef PG8_LDB
#undef PG8_MMA
#undef PG8_WAIT_V
#undef PG8_WAIT_L
#undef PG8_BAR
#undef PG8_SCHED
}
template <class Epi, class Sched, bool ALIGN_EPI = false, bool SP2 = false>
__device__ __forceinline__ void gemm_phase2(PG8_LAS unsigned char* lds, const Gemm g0, const Gemm g1, const Sched& S, const Epi& E) {
    int tid_ = threadIdx.x; asm volatile("" : "+v"(tid_));
    const int tid = tid_, wid = __builtin_amdgcn_readfirstlane(tid >> 6), lane = tid & 63, wr = wid >> 2, wc = wid & 3, fr = lane & 15, fq = lane >> 4;
    unsigned voffA0[2], voffB0[2], voffA1[2], voffB1[2];
#pragma unroll
    for (int i = 0; i < 2; ++i) { int R, C; stage_rc(tid * 16 + i * 8192, R, C);
        voffA0[i] = (unsigned)(R * g0.lda + C) * 2u; voffB0[i] = (unsigned)(R * g0.ldb + C) * 2u; voffA1[i] = (unsigned)(R * g1.lda + C) * 2u; voffB1[i] = (unsigned)(R * g1.ldb + C) * 2u; }
    const size_t kstep = (size_t)(BK * 2);
    const size_t hstepA0 = (size_t)HALF * g0.lda * 2, hstepB0 = (size_t)HALF * g0.ldb * 2, hstepA1 = (size_t)HALF * g1.lda * 2, hstepB1 = (size_t)HALF * g1.ldb * 2;
    const size_t tstepA0 = 2 * hstepA0, tstepB0 = 2 * hstepB0, tstepA1 = 2 * hstepA1, tstepB1 = 2 * hstepB1;
    const unsigned ldsw = (unsigned)wid * 1024u;
    const int aoff = lds_byte(wr * 64 + fr, fq * 8), boff = lds_byte(wc * 32 + fr, fq * 8);
#define PG8_SA(b, h) (((b) * 2 + (h)) * HTB)
#define PG8_SB(b, h) ((4 + (b) * 2 + (h)) * HTB)
#define PG8_STAGE(bufoff, gbase, voff) do { _Pragma("unroll") for (int _i = 0; _i < 2; ++_i) \
        __builtin_amdgcn_global_load_lds((const unsigned*)((const char*)(gbase) + (voff)[_i]), (PG8_LAS unsigned*)(lds + (bufoff) + ldsw + _i * 8192), 16, 0, 0); } while (0)
#define PG8_LDA(dst, b, h) do { _Pragma("unroll") for (int m = 0; m < 4; ++m) _Pragma("unroll") for (int k = 0; k < 2; ++k) dst[m][k] = *(const PG8_LAS bf16x8*)(lds + PG8_SA(b, h) + aoff + m * 2048 + k * 1024); } while (0)
#define PG8_LDB(dst, b, h) do { _Pragma("unroll") for (int n = 0; n < 2; ++n) _Pragma("unroll") for (int k = 0; k < 2; ++k) dst[n][k] = *(const PG8_LAS bf16x8*)(lds + PG8_SB(b, h) + boff + n * 2048 + k * 1024); } while (0)
#define PG8_MMA(ai, bj, At, Bt) do { __builtin_amdgcn_s_setprio(1); _Pragma("unroll") for (int m = 0; m < 4; ++m) _Pragma("unroll") for (int n = 0; n < 2; ++n) _Pragma("unroll") for (int k = 0; k < 2; ++k) \
        acc[ai][bj][m][n] = __builtin_amdgcn_mfma_f32_16x16x32_bf16(Bt[n][k], At[m][k], acc[ai][bj][m][n], 0, 0, 0); __builtin_amdgcn_s_setprio(0); } while (0)
#define PG8_WAIT_V(n) asm volatile("s_waitcnt vmcnt(" #n ")" ::: "memory")
#define PG8_WAIT_L(n) asm volatile("s_waitcnt lgkmcnt(" #n ")" ::: "memory")
#define PG8_BAR __builtin_amdgcn_s_barrier()
#define PG8_SCHED __builtin_amdgcn_sched_barrier(0)
    Unit cur, nxt; int ui = 0;
    if (!S.next(0, cur)) return;
    f32x4 acc[2][2][4][2];
#pragma unroll
    for (int a = 0; a < 2; ++a)
#pragma unroll
        for (int b = 0; b < 2; ++b)
#pragma unroll
            for (int m = 0; m < 4; ++m)
#pragma unroll
                for (int n = 0; n < 2; ++n) acc[a][b][m][n] = (f32x4){0.f, 0.f, 0.f, 0.f};
    bf16x8 At[4][2], B0[2][2], B1[2][2];
#define PG8_UA(u_) ((u_).seg ? (const char*)g1.A + (size_t)(u_).pm * tstepA1 : (const char*)g0.A + (size_t)(u_).pm * tstepA0)
#define PG8_UB(u_) ((u_).seg ? (const char*)g1.Bt + (size_t)(u_).pn * tstepB1 : (const char*)g0.Bt + (size_t)(u_).pn * tstepB0)
    const char* cA = PG8_UA(cur); const char* cB = PG8_UB(cur);
    size_t hAc = cur.seg ? hstepA1 : hstepA0, hBc = cur.seg ? hstepB1 : hstepB0; unsigned vAc[2], vBc[2];
#pragma unroll
    for (int i = 0; i < 2; ++i) { vAc[i] = cur.seg ? voffA1[i] : voffA0[i]; vBc[i] = cur.seg ? voffB1[i] : voffB0[i]; }
    int nt = (cur.seg ? g1.K : g0.K) / BK;
    S.a_ready(cur);
    if constexpr (SP2) {
        PG8_STAGE(PG8_SB(0, 0), cB, vBc); PG8_STAGE(PG8_SB(0, 1), cB + hBc, vBc); PG8_STAGE(PG8_SA(0, 0), cA, vAc); PG8_STAGE(PG8_SA(0, 1), cA + hAc, vAc);
        if (wr == 1) PG8_BAR;
        PG8_WAIT_V(2); PG8_BAR;
        PG8_STAGE(PG8_SB(1, 0), cB + kstep, vBc); PG8_STAGE(PG8_SA(1, 0), cA + kstep, vAc); PG8_STAGE(PG8_SB(1, 1), cB + hBc + kstep, vBc);
        PG8_WAIT_V(6); PG8_BAR;
    } else {
        PG8_STAGE(PG8_SB(0, 0), cB, vBc); PG8_STAGE(PG8_SA(0, 0), cA, vAc); PG8_STAGE(PG8_SB(0, 1), cB + hBc, vBc); PG8_STAGE(PG8_SA(0, 1), cA + hAc, vAc);
        if (wr == 1) PG8_BAR;
        PG8_WAIT_V(4); PG8_BAR;
        PG8_STAGE(PG8_SB(1, 0), cB + kstep, vBc); PG8_STAGE(PG8_SA(1, 0), cA + kstep, vAc); PG8_STAGE(PG8_SB(1, 1), cB + hBc + kstep, vBc);
        PG8_WAIT_V(6); PG8_BAR;
    }
    for (;;) {
        const bool has_next = S.next(ui + 1, nxt);
        const char* nA = has_next ? PG8_UA(nxt) : cA; const char* nB = has_next ? PG8_UB(nxt) : cB;
        const int sn = has_next ? nxt.seg : cur.seg; const size_t hAn = sn ? hstepA1 : hstepA0, hBn = sn ? hstepB1 : hstepB0; unsigned vAn[2], vBn[2];
#pragma unroll
        for (int i = 0; i < 2; ++i) { vAn[i] = sn ? voffA1[i] : voffA0[i]; vBn[i] = sn ? voffB1[i] : voffB0[i]; }
        for (int t = 0; t < nt; t += 2) {
            const bool last = (t == nt - 2);
            const size_t hA2 = last ? hAn : hAc, hB2 = last ? hBn : hBc; unsigned vA2[2], vB2[2];
#pragma unroll
            for (int i = 0; i < 2; ++i) { vA2[i] = last ? vAn[i] : vAc[i]; vB2[i] = last ? vBn[i] : vBc[i]; }
            const char* a1 = cA + (size_t)(t + 1) * kstep;
            const char* a2 = last ? nA : cA + (size_t)(t + 2) * kstep; const char* b2 = last ? nB : cB + (size_t)(t + 2) * kstep;
            const char* a3 = a2 + kstep; const char* b3 = b2 + kstep;
            if (last && has_next) S.a_ready(nxt);
            if constexpr (SP2) {
            PG8_LDB(B0, 0, 0); PG8_LDB(B1, 0, 1); PG8_SCHED; PG8_LDA(At, 0, 0); PG8_STAGE(PG8_SA(1, 1), a1 + hAc, vAc);
            PG8_WAIT_V(8); PG8_WAIT_L(0); PG8_BAR; PG8_MMA(0, 0, At, B0); PG8_MMA(0, 1, At, B1); PG8_BAR; PG8_SCHED;
            PG8_LDA(At, 0, 1); PG8_STAGE(PG8_SB(0, 0), b2, vB2); PG8_STAGE(PG8_SB(0, 1), b2 + hB2, vB2); PG8_STAGE(PG8_SA(0, 0), a2, vA2);
            PG8_WAIT_V(8); PG8_WAIT_L(0); PG8_BAR; PG8_MMA(1, 0, At, B0); PG8_MMA(1, 1, At, B1); PG8_BAR; PG8_SCHED;
            PG8_LDB(B0, 1, 0); PG8_LDB(B1, 1, 1); PG8_SCHED; PG8_LDA(At, 1, 0); PG8_STAGE(PG8_SA(0, 1), a2 + hA2, vA2);
            PG8_WAIT_V(8); PG8_WAIT_L(0); PG8_BAR; PG8_MMA(0, 0, At, B0); PG8_MMA(0, 1, At, B1); PG8_BAR; PG8_SCHED;
            PG8_LDA(At, 1, 1); PG8_STAGE(PG8_SB(1, 0), b3, vB2); PG8_STAGE(PG8_SB(1, 1), b3 + hB2, vB2); PG8_STAGE(PG8_SA(1, 0), a3, vA2);
            PG8_WAIT_V(8); PG8_WAIT_L(0); PG8_BAR; PG8_MMA(1, 0, At, B0); PG8_MMA(1, 1, At, B1); PG8_BAR; PG8_SCHED;
            } else {
            PG8_LDB(B0, 0, 0); PG8_SCHED; PG8_LDA(At, 0, 0); PG8_STAGE(PG8_SA(1, 1), a1 + hAc, vAc);
            PG8_WAIT_L(8); PG8_BAR; PG8_WAIT_L(0); PG8_MMA(0, 0, At, B0); PG8_BAR; PG8_SCHED;
            PG8_LDB(B1, 0, 1); PG8_STAGE(PG8_SB(0, 0), b2, vB2);
            PG8_BAR; PG8_WAIT_L(0); PG8_MMA(0, 1, At, B1); PG8_BAR;
            PG8_LDA(At, 0, 1); PG8_STAGE(PG8_SA(0, 0), a2, vA2);
            PG8_BAR; PG8_WAIT_L(0); PG8_MMA(1, 0, At, B0); PG8_BAR; PG8_SCHED;
            PG8_STAGE(PG8_SB(0, 1), b2 + hB2, vB2);
            PG8_WAIT_V(6); PG8_BAR; PG8_MMA(1, 1, At, B1); PG8_BAR;
            PG8_LDB(B0, 1, 0); PG8_SCHED; PG8_LDA(At, 1, 0); PG8_STAGE(PG8_SA(0, 1), a2 + hA2, vA2);
            PG8_WAIT_L(8); PG8_BAR; PG8_WAIT_L(0); PG8_MMA(0, 0, At, B0); PG8_BAR; PG8_SCHED;
            PG8_LDB(B1, 1, 1); PG8_STAGE(PG8_SB(1, 0), b3, vB2);
            PG8_BAR; PG8_WAIT_L(0); PG8_MMA(0, 1, At, B1); PG8_BAR;
            PG8_LDA(At, 1, 1); PG8_STAGE(PG8_SA(1, 0), a3, vA2);
            PG8_BAR; PG8_WAIT_L(0); PG8_MMA(1, 0, At, B0); PG8_BAR; PG8_SCHED;
            PG8_STAGE(PG8_SB(1, 1), b3 + hB2, vB2);
            PG8_WAIT_V(6); PG8_BAR; PG8_MMA(1, 1, At, B1); PG8_BAR;
            }
        }
        if constexpr (ALIGN_EPI) { if (wr == 0) PG8_BAR; }
        if (cur.seg == 0) E.mid(acc, cur, wr, wc, fr, fq); else { E(acc, cur, wr, wc, fr, fq); S.done(cur); }
        if (!has_next) break;
        if (cur.seg == 1) {
#pragma unroll
        for (int a = 0; a < 2; ++a)
#pragma unroll
            for (int b = 0; b < 2; ++b)
#pragma unroll
                for (int m = 0; m < 4; ++m)
#pragma unroll
                    for (int n = 0; n < 2; ++n) acc[a][b][m][n] = (f32x4){0.f, 0.f, 0.f, 0.f};
        }
        cur = nxt; cA = nA; cB = nB; ++ui; hAc = hAn; hBc = hBn; vAc[0] = vAn[0]; vAc[1] = vAn[1]; vBc[0] = vBn[0]; vBc[1] = vBn[1]; nt = (cur.seg ? g1.K : g0.K) / BK;
        if constexpr (ALIGN_EPI) { if (wr == 1) PG8_BAR; }
    }
    PG8_WAIT_V(0);
    if constexpr (!ALIGN_EPI) { if (wr == 0) PG8_BAR; }
    PG8_BAR;
#undef PG8_UA
#undef PG8_UB
#undef PG8_SA
#undef PG8_SB
#undef PG8_STAGE
#undef PG8_LDA
#undef PG8_LDB
#undef PG8_MMA
#undef PG8_WAIT_V
#undef PG8_WAIT_L
#undef PG8_BAR
#undef PG8_SCHED
}
}

#define XB_TMO      128
#define XB_XCNT(j)  (256  + 64 * (j))
#define XB_XSUB(j)  (1280 + 64 * (j))
#define XB_XGEN(j)  (2304 + 64 * (j))
#define XB_TOP      3328
#define XB_TOPGEN   3392
#define XCD_BAR_WORDS 3456
#define XB_SPIN_CAP (1u << 18)

__device__ __forceinline__ unsigned xb_ld(unsigned* p)              { return __hip_atomic_load(p, __ATOMIC_RELAXED, __HIP_MEMORY_SCOPE_AGENT); }
__device__ __forceinline__ unsigned xb_add(unsigned* p, unsigned v) { return __hip_atomic_fetch_add(p, v, __ATOMIC_RELAXED, __HIP_MEMORY_SCOPE_AGENT); }
__device__ __forceinline__ unsigned xb_xcc_id() { return (unsigned)__builtin_amdgcn_s_getreg((3 << 11) | 20) & 0xFu; }
#define XB_SPIN(cond, bar) do { unsigned _sp = 0; while (cond) { __builtin_amdgcn_s_sleep(1); \
    if ((++_sp & 255u) == 0u) { if (xb_ld(&(bar)[XB_TMO])) break; if (_sp > XB_SPIN_CAP) { atomicAdd(&(bar)[XB_TMO], 1u); break; } } } } while (0)

struct XcdBarrier {
    unsigned* bar; unsigned x;
    volatile LAS unsigned* st;
};

__device__ __forceinline__ XcdBarrier xcd_barrier_post(unsigned* bar, volatile LAS unsigned* st) {
    XcdBarrier b; b.bar = bar; b.x = xb_xcc_id(); b.st = st;
    if (threadIdx.x == 0) (void)xb_add(&bar[XB_XCNT(b.x)], 1u);
    return b;
}
__device__ __forceinline__ void xcd_barrier_complete(unsigned* bar, unsigned x, unsigned& nloc, unsigned& nx) {
    const unsigned G = gridDim.x * gridDim.y * gridDim.z;
    unsigned sum, cnt, mine, sp = 0u;
    for (;;) {
        sum = 0u; cnt = 0u; mine = 0u;
#pragma unroll
        for (unsigned j = 0; j < 16; ++j) { const unsigned c = xb_ld(&bar[XB_XCNT(j)]); sum += c; cnt += (c > 0u) ? 1u : 0u; mine = (j == x) ? c : mine; }
        if (sum == G) break;
        __builtin_amdgcn_s_sleep(1);
        if ((++sp & 255u) == 0u) { if (xb_ld(&bar[XB_TMO])) break; if (sp > XB_SPIN_CAP) { atomicAdd(&bar[XB_TMO], 1u); break; } }
    }
    nloc = mine > 0u ? mine : 1u; nx = cnt > 0u ? cnt : 1u;
}

__device__ __forceinline__ void xcd_barrier(const XcdBarrier& b) {
    asm volatile("s_waitcnt vmcnt(0)" ::: "memory");
    __syncthreads();
    if (threadIdx.x == 0) {
        unsigned* bar = b.bar;
        __builtin_amdgcn_s_waitcnt(0);
        unsigned nloc = b.st[0], nx = b.st[1];
        if (nloc == 0u) { xcd_barrier_complete(bar, b.x, nloc, nx); b.st[0] = nloc; b.st[1] = nx; }
        const unsigned old = xb_add(&bar[XB_XSUB(b.x)], 1u);
        const unsigned gen = old / nloc;
        if (old + 1u == (gen + 1u) * nloc) {
            __builtin_amdgcn_fence(__ATOMIC_RELEASE, "agent");
            asm volatile("s_waitcnt vmcnt(0)" ::: "memory");
            const unsigned og = xb_add(&bar[XB_TOP], 1u);
            const unsigned tg = og / nx;
            if (og + 1u == (tg + 1u) * nx) xb_add(&bar[XB_TOPGEN], 1u);
            else XB_SPIN(xb_ld(&bar[XB_TOPGEN]) == tg, bar);
            __builtin_amdgcn_fence(__ATOMIC_ACQUIRE, "agent");
            xb_add(&bar[XB_XGEN(b.x)], 1u);
            asm volatile("s_waitcnt vmcnt(0)" ::: "memory");
        } else {
            XB_SPIN(xb_ld(&bar[XB_XGEN(b.x)]) == gen, bar);
            __builtin_amdgcn_fence(__ATOMIC_ACQUIRE, "agent");
            asm volatile("s_waitcnt vmcnt(0)" ::: "memory");
        }
    }
    __syncthreads();
}

constexpr size_t MiB = 1u << 20;
constexpr size_t WS_CTL = 0, CTL_ZERO_BYTES = 192 * 1024;
constexpr size_t WS_SUMSQ = 128 * 1024;
constexpr int CW_BAR = 1024;
constexpr size_t WS_WIN = 1 * MiB;
constexpr size_t WS_WA = 14 * MiB;
constexpr size_t WS_WB = 16 * MiB;
constexpr size_t WS_WO = 17 * MiB;
constexpr size_t WS_WQ = 19 * MiB;
constexpr size_t WS_SKB = 23 * MiB;
constexpr size_t WS_ROPE = 24 * MiB;
constexpr size_t WS_BIAS = 25 * MiB;
constexpr size_t WS_KM = 25 * MiB + 256 * 1024;
constexpr size_t WS_PREV = 26 * MiB;
constexpr size_t WS_ACT = 42 * MiB;
constexpr size_t WS_RQ = WS_ACT, WS_RK = WS_RQ + 16 * MiB, WS_RV = WS_RK + 16 * MiB, WS_RG = WS_RV + 32 * MiB;
constexpr size_t WS_MQ = WS_RG + 32 * MiB, WS_MK = WS_MQ + 16 * MiB, WS_MV = WS_MK + 16 * MiB;
constexpr size_t WS_GA = WS_MV + 16 * MiB, WS_GB = WS_GA + 32 * MiB;
constexpr size_t WS_END = 256 * MiB;
constexpr size_t WS_YB = WS_ACT;
constexpr size_t WS_MRG = WS_ACT + 32 * MiB;
constexpr size_t WS_H2 = WS_ACT + 64 * MiB;
constexpr size_t WS_EG = WS_ACT + 96 * MiB;
constexpr size_t WS_QP = WS_ACT;
constexpr size_t WS_UV = WS_ACT;
constexpr size_t WS_UV8 = WS_ACT + 112 * MiB;
constexpr size_t WS_ST = WS_ACT + 144 * MiB;
static_assert(WS_GB + 32 * MiB <= WS_END && WS_EG + 16 * MiB <= WS_ST && WS_ST + 64 * MiB <= WS_END, "d_ws map");

constexpr int LDS_BYTES = 159 * 1024;
constexpr int MISC_OFF = LDS_BYTES - 256;
constexpr int NWAVES = 8;


using pg8::Unit;
__device__ __forceinline__ void store8_bf16(bf16* p, f32x4 a, f32x4 b) { v4u w; w.x = pk2(a[0], a[1]); w.y = pk2(a[2], a[3]); w.z = pk2(b[0], b[1]); w.w = pk2(b[2], b[3]); *(v4u*)p = w; }
__device__ __forceinline__ void load8_bf16(const bf16* p, f32x4& a, f32x4& b) { const v4u w = *(const v4u*)p; a = (f32x4){bflo(w.x), bfhi(w.x), bflo(w.y), bfhi(w.y)}; b = (f32x4){bflo(w.z), bfhi(w.z), bflo(w.w), bfhi(w.w)}; }
__device__ __forceinline__ float sigmoidf_(float x) { return __builtin_amdgcn_rcpf(1.0f + __builtin_amdgcn_exp2f(-1.4426950408889634f * x)); }
__device__ __forceinline__ f32x4 sig4(f32x4 v) { return (f32x4){sigmoidf_(v[0]), sigmoidf_(v[1]), sigmoidf_(v[2]), sigmoidf_(v[3])}; }
__device__ __forceinline__ f32x4 silu4(f32x4 v) { return v * sig4(v); }

#ifdef MOBA_NAIVE
constexpr float MOBA_QSCALE = 0.125f;
#else
constexpr float MOBA_QSCALE = 0.125f * 1.4426950408889634f;
#endif
struct EpiInProj {
    static constexpr bool AFTER_DRAIN = false;
    bf16 *RQ, *RK, *RV, *RG, *MQ, *MK, *MV, *GA, *GB; const float* rope; const float* qgain; const float* kgain; float* KMP;
    __device__ __forceinline__ void operator()(const f32x4 (&acc)[2][2][4][2], const Unit& u, int wr, int wc, int fr, int fq) const {
        const int pn = u.pn, rowb = u.pm * 256 + wr * 64 + fr, cw = 64 * wc + 8 * fq;
        if (pn < 4) {
            bf16* dst = (pn < 2 ? RQ : RK) + (pn & 1) * 256 + cw; const float sc = pn < 2 ? 1.0f : 0.125f;
#pragma unroll
            for (int ai = 0; ai < 2; ++ai)
#pragma unroll
                for (int m = 0; m < 4; ++m) {
                    const int row = rowb + ai * 128 + m * 16; const float* rp = rope + (size_t)(row & (SEQ - 1)) * 64 + 8 * fq;
                    const f32x4 c0 = *(const f32x4*)rp * sc, c1 = *(const f32x4*)(rp + 4) * sc, s0 = *(const f32x4*)(rp + 32) * sc, s1 = *(const f32x4*)(rp + 36) * sc;
                    const f32x4 x10 = acc[ai][0][m][0], x11 = acc[ai][0][m][1], x20 = acc[ai][1][m][0], x21 = acc[ai][1][m][1];
                    bf16* p = dst + (size_t)row * 512;
                    store8_bf16(p, x10 * c0 - x20 * s0, x11 * c1 - x21 * s1);
                    store8_bf16(p + 32, x10 * s0 + x20 * c0, x11 * s1 + x21 * c1);
                }
        } else if (pn < 12 || (pn >= 16)) {
            bf16* dst; int ld, mode;
            if (pn < 8) { dst = RV + (pn - 4) * 256; ld = 1024; mode = 0; }
            else if (pn < 12) { dst = RG + (pn - 8) * 256; ld = 1024; mode = 1; }
            else if (pn < 18) { dst = MV + (pn - 16) * 256; ld = 512; mode = 0; }
            else if (pn < 22) { dst = GA + (pn - 18) * 256; ld = 1024; mode = 2; }
            else { dst = GB + (pn - 22) * 256; ld = 1024; mode = 2; }
            dst += cw;
#pragma unroll
            for (int ai = 0; ai < 2; ++ai)
#pragma unroll
                for (int m = 0; m < 4; ++m) {
                    const int row = rowb + ai * 128 + m * 16; bf16* p = dst + (size_t)row * ld;
#pragma unroll
                    for (int bj = 0; bj < 2; ++bj) {
                        f32x4 a = acc[ai][bj][m][0], b = acc[ai][bj][m][1];
                        if (mode == 1) { a = silu4(a); b = silu4(b); } else if (mode == 2) { a = sig4(a); b = sig4(b); }
                        store8_bf16(p + 32 * bj, a, b);
                    }
                }
        } else {
            const bool isq = pn < 14; bf16* dst = (isq ? MQ : MK) + (pn & 1) * 256 + cw; const float* gain = (isq ? qgain : kgain) + 8 * fq; const float sc = isq ? MOBA_QSCALE : 1.0f;
            f32x4 cs00 = {0.f, 0.f, 0.f, 0.f}, cs01 = cs00, cs10 = cs00, cs11 = cs00;
            const f32x4 g00 = *(const f32x4*)gain * sc, g01 = *(const f32x4*)(gain + 4) * sc, g10 = *(const f32x4*)(gain + 32) * sc, g11 = *(const f32x4*)(gain + 36) * sc;
#pragma unroll
            for (int ai = 0; ai < 2; ++ai)
#pragma unroll
                for (int m = 0; m < 4; ++m) {
                    const int row = rowb + ai * 128 + m * 16; bf16* p = dst + (size_t)row * 512;
                    const f32x4 a0 = acc[ai][0][m][0], a1 = acc[ai][0][m][1], b0 = acc[ai][1][m][0], b1 = acc[ai][1][m][1];
                    const f32x4 q = a0 * a0 + a1 * a1 + b0 * b0 + b1 * b1; float ss = (q[0] + q[1]) + (q[2] + q[3]);
                    ss += __shfl_xor(ss, 16); ss += __shfl_xor(ss, 32);
                    const float r = rsqrtf(ss * (1.0f / 64.0f) + EPS);
                    const f32x4 y00 = a0 * r * g00, y01 = a1 * r * g01, y10 = b0 * r * g10, y11 = b1 * r * g11;
                    store8_bf16(p, y00, y01);
                    store8_bf16(p + 32, y10, y11);
                    if (!isq) { cs00 += y00; cs01 += y01; cs10 += y10; cs11 += y11; }
                }
            if (!isq) {
#pragma unroll
                for (int e = 0; e < 4; ++e) {
#pragma unroll
                    for (int o = 1; o < 16; o <<= 1) { cs00[e] += __shfl_xor(cs00[e], o); cs01[e] += __shfl_xor(cs01[e], o); cs10[e] += __shfl_xor(cs10[e], o); cs11[e] += __shfl_xor(cs11[e], o); }
                }
                if (fr == 0) { float* kp = KMP + (((size_t)u.pm * 2 + (pn & 1)) * 2 + wr) * 256 + cw;
                    *(f32x4*)kp = cs00; *(f32x4*)(kp + 4) = cs01; *(f32x4*)(kp + 32) = cs10; *(f32x4*)(kp + 36) = cs11; }
            }
        }
    }
};
struct EpiMerge2 {
    static constexpr bool AFTER_DRAIN = false;
    bf16* O; const bf16* GA; const bf16* GB;
    __device__ __forceinline__ void mid(f32x4 (&acc)[2][2][4][2], const Unit& u, int wr, int wc, int fr, int fq) const {
        const int rowb = u.pm * 256 + wr * 64 + fr, col = u.pn * 256 + 64 * wc + 8 * fq;
#pragma unroll
        for (int ai = 0; ai < 2; ++ai)
#pragma unroll
            for (int m = 0; m < 4; ++m) {
                const size_t off = (size_t)(rowb + ai * 128 + m * 16) * 1024 + col;
#pragma unroll
                for (int bj = 0; bj < 2; ++bj) { f32x4 a0, a1, b0, b1; load8_bf16(GA + off + 32 * bj, a0, a1); load8_bf16(GB + off + 32 * bj, b0, b1);
#pragma unroll
                    for (int e = 0; e < 4; ++e) { acc[ai][bj][m][0][e] *= b0[e] * __builtin_amdgcn_rcpf(fmaxf(a0[e], 1e-6f)); acc[ai][bj][m][1][e] *= b1[e] * __builtin_amdgcn_rcpf(fmaxf(a1[e], 1e-6f)); } }
            }
    }
    __device__ __forceinline__ void operator()(const f32x4 (&acc)[2][2][4][2], const Unit& u, int wr, int wc, int fr, int fq) const {
        const int rowb = u.pm * 256 + wr * 64 + fr, col = u.pn * 256 + 64 * wc + 8 * fq;
#pragma unroll
        for (int ai = 0; ai < 2; ++ai)
#pragma unroll
            for (int m = 0; m < 4; ++m) {
                const size_t off = (size_t)(rowb + ai * 128 + m * 16) * 1024 + col;
#pragma unroll
                for (int bj = 0; bj < 2; ++bj) { f32x4 a0, a1; load8_bf16(GA + off + 32 * bj, a0, a1);
#pragma unroll
                    for (int e = 0; e < 4; ++e) { a0[e] = fmaxf(a0[e], 1e-6f); a1[e] = fmaxf(a1[e], 1e-6f); }
                    store8_bf16(O + off + 32 * bj, acc[ai][bj][m][0] * a0, acc[ai][bj][m][1] * a1); }
            }
    }
};
struct TwoSegOrder {
    pg8::StaticOrder B;
    __device__ __forceinline__ bool next(int i, pg8::Unit& u) const { if (!B.next(i >> 1, u)) return false; u.seg = i & 1; return true; }
    __device__ __forceinline__ void a_ready(const pg8::Unit&) const {}
    __device__ __forceinline__ void done(const pg8::Unit&) const {}
};
struct EpiResid {
    static constexpr bool AFTER_DRAIN = false;
    const float* base; float* out; bf16* XG; const float* g2; float* SS;
    __device__ __forceinline__ void operator()(const f32x4 (&acc)[2][2][4][2], const Unit& u, int wr, int wc, int fr, int fq) const {
        const int rowb = u.pm * 256 + wr * 64 + fr, col = u.pn * 256 + 64 * wc + 8 * fq;
        const f32x4 g00 = *(const f32x4*)(g2 + col), g01 = *(const f32x4*)(g2 + col + 4), g10 = *(const f32x4*)(g2 + col + 32), g11 = *(const f32x4*)(g2 + col + 36);
#pragma unroll
        for (int ai = 0; ai < 2; ++ai)
#pragma unroll
            for (int m = 0; m < 4; ++m) {
                const int row = rowb + ai * 128 + m * 16; const size_t off = (size_t)row * 1024 + col;
                const f32x4 x00 = *(const f32x4*)(base + off) + acc[ai][0][m][0], x01 = *(const f32x4*)(base + off + 4) + acc[ai][0][m][1];
                const f32x4 x10 = *(const f32x4*)(base + off + 32) + acc[ai][1][m][0], x11 = *(const f32x4*)(base + off + 36) + acc[ai][1][m][1];
                *(f32x4*)(out + off) = x00; *(f32x4*)(out + off + 4) = x01; *(f32x4*)(out + off + 32) = x10; *(f32x4*)(out + off + 36) = x11;
                store8_bf16(XG + off, x00 * g00, x01 * g01); store8_bf16(XG + off + 32, x10 * g10, x11 * g11);
                const f32x4 q = x00 * x00 + x01 * x01 + x10 * x10 + x11 * x11; float ss = (q[0] + q[1]) + (q[2] + q[3]);
                ss += __shfl_xor(ss, 16); ss += __shfl_xor(ss, 32);
                if (fq == 0) atomicAdd(SS + row, ss);
            }
    }
};
struct EpiPlainBf16 {
    static constexpr bool AFTER_DRAIN = false;
    bf16* O; int ldc;
    __device__ __forceinline__ void operator()(const f32x4 (&acc)[2][2][4][2], const Unit& u, int wr, int wc, int fr, int fq) const {
        const int rowb = u.pm * 256 + wr * 64 + fr, col = u.pn * 256 + 64 * wc + 8 * fq;
#pragma unroll
        for (int ai = 0; ai < 2; ++ai)
#pragma unroll
            for (int m = 0; m < 4; ++m) {
                const size_t off = (size_t)(rowb + ai * 128 + m * 16) * ldc + col;
#pragma unroll
                for (int bj = 0; bj < 2; ++bj) store8_bf16(O + off + 32 * bj, acc[ai][bj][m][0], acc[ai][bj][m][1]);
            }
    }
};
struct EpiNatBf16 {
    static constexpr bool AFTER_DRAIN = false;
    bf16* O; int ldc; const float* SS;
    __device__ __forceinline__ void operator()(const f32x4 (&acc)[2][2][4][2], const Unit& u, int wr, int wc, int fr, int fq) const {
        const int rowb = u.pm * 256 + wr * 64 + fr, col = u.pn * 256 + 32 * wc + 4 * fq;
        f32x4 rs[2][2];
#pragma unroll
        for (int bj = 0; bj < 2; ++bj)
#pragma unroll
            for (int n = 0; n < 2; ++n) { const f32x4 s = *(const f32x4*)(SS + col + 128 * bj + 16 * n); rs[bj][n] = (f32x4){rsqrtf(s[0] * (1.0f / DM) + EPS), rsqrtf(s[1] * (1.0f / DM) + EPS), rsqrtf(s[2] * (1.0f / DM) + EPS), rsqrtf(s[3] * (1.0f / DM) + EPS)}; }
#pragma unroll
        for (int ai = 0; ai < 2; ++ai)
#pragma unroll
            for (int m = 0; m < 4; ++m) {
                const size_t off = (size_t)(rowb + ai * 128 + m * 16) * ldc + col;
#pragma unroll
                for (int bj = 0; bj < 2; ++bj)
#pragma unroll
                    for (int n = 0; n < 2; ++n) { const f32x4 v = acc[ai][bj][m][n] * rs[bj][n]; v2u w; w.x = pk2(v[0], v[1]); w.y = pk2(v[2], v[3]); *(v2u*)(O + off + 128 * bj + 16 * n) = w; }
            }
    }
};

struct Frame {
    LAS unsigned char* lds;
    volatile LAS unsigned* MISC;
    gu32* ctl;
    int tid, lane, wave, G, bid;
};

__device__ __forceinline__ void p0_transpose_item(const float* W, int K, int N, bf16* WT, LAS float* scr, int item, int lane) {
    const int nblk = N / 32, kb = item / nblk, nb = item % nblk, k0 = 64 * kb, n0 = 32 * nb;
#pragma unroll 8
    for (int i = 0; i < 32; ++i) { const int kk = 2 * i + (lane >> 5); scr[kk * 33 + (lane & 31)] = W[(size_t)(k0 + kk) * N + n0 + (lane & 31)]; }
    LDS_WAIT(); asm volatile("" ::: "memory");
    const int c = lane & 7;
#pragma unroll
    for (int j = 0; j < 4; ++j) { const int n = (lane >> 3) + 8 * j; const LAS float* s = scr + (8 * c) * 33 + n;
        v4u o; o.x = pk2(s[0 * 33], s[1 * 33]); o.y = pk2(s[2 * 33], s[3 * 33]); o.z = pk2(s[4 * 33], s[5 * 33]); o.w = pk2(s[6 * 33], s[7 * 33]);
        *(GAS v4u*)(WT + (size_t)perm_row_of_col(n0 + n) * K + k0 + 8 * c) = o; }
    LDS_WAIT(); asm volatile("" ::: "memory");
}
__device__ __forceinline__ void rms_row_to_bf16(const float* xrow, const float* g, bf16* orow, int lane) {
    const GAS f32x4* xr = (const GAS f32x4*)xrow + lane; const GAS f32x4* gr = (const GAS f32x4*)g + lane;
    f32x4 v[4]; float s = 0.f;
#pragma unroll
    for (int j = 0; j < 4; ++j) { v[j] = __builtin_nontemporal_load(&xr[64 * j]); s += (v[j].x * v[j].x + v[j].y * v[j].y) + (v[j].z * v[j].z + v[j].w * v[j].w); }
    const float r = rsqrtf(wave_sum(s) * (1.0f / DM) + EPS);
    GAS v2u* o8 = (GAS v2u*)orow + lane;
#pragma unroll
    for (int j = 0; j < 4; ++j) { const f32x4 gg = gr[64 * j]; v2u w; w.x = pk2(v[j].x * r * gg.x, v[j].y * r * gg.y); w.y = pk2(v[j].z * r * gg.z, v[j].w * r * gg.w); o8[64 * j] = w; }
}
__device__ __forceinline__ float t5_bias_of_dist(const float* rel_bias, int h, int dist) {
    int bkt;
    if (dist < 16) bkt = dist;
    else { const float nf = (float)dist; int lg = 16 + (int)(logf(nf / 16.0f) / 4.852030263919617f * 16.0f); bkt = lg < 31 ? lg : 31; }
    return rel_bias[bkt * MH + h];
}

struct Ptrs {
    const float *x, *mix_g, *w_in, *ret_w, *q_gain, *k_gain, *moba_w, *rel_bias, *w_out, *ffn_g, *peer_wq, *sub_keys, *peer_u, *peer_v;
    float* out; unsigned char* ws;
};

__device__ __forceinline__ void p0_prologue(Frame& F, const Ptrs& P) {
    LAS float* scr = (LAS float*)(F.lds + F.wave * 16384);
    const int gw = F.bid * NWAVES + F.wave, NGW = F.G * NWAVES;
    unsigned char* ws = P.ws;
    constexpr int I_IN = (DM / 64) * (INW / 32), I_A = (1024 / 64) * (1024 / 32), I_B = (512 / 64) * (1024 / 32), I_O = I_A, I_Q = (1024 / 64) * (2048 / 32);
    constexpr int NITEMS = I_IN + I_A + I_B + I_O; (void)I_Q;
    (void)NITEMS;
    for (int it = gw; it < I_IN; it += NGW) p0_transpose_item(P.w_in, DM, INW, (bf16*)(ws + WS_WIN), scr, it, F.lane);
    bf16* XN = (bf16*)P.out;
    for (int m = gw; m < T; m += NGW) rms_row_to_bf16(P.x + (size_t)m * DM, P.mix_g, XN + (size_t)m * DM, F.lane);
    const int gt = F.bid * 512 + F.tid, NGT = F.G * 512;
    float* rope = (float*)(ws + WS_ROPE);
    for (int i = gt; i < SEQ * 32; i += NGT) { const int pos = i >> 5, j = i & 31; const float inv = powf(10000.0f, -(float)j / 32.0f); const float ang = (float)pos * inv; float sn, cs; sincosf(ang, &sn, &cs);
        rope[pos * 64 + j] = cs; rope[pos * 64 + 32 + j] = sn; }
    float* BT = (float*)(ws + WS_BIAS);
    for (int i = gt; i < MH * SEQ; i += NGT) { const int h = i >> 12, dist = i & (SEQ - 1); BT[i] = t5_bias_of_dist(P.rel_bias, h, dist); }
}


__device__ __forceinline__ void p0b_late_weights(Frame& F, const Ptrs& P, int idx, int n) {
    LAS float* scr = (LAS float*)(F.lds + F.wave * 16384);
    const int gw = idx * NWAVES + F.wave, NGW = n * NWAVES;
    unsigned char* ws = P.ws;
    constexpr int I_A = (1024 / 64) * (1024 / 32), I_B = (512 / 64) * (1024 / 32), I_O = I_A;
    for (int it = gw; it < I_A + I_B + I_O; it += NGW) {
        int r = it;
        if (r < I_A) { p0_transpose_item(P.ret_w, 1024, 1024, (bf16*)(ws + WS_WA), scr, r, F.lane); continue; } r -= I_A;
        if (r < I_B) { p0_transpose_item(P.moba_w, 512, 1024, (bf16*)(ws + WS_WB), scr, r, F.lane); continue; } r -= I_B;
        p0_transpose_item(P.w_out, 1024, 1024, (bf16*)(ws + WS_WO), scr, r, F.lane);
    }
    { bf16* WST = (bf16*)(ws + WS_WQ);
      for (int wt = gw; wt < 16 * 4 * 32; wt += NGW) {
          const int blk = wt >> 7, nt = (wt >> 5) & 3, mt = wt & 31, r32 = F.lane & 31, hi = F.lane >> 5;
          const float* ap = P.sub_keys + ((size_t)blk * PNK + 32 * nt + r32) * 128 + 8 * hi;
          const float* bp = P.peer_wq + (size_t)(32 * mt + r32) * 2048 + blk * 128 + 8 * hi;
          f32x16 acc;
#pragma unroll
          for (int r = 0; r < 16; ++r) acc[r] = 0.f;
#pragma unroll
          for (int ds = 0; ds < 8; ++ds) {
              const f32x4 a0 = *(const f32x4*)(ap + 16 * ds), a1 = *(const f32x4*)(ap + 16 * ds + 4), b0 = *(const f32x4*)(bp + 16 * ds), b1 = *(const f32x4*)(bp + 16 * ds + 4);
              v4u aw, bw; aw.x = pk2(a0[0], a0[1]); aw.y = pk2(a0[2], a0[3]); aw.z = pk2(a1[0], a1[1]); aw.w = pk2(a1[2], a1[3]);
              bw.x = pk2(b0[0], b0[1]); bw.y = pk2(b0[2], b0[3]); bw.z = pk2(b1[0], b1[1]); bw.w = pk2(b1[2], b1[3]);
              acc = __builtin_amdgcn_mfma_f32_32x32x16_bf16(__builtin_bit_cast(bf16x8, aw), __builtin_bit_cast(bf16x8, bw), acc, 0, 0, 0);
          }
          bf16* op = WST + ((size_t)blk * 128 + 32 * nt) * DM + 32 * mt + r32;
#pragma unroll
          for (int r = 0; r < 16; ++r) op[(size_t)((r & 3) + 8 * (r >> 2) + 4 * hi) * DM] = (bf16)f2bf(acc[r]);
      } }
}
__device__ __forceinline__ void p2a_kv(Frame& F, const Ptrs& P) {
    unsigned char* ws = P.ws; const bf16* RK = (const bf16*)(ws + WS_RK); const bf16* RV = (const bf16*)(ws + WS_RV); const bf16* MK = (const bf16*)(ws + WS_MK);
    float* KVT = (float*)((unsigned char*)P.out + 32 * MiB); float* KM = (float*)(ws + WS_KM);
    LAS bf16* lK = (LAS bf16*)F.lds;
    LAS bf16* lV = (LAS bf16*)(F.lds + 16384);
    const int tid = F.tid;
    for (int task = F.bid; task < BATCH * RH * NCH; task += F.G) {
        const int b = task >> 8, h = (task >> 5) & 7, n = task & 31; const size_t row0 = (size_t)b * SEQ + n * RC; const float l2g = ret_l2g(h);
#pragma unroll
        for (int j = 0; j < 2; ++j) { const int idx = tid + 512 * j, c = idx >> 3, part = idx & 7; *(LAS v4u*)(lK + c * 64 + part * 8) = *(const v4u*)(RK + (row0 + c) * 512 + h * 64 + part * 8); }
#pragma unroll
        for (int j = 0; j < 4; ++j) { const int idx = tid + 512 * j, c = idx >> 4, part = idx & 15; *(LAS v4u*)(lV + c * 128 + part * 8) = *(const v4u*)(RV + (row0 + c) * 1024 + h * 128 + part * 8); }
        __syncthreads();
        const int dk = tid & 63, dv0 = (tid >> 6) * 16;
        float acc[16];
#pragma unroll
        for (int e = 0; e < 16; ++e) acc[e] = 0.f;
        for (int c = 0; c < RC; ++c) {
            const float kd = bf2f(lK[c * 64 + dk]) * exp2f((float)(RC - 1 - c) * l2g);
            const v4u v0 = *(LAS v4u*)(lV + c * 128 + dv0), v1 = *(LAS v4u*)(lV + c * 128 + dv0 + 8);
            acc[0] += kd * bflo(v0.x); acc[1] += kd * bfhi(v0.x); acc[2] += kd * bflo(v0.y); acc[3] += kd * bfhi(v0.y);
            acc[4] += kd * bflo(v0.z); acc[5] += kd * bfhi(v0.z); acc[6] += kd * bflo(v0.w); acc[7] += kd * bfhi(v0.w);
            acc[8] += kd * bflo(v1.x); acc[9] += kd * bfhi(v1.x); acc[10] += kd * bflo(v1.y); acc[11] += kd * bfhi(v1.y);
            acc[12] += kd * bflo(v1.z); acc[13] += kd * bfhi(v1.z); acc[14] += kd * bflo(v1.w); acc[15] += kd * bfhi(v1.w);
        }
        float* o = KVT + (size_t)task * (RDV * RDK);
#pragma unroll
        for (int e = 0; e < 16; ++e) o[(dv0 + e) * 64 + dk] = acc[e];
        __syncthreads();
    }
    const int gw = F.bid * NWAVES + F.wave, NGW = F.G * NWAVES;
    for (int wt = gw; wt < BATCH * MH * NBLK; wt += NGW) {
        const int b = wt >> 7, h = (wt >> 4) & 7, blk = wt & 15; const bf16* p = MK + ((size_t)b * SEQ + blk * MBLK) * 512 + h * 64 + F.lane;
        float s = 0.f;
        for (int j = 0; j < MBLK; ++j) s += bf2f(p[(size_t)j * 512]);
        KM[wt * 64 + F.lane] = s * (1.0f / MBLK);
    }
}
__device__ __forceinline__ void p2b_scan(Frame& F, const Ptrs& P) {
    const float* KVT = (const float*)((unsigned char*)P.out + 32 * MiB); bf16* PREV = (bf16*)(P.ws + WS_PREV);
    const int gt = F.bid * 512 + F.tid, NGT = F.G * 512;
    for (int e = gt; e < BATCH * RH * RDV * RDK; e += NGT) {
        const int bh = e >> 13, el = e & 8191, h = bh & 7; const float dC = exp2f((float)RC * ret_l2g(h));
        float S = 0.f; const size_t base = (size_t)bh * NCH * 8192 + el;
        for (int n = 0; n < NCH; ++n) { PREV[base + (size_t)n * 8192] = (bf16)f2bf(S); S = S * dC + KVT[base + (size_t)n * 8192]; }
    }
}
__device__ __forceinline__ void p3a_retention(Frame& F, const Ptrs& P) {
    unsigned char* ws = P.ws; const bf16* RQ = (const bf16*)(ws + WS_RQ); const bf16* RK = (const bf16*)(ws + WS_RK); const bf16* RV = (const bf16*)(ws + WS_RV);
    const bf16* RG = (const bf16*)(ws + WS_RG); const bf16* PREV = (const bf16*)(ws + WS_PREV); bf16* RETG = (bf16*)P.out;
    LAS bf16* lQ = (LAS bf16*)F.lds;
    LAS bf16* lK = (LAS bf16*)(F.lds + 16384);
    LAS bf16* lV = (LAS bf16*)(F.lds + 16384 + 16896);
    LAS bf16* lP = (LAS bf16*)(F.lds + 16384 + 16896 + 32768);
    LAS float* lS = (LAS float*)(F.lds + 16384 + 16896 + 32768 + 16896);
    const int tid = F.tid, lane = F.lane, wave = F.wave;
    for (int task = F.bid; task < BATCH * RH * NCH; task += F.G) {
        const int b = task >> 8, h = (task >> 5) & 7, n = task & 31; const size_t row0 = (size_t)b * SEQ + n * RC; const float l2g = ret_l2g(h);
#pragma unroll
        for (int j = 0; j < 2; ++j) { const int idx = tid + 512 * j, c = idx >> 3, part = idx & 7; *(LAS v4u*)(lQ + c * 64 + part * 8) = *(const v4u*)(RQ + (row0 + c) * 512 + h * 64 + part * 8); }
#pragma unroll
        for (int j = 0; j < 8; ++j) { const int idx = tid + 512 * j, c = idx >> 5, w = idx & 31; *(LAS unsigned*)(lK + c * 66 + w * 2) = *(const unsigned*)(RK + (row0 + c) * 512 + h * 64 + w * 2); }
#pragma unroll
        for (int j = 0; j < 4; ++j) { const int idx = tid + 512 * j, c = idx >> 4, part = idx & 15; *(LAS v4u*)(lV + c * 128 + part * 8) = *(const v4u*)(RV + (row0 + c) * 1024 + h * 128 + part * 8); }
#pragma unroll
        for (int j = 0; j < 8; ++j) { const int idx = tid + 512 * j, dv = idx >> 5, w = idx & 31; *(LAS unsigned*)(lP + dv * 66 + w * 2) = *(const unsigned*)(PREV + (size_t)task * 8192 + dv * 64 + w * 2); }
        __syncthreads();
        for (int t = 0; t < 32; ++t) {
            const int e = tid + 512 * t, i = e >> 7, j = e & 127;
            float s = 0.f;
            if (j <= i) {
                float d = 0.f;
#pragma unroll
                for (int w = 0; w < 32; ++w) { const unsigned qa = *(LAS unsigned*)(lQ + i * 64 + 2 * w), ka = *(LAS unsigned*)(lK + j * 66 + 2 * w); d += bflo(qa) * bflo(ka) + bfhi(qa) * bfhi(ka); }
                s = d * exp2f((float)(i - j) * l2g);
            }
            lS[i * 128 + j] = s;
        }
        __syncthreads();
        for (int r = 0; r < 16; ++r) {
            const int i = wave * 16 + r;
            float a0 = 0.f, a1 = 0.f;
            for (int j = 0; j <= i; ++j) { const float sv = lS[i * 128 + j]; a0 += sv * bf2f(lV[j * 128 + lane]); a1 += sv * bf2f(lV[j * 128 + lane + 64]); }
            float c0 = 0.f, c1 = 0.f;
#pragma unroll 8
            for (int w = 0; w < 32; ++w) { const unsigned qa = *(LAS unsigned*)(lQ + i * 64 + 2 * w), p0 = *(LAS unsigned*)(lP + lane * 66 + 2 * w), p1 = *(LAS unsigned*)(lP + (lane + 64) * 66 + 2 * w);
                c0 += bflo(qa) * bflo(p0) + bfhi(qa) * bfhi(p0); c1 += bflo(qa) * bflo(p1) + bfhi(qa) * bfhi(p1); }
            const float qd = exp2f((float)(i + 1) * l2g);
            const float o0 = a0 + c0 * qd, o1 = a1 + c1 * qd;
            const float mu = wave_sum(o0 + o1) * (1.0f / RDV); const float d0 = o0 - mu, d1 = o1 - mu;
            const float var = wave_sum(d0 * d0 + d1 * d1) * (1.0f / RDV); const float rs = rsqrtf(var + EPS);
            const size_t off = (row0 + i) * 1024 + h * 128 + lane;
            RETG[off] = (bf16)f2bf(d0 * rs * bf2f(RG[off])); RETG[off + 64] = (bf16)f2bf(d1 * rs * bf2f(RG[off + 64]));
        }
        __syncthreads();
    }
}
__device__ __forceinline__ void p3b_moba(Frame& F, const Ptrs& P) {
    unsigned char* ws = P.ws; const bf16* MQ = (const bf16*)(ws + WS_MQ); const bf16* MK = (const bf16*)(ws + WS_MK); const bf16* MV = (const bf16*)(ws + WS_MV);
    const float* KM = (const float*)(ws + WS_KM); const float* BT = (const float*)(ws + WS_BIAS); bf16* ATT = (bf16*)((unsigned char*)P.out + 32 * MiB);
    LAS float* lB = (LAS float*)F.lds;
    LAS bf16* lK = (LAS bf16*)(F.lds + 16384);
    LAS bf16* lV = (LAS bf16*)(F.lds + 16384 + 32768);
    LAS float* lKM = (LAS float*)(F.lds + 16384 + 65536);
    const int tid = F.tid, ql = tid >> 2, sub = tid & 3;
    for (int unit = F.bid; unit < BATCH * MH * 32; unit += F.G) {
        const int qh = 31 - (unit >> 5), bh = unit & 31, b = bh >> 3, h = bh & 7;
        const int qpos = qh * 128 + ql, qb = qh >> 1;
        for (int i = tid; i < SEQ; i += 512) lB[i] = BT[h * SEQ + i];
        float qf[64];
        { const bf16* qp = MQ + ((size_t)b * SEQ + qpos) * 512 + h * 64;
#pragma unroll
          for (int w = 0; w < 8; ++w) { const v4u x = *(const v4u*)(qp + 8 * w); qf[8 * w] = bflo(x.x); qf[8 * w + 1] = bfhi(x.x); qf[8 * w + 2] = bflo(x.y); qf[8 * w + 3] = bfhi(x.y);
              qf[8 * w + 4] = bflo(x.z); qf[8 * w + 5] = bfhi(x.z); qf[8 * w + 6] = bflo(x.w); qf[8 * w + 7] = bfhi(x.w); } }
        for (int i = tid; i < qb * 64; i += 512) lKM[i] = KM[(size_t)bh * NBLK * 64 + i];
        __syncthreads();
        unsigned mask;
        if (qb <= 3) mask = (1u << qb) - 1u;
        else {
            float g1 = -3e38f, g2 = -3e38f, g3 = -3e38f; int i1 = 0, i2 = 0, i3 = 0;
            for (int kb = 0; kb < qb; ++kb) {
                const LAS float* km = lKM + kb * 64; float g = 0.f;
#pragma unroll
                for (int d = 0; d < 64; ++d) g += qf[d] * km[d];
                if (g > g1) { g3 = g2; i3 = i2; g2 = g1; i2 = i1; g1 = g; i1 = kb; }
                else if (g > g2) { g3 = g2; i3 = i2; g2 = g; i2 = kb; }
                else if (g > g3) { g3 = g; i3 = kb; }
            }
            mask = (1u << i1) | (1u << i2) | (1u << i3);
        }
        float m = -1e30f, l = 0.f, o[64];
#pragma unroll
        for (int d = 0; d < 64; ++d) o[d] = 0.f;
        for (int kb = 0; kb <= qb; ++kb) {
            __syncthreads();
            const size_t krow0 = (size_t)b * SEQ + kb * MBLK;
#pragma unroll
            for (int j = 0; j < 4; ++j) { const int idx = tid + 512 * j, r = idx >> 3, part = idx & 7;
                *(LAS v4u*)(lK + r * 64 + part * 8) = *(const v4u*)(MK + (krow0 + r) * 512 + h * 64 + part * 8);
                *(LAS v4u*)(lV + r * 64 + part * 8) = *(const v4u*)(MV + (krow0 + r) * 512 + h * 64 + part * 8); }
            __syncthreads();
            const bool act = (kb == qb) || ((mask >> kb) & 1u);
            if (act) {
                for (int jj = 0; jj < 64; ++jj) {
                    const int j = jj * 4 + sub, kpos = kb * MBLK + j;
                    if (kpos > qpos) continue;
                    float dot = 0.f;
#pragma unroll
                    for (int w = 0; w < 8; ++w) { const v4u x = *(LAS v4u*)(lK + j * 64 + 8 * w);
                        dot += qf[8 * w] * bflo(x.x) + qf[8 * w + 1] * bfhi(x.x) + qf[8 * w + 2] * bflo(x.y) + qf[8 * w + 3] * bfhi(x.y)
                             + qf[8 * w + 4] * bflo(x.z) + qf[8 * w + 5] * bfhi(x.z) + qf[8 * w + 6] * bflo(x.w) + qf[8 * w + 7] * bfhi(x.w); }
                    const float logit = dot + lB[qpos - kpos];
                    const float mn = fmaxf(m, logit), sc = __expf(m - mn), p = __expf(logit - mn);
                    l = l * sc + p; m = mn;
#pragma unroll
                    for (int w = 0; w < 8; ++w) { const v4u x = *(LAS v4u*)(lV + j * 64 + 8 * w);
                        o[8 * w] = o[8 * w] * sc + p * bflo(x.x); o[8 * w + 1] = o[8 * w + 1] * sc + p * bfhi(x.x); o[8 * w + 2] = o[8 * w + 2] * sc + p * bflo(x.y); o[8 * w + 3] = o[8 * w + 3] * sc + p * bfhi(x.y);
                        o[8 * w + 4] = o[8 * w + 4] * sc + p * bflo(x.z); o[8 * w + 5] = o[8 * w + 5] * sc + p * bfhi(x.z); o[8 * w + 6] = o[8 * w + 6] * sc + p * bflo(x.w); o[8 * w + 7] = o[8 * w + 7] * sc + p * bfhi(x.w); }
                }
            }
        }
        float mm = fmaxf(m, __shfl_xor(m, 1)); mm = fmaxf(mm, __shfl_xor(mm, 2));
        const float f = __expf(m - mm); l *= f; l += __shfl_xor(l, 1); l += __shfl_xor(l, 2);
        const float il = 1.0f / l;
#pragma unroll
        for (int d = 0; d < 64; ++d) { float v = o[d] * f; v += __shfl_xor(v, 1); v += __shfl_xor(v, 2); o[d] = v * il; }
        bf16* op = ATT + ((size_t)b * SEQ + qpos) * 512 + h * 64;
#pragma unroll
        for (int s4 = 0; s4 < 4; ++s4) if (sub == s4) {
            v4u w0, w1; w0.x = pk2(o[16 * s4], o[16 * s4 + 1]); w0.y = pk2(o[16 * s4 + 2], o[16 * s4 + 3]); w0.z = pk2(o[16 * s4 + 4], o[16 * s4 + 5]); w0.w = pk2(o[16 * s4 + 6], o[16 * s4 + 7]);
            w1.x = pk2(o[16 * s4 + 8], o[16 * s4 + 9]); w1.y = pk2(o[16 * s4 + 10], o[16 * s4 + 11]); w1.z = pk2(o[16 * s4 + 12], o[16 * s4 + 13]); w1.w = pk2(o[16 * s4 + 14], o[16 * s4 + 15]);
            *(v4u*)(op + 16 * s4) = w0; *(v4u*)(op + 16 * s4 + 8) = w1; }
        __syncthreads();
    }
}

typedef short s16x4 __attribute__((ext_vector_type(4)));
typedef short v4i16_t __attribute__((ext_vector_type(4)));
__device__ __forceinline__ s16x4 vtr_read(const LAS unsigned char* p) { return __builtin_bit_cast(s16x4, __builtin_amdgcn_ds_read_tr16_b64_v4i16((LAS v4i16_t*)p)); }
constexpr float LOG2E = 1.4426950408889634f;
constexpr float MOBA_NEG = -1.0e30f;

constexpr int MB_LB = 0, MB_LKM = 16640, MB_WSC = 20480, MB_K0 = 24576, MB_V0 = 24576 + 65536;
static_assert(MB_V0 + 65536 <= MISC_OFF, "MoBA LDS map");

template <int ABL> __device__ __forceinline__ void p3b_moba_mfma(Frame& F, const Ptrs& P) {
    unsigned char* ws = P.ws; const bf16* MQ = (const bf16*)(ws + WS_MQ); const bf16* MK = (const bf16*)(ws + WS_MK); const bf16* MV = (const bf16*)(ws + WS_MV);
    const float* KMP = (const float*)(ws + WS_KM); const float* BT = (const float*)(ws + WS_BIAS); bf16* ATT = (bf16*)((unsigned char*)P.out + (ABL ? 48 : 32) * MiB);
    LAS float* lB = (LAS float*)(F.lds + MB_LB);
    LAS float* lKM = (LAS float*)(F.lds + MB_LKM);
    LAS float* wsc = (LAS float*)(F.lds + MB_WSC) + F.wave * 64;
    const int tid = F.tid, lane = F.lane, wave = F.wave, r32 = lane & 31, hi = lane >> 5;
    for (int vcu0 = F.bid; vcu0 < 256; vcu0 += F.G) {
    const int vcu = (F.G == 256) ? (vcu0 & 7) * 32 + (vcu0 >> 3) : vcu0;
    const int bh = vcu >> 3, sidx = vcu & 7, b = bh >> 3, h = bh & 7;
    __syncthreads();
    for (int i = tid; i < SEQ + 64; i += 512) lB[i] = (i < 64) ? 0.f : BT[h * SEQ + (i - 64)] * LOG2E;
    float mbound;
    { float gq = fabsf(P.q_gain[lane]), gk = fabsf(P.k_gain[lane]), bb = lane < 32 ? P.rel_bias[lane * MH + h] : 0.f;
#pragma unroll
      for (int o = 1; o < 64; o <<= 1) { gq = fmaxf(gq, __shfl_xor(gq, o)); gk = fmaxf(gk, __shfl_xor(gk, o)); bb = fmaxf(bb, __shfl_xor(bb, o)); }
      mbound = (8.0f * gq * gk * 1.02f + bb) * LOG2E + 0.5f; }
    unsigned ksrc[4], vsrc[4];
#pragma unroll
    for (int j = 0; j < 4; ++j) { const int pc = wave * 4 + j, krow = 8 * pc + (lane >> 3); ksrc[j] = (unsigned)(krow * 512 + (((lane & 7) ^ (krow & 7)) * 8));
        const int vkey = 8 * pc + ((lane & 31) >> 2); vsrc[j] = (unsigned)(vkey * 512 + 32 * (lane >> 5) + 8 * (lane & 3)); }
#define MOBA_STAGE(kgp, vgp, kdst, vdst) do { _Pragma("unroll") for (int j = 0; j < 4; ++j) { \
        __builtin_amdgcn_global_load_lds((const unsigned*)((kgp) + ksrc[j]), (LAS unsigned*)(F.lds + (kdst) + (wave * 4 + j) * 1024), 16, 0, 0); \
        __builtin_amdgcn_global_load_lds((const unsigned*)((vgp) + vsrc[j]), (LAS unsigned*)(F.lds + (vdst) + (wave * 4 + j) * 1024), 16, 0, 0); } } while (0)
    const unsigned vbase = (unsigned)((4 * hi + ((lane & 15) >> 2)) * 64 + ((lane >> 4) & 1) * 32 + (lane & 3) * 8);
    for (int ui = 0; ui < 2; ++ui) {
        const int qb = ui == 0 ? 15 - sidx : sidx;
        const int nblk = qb + 1;
        __syncthreads();
        for (int i = tid; i < qb * 64; i += 512) { const int kb = i >> 6, dd = i & 63; const float* kp = KMP + (((size_t)(b * NBLK + kb) * 2 + (h >> 2)) * 2) * 256 + (h & 3) * 64 + dd; lKM[i] = (kp[0] + kp[256]) * (1.0f / MBLK); }
        const int qw0 = qb * MBLK + wave * 32, qpos = qw0 + r32;
        bf16x8 qf[4];
        { const bf16* qp = MQ + ((size_t)b * SEQ + qpos) * 512 + h * 64 + 8 * hi;
#pragma unroll
          for (int ds = 0; ds < 4; ++ds) qf[ds] = *(const bf16x8*)(qp + 16 * ds); }
        { const bf16* kg = MK + ((size_t)b * SEQ + (size_t)qb * MBLK) * 512 + h * 64; const bf16* vg = MV + ((size_t)b * SEQ + (size_t)qb * MBLK) * 512 + h * 64;
          MOBA_STAGE(kg, vg, MB_K0, MB_V0); }
        VM_WAIT(); __syncthreads();
        unsigned mask;
        if (qb <= 3) mask = (1u << qb) - 1u;
        else {
            float g1 = -3e38f, g2 = -3e38f, g3 = -3e38f; int i1 = 0, i2 = 0, i3 = 0;
            for (int kb = 0; kb < qb; ++kb) {
                float g = 0.f;
#pragma unroll
                for (int ds = 0; ds < 4; ++ds) { const LAS float* km = lKM + kb * 64 + 16 * ds + 8 * hi; const f32x4 k0 = *(const LAS f32x4*)km, k1 = *(const LAS f32x4*)(km + 4);
                    const v4u qx = __builtin_bit_cast(v4u, qf[ds]);
                    g += bflo(qx.x) * k0[0] + bfhi(qx.x) * k0[1] + bflo(qx.y) * k0[2] + bfhi(qx.y) * k0[3] + bflo(qx.z) * k1[0] + bfhi(qx.z) * k1[1] + bflo(qx.w) * k1[2] + bfhi(qx.w) * k1[3]; }
                g += __shfl_xor(g, 32);
                if (g > g1) { g3 = g2; i3 = i2; g2 = g1; i2 = i1; g1 = g; i1 = kb; }
                else if (g > g2) { g3 = g2; i3 = i2; g2 = g; i2 = kb; }
                else if (g > g3) { g3 = g; i3 = kb; }
            }
            mask = (1u << i1) | (1u << i2) | (1u << i3);
        }
        const float m = mbound; float l = 0.f; bool pending = false;
        f32x16 o0, o1; v4u ppa[4]; unsigned pvoff = MB_V0;
#pragma unroll
        for (int r = 0; r < 16; ++r) { o0[r] = 0.f; o1[r] = 0.f; }
#pragma unroll
        for (int q = 0; q < 4; ++q) ppa[q] = (v4u){0u, 0u, 0u, 0u};
#define MOBA_PV(pa_, voff_) do { const LAS unsigned char* vp_ = F.lds + (voff_) + vbase; \
        _Pragma("unroll") for (int ks = 0; ks < 4; ++ks) { const bf16x8 pav = __builtin_bit_cast(bf16x8, pa_[ks]); \
            _Pragma("unroll") for (int db = 0; db < 2; ++db) { const s16x4 lo = vtr_read(vp_ + ((2 * ks) * 2 + db) * 512), hh = vtr_read(vp_ + ((2 * ks + 1) * 2 + db) * 512); \
                const bf16x8 vf = (bf16x8){lo[0], lo[1], lo[2], lo[3], hh[0], hh[1], hh[2], hh[3]}; \
                if (db == 0) o0 = __builtin_amdgcn_mfma_f32_32x32x16_bf16(pav, vf, o0, 0, 0, 0); else o1 = __builtin_amdgcn_mfma_f32_32x32x16_bf16(pav, vf, o1, 0, 0, 0); } } } while (0)
        for (int bi = 0; bi < nblk; ++bi) {
            const int kb = bi == 0 ? qb : bi - 1;
            const unsigned kbuf = MB_K0 + (bi & 1) * 32768, vbuf = MB_V0 + (bi & 1) * 32768;
            const bool has_next = bi + 1 < nblk;
            if (has_next) { const int kn = bi;
                if (pending) { MOBA_PV(ppa, pvoff); pending = false;
#pragma unroll
                    for (int q = 0; q < 4; ++q) ppa[q] = (v4u){0u, 0u, 0u, 0u}; }
                const bf16* kg = MK + ((size_t)b * SEQ + (size_t)kn * MBLK) * 512 + h * 64; const bf16* vg = MV + ((size_t)b * SEQ + (size_t)kn * MBLK) * 512 + h * 64;
                MOBA_STAGE(kg, vg, MB_K0 + ((bi + 1) & 1) * 32768, MB_V0 + ((bi + 1) & 1) * 32768); }
            const bool own = bi == 0;
            const bool sel = own || ((mask >> kb) & 1u);
            if (!(ABL & 16) && __any(sel)) {
                float msub = sel ? m : 1.0e30f;
                f32x16 cneg;
#pragma unroll
                for (int r = 0; r < 16; ++r) cneg[r] = -msub;
                const int npair = own ? (wave >> 1) + 1 : 4;
#define MOBA_QK(jq_, dA_, dB_) do { const int keyA_ = 64 * (jq_) + r32, keyB_ = keyA_ + 32; const LAS unsigned char* kpA_ = F.lds + kbuf + keyA_ * 128; const LAS unsigned char* kpB_ = F.lds + kbuf + keyB_ * 128; \
        _Pragma("unroll") for (int ds = 0; ds < 4; ++ds) { const bf16x8 aA_ = *(const LAS bf16x8*)(kpA_ + (((2 * ds + hi) ^ (keyA_ & 7)) * 16)), aB_ = *(const LAS bf16x8*)(kpB_ + (((2 * ds + hi) ^ (keyB_ & 7)) * 16)); \
            if (!(ABL & 8)) { dA_ = __builtin_amdgcn_mfma_f32_32x32x16_bf16(aA_, qf[ds], ds == 0 ? cneg : dA_, 0, 0, 0); dB_ = __builtin_amdgcn_mfma_f32_32x32x16_bf16(aB_, qf[ds], ds == 0 ? cneg : dB_, 0, 0, 0); } else if (ds == 0) { dA_ = cneg; dB_ = cneg; } } } while (0)
                f32x16 sA, sB, nA, nB;
                MOBA_QK(0, sA, sB);
                for (int jp = 0; jp < npair; ++jp) {
                    const int k0 = kb * MBLK + 64 * jp, dmin = qw0 - k0 - 63, dmax = qw0 + 31 - k0;
                    bool uni = false; float bu = 0.f;
                    if (dmin >= 256) { const float b0 = lB[64 + dmin], b1 = lB[64 + dmax]; uni = (b0 == b1); bu = b0; }
                    if (ABL & 1) {} else if (uni) {
#pragma unroll
                        for (int r = 0; r < 16; ++r) { sA[r] += bu; sB[r] += bu; }
                    } else {
                        const LAS float* bp = lB + (64 + qpos - k0 - 4 * hi - 27 - 32);
#pragma unroll
                        for (int r = 0; r < 16; ++r) { sA[r] += bp[32 + 27 - ((r & 3) + 8 * (r >> 2))]; sB[r] += bp[27 - ((r & 3) + 8 * (r >> 2))]; }
                    }
                    if (own && 2 * jp + 1 >= wave) {
                        const int limA = 32 * wave + r32 - 64 * jp - 4 * hi, limB = limA - 32;
#pragma unroll
                        for (int r = 0; r < 16; ++r) { const int cr = (r & 3) + 8 * (r >> 2); if (cr > limA) sA[r] = MOBA_NEG; if (cr > limB) sB[r] = MOBA_NEG; }
                    }
                    {
                        const int jn = jp + 1 < npair ? jp + 1 : jp;
                        const int keyA_ = 64 * jn + r32, keyB_ = keyA_ + 32; const LAS unsigned char* kpA_ = F.lds + kbuf + keyA_ * 128; const LAS unsigned char* kpB_ = F.lds + kbuf + keyB_ * 128;
                        const LAS unsigned char* vp_ = F.lds + pvoff + vbase;
                        float ps = 0.f;
#pragma unroll
                        for (int i = 0; i < 4; ++i) {
                            if (!(ABL & 4)) { const bf16x8 pav = __builtin_bit_cast(bf16x8, ppa[i]);
#pragma unroll
                                for (int db = 0; db < 2; ++db) { const s16x4 lo = vtr_read(vp_ + ((2 * i) * 2 + db) * 512), hh = vtr_read(vp_ + ((2 * i + 1) * 2 + db) * 512);
                                    const bf16x8 vf = (bf16x8){lo[0], lo[1], lo[2], lo[3], hh[0], hh[1], hh[2], hh[3]};
                                    if (db == 0) o0 = __builtin_amdgcn_mfma_f32_32x32x16_bf16(pav, vf, o0, 0, 0, 0); else o1 = __builtin_amdgcn_mfma_f32_32x32x16_bf16(pav, vf, o1, 0, 0, 0); } }
                            { const bf16x8 aA_ = *(const LAS bf16x8*)(kpA_ + (((2 * i + hi) ^ (keyA_ & 7)) * 16)), aB_ = *(const LAS bf16x8*)(kpB_ + (((2 * i + hi) ^ (keyB_ & 7)) * 16));
                              if (!(ABL & 8)) { nA = __builtin_amdgcn_mfma_f32_32x32x16_bf16(aA_, qf[i], i == 0 ? cneg : nA, 0, 0, 0); nB = __builtin_amdgcn_mfma_f32_32x32x16_bf16(aB_, qf[i], i == 0 ? cneg : nB, 0, 0, 0); } else if (i == 0) { nA = cneg; nB = cneg; } }
                            float pv8[8];
#pragma unroll
                            for (int q = 0; q < 8; ++q) { const float sv = i < 2 ? sA[8 * i + q] : sB[8 * (i - 2) + q]; pv8[q] = (ABL & 2) ? sv : __builtin_amdgcn_exp2f(sv); ps += pv8[q]; }
                            ppa[i].x = pk2(pv8[0], pv8[1]); ppa[i].y = pk2(pv8[2], pv8[3]); ppa[i].z = pk2(pv8[4], pv8[5]); ppa[i].w = pk2(pv8[6], pv8[7]);
                            __builtin_amdgcn_sched_barrier(0);
                        }
                        l += ps;
                    }
                    pvoff = vbuf + (8 * jp) * 1024; pending = true;
                    sA = nA; sB = nB;
                }
#undef MOBA_QK
            }
            VM_WAIT(); __syncthreads();
        }
        if (pending) { MOBA_PV(ppa, pvoff); pending = false; }
#undef MOBA_PV
        l += __shfl_xor(l, 32);
        if (hi == 0) wsc[r32] = 1.0f / l;
        LDS_WAIT(); asm volatile("" ::: "memory");
        bf16* op = ATT + ((size_t)b * SEQ + qw0) * 512 + h * 64 + r32;
#pragma unroll
        for (int r = 0; r < 16; ++r) { const int qr = (r & 3) + 8 * (r >> 2) + 4 * hi; const float a = wsc[qr];
            op[(size_t)qr * 512] = (bf16)f2bf(o0[r] * a); op[(size_t)qr * 512 + 32] = (bf16)f2bf(o1[r] * a); }
        LDS_WAIT(); asm volatile("" ::: "memory");
    }
    }
#undef MOBA_STAGE
}


constexpr int RT_K = 0, RT_P = 16384, RT_V = 32768, RT_O = 65536, RT_OP = 132;
__device__ __forceinline__ void p3a_retention_mfma(Frame& F, const Ptrs& P) {
    unsigned char* ws = P.ws; const bf16* RQ = (const bf16*)(ws + WS_RQ); const bf16* RK = (const bf16*)(ws + WS_RK); const bf16* RV = (const bf16*)(ws + WS_RV);
    const bf16* RG = (const bf16*)(ws + WS_RG); const bf16* PREV = (const bf16*)(ws + WS_PREV); bf16* RETG = (bf16*)P.out;
    LAS float* lO = (LAS float*)(F.lds + RT_O);
    const int lane = F.lane, wave = F.wave, r32 = lane & 31, hi = lane >> 5, rt = wave >> 1, dh = wave & 1;
    const unsigned vbase = (unsigned)((4 * hi + ((lane & 15) >> 2)) * 64 + ((lane >> 4) & 1) * 32 + (lane & 3) * 8);
    unsigned ksrc[2], psrc[2], vsrc[4];
#pragma unroll
    for (int j = 0; j < 2; ++j) { const int pc = wave * 2 + j, row = 8 * pc + (lane >> 3), ch = (lane & 7) ^ (row & 7); ksrc[j] = (unsigned)(row * 512 + ch * 8); psrc[j] = (unsigned)(row * 64 + ch * 8); }
#pragma unroll
    for (int j = 0; j < 4; ++j) { const int pc = wave * 4 + j, key = 8 * (pc >> 1) + ((lane & 31) >> 2), db = 2 * (pc & 1) + (lane >> 5); vsrc[j] = (unsigned)(key * 1024 + 32 * db + 8 * (lane & 3)); }
#define RT_STAGE(task_) do { const int b_ = (task_) >> 8, h_ = ((task_) >> 5) & 7, n_ = (task_) & 31; const size_t r0_ = (size_t)b_ * SEQ + n_ * RC; \
        const bf16* kg_ = RK + r0_ * 512 + h_ * 64; const bf16* pg_ = PREV + (size_t)(task_) * 8192; const bf16* vg_ = RV + r0_ * 1024 + h_ * 128; \
        _Pragma("unroll") for (int j = 0; j < 2; ++j) { __builtin_amdgcn_global_load_lds((const unsigned*)(kg_ + ksrc[j]), (LAS unsigned*)(F.lds + RT_K + (wave * 2 + j) * 1024), 16, 0, 0); \
            __builtin_amdgcn_global_load_lds((const unsigned*)(pg_ + psrc[j]), (LAS unsigned*)(F.lds + RT_P + (wave * 2 + j) * 1024), 16, 0, 0); } \
        _Pragma("unroll") for (int j = 0; j < 4; ++j) __builtin_amdgcn_global_load_lds((const unsigned*)(vg_ + vsrc[j]), (LAS unsigned*)(F.lds + RT_V + (wave * 4 + j) * 1024), 16, 0, 0); } while (0)
    int task = F.bid;
    if (task < BATCH * RH * NCH) RT_STAGE(task);
    for (; task < BATCH * RH * NCH; task += F.G) {
        const int b = task >> 8, h = (task >> 5) & 7, n = task & 31; const size_t row0 = (size_t)b * SEQ + n * RC; const float l2g = ret_l2g(h);
        bf16x8 qf[4];
        { const bf16* qp = RQ + (row0 + 32 * rt + r32) * 512 + h * 64 + 8 * hi;
#pragma unroll
          for (int ds = 0; ds < 4; ++ds) qf[ds] = *(const bf16x8*)(qp + 16 * ds); }
        VM_WAIT(); __syncthreads();
        f32x16 o0, o1;
#pragma unroll
        for (int r = 0; r < 16; ++r) { o0[r] = 0.f; o1[r] = 0.f; }
#pragma unroll
        for (int ds = 0; ds < 4; ++ds) {
#pragma unroll
            for (int db = 0; db < 2; ++db) { const int dv = 64 * dh + 32 * db + r32; const bf16x8 bfr = *(const LAS bf16x8*)(F.lds + RT_P + dv * 128 + (((2 * ds + hi) ^ (dv & 7)) * 16));
                if (db == 0) o0 = __builtin_amdgcn_mfma_f32_32x32x16_bf16(qf[ds], bfr, o0, 0, 0, 0); else o1 = __builtin_amdgcn_mfma_f32_32x32x16_bf16(qf[ds], bfr, o1, 0, 0, 0); }
        }
#pragma unroll
        for (int r = 0; r < 16; ++r) { const float qd = __builtin_amdgcn_exp2f((float)(32 * rt + (r & 3) + 8 * (r >> 2) + 4 * hi + 1) * l2g); o0[r] *= qd; o1[r] *= qd; }
        for (int kt = 0; kt <= rt; ++kt) {
            f32x16 s;
#pragma unroll
            for (int r = 0; r < 16; ++r) s[r] = 0.f;
            { const int key = 32 * kt + r32; const LAS unsigned char* kp = F.lds + RT_K + key * 128;
#pragma unroll
              for (int ds = 0; ds < 4; ++ds) { const bf16x8 a = *(const LAS bf16x8*)(kp + (((2 * ds + hi) ^ (key & 7)) * 16)); s = __builtin_amdgcn_mfma_f32_32x32x16_bf16(a, qf[ds], s, 0, 0, 0); } }
            const int dbase = 32 * (rt - kt) + r32 - 4 * hi;
#pragma unroll
            for (int r = 0; r < 16; ++r) { const int dj = dbase - ((r & 3) + 8 * (r >> 2)); s[r] = dj >= 0 ? s[r] * __builtin_amdgcn_exp2f((float)dj * l2g) : 0.f; }
            v4u pa0, pa1;
            pa0.x = pk2(s[0], s[1]); pa0.y = pk2(s[2], s[3]); pa0.z = pk2(s[4], s[5]); pa0.w = pk2(s[6], s[7]);
            pa1.x = pk2(s[8], s[9]); pa1.y = pk2(s[10], s[11]); pa1.z = pk2(s[12], s[13]); pa1.w = pk2(s[14], s[15]);
            const LAS unsigned char* vp = F.lds + RT_V + vbase + (4 * kt) * 2048 + (2 * dh) * 512;
#pragma unroll
            for (int ks = 0; ks < 2; ++ks) {
                const bf16x8 pa = __builtin_bit_cast(bf16x8, ks == 0 ? pa0 : pa1);
#pragma unroll
                for (int db = 0; db < 2; ++db) {
                    const s16x4 lo = vtr_read(vp + (2 * ks) * 2048 + db * 512), hh = vtr_read(vp + (2 * ks + 1) * 2048 + db * 512);
                    const bf16x8 vf = (bf16x8){lo[0], lo[1], lo[2], lo[3], hh[0], hh[1], hh[2], hh[3]};
                    if (db == 0) o0 = __builtin_amdgcn_mfma_f32_32x32x16_bf16(pa, vf, o0, 0, 0, 0); else o1 = __builtin_amdgcn_mfma_f32_32x32x16_bf16(pa, vf, o1, 0, 0, 0);
                }
            }
        }
#pragma unroll
        for (int r = 0; r < 16; ++r) { const int qr = 32 * rt + (r & 3) + 8 * (r >> 2) + 4 * hi; lO[qr * RT_OP + 64 * dh + r32] = o0[r]; lO[qr * RT_OP + 64 * dh + 32 + r32] = o1[r]; }
        __syncthreads();
        if (task + F.G < BATCH * RH * NCH) RT_STAGE(task + F.G);
#pragma unroll
        for (int it = 0; it < 2; ++it) {
            const int i = wave * 16 + it * 8 + (lane >> 3), cc = lane & 7;
            f32x4 v[4];
#pragma unroll
            for (int q = 0; q < 4; ++q) v[q] = *(const LAS f32x4*)(lO + i * RT_OP + 16 * cc + 4 * q);
            const f32x4 sv = (v[0] + v[1]) + (v[2] + v[3]);
            const float mu = dpp_sum8((sv[0] + sv[1]) + (sv[2] + sv[3])) * (1.0f / RDV);
            f32x4 qv = {0.f, 0.f, 0.f, 0.f};
#pragma unroll
            for (int q = 0; q < 4; ++q) { v[q] = v[q] - mu; qv += v[q] * v[q]; }
            const float rs = rsqrtf(dpp_sum8((qv[0] + qv[1]) + (qv[2] + qv[3])) * (1.0f / RDV) + EPS);
            const size_t off = (row0 + i) * 1024 + h * 128 + 16 * cc;
            f32x4 g0, g1, g2, g3; load8_bf16(RG + off, g0, g1); load8_bf16(RG + off + 8, g2, g3);
            store8_bf16(RETG + off, v[0] * rs * g0, v[1] * rs * g1); store8_bf16(RETG + off + 8, v[2] * rs * g2, v[3] * rs * g3);
        }
    }
#undef RT_STAGE
}
constexpr int KV_K = 0, KV_V = 16384;
__device__ __forceinline__ void p2a_kv_mfma(Frame& F, const Ptrs& P) {
    unsigned char* ws = P.ws; const bf16* RK = (const bf16*)(ws + WS_RK); const bf16* RV = (const bf16*)(ws + WS_RV); float* KVT = (float*)((unsigned char*)P.out + 32 * MiB);
    const int tid = F.tid, lane = F.lane, wave = F.wave, r32 = lane & 31, hi = lane >> 5, mb = wave >> 1, nb = wave & 1;
    const unsigned vbase = (unsigned)((4 * hi + ((lane & 15) >> 2)) * 64 + ((lane >> 4) & 1) * 32 + (lane & 3) * 8);
    for (int task = F.bid; task < BATCH * RH * NCH; task += F.G) {
        const int b = task >> 8, h = (task >> 5) & 7, n = task & 31; const size_t row0 = (size_t)b * SEQ + n * RC; const float l2g = ret_l2g(h);
        __syncthreads();
#pragma unroll
        for (int j = 0; j < 2; ++j) { const int idx = tid + 512 * j, r = idx >> 3, c = idx & 7; const v4u kx = *(const v4u*)(RK + (row0 + r) * 512 + h * 64 + c * 8);
            const float dec = __builtin_amdgcn_exp2f((float)(RC - 1 - r) * l2g); v4u ko;
            ko.x = pk2(bflo(kx.x) * dec, bfhi(kx.x) * dec); ko.y = pk2(bflo(kx.y) * dec, bfhi(kx.y) * dec); ko.z = pk2(bflo(kx.z) * dec, bfhi(kx.z) * dec); ko.w = pk2(bflo(kx.w) * dec, bfhi(kx.w) * dec);
            *(LAS v4u*)(F.lds + KV_K + (((r >> 3) * 2 + (c >> 2)) * 512) + (r & 7) * 64 + (c & 3) * 16) = ko; }
#pragma unroll
        for (int j = 0; j < 4; ++j) { const int idx = tid + 512 * j, r = idx >> 4, c = idx & 15;
            *(LAS v4u*)(F.lds + KV_V + (((r >> 3) * 4 + (c >> 2)) * 512) + (r & 7) * 64 + (c & 3) * 16) = *(const v4u*)(RV + (row0 + r) * 1024 + h * 128 + c * 8); }
        __syncthreads();
        f32x16 acc;
#pragma unroll
        for (int r = 0; r < 16; ++r) acc[r] = 0.f;
#pragma unroll
        for (int ks = 0; ks < 8; ++ks) {
            const LAS unsigned char* ap = F.lds + KV_V + vbase + ((2 * ks) * 4 + mb) * 512; const LAS unsigned char* bp = F.lds + KV_K + vbase + ((2 * ks) * 2 + nb) * 512;
            const s16x4 alo = vtr_read(ap), ahi = vtr_read(ap + 4 * 512), blo = vtr_read(bp), bhi = vtr_read(bp + 2 * 512);
            const bf16x8 af = (bf16x8){alo[0], alo[1], alo[2], alo[3], ahi[0], ahi[1], ahi[2], ahi[3]}, bfv = (bf16x8){blo[0], blo[1], blo[2], blo[3], bhi[0], bhi[1], bhi[2], bhi[3]};
            acc = __builtin_amdgcn_mfma_f32_32x32x16_bf16(af, bfv, acc, 0, 0, 0);
        }
        float* o = KVT + (size_t)task * (RDV * RDK) + 32 * nb + r32;
#pragma unroll
        for (int r = 0; r < 16; ++r) o[(32 * mb + (r & 3) + 8 * (r >> 2) + 4 * hi) * 64] = acc[r];
    }
}
#define CE_D(a, i, j) do { const unsigned _hi = a[i] > a[j] ? a[i] : a[j]; const unsigned _lo = a[i] > a[j] ? a[j] : a[i]; a[i] = _hi; a[j] = _lo; } while (0)
#define CE_A(a, i, j) do { const unsigned _hi = a[i] > a[j] ? a[i] : a[j]; const unsigned _lo = a[i] > a[j] ? a[j] : a[i]; a[i] = _lo; a[j] = _hi; } while (0)
#define SORT16_DESC(a) do { CE_D(a, 0, 1); CE_A(a, 2, 3); CE_D(a, 4, 5); CE_A(a, 6, 7); CE_D(a, 8, 9); CE_A(a, 10, 11); CE_D(a, 12, 13); CE_A(a, 14, 15); CE_D(a, 0, 2); CE_D(a, 1, 3); CE_A(a, 4, 6); CE_A(a, 5, 7); CE_D(a, 8, 10); CE_D(a, 9, 11); CE_A(a, 12, 14); CE_A(a, 13, 15); CE_D(a, 0, 1); CE_D(a, 2, 3); CE_A(a, 4, 5); CE_A(a, 6, 7); CE_D(a, 8, 9); CE_D(a, 10, 11); CE_A(a, 12, 13); CE_A(a, 14, 15); CE_D(a, 0, 4); CE_D(a, 1, 5); CE_D(a, 2, 6); CE_D(a, 3, 7); CE_A(a, 8, 12); CE_A(a, 9, 13); CE_A(a, 10, 14); CE_A(a, 11, 15); CE_D(a, 0, 2); CE_D(a, 1, 3); CE_D(a, 4, 6); CE_D(a, 5, 7); CE_A(a, 8, 10); CE_A(a, 9, 11); CE_A(a, 12, 14); CE_A(a, 13, 15); CE_D(a, 0, 1); CE_D(a, 2, 3); CE_D(a, 4, 5); CE_D(a, 6, 7); CE_A(a, 8, 9); CE_A(a, 10, 11); CE_A(a, 12, 13); CE_A(a, 14, 15); CE_D(a, 0, 8); CE_D(a, 1, 9); CE_D(a, 2, 10); CE_D(a, 3, 11); CE_D(a, 4, 12); CE_D(a, 5, 13); CE_D(a, 6, 14); CE_D(a, 7, 15); CE_D(a, 0, 4); CE_D(a, 1, 5); CE_D(a, 2, 6); CE_D(a, 3, 7); CE_D(a, 8, 12); CE_D(a, 9, 13); CE_D(a, 10, 14); CE_D(a, 11, 15); CE_D(a, 0, 2); CE_D(a, 1, 3); CE_D(a, 4, 6); CE_D(a, 5, 7); CE_D(a, 8, 10); CE_D(a, 9, 11); CE_D(a, 12, 14); CE_D(a, 13, 15); CE_D(a, 0, 1); CE_D(a, 2, 3); CE_D(a, 4, 5); CE_D(a, 6, 7); CE_D(a, 8, 9); CE_D(a, 10, 11); CE_D(a, 12, 13); CE_D(a, 14, 15); } while (0)
#define MERGE16_DESC(a) do { CE_D(a, 0, 8); CE_D(a, 1, 9); CE_D(a, 2, 10); CE_D(a, 3, 11); CE_D(a, 4, 12); CE_D(a, 5, 13); CE_D(a, 6, 14); CE_D(a, 7, 15); CE_D(a, 0, 4); CE_D(a, 1, 5); CE_D(a, 2, 6); CE_D(a, 3, 7); CE_D(a, 8, 12); CE_D(a, 9, 13); CE_D(a, 10, 14); CE_D(a, 11, 15); CE_D(a, 0, 2); CE_D(a, 1, 3); CE_D(a, 4, 6); CE_D(a, 5, 7); CE_D(a, 8, 10); CE_D(a, 9, 11); CE_D(a, 12, 14); CE_D(a, 13, 15); CE_D(a, 0, 1); CE_D(a, 2, 3); CE_D(a, 4, 5); CE_D(a, 6, 7); CE_D(a, 8, 9); CE_D(a, 10, 11); CE_D(a, 12, 13); CE_D(a, 14, 15); } while (0)

#ifndef CONV_IN_TOPK
#define CONV_IN_TOPK 1
#endif
constexpr size_t CONV_N16 = (size_t)NEXP * DM / 16;
__device__ __forceinline__ void conv_load(const Ptrs& P, size_t i, f32x4 (&a)[4]) {
    const float* src = (i < CONV_N16) ? P.peer_u + i * 16 : P.peer_v + (i - CONV_N16) * 16;
#pragma unroll
    for (int q = 0; q < 4; ++q) a[q] = __builtin_nontemporal_load((const f32x4*)(src + 4 * q));
}
__device__ __forceinline__ void conv_store(const Ptrs& P, size_t i, const f32x4 (&a)[4]) {
    v2u w;
#pragma unroll
    for (int q = 0; q < 2; ++q) { unsigned pk = 0u;
        const f32x4 s0 = a[2 * q] * 64.0f, s1 = a[2 * q + 1] * 64.0f;
        pk = __builtin_amdgcn_cvt_scalef32_pk_fp4_f32(pk, s0[0], s0[1], 1.0f, 0); pk = __builtin_amdgcn_cvt_scalef32_pk_fp4_f32(pk, s0[2], s0[3], 1.0f, 1);
        pk = __builtin_amdgcn_cvt_scalef32_pk_fp4_f32(pk, s1[0], s1[1], 1.0f, 2); pk = __builtin_amdgcn_cvt_scalef32_pk_fp4_f32(pk, s1[2], s1[3], 1.0f, 3);
        w[q] = pk; }
    *(v2u*)(P.ws + WS_UV8 + i * 8) = w;
}
__device__ __forceinline__ void conv_all(Frame& F, const Ptrs& P) {
    const size_t cbase = (size_t)F.bid * 512 + F.tid, CNGT = (size_t)F.G * 512;
    for (size_t ci = cbase; ci < 2 * CONV_N16; ci += CNGT) { f32x4 cv[4]; conv_load(P, ci, cv); conv_store(P, ci, cv); }
}
__device__ __forceinline__ unsigned mono32(float f) { const unsigned u = __builtin_bit_cast(unsigned, f); return u ^ ((u >> 31) ? 0xffffffffu : 0x80000000u); }
__device__ __forceinline__ float unmono32(unsigned k) { const unsigned u = k ^ ((k >> 31) ? 0x80000000u : 0xffffffffu); return __builtin_bit_cast(float, u); }
__device__ __forceinline__ float key_val(unsigned k) { const unsigned m = k >> 16; return __builtin_bit_cast(float, (m ^ ((m & 0x8000u) ? 0x8000u : 0xffffu)) << 16); }
#define INS16(a, x) do { _Pragma("unroll") for (int _j = 0; _j < 16; ++_j) { const unsigned _t = a[_j] > x ? a[_j] : x; x = a[_j] > x ? x : a[_j]; a[_j] = _t; } } while (0)
__device__ __forceinline__ void p6_topk(Frame& F, const Ptrs& P) {
    unsigned char* ws = P.ws; const bf16* ST = (const bf16*)(ws + WS_ST); int* EXP = (int*)(ws + WS_EG); float* GT = (float*)(ws + WS_EG + 8 * MiB);
    LAS unsigned* lsc = (LAS unsigned*)F.lds;
    pg8::StaticOrder S8; S8.init(T, 2048, F.G, F.bid);
    pg8::Unit uq;
    const size_t cbase = (size_t)F.bid * 512 + F.tid, CNGT = (size_t)F.G * 512; int citem = 0;
    for (int ii = F.wave >> 2; S8.next(ii, uq); ii += 2) {
        const int hd = uq.pn, tok = uq.pm * 256 + (F.wave & 3) * 64 + F.lane;
        const bf16* sp = ST + (size_t)hd * 256 * T + tok;
        unsigned a1[16], a2[16];
#pragma unroll
        for (int j = 0; j < 16; ++j) { a1[j] = 0u; a2[j] = 0u; }
#pragma unroll 1
        for (int g = 0; g < 8; ++g) {
            f32x4 cv0[4], cv1[4]; const size_t ci0 = cbase + (size_t)citem * CNGT, ci1 = ci0 + CNGT; const bool ok0 = CONV_IN_TOPK && ci0 < 2 * CONV_N16, ok1 = CONV_IN_TOPK && ci1 < 2 * CONV_N16;
            unsigned short rr1[16], rr2[16];
#pragma unroll
            for (int q = 0; q < 16; ++q) { const int n = 16 * g + q; rr1[q] = sp[(size_t)n * T]; rr2[q] = sp[(size_t)(PNK + n) * T]; }
            asm volatile("" ::: "memory");
            if (ok0) conv_load(P, ci0, cv0);
            if (ok1) conv_load(P, ci1, cv1);
            unsigned g1[16], g2[16];
#pragma unroll
            for (int q = 0; q < 16; ++q) { const int n = 16 * g + q; const unsigned short r1 = rr1[q], r2 = rr2[q];
                g1[q] = (((unsigned)r1 ^ ((r1 & 0x8000u) ? 0xffffu : 0x8000u)) << 16) | (unsigned)(127 - n);
                g2[q] = (((unsigned)r2 ^ ((r2 & 0x8000u) ? 0xffffu : 0x8000u)) << 16) | (unsigned)(127 - n); }
            SORT16_DESC(g1); SORT16_DESC(g2);
            if (g == 0) {
#pragma unroll
                for (int q = 0; q < 16; ++q) { a1[q] = g1[q]; a2[q] = g2[q]; }
            } else {
#pragma unroll
                for (int q = 0; q < 16; ++q) { a1[q] = a1[q] > g1[15 - q] ? a1[q] : g1[15 - q]; a2[q] = a2[q] > g2[15 - q] ? a2[q] : g2[15 - q]; }
                MERGE16_DESC(a1); MERGE16_DESC(a2);
            }
            if (ok0) conv_store(P, ci0, cv0);
            if (ok1) conv_store(P, ci1, cv1);
            citem += 2;
            __builtin_amdgcn_sched_barrier(0);
        }
#pragma unroll
        for (int i = 0; i < 16; ++i) { lsc[i * 512 + F.tid] = a1[i]; lsc[(16 + i) * 512 + F.tid] = a2[i]; }
#define CK_(I, J) ((mono32(key_val(a1[I]) + key_val(a2[J])) & 0xffffff00u) | (unsigned)((I) * 16 + (J)))
        unsigned kb[16] = {CK_(0, 0), CK_(0, 1), CK_(0, 2), CK_(0, 3), CK_(0, 4), CK_(0, 5), CK_(0, 6), CK_(0, 7), CK_(0, 8), CK_(0, 9), CK_(0, 10), CK_(0, 11), CK_(0, 12), CK_(0, 13), CK_(0, 14), CK_(0, 15)};
        SORT16_DESC(kb);
        __builtin_amdgcn_sched_barrier(0);
        { unsigned g[16] = {CK_(1, 0), CK_(1, 1), CK_(1, 2), CK_(1, 3), CK_(1, 4), CK_(1, 5), CK_(1, 6), CK_(1, 7), CK_(2, 0), CK_(2, 1), CK_(2, 2), CK_(2, 3), CK_(2, 4), CK_(3, 0), CK_(3, 1), CK_(3, 2)};
          SORT16_DESC(g);
#pragma unroll
          for (int q = 0; q < 16; ++q) kb[q] = kb[q] > g[15 - q] ? kb[q] : g[15 - q];
          MERGE16_DESC(kb); }
        __builtin_amdgcn_sched_barrier(0);
        { unsigned g[16] = {CK_(3, 3), CK_(4, 0), CK_(4, 1), CK_(4, 2), CK_(5, 0), CK_(5, 1), CK_(6, 0), CK_(6, 1), CK_(7, 0), CK_(7, 1), CK_(8, 0), CK_(9, 0), CK_(10, 0), CK_(11, 0), CK_(12, 0), CK_(13, 0)};
          SORT16_DESC(g);
#pragma unroll
          for (int q = 0; q < 16; ++q) kb[q] = kb[q] > g[15 - q] ? kb[q] : g[15 - q];
          MERGE16_DESC(kb); }
        __builtin_amdgcn_sched_barrier(0);
        { unsigned xk = CK_(14, 0); INS16(kb, xk); }
        { unsigned xk = CK_(15, 0); INS16(kb, xk); }
#undef CK_
        float sv[16]; unsigned ev[16]; float smax = -3e38f;
#pragma unroll
        for (int q = 0; q < 16; ++q) { const unsigned i = (kb[q] >> 4) & 15u, j = kb[q] & 15u; const unsigned k1 = lsc[i * 512 + F.tid], k2 = lsc[(16 + j) * 512 + F.tid];
            sv[q] = key_val(k1) + key_val(k2); ev[q] = (127u - (k1 & 127u)) * 128u + (127u - (k2 & 127u)); smax = fmaxf(smax, sv[q]); }
        float gs = 0.f;
#pragma unroll
        for (int q = 0; q < 16; ++q) { sv[q] = __expf(sv[q] - smax); gs += sv[q]; }
        const float ig = 1.0f / gs;
        int* ep = EXP + (size_t)tok * 128 + hd * 16; float* gp = GT + (size_t)tok * 128 + hd * 16;
#pragma unroll
        for (int q = 0; q < 4; ++q) { *(v4u*)(ep + 4 * q) = (v4u){ev[4 * q], ev[4 * q + 1], ev[4 * q + 2], ev[4 * q + 3]};
            *(f32x4*)(gp + 4 * q) = (f32x4){sv[4 * q] * ig, sv[4 * q + 1] * ig, sv[4 * q + 2] * ig, sv[4 * q + 3] * ig}; }
    }
    if (CONV_IN_TOPK) for (;; ++citem) { const size_t ci = cbase + (size_t)citem * CNGT; if (ci >= 2 * CONV_N16) break; f32x4 cv[4]; conv_load(P, ci, cv); conv_store(P, ci, cv); }
}
__device__ __forceinline__ float dot8(const v4u w, const float* h) {
    return h[0] * bflo(w.x) + h[1] * bfhi(w.x) + h[2] * bflo(w.y) + h[3] * bfhi(w.y) + h[4] * bflo(w.z) + h[5] * bfhi(w.z) + h[6] * bflo(w.w) + h[7] * bfhi(w.w);
}
__device__ __forceinline__ void axpy8(float* acc, float c, const v4u w) {
    acc[0] += c * bflo(w.x); acc[1] += c * bfhi(w.x); acc[2] += c * bflo(w.y); acc[3] += c * bfhi(w.y); acc[4] += c * bflo(w.z); acc[5] += c * bfhi(w.z); acc[6] += c * bflo(w.w); acc[7] += c * bfhi(w.w);
}
#ifndef PB
#define PB 8
#endif
__device__ __forceinline__ void p7_peer(Frame& F, const Ptrs& P, float* dst) {
    unsigned char* ws = P.ws; const bf16* H2 = (const bf16*)(ws + WS_H2); const int* EXP = (const int*)(ws + WS_EG); const float* GT = (const float*)(ws + WS_EG + 8 * MiB);
    const bf16* U = (const bf16*)(ws + WS_UV); const bf16* V = U + (size_t)NEXP * DM; float* out = P.out;
    const int gw = F.bid * NWAVES + F.wave, NGW = F.G * NWAVES, lane = F.lane;
    for (int tok = gw; tok < T; tok += NGW) {
        float hv[16], acc[16];
        { const v4u h0 = *(const v4u*)(H2 + (size_t)tok * DM + 8 * lane), h1 = *(const v4u*)(H2 + (size_t)tok * DM + 512 + 8 * lane);
          hv[0] = bflo(h0.x); hv[1] = bfhi(h0.x); hv[2] = bflo(h0.y); hv[3] = bfhi(h0.y); hv[4] = bflo(h0.z); hv[5] = bfhi(h0.z); hv[6] = bflo(h0.w); hv[7] = bfhi(h0.w);
          hv[8] = bflo(h1.x); hv[9] = bfhi(h1.x); hv[10] = bflo(h1.y); hv[11] = bfhi(h1.y); hv[12] = bflo(h1.z); hv[13] = bfhi(h1.z); hv[14] = bflo(h1.w); hv[15] = bfhi(h1.w); }
#pragma unroll
        for (int e = 0; e < 16; ++e) acc[e] = 0.f;
        int e_lo = EXP[(size_t)tok * 128 + lane], e_hi = EXP[(size_t)tok * 128 + 64 + lane];
        float g_lo = GT[(size_t)tok * 128 + lane], g_hi = GT[(size_t)tok * 128 + 64 + lane];
#ifndef PEER_NOSORT
        {
            LAS unsigned* le = (LAS unsigned*)(F.lds + F.wave * 1024); LAS float* lg = (LAS float*)(le + 128);
            const unsigned b_lo = (unsigned)e_lo >> 9, b_hi = (unsigned)e_hi >> 9; unsigned pos_lo = 0, pos_hi = 0, base = 0;
            for (unsigned bk = 0; bk < 32; ++bk) {
                const unsigned long long mlo = __ballot(b_lo == bk), mhi = __ballot(b_hi == bk);
                const unsigned clo = (unsigned)__popcll(mlo), chi = (unsigned)__popcll(mhi);
                if (b_lo == bk) pos_lo = base + __builtin_amdgcn_mbcnt_hi((unsigned)(mlo >> 32), __builtin_amdgcn_mbcnt_lo((unsigned)mlo, 0u));
                if (b_hi == bk) pos_hi = base + clo + __builtin_amdgcn_mbcnt_hi((unsigned)(mhi >> 32), __builtin_amdgcn_mbcnt_lo((unsigned)mhi, 0u));
                base += clo + chi;
            }
            le[pos_lo] = (unsigned)e_lo; lg[pos_lo] = g_lo; le[pos_hi] = (unsigned)e_hi; lg[pos_hi] = g_hi;
            LDS_WAIT(); asm volatile("" ::: "memory");
            e_lo = (int)le[lane]; e_hi = (int)le[64 + lane]; g_lo = lg[lane]; g_hi = lg[64 + lane];
            LDS_WAIT(); asm volatile("" ::: "memory");
        }
#endif
        for (int k = 0; k < 128; k += PB) {
            int ex[PB]; float gg[PB]; v4u u0[PB], u1[PB], v0[PB], v1[PB];
#pragma unroll
            for (int q = 0; q < PB; ++q) { const int kk = k + q; ex[q] = __shfl(kk < 64 ? e_lo : e_hi, kk & 63); gg[q] = __shfl(kk < 64 ? g_lo : g_hi, kk & 63); }
#pragma unroll
            for (int q = 0; q < PB; ++q) { const bf16* up = U + (size_t)ex[q] * DM + 8 * lane; const bf16* vp = V + (size_t)ex[q] * DM + 8 * lane;
                u0[q] = *(const v4u*)up; u1[q] = *(const v4u*)(up + 512); v0[q] = *(const v4u*)vp; v1[q] = *(const v4u*)(vp + 512); }
            float d[PB];
#pragma unroll
            for (int q = 0; q < PB; ++q) d[q] = dot8(u0[q], hv) + dot8(u1[q], hv + 8);
#pragma unroll
            for (int o = 1; o < 64; o <<= 1) {
#pragma unroll
                for (int q = 0; q < PB; ++q) d[q] += __shfl_xor(d[q], o);
            }
#pragma unroll
            for (int q = 0; q < PB; ++q) { const float z = d[q]; const float a = 0.5f * z * (1.0f + erff(z * 0.70710678118654752f)); const float c = gg[q] * a; axpy8(acc, c, v0[q]); axpy8(acc + 8, c, v1[q]); }
        }
        float* op = out + (size_t)tok * DM + 8 * lane;
        f32x4 x0 = *(const f32x4*)op, x1 = *(const f32x4*)(op + 4), x2 = *(const f32x4*)(op + 512), x3 = *(const f32x4*)(op + 516);
        x0 += (f32x4){acc[0], acc[1], acc[2], acc[3]}; x1 += (f32x4){acc[4], acc[5], acc[6], acc[7]}; x2 += (f32x4){acc[8], acc[9], acc[10], acc[11]}; x3 += (f32x4){acc[12], acc[13], acc[14], acc[15]};
        float* wp = dst + (size_t)tok * DM + 8 * lane;
        *(f32x4*)wp = x0; *(f32x4*)(wp + 4) = x1; *(f32x4*)(wp + 512) = x2; *(f32x4*)(wp + 516) = x3;
    }
}

typedef float f32x2v __attribute__((ext_vector_type(2)));
typedef _Float16 f16x2v __attribute__((ext_vector_type(2)));
constexpr size_t WS_PART = WS_ST;
constexpr size_t WS_CG = WS_ACT + 32 * MiB;
__device__ __forceinline__ void fp8x16_to_f32(const v4u w, float* f) {
#pragma unroll
    for (int q = 0; q < 4; ++q) { const f32x2v lo = __builtin_amdgcn_cvt_pk_f32_fp8((int)w[q], false), hi = __builtin_amdgcn_cvt_pk_f32_fp8((int)w[q], true); f[4 * q] = lo.x; f[4 * q + 1] = lo.y; f[4 * q + 2] = hi.x; f[4 * q + 3] = hi.y; }
}
__device__ __forceinline__ float fmac_s(float acc, float a, float b) { asm("v_fmac_f32_e32 %0, %1, %2" : "+v"(acc) : "v"(a), "v"(b)); return acc; }
constexpr int TROW = DM / 2;
typedef int v8i __attribute__((ext_vector_type(8))); typedef int v2i_t __attribute__((ext_vector_type(2)));
template <int MODE> __device__ __forceinline__ void p7u_dots(Frame& F, const Ptrs& P) {
    unsigned char* ws = P.ws; const bf16* H2 = (const bf16*)(ws + WS_H2); const int* EXP = (const int*)(ws + WS_EG); const unsigned char* U4 = ws + WS_UV8; float* PART = (float*)(ws + (MODE ? WS_ACT : WS_PART)); const float* SS = (const float*)(ws + WS_SUMSQ);
    const int lane = F.lane, r = lane >> 3, c = lane & 7, i = lane & 15, kb = lane >> 4;
    LAS unsigned char* lB = F.lds; LAS float* lS = (LAS float*)(F.lds + 32768);
    LAS unsigned char* lI = F.lds + 34816 + F.wave * 2048;
    LAS unsigned char* lT = F.lds + 51200 + F.wave * 8192;
    const int wr0 = r * 128 + ((c ^ (r >> 1)) << 4), wr1 = (8 + r) * 128 + ((c ^ (4 + (r >> 1))) << 4);
    const int rd0 = i * 128 + ((kb ^ ((i >> 1) & 7)) << 4), rd1 = i * 128 + (((4 + kb) ^ ((i >> 1) & 7)) << 4);
#define PU_LOADW(tk) (*(const v2u*)(EXP + (size_t)(tbase + ((tk) < 31 ? (tk) : 31)) * 128 + 2 * lane))
#define PU_PUTW(tk, wv) do { *(LAS v2u*)(lI + ((tk) & 3) * 512 + 8 * lane) = wv; } while (0)
#define PU_ISSUE(tk, ul) do { _Pragma("unroll") for (int d_ = 0; d_ < 16; ++d_) { const unsigned ev = *(const LAS unsigned*)(lI + ((tk) & 3) * 512 + (8 * d_ + r) * 4); ul[d_] = *(const v4u*)(U4 + ((ev << 9) + loff)); } } while (0)
#define PU_V8(lo) (v8i){(int)(lo).x, (int)(lo).y, (int)(lo).z, (int)(lo).w, 0, 0, 0, 0}
#define PU_COMPUTE(tk, ul) do { const LAS unsigned char* bp_ = lB + (32 * F.wave + (tk)) * 128 + 16 * kb; const v4u bq0 = *(const LAS v4u*)bp_, bq1 = *(const LAS v4u*)(bp_ + 64); const float osc = lS[32 * F.wave + (tk)]; \
        const v8i b0 = PU_V8(bq0), b1 = PU_V8(bq1); \
        float* pp = PART + ((size_t)sl * T + (tbase + (tk))) * 128 + 4 * kb; \
        f32x4 acc[8]; \
        _Pragma("unroll") for (int g = 0; g < 8; ++g) { LAS unsigned char* tb_ = lT + (g & 3) * 2048; \
            *(LAS v4u*)(tb_ + wr0) = ul[2 * g]; *(LAS v4u*)(tb_ + wr1) = ul[2 * g + 1]; \
            const v4u a0 = *(const LAS v4u*)(tb_ + rd0), a1 = *(const LAS v4u*)(tb_ + rd1); \
            acc[g] = __builtin_amdgcn_mfma_scale_f32_16x16x128_f8f6f4(PU_V8(a0), b0, (f32x4){0.f, 0.f, 0.f, 0.f}, 4, 4, 0, 0, 0, 0); \
            acc[g] = __builtin_amdgcn_mfma_scale_f32_16x16x128_f8f6f4(PU_V8(a1), b1, acc[g], 4, 4, 0, 0, 0, 0); \
            asm volatile("" : "+v"(acc[g])); }     \
        if (i == 0) { _Pragma("unroll") for (int g = 0; g < 8; ++g) *(f32x4*)(pp + 16 * g) = acc[g] * osc; } } while (0)
    for (int vb = F.bid; vb < 256; vb += F.G) {
        const int x = vb & 7, j = vb >> 3, sl = x & 3; const int tb0 = (x >> 2) * (T / 2) + 256 * j, tbase = tb0 + 32 * F.wave; const unsigned loff = 128 * sl + 16 * c;
        v2u w0 = PU_LOADW(0), w1 = PU_LOADW(1), w2 = PU_LOADW(2), w3 = PU_LOADW(3); v4u ulA[16], ulB[16];
        __syncthreads();
        {
            const int tok = F.tid >> 1, hf = F.tid & 1; const bf16* hp = H2 + (size_t)(tb0 + tok) * DM + 256 * sl + 128 * hf;
            const float ms = SS[tb0 + tok] * (1.0f / DM) + EPS, rstd = rsqrtf(ms);
            const float sc = __builtin_bit_cast(float, (__builtin_bit_cast(unsigned, 2.0f * rstd) + 0x00400000u) & 0xFF800000u);
#pragma unroll
            for (int c4 = 0; c4 < 4; ++c4) { v4u o;
#pragma unroll
                for (int q = 0; q < 4; ++q) { const v4u a = *(const v4u*)(hp + 32 * c4 + 8 * q); unsigned pk = 0u;
                    pk = __builtin_amdgcn_cvt_scalef32_pk_fp4_f32(pk, bflo(a.x) * sc, bfhi(a.x) * sc, 1.0f, 0); pk = __builtin_amdgcn_cvt_scalef32_pk_fp4_f32(pk, bflo(a.y) * sc, bfhi(a.y) * sc, 1.0f, 1);
                    pk = __builtin_amdgcn_cvt_scalef32_pk_fp4_f32(pk, bflo(a.z) * sc, bfhi(a.z) * sc, 1.0f, 2); pk = __builtin_amdgcn_cvt_scalef32_pk_fp4_f32(pk, bflo(a.w) * sc, bfhi(a.w) * sc, 1.0f, 3); o[q] = pk; }
                *(LAS v4u*)(lB + tok * 128 + hf * 64 + c4 * 16) = o; }
            if (hf == 0) lS[tok] = rstd / sc;
        }
        PU_PUTW(0, w0); PU_ISSUE(0, ulA); w0 = PU_LOADW(4);
        __syncthreads();
        for (int tk = 0; tk < 32; tk += 4) {
            PU_PUTW(tk + 1, w1); PU_ISSUE(tk + 1, ulB); w1 = PU_LOADW(tk + 5); PU_COMPUTE(tk, ulA);
            PU_PUTW(tk + 2, w2); PU_ISSUE(tk + 2, ulA); w2 = PU_LOADW(tk + 6); PU_COMPUTE(tk + 1, ulB);
            PU_PUTW(tk + 3, w3); PU_ISSUE(tk + 3, ulB); w3 = PU_LOADW(tk + 7); PU_COMPUTE(tk + 2, ulA);
            PU_PUTW(tk + 4, w0); PU_ISSUE(tk + 4, ulA); w0 = PU_LOADW(tk + 8); PU_COMPUTE(tk + 3, ulB);
        }
    }
#undef PU_LOADW
#undef PU_PUTW
#undef PU_ISSUE
#undef PU_COMPUTE
#undef PU_V8
}
constexpr size_t WS_CGS = WS_CG + 4 * MiB;
__device__ __forceinline__ void p7z_gate(Frame& F, const Ptrs& P) {
    unsigned char* ws = P.ws; const float* PART = (const float*)(ws + WS_PART); const float* GT = (const float*)(ws + WS_EG + 8 * MiB); unsigned char* CGQ = ws + WS_CG; float* CGS = (float*)(ws + WS_CGS);
    const size_t gt = (size_t)F.bid * 512 + F.tid, NGT = (size_t)F.G * 512, n4 = (size_t)T * 128 / 4;
    for (size_t i = gt; i < n4; i += NGT) {
        f32x4 z = *(const f32x4*)(PART + i * 4);
#pragma unroll
        for (int x = 1; x < 4; ++x) z += *(const f32x4*)(PART + (size_t)x * T * 128 + i * 4);
        const f32x4 g = *(const f32x4*)(GT + i * 4); f32x4 v; float m = 1e-30f;
#pragma unroll
        for (int q = 0; q < 4; ++q) { const float zz = z[q] * (1.0f / 64.0f); v[q] = g[q] * 0.5f * zz * (1.0f + erff(zz * 0.70710678118654752f)); m = fmaxf(m, fabsf(v[q])); }
#pragma unroll
        for (int o = 1; o < 32; o <<= 1) m = fmaxf(m, __shfl_xor(m, o));
        const unsigned eb = (__builtin_bit_cast(unsigned, m) >> 23) & 0xFFu; const float sc = __builtin_bit_cast(float, (255u - eb) << 23);
        v = v * sc;
        const size_t t = i >> 5; const int ip = (int)(i & 31);
#pragma unroll
        for (int term = 0; term < 4; ++term) {
            unsigned pk = 0u; pk = __builtin_amdgcn_cvt_scalef32_pk_fp4_f32(pk, v[0], v[1], 1.0f, 0); pk = __builtin_amdgcn_cvt_scalef32_pk_fp4_f32(pk, v[2], v[3], 1.0f, 1);
            *(unsigned short*)(CGQ + t * 256 + term * 64 + 2 * ip) = (unsigned short)pk;
            const f32x2v d0 = __builtin_amdgcn_cvt_scalef32_pk_f32_fp4(pk, 1.0f, 0), d1 = __builtin_amdgcn_cvt_scalef32_pk_f32_fp4(pk, 1.0f, 1);
            v = (v - (f32x4){d0.x, d0.y, d1.x, d1.y}) * 4.0f;
        }
        if (ip == 0) CGS[t] = 1.0f / (sc * 64.0f);
    }
}
template <int MODE> __device__ __forceinline__ void p7v_accum(Frame& F, const Ptrs& P, float* dst) {
    unsigned char* ws = P.ws; const unsigned char* CGQ = ws + WS_CG; const float* CGS = (const float*)(ws + WS_CGS); const int* EXP = (const int*)(ws + WS_EG); const unsigned char* V4 = ws + WS_UV8 + 8 * MiB; const float* x1 = P.out;
    const int lane = F.lane, r = lane >> 3, c = lane & 7, i = lane & 15, kb = lane >> 4;
    LAS unsigned char* lT = F.lds + F.wave * 16384;
    LAS unsigned char* lI = F.lds + 131072 + F.wave * 2048;
    LAS float* lO = (LAS float*)(F.lds + 147456 + F.wave * 1024);
    const int wrA = r * 128 + ((c ^ r) << 4);
    const int rdb = (32 * kb + i) * 128, rdm = 2 * (i & 7) + (i >> 3);
#define PV_LOADW(tk) (*(const v2u*)(EXP + (size_t)(tbase + ((tk) < 31 ? (tk) : 31)) * 128 + 2 * lane))
#define PV_PUTW(tk, wv) do { *(LAS v2u*)(lI + ((tk) & 3) * 512 + 8 * lane) = wv; } while (0)
#define PV_ISSUE(tk, ul, av, sv, xv) do { const int t_ = tbase + ((tk) < 31 ? (tk) : 31); \
        _Pragma("unroll") for (int d_ = 0; d_ < 16; ++d_) { const unsigned ev = *(const LAS unsigned*)(lI + ((tk) & 3) * 512 + (8 * d_ + r) * 4); ul[d_] = *(const v4u*)(V4 + ((ev << 9) + loff)); } \
        av = *(const v4u*)(CGQ + (size_t)t_ * 256 + (i & 3) * 64 + kb * 16); sv = CGS[t_]; xv = *(const f32x4*)(x1 + (size_t)t_ * DM + 256 * sl + 4 * lane); } while (0)
#define PV_V8(lo) (v8i){(int)(lo).x, (int)(lo).y, (int)(lo).z, (int)(lo).w, 0, 0, 0, 0}
#define PV_COMPUTE(tk, ul, av, sv, xv) do { \
        _Pragma("unroll") for (int d_ = 0; d_ < 16; ++d_) *(LAS v4u*)(lT + d_ * 1024 + wrA) = (d_ & 1) ? (v4u){ul[d_].z, ul[d_].w, ul[d_].x, ul[d_].y} : ul[d_]; \
        const v4u am = i < 4 ? av : (v4u){0u, 0u, 0u, 0u}; const v8i a8 = PV_V8(am); \
        _Pragma("unroll") for (int n = 0; n < 16; ++n) { const LAS unsigned char* rp_ = lT + rdb + ((n ^ rdm) << 3); \
            const v2i_t lo_ = __builtin_amdgcn_ds_read_tr4_b64_v2i32((LAS v2i_t*)rp_), hi_ = __builtin_amdgcn_ds_read_tr4_b64_v2i32((LAS v2i_t*)(rp_ + 2048)); \
            const v8i b8 = {lo_.x, lo_.y, hi_.x, hi_.y, 0, 0, 0, 0}; \
            f32x4 acc = __builtin_amdgcn_mfma_scale_f32_16x16x128_f8f6f4(a8, b8, (f32x4){0.f, 0.f, 0.f, 0.f}, 4, 4, 0, 0, 0, 0); \
            asm volatile("" : "+v"(acc)); \
            const float val = (acc[0] + 0.25f * acc[1] + 0.0625f * acc[2] + 0.015625f * acc[3]) * sv; \
            if (lane < 16) lO[n * 16 + lane] = val; } \
        const f32x4 o_ = *(const LAS f32x4*)(lO + 4 * lane); \
        *(f32x4*)(dst + (size_t)(tbase + (tk)) * DM + 256 * sl + 4 * lane) = xv + o_; } while (0)
    for (int vb = F.bid; vb < 256; vb += F.G) {
        const int x = vb & 7, j = vb >> 3, sl = x & 3; const int tbase = (x >> 2) * (T / 2) + 256 * j + 32 * F.wave; const unsigned loff = 128 * sl + 16 * c;
        v2u w0 = PV_LOADW(0), w1 = PV_LOADW(1), w2 = PV_LOADW(2), w3 = PV_LOADW(3); v4u ulA[16], ulB[16], aA, aB; float sA, sB; f32x4 xA, xB;
        PV_PUTW(0, w0); PV_ISSUE(0, ulA, aA, sA, xA); w0 = PV_LOADW(4);
        for (int tk = 0; tk < 32; tk += 4) {
            PV_PUTW(tk + 1, w1); PV_ISSUE(tk + 1, ulB, aB, sB, xB); w1 = PV_LOADW(tk + 5); PV_COMPUTE(tk, ulA, aA, sA, xA);
            PV_PUTW(tk + 2, w2); PV_ISSUE(tk + 2, ulA, aA, sA, xA); w2 = PV_LOADW(tk + 6); PV_COMPUTE(tk + 1, ulB, aB, sB, xB);
            PV_PUTW(tk + 3, w3); PV_ISSUE(tk + 3, ulB, aB, sB, xB); w3 = PV_LOADW(tk + 7); PV_COMPUTE(tk + 2, ulA, aA, sA, xA);
            PV_PUTW(tk + 4, w0); PV_ISSUE(tk + 4, ulA, aA, sA, xA); w0 = PV_LOADW(tk + 8); PV_COMPUTE(tk + 3, ulB, aB, sB, xB);
        }
    }
#undef PV_LOADW
#undef PV_PUTW
#undef PV_ISSUE
#undef PV_COMPUTE
#undef PV_V8
}

struct MirrorOrder {
    pg8::StaticOrder S8;
    __device__ __forceinline__ bool next(int i, pg8::Unit& u) const { pg8::Unit v; if (!S8.next(i, v)) return false; u.pm = v.pn; u.pn = v.pm; return true; }
    __device__ __forceinline__ void a_ready(const pg8::Unit&) const {}
    __device__ __forceinline__ void done(const pg8::Unit&) const {}
};
struct Args { const float* in[14]; float* out; unsigned char* ws; int ph_lo, ph_hi; };
#ifdef PEER_BF16
constexpr int N_PHASES = 12;
#else
constexpr int N_PHASES = 14;
#endif
#ifndef MK_PER_PHASE
#define MK_PER_PHASE 0
#endif

__global__ void __launch_bounds__(NWAVES * 64, 2) hybrid_fwd(Args args) {
    extern __shared__ __attribute__((aligned(16))) unsigned char lds[];
    Frame F;
    F.lds = (LAS unsigned char*)lds; F.MISC = (volatile LAS unsigned*)(F.lds + MISC_OFF);
    F.tid = threadIdx.x; F.lane = F.tid & 63; F.wave = __builtin_amdgcn_readfirstlane(F.tid >> 6); F.G = gridDim.x; F.bid = blockIdx.x;
    F.ctl = (gu32*)(args.ws + WS_CTL);
    if (F.tid < 64) ((LAS unsigned*)(F.lds + MISC_OFF))[F.tid] = 0u;
    __syncthreads();
    XcdBarrier bar; bar.bar = (unsigned*)(F.ctl + CW_BAR); bar.x = 0; bar.st = nullptr;
    if (!MK_PER_PHASE) bar = xcd_barrier_post((unsigned*)(F.ctl + CW_BAR), F.MISC + 8);
    const int lo = args.ph_lo, hi = args.ph_hi;
#define LOADP() { int t_ = threadIdx.x; asm volatile("" : "+v"(t_)); F.tid = t_; F.lane = t_ & 63; F.wave = __builtin_amdgcn_readfirstlane(t_ >> 6); } Ptrs P; { const __attribute__((address_space(4))) Args* ap = (const __attribute__((address_space(4))) Args*)__builtin_amdgcn_kernarg_segment_ptr(); asm volatile("" : "+s"(ap)); \
    P.x = ap->in[0]; P.mix_g = ap->in[1]; P.w_in = ap->in[2]; P.ret_w = ap->in[3]; P.q_gain = ap->in[4]; P.k_gain = ap->in[5]; P.moba_w = ap->in[6]; P.rel_bias = ap->in[7]; \
    P.w_out = ap->in[8]; P.ffn_g = ap->in[9]; P.peer_wq = ap->in[10]; P.sub_keys = ap->in[11]; P.peer_u = ap->in[12]; P.peer_v = ap->in[13]; P.out = ap->out; P.ws = ap->ws; } \
    unsigned char* ws = P.ws; bf16* XN = (bf16*)P.out; bf16* RETG = (bf16*)P.out; bf16* ATT = (bf16*)((unsigned char*)P.out + 32 * MiB); (void)ws; (void)XN; (void)RETG; (void)ATT;
#ifdef RET_NAIVE
#define RET_FN p3a_retention
#else
#define RET_FN p3a_retention_mfma
#endif
#ifdef MOBA_NAIVE
#define MOBA_FN p3b_moba
#else
#define MOBA_FN p3b_moba_mfma<0>
#endif
#ifndef DUP_MASK
#define DUP_MASK 0
#endif
#ifndef DUPPH
#define DUPPH 0
#endif
#define REPS(k) ((((DUPPH) >> (k)) & 1) ? 2 : 1)
#ifndef PH_MASK
#define PH_MASK 0xFFFF
#endif
#define IN(k) (((PH_MASK >> (k)) & 1) && lo <= (k) && (k) < hi)
#define LOCAL_SEAM(k) do { if (MK_PER_PHASE) {} } while (0)
#define SEAM(k) do { if (IN(k) && IN((k) + 1)) xcd_barrier(bar); } while (0)
    LAS unsigned char* ring = F.lds;

    if (IN(0)) for (int rep_ = 0; rep_ < REPS(0); ++rep_) { LOADP(); p0_prologue(F, P); } SEAM(0);
    if (IN(1)) for (int rep_ = 0; rep_ < REPS(1); ++rep_) { LOADP();
        pg8::Gemm g{XN, (const bf16*)(ws + WS_WIN), T, INW, DM, DM, DM, 0}; pg8::StaticOrder S; S.init(T, INW, F.G, F.bid);
        EpiInProj E{(bf16*)(ws + WS_RQ), (bf16*)(ws + WS_RK), (bf16*)(ws + WS_RV), (bf16*)(ws + WS_RG), (bf16*)(ws + WS_MQ), (bf16*)(ws + WS_MK), (bf16*)(ws + WS_MV), (bf16*)(ws + WS_GA), (bf16*)(ws + WS_GB),
                    (const float*)(ws + WS_ROPE), P.q_gain, P.k_gain, (float*)(ws + WS_KM)};
        pg8::gemm_phase<EpiInProj, pg8::StaticOrder, true, true>(ring, g, S, E);
        { const int nunit = (T / 256) * (INW / 256), rem = nunit % F.G;
          if (rem == 0) p0b_late_weights(F, P, F.bid, F.G); else if (F.bid >= rem) p0b_late_weights(F, P, F.bid - rem, F.G - rem); }
    } SEAM(1);
#ifdef EXTRA_BARS
    for (int xb_ = 0; xb_ < EXTRA_BARS; ++xb_) xcd_barrier(bar);
#endif
    if (IN(2)) for (int rep_ = 0; rep_ < REPS(2); ++rep_) { LOADP(); p2a_kv_mfma(F, P); } SEAM(2);
    if (IN(3)) for (int rep_ = 0; rep_ < REPS(3); ++rep_) { LOADP(); p2b_scan(F, P); } SEAM(3);
    if (IN(4)) for (int rep_ = 0; rep_ < REPS(4); ++rep_) { LOADP(); RET_FN(F, P); if (DUP_MASK & 1) RET_FN(F, P); MOBA_FN(F, P); if (DUP_MASK & 2) MOBA_FN(F, P);
#ifdef MOBA_ABL
        p3b_moba_mfma<MOBA_ABL>(F, P);
#endif
    } SEAM(4);
    if (IN(5)) for (int rep_ = 0; rep_ < REPS(5); ++rep_) { LOADP();
        pg8::Gemm g0{ATT, (const bf16*)(ws + WS_WB), T, DM, 512, 512, 512, 0}, g1{RETG, (const bf16*)(ws + WS_WA), T, DM, DM, DM, DM, 0};
        TwoSegOrder S; S.B.init(T, DM, F.G, F.bid);
        EpiMerge2 E{(bf16*)(ws + WS_MRG), (const bf16*)(ws + WS_GA), (const bf16*)(ws + WS_GB)};
        pg8::gemm_phase2<EpiMerge2, TwoSegOrder, true, true>(ring, g0, g1, S, E);
    } SEAM(5);
    if (IN(6)) for (int rep_ = 0; rep_ < REPS(6); ++rep_) { LOADP();
        pg8::Gemm g{(const bf16*)(ws + WS_MRG), (const bf16*)(ws + WS_WO), T, DM, DM, DM, DM, 0}; pg8::StaticOrder S; S.init(T, DM, F.G, F.bid);
        EpiResid E{P.x, P.out, (bf16*)(ws + WS_H2), P.ffn_g, (float*)(ws + WS_SUMSQ)};
        pg8::gemm_phase<EpiResid, pg8::StaticOrder, true, true>(ring, g, S, E);
    } SEAM(6);
    if (IN(9)) for (int rep_ = 0; rep_ < REPS(9); ++rep_) { LOADP();
        pg8::Gemm g{(const bf16*)(ws + WS_WQ), (const bf16*)(ws + WS_H2), PH * 256, T, DM, DM, DM, 0}; MirrorOrder S; S.S8.init(T, 2048, F.G, F.bid);
        EpiNatBf16 E{(bf16*)(ws + WS_ST), T, (const float*)(ws + WS_SUMSQ)};
        pg8::gemm_phase<EpiNatBf16, MirrorOrder, true, true>(ring, g, S, E);
        VM_WAIT(); __syncthreads();
    } LOCAL_SEAM(9);
    if (IN(10)) for (int rep_ = 0; rep_ < REPS(10); ++rep_) { LOADP(); p6_topk(F, P); } SEAM(10);
#ifdef PEER_BF16
    if (IN(11)) for (int rep_ = 0; rep_ < REPS(11); ++rep_) { LOADP(); if (DUP_MASK & 4) p7_peer(F, P, (float*)(ws + WS_ST)); p7_peer(F, P, P.out); }
#else
    if (IN(11)) for (int rep_ = 0; rep_ < REPS(11); ++rep_) { LOADP(); p7u_dots<0>(F, P); if (DUP_MASK & 4) p7u_dots<2>(F, P); } SEAM(11);
    if (IN(12)) for (int rep_ = 0; rep_ < REPS(12); ++rep_) { LOADP(); p7z_gate(F, P); } SEAM(12);
    if (IN(13)) for (int rep_ = 0; rep_ < REPS(13); ++rep_) { LOADP(); if (DUP_MASK & 16) p7v_accum<0>(F, P, (float*)(ws + WS_PART)); p7v_accum<0>(F, P, P.out); }
#endif
#undef IN
#undef SEAM
}

extern "C" void kernel_launch(void* const* d_in, const int* in_sizes, int n_in, void* d_out, int out_size, void* d_ws, size_t ws_size, hipStream_t stream) {
    static int grid = 0;
    if (grid == 0) {
        if (n_in != 14 || out_size != T * DM || ws_size < WS_END) { fprintf(stderr, "kernel_launch: unexpected problem (n_in %d, out %d, ws %zu); nothing launched\n", n_in, out_size, ws_size); grid = -1; return; }
        int dev = 0, cus = 0, per_cu = 0;
        if (hipGetDevice(&dev) != hipSuccess || hipDeviceGetAttribute(&cus, hipDeviceAttributeMultiprocessorCount, dev) != hipSuccess) { grid = -1; return; }
        if (hipFuncSetAttribute((const void*)hybrid_fwd, hipFuncAttributeMaxDynamicSharedMemorySize, LDS_BYTES) != hipSuccess) { fprintf(stderr, "kernel_launch: hipFuncSetAttribute failed\n"); grid = -1; return; }
        if (hipOccupancyMaxActiveBlocksPerMultiprocessor(&per_cu, (const void*)hybrid_fwd, NWAVES * 64, LDS_BYTES) != hipSuccess || per_cu < 1)
            fprintf(stderr, "kernel_launch: note: occupancy query reports %d workgroups per CU\n", per_cu);
        (void)hipGetLastError();
        grid = cus;
    }
    if (grid < 0) return;
    (void)hipMemsetAsync((char*)d_ws + WS_CTL, 0, CTL_ZERO_BYTES, stream);
    Args a{};
    for (int i = 0; i < 14; ++i) a.in[i] = (const float*)d_in[i];
    a.out = (float*)d_out; a.ws = (unsigned char*)d_ws;
#if MK_PER_PHASE
    for (int p = 0; p < N_PHASES; ++p) { a.ph_lo = p; a.ph_hi = p + 1; hipLaunchKernelGGL(hybrid_fwd, dim3(grid), dim3(NWAVES * 64), LDS_BYTES, stream, a); }
#else
    a.ph_lo = 0; a.ph_hi = N_PHASES;
    hipLaunchKernelGGL(hybrid_fwd, dim3(grid), dim3(NWAVES * 64), LDS_BYTES, stream, a);
#endif
}
```
